# Optimizing an MI355X kernel written in HIP

```python
import jax
import jax.numpy as jnp
from jax import lax
import numpy as np

D_MODEL = 1024
BATCH = 8
SEQ = 4096
DEPTH = 4

GRID_W = 64
CTX_LEN = 256
ATT_HEADS = 8
ATT_KV_HEADS = 2
ATT_HEAD_DIM = 64
ATT_GROUP = ATT_HEADS // ATT_KV_HEADS
WINDOW = 128
ATT_BLOCK = 128
ATT_SPAN = ATT_BLOCK + 2 * WINDOW
ROPE_THETA = 10000.0
ML_HEADS = 4
ML_QK_DIM = 64
ML_V_DIM = 128
ML_CHUNK = 64
ML_CONV = 5
GATE_CAP = 15.0
ATT_WIDTH = ATT_HEADS * ATT_HEAD_DIM
ATT_KV_WIDTH = ATT_KV_HEADS * ATT_HEAD_DIM
ML_QK_WIDTH = ML_HEADS * ML_QK_DIM
ML_WIDTH = ML_HEADS * ML_V_DIM
ML_GATES = 4 * ML_HEADS
MIX_WIDTH = ATT_WIDTH + ML_WIDTH
SPLIT_SIZES = (ATT_WIDTH, ATT_KV_WIDTH, ATT_KV_WIDTH, ML_QK_WIDTH, ML_QK_WIDTH, ML_WIDTH, ML_WIDTH, ML_GATES)
IN_WIDTH = ATT_WIDTH + 2 * ATT_KV_WIDTH + 2 * ML_QK_WIDTH + 2 * ML_WIDTH + ML_GATES
FFN_DIM = 2816
N_EXPERTS = 8
TOP_K = 2
EPS = 1e-6

kernel_name = 'hybrid_swa_mlstm_moe_diffusion'


def rmsnorm(x, g):
    xf = x.astype(jnp.float32)
    y = xf * lax.rsqrt(jnp.mean(xf * xf, axis=-1, keepdims=True) + EPS)
    return (y * g.astype(jnp.float32)).astype(x.dtype)


def adaln(x, g, shift, scale):
    return rmsnorm(x, g) * (1 + scale) + shift


def split_columns(u):
    points = [int(p) for p in np.cumsum(SPLIT_SIZES)[:-1]]
    return jnp.split(u, points, axis=-1)


def axial_rope_tables(n_tokens):
    rows = n_tokens // GRID_W
    t = jnp.arange(rows * GRID_W)
    row = jnp.repeat(jnp.arange(rows), GRID_W).astype(jnp.float32)
    col = (t % GRID_W).astype(jnp.float32)
    quarter = ATT_HEAD_DIM // 4
    inv = ROPE_THETA ** (-jnp.arange(quarter, dtype=jnp.float32) / quarter)
    ang_r = row[:, None] * inv[None, :]
    ang_c = col[:, None] * inv[None, :]
    return (jnp.cos(ang_r), jnp.sin(ang_r), jnp.cos(ang_c), jnp.sin(ang_c))


def _rotate_half(x, cos, sin):
    x1, x2 = jnp.split(x, 2, axis=-1)
    return jnp.concatenate([x1 * cos - x2 * sin, x2 * cos + x1 * sin], axis=-1)


def apply_axial_rope(x, tabs):
    cos_r, sin_r, cos_c, sin_c = [t[:, None, :] for t in tabs]
    xf = x.astype(jnp.float32)
    half = x.shape[-1] // 2
    out = jnp.concatenate([_rotate_half(xf[..., :half], cos_r, sin_r),
                           _rotate_half(xf[..., half:], cos_c, sin_c)], axis=-1)
    return out.astype(x.dtype)


def sink_attention(qg, kv_sets, sink_g):
    sink = sink_g[None, :, :, None]
    m = sink
    scores = []
    for k, v, mask in kv_sets:
        s = jnp.einsum('bqhgd,bkhd->bhgqk', qg, k).astype(jnp.float32)
        if mask is not None:
            s = jnp.where(mask, s, -jnp.inf)
        scores.append(s)
        m = jnp.maximum(m, s.max(-1))
    denom = jnp.exp(sink - m)
    num = None
    for s, (k, v, mask) in zip(scores, kv_sets):
        p = jnp.exp(s - m[..., None])
        denom = denom + p.sum(-1)
        o = jnp.einsum('bhgqk,bkhd->bhgqd', p, v.astype(jnp.float32))
        num = o if num is None else num + o
    out = num / denom[..., None]
    return jnp.transpose(out, (0, 3, 1, 2, 4))


def window_attention(q, k, v, k_ctx, v_ctx, sink_g):
    B, S = q.shape[:2]
    nb = S // ATT_BLOCK
    qg = (q * (ATT_HEAD_DIM ** -0.5)).reshape(B, nb, ATT_BLOCK, ATT_KV_HEADS, ATT_GROUP, ATT_HEAD_DIM)
    pad = ((0, 0), (WINDOW, WINDOW), (0, 0), (0, 0))
    kp = jnp.pad(k, pad)
    vp = jnp.pad(v, pad)
    valid = jnp.pad(jnp.ones((S,), dtype=bool), (WINDOW, WINDOW))
    rel = jnp.abs(jnp.arange(ATT_BLOCK)[:, None] + WINDOW - jnp.arange(ATT_SPAN)[None, :]) <= WINDOW

    def block(j):
        start = j * ATT_BLOCK
        qb = lax.dynamic_index_in_dim(qg, j, axis=1, keepdims=False)
        kb = lax.dynamic_slice_in_dim(kp, start, ATT_SPAN, axis=1)
        vb = lax.dynamic_slice_in_dim(vp, start, ATT_SPAN, axis=1)
        mask = rel & lax.dynamic_slice_in_dim(valid, start, ATT_SPAN)[None, :]
        out = sink_attention(qb, ((kb, vb, mask), (k_ctx, v_ctx, None)), sink_g)
        return out.reshape(B, ATT_BLOCK, ATT_WIDTH).astype(q.dtype)

    outs = lax.map(block, jnp.arange(nb))
    return jnp.moveaxis(outs, 0, 1).reshape(B, S, ATT_WIDTH)


def mlstm_chunkwise(q, k, v, i_pre, f_pre, state):
    B, T, H, DK = q.shape
    DV = v.shape[-1]
    nc = T // ML_CHUNK
    f32 = jnp.float32

    def chunks(a):
        return jnp.moveaxis(a.reshape((B, nc, ML_CHUNK) + a.shape[2:]), 1, 0)

    qs = chunks(q.astype(f32) * (DK ** -0.5))
    ks = chunks(k.astype(f32))
    vs = chunks(v.astype(f32))
    lis = chunks(i_pre.astype(f32))
    lfs = chunks(jax.nn.log_sigmoid(f_pre.astype(f32)))
    causal = jnp.tril(jnp.ones((ML_CHUNK, ML_CHUNK), dtype=bool))

    def step(carry, inp):
        C, n, m = carry
        qc, kc, vc, li, lf = inp
        b = jnp.cumsum(lf, axis=1).transpose(0, 2, 1)
        ig = li.transpose(0, 2, 1)
        d = jnp.where(causal, b[..., :, None] - b[..., None, :] + ig[..., None, :], -jnp.inf)
        inter = b + m[..., None]
        m_t = jnp.maximum(inter, d.max(-1))
        w_inter = jnp.exp(inter - m_t)
        s = jnp.einsum('bthd,bshd->bhts', qc, kc) * jnp.exp(d - m_t[..., None])
        num = jnp.einsum('bhts,bshe->bhte', s, vc) + w_inter[..., None] * jnp.einsum('bthd,bhde->bhte', qc, C)
        den = s.sum(-1) + w_inter * jnp.einsum('bthd,bhd->bht', qc, n)
        h = num / jnp.maximum(jnp.abs(den), jnp.exp(-m_t))[..., None]
        b_end = b[..., -1]
        g = b_end[..., None] - b + ig
        m_new = jnp.maximum(b_end + m, g.max(-1))
        decay = jnp.exp(b_end + m - m_new)
        wk = jnp.exp(g - m_new[..., None])
        C_new = decay[..., None, None] * C + jnp.einsum('bhs,bshd,bshe->bhde', wk, kc, vc)
        n_new = decay[..., None] * n + jnp.einsum('bhs,bshd->bhd', wk, kc)
        return (C_new, n_new, m_new), h.transpose(0, 2, 1, 3)

    state, hs = lax.scan(step, state, (qs, ks, vs, lis, lfs))
    h = jnp.moveaxis(hs, 0, 1).reshape(B, T, H, DV)
    return h, state


def depthwise_conv(x, w, b):
    C = x.shape[-1]
    y = lax.conv_general_dilated(x, w.reshape(ML_CONV, 1, C).astype(x.dtype), (1,),
                                 [(ML_CONV // 2, ML_CONV // 2)],
                                 dimension_numbers=('NWC', 'WIO', 'NWC'), feature_group_count=C)
    return y + b


def mlstm_inputs(qm, km, vm, gt, conv_w, conv_b, b_gates):
    B, T, _ = qm.shape
    qk = jax.nn.silu(depthwise_conv(jnp.concatenate([qm, km], axis=-1), conv_w, conv_b))
    q, k = jnp.split(qk, 2, axis=-1)
    q = q.reshape(B, T, ML_HEADS, ML_QK_DIM)
    k = k.reshape(B, T, ML_HEADS, ML_QK_DIM)
    v = vm.reshape(B, T, ML_HEADS, ML_V_DIM)
    g = gt.astype(jnp.float32) + b_gates.astype(jnp.float32)
    g = (GATE_CAP * jnp.tanh(g / GATE_CAP)).reshape(B, T, 4, ML_HEADS)
    return q, k, v, g[:, :, 0], g[:, :, 1], g[:, :, 2], g[:, :, 3]


def init_state(B):
    f32 = jnp.float32
    return (jnp.zeros((B, ML_HEADS, ML_QK_DIM, ML_V_DIM), f32),
            jnp.zeros((B, ML_HEADS, ML_QK_DIM), f32),
            jnp.zeros((B, ML_HEADS), f32))


def merge_groups(att, h_ml, o_pre, g_att, g_ml, w_out):
    B, T = att.shape[:2]
    att_n = rmsnorm(att, g_att)
    hf = h_ml.astype(jnp.float32)
    hn = hf * lax.rsqrt(jnp.mean(hf * hf, axis=-1, keepdims=True) + EPS)
    hn = hn * g_ml.astype(jnp.float32).reshape(ML_HEADS, ML_V_DIM)
    ml = hn.reshape(B, T, ML_WIDTH).astype(att.dtype) * jax.nn.sigmoid(o_pre)
    return jnp.concatenate([att_n, ml], axis=-1) @ w_out


def token_mixing(hx, hc, w_in, conv_w, conv_b, b_gates, attn_sink, g_att, g_ml, w_out, rope, with_ctx_out):
    B, S, _ = hx.shape
    L = hc.shape[1]
    qa_x, ka_x, va_x, qm_x, km_x, vm_x, om_x, gt_x = split_columns(hx @ w_in)
    qa_c, ka_c, va_c, qm_c, km_c, vm_c, om_c, gt_c = split_columns(hc @ w_in)
    sink_g = attn_sink.astype(jnp.float32).reshape(ATT_KV_HEADS, ATT_GROUP)
    k_ctx = ka_c.reshape(B, L, ATT_KV_HEADS, ATT_HEAD_DIM)
    v_ctx = va_c.reshape(B, L, ATT_KV_HEADS, ATT_HEAD_DIM)
    q = apply_axial_rope(qa_x.reshape(B, S, ATT_HEADS, ATT_HEAD_DIM), rope)
    k = apply_axial_rope(ka_x.reshape(B, S, ATT_KV_HEADS, ATT_HEAD_DIM), rope)
    v = va_x.reshape(B, S, ATT_KV_HEADS, ATT_HEAD_DIM)
    att_x = window_attention(q, k, v, k_ctx, v_ctx, sink_g)
    qc_, kc_, vc_, icf, fcf, icb, fcb = mlstm_inputs(qm_c, km_c, vm_c, gt_c, conv_w, conv_b, b_gates)
    qx_, kx_, vx_, ixf, fxf, ixb, fxb = mlstm_inputs(qm_x, km_x, vm_x, gt_x, conv_w, conv_b, b_gates)
    flip = lambda a: jnp.flip(a, axis=1)
    h_cf, st_f = mlstm_chunkwise(qc_, kc_, vc_, icf, fcf, init_state(B))
    h_cb, st_b = mlstm_chunkwise(flip(qc_), flip(kc_), flip(vc_), flip(icb), flip(fcb), init_state(B))
    h_xf, _ = mlstm_chunkwise(qx_, kx_, vx_, ixf, fxf, st_f)
    h_xb, _ = mlstm_chunkwise(flip(qx_), flip(kx_), flip(vx_), flip(ixb), flip(fxb), st_b)
    out_x = merge_groups(att_x, h_xf + flip(h_xb), om_x, g_att, g_ml, w_out)
    if not with_ctx_out:
        return out_x, None
    qg_c = (qa_c * (ATT_HEAD_DIM ** -0.5)).reshape(B, L, ATT_KV_HEADS, ATT_GROUP, ATT_HEAD_DIM)
    att_c = sink_attention(qg_c, ((k_ctx, v_ctx, None),), sink_g).reshape(B, L, ATT_WIDTH).astype(hc.dtype)
    out_c = merge_groups(att_c, h_cf + flip(h_cb), om_c, g_att, g_ml, w_out)
    return out_x, out_c


def swiglu(t, w1, w3, w2):
    return (jax.nn.silu(t @ w1) * (t @ w3)) @ w2


def moe_swiglu(h, w_router, b_router, w1, w3, w2):
    shp = h.shape
    t = h.reshape(-1, shp[-1])
    logits = (t @ w_router).astype(jnp.float32) + b_router.astype(jnp.float32)
    top_v, top_i = lax.top_k(logits, TOP_K)
    top_w = jax.nn.softmax(top_v, axis=-1)
    combine = jnp.sum(jax.nn.one_hot(top_i, N_EXPERTS, dtype=jnp.float32) * top_w[..., None], axis=1)
    y = None
    for e in range(N_EXPERTS):
        ye = combine[:, e:e + 1] * swiglu(t, w1[e], w3[e], w2[e]).astype(jnp.float32)
        y = ye if y is None else y + ye
    return y.astype(h.dtype).reshape(shp)


def channel_mix(h, layer, ffn_w1, ffn_w3, ffn_w2, w_router, b_router, exp_w1, exp_w3, exp_w2):
    i = layer // 2
    if layer % 2 == 0:
        return swiglu(h, ffn_w1[i], ffn_w3[i], ffn_w2[i])
    return moe_swiglu(h, w_router[i], b_router[i], exp_w1[i], exp_w3[i], exp_w2[i])


def setup_inputs(seed: int = 0) -> dict:
    key = jax.random.key(seed)
    ks = jax.random.split(key, 26)
    D = D_MODEL
    n_dense = (DEPTH + 1) // 2
    n_moe = DEPTH // 2

    def nrm(i, shape, scale):
        return jax.random.normal(ks[i], shape, jnp.float32) * scale

    i_bias = -2.0 + nrm(11, (DEPTH, 2, ML_HEADS), 0.1)
    f_bias = 4.0 + nrm(12, (DEPTH, 2, ML_HEADS), 0.5)
    b_gates = jnp.stack([i_bias[:, 0], f_bias[:, 0], i_bias[:, 1], f_bias[:, 1]], axis=1).reshape(DEPTH, ML_GATES)
    return {
        'x': nrm(0, (BATCH, SEQ, D), 1.0),
        'c': nrm(1, (BATCH, D), 1.0),
        'ctx': nrm(2, (BATCH, CTX_LEN, D), 1.0),
        'c_ctx': nrm(3, (D,), 1.0),
        'norm1_g': 1.0 + nrm(4, (DEPTH, D), 0.02),
        'norm2_g': 1.0 + nrm(5, (DEPTH, D), 0.02),
        'w_mod': nrm(6, (DEPTH, D, 6 * D), 0.5 * D ** -0.5),
        'b_mod': nrm(7, (DEPTH, 6 * D), 0.02),
        'w_in': nrm(8, (DEPTH, D, IN_WIDTH), D ** -0.5),
        'conv_w': nrm(9, (DEPTH, ML_CONV, 2 * ML_QK_WIDTH), ML_CONV ** -0.5),
        'conv_b': nrm(10, (DEPTH, 2 * ML_QK_WIDTH), 0.02),
        'b_gates': b_gates,
        'attn_sink': nrm(13, (DEPTH, ATT_HEADS), 0.5),
        'g_att': 1.0 + nrm(14, (DEPTH, ATT_WIDTH), 0.02),
        'g_ml': 1.0 + nrm(15, (DEPTH, ML_WIDTH), 0.02),
        'w_out': nrm(16, (DEPTH, MIX_WIDTH, D), MIX_WIDTH ** -0.5),
        'ffn_w1': nrm(17, (n_dense, D, FFN_DIM), D ** -0.5),
        'ffn_w3': nrm(18, (n_dense, D, FFN_DIM), D ** -0.5),
        'ffn_w2': nrm(19, (n_dense, FFN_DIM, D), FFN_DIM ** -0.5),
        'w_router': nrm(20, (n_moe, D, N_EXPERTS), D ** -0.5),
        'b_router': nrm(21, (n_moe, N_EXPERTS), 0.01),
        'exp_w1': nrm(22, (n_moe, N_EXPERTS, D, FFN_DIM), D ** -0.5),
        'exp_w3': nrm(23, (n_moe, N_EXPERTS, D, FFN_DIM), D ** -0.5),
        'exp_w2': nrm(24, (n_moe, N_EXPERTS, FFN_DIM, D), FFN_DIM ** -0.5),
        'final_g': 1.0 + nrm(25, (D,), 0.02),
    }


def reference(x, c, ctx, c_ctx, norm1_g, norm2_g, w_mod, b_mod, w_in, conv_w, conv_b, b_gates,
              attn_sink, g_att, g_ml, w_out, ffn_w1, ffn_w3, ffn_w2, w_router, b_router,
              exp_w1, exp_w3, exp_w2, final_g):
    rope = axial_rope_tables(x.shape[1])
    cond_x = jax.nn.silu(c)
    cond_c = jax.nn.silu(c_ctx)[None]
    for layer in range(DEPTH):
        last = layer == DEPTH - 1
        mod_x = jnp.split((cond_x @ w_mod[layer] + b_mod[layer])[:, None, :], 6, axis=-1)
        mod_c = jnp.split((cond_c @ w_mod[layer] + b_mod[layer])[:, None, :], 6, axis=-1)
        hx = adaln(x, norm1_g[layer], mod_x[0], mod_x[1])
        hc = adaln(ctx, norm1_g[layer], mod_c[0], mod_c[1])
        mix_x, mix_c = token_mixing(hx, hc, w_in[layer], conv_w[layer], conv_b[layer], b_gates[layer],
                                    attn_sink[layer], g_att[layer], g_ml[layer], w_out[layer], rope,
                                    not last)
        x = x + mod_x[2] * mix_x
        hx = adaln(x, norm2_g[layer], mod_x[3], mod_x[4])
        x = x + mod_x[5] * channel_mix(hx, layer, ffn_w1, ffn_w3, ffn_w2, w_router, b_router,
                                       exp_w1, exp_w3, exp_w2)
        if not last:
            ctx = ctx + mod_c[2] * mix_c
            hc = adaln(ctx, norm2_g[layer], mod_c[3], mod_c[4])
            ctx = ctx + mod_c[5] * channel_mix(hc, layer, ffn_w1, ffn_w3, ffn_w2, w_router, b_router,
                                               exp_w1, exp_w3, exp_w2)
    return rmsnorm(x, final_g)
```

```cpp
#include <hip/hip_runtime.h>
#include <cstdio>
#include <cstdint>

#ifndef MEGA
#define MEGA 1
#endif
typedef unsigned short bf16;
typedef unsigned v4u __attribute__((ext_vector_type(4)));
typedef unsigned v2u __attribute__((ext_vector_type(2)));
typedef float f32x4 __attribute__((ext_vector_type(4)));

constexpr int D = 1024, NB = 8, SEQ = 4096, CTX = 256, TPB = SEQ + CTX, T_ALL = NB * TPB, DEPTH = 4;
constexpr int INW = 2320, UW = 2304, FFN = 2816, NE = 8;
constexpr int U_QA = 0, U_KA = 512, U_VA = 640, U_QM = 768, U_KM = 1024, U_VM = 1280, U_OM = 1792;
constexpr int MODW = 6 * D, MODR = NB + 1;
constexpr int MOE_ROWS = 2 * T_ALL + NE * 256;
constexpr int MOE_TILES = MOE_ROWS / 256;
constexpr float EPS = 1e-6f;
constexpr int NWG = 256, NTHR = 512;
constexpr int ROWS_PER_WG = T_ALL / NWG;

constexpr size_t MiB = 1u << 20;
constexpr size_t al(size_t x) { return (x + 255) & ~(size_t)255; }
constexpr size_t WS_CTL = 0;
constexpr size_t WS_ROPE = 1 * MiB;
constexpr size_t WS_MOD = WS_ROPE + 65536;
constexpr size_t WS_TOKE = al(WS_MOD + (size_t)DEPTH * MODR * MODW * 4);
constexpr size_t WS_TOKW = al(WS_TOKE + (size_t)T_ALL * 8);
constexpr size_t WS_TOKP = al(WS_TOKW + (size_t)T_ALL * 8);
constexpr size_t WS_ROWT = al(WS_TOKP + (size_t)T_ALL * 8);
constexpr size_t WS_ROWW = al(WS_ROWT + (size_t)MOE_ROWS * 4);
constexpr size_t WS_TILEE = al(WS_ROWW + (size_t)MOE_ROWS * 4);
constexpr size_t WS_CNT = al(WS_TILEE + 4096);
constexpr size_t WS_GATES = al(WS_CNT + (size_t)NWG * 8 * 4);
constexpr size_t WS_WIN = al(WS_GATES + (size_t)T_ALL * 16 * 4);
constexpr size_t WS_WOUT = al(WS_WIN + (size_t)DEPTH * UW * D * 2);
constexpr size_t WS_WF13 = al(WS_WOUT + (size_t)DEPTH * D * D * 2);
constexpr size_t WS_WF2 = al(WS_WF13 + (size_t)2 * 2 * FFN * D * 2);
constexpr size_t WS_WE2 = al(WS_WF2 + (size_t)2 * D * FFN * 2);
constexpr size_t WS_WE13 = al(WS_WE2 + (size_t)NE * D * FFN * 2);
constexpr size_t WS_YS = WS_WE13;
constexpr size_t WS_HX = al(WS_YS + (size_t)MOE_ROWS * D * 2);
constexpr size_t WS_X = al(WS_HX + (size_t)T_ALL * D * 2);
constexpr size_t WS_BIG = al(WS_X + (size_t)T_ALL * D * 4);
static_assert(WS_YS + (size_t)MOE_ROWS * D * 2 <= WS_HX && WS_WE13 + (size_t)NE * 2 * FFN * D * 2 <= WS_HX, "YS overlay");
constexpr size_t WS_U = WS_BIG;
constexpr size_t WS_MIX = al(WS_U + (size_t)T_ALL * UW * 2);
constexpr size_t WS_HDIR = al(WS_MIX + (size_t)T_ALL * D * 2);
constexpr int NCHUNK = TPB / 64, NCHAIN = NB * 4 * 2;
constexpr size_t WS_ST = WS_HDIR;
constexpr size_t WS_NL = al(WS_ST + (size_t)NCHAIN * NCHUNK * 16384);
constexpr size_t WS_SC = al(WS_NL + (size_t)NCHAIN * NCHUNK * 64 * 4);
constexpr size_t WS_HID = WS_BIG;
constexpr size_t WS_END = al(WS_BIG + (size_t)MOE_ROWS * FFN * 2);
static_assert(WS_HDIR + (size_t)2 * T_ALL * 512 * 4 <= WS_END && WS_SC + (size_t)NCHAIN * NCHUNK * 16 <= WS_END, "HDIR / state buffers fit");

struct P {
    const float *x, *c, *ctx, *c_ctx, *norm1_g, *norm2_g, *w_mod, *b_mod, *w_in, *conv_w, *conv_b, *b_gates, *attn_sink, *g_att, *g_ml, *w_out,
        *ffn_w1, *ffn_w3, *ffn_w2, *w_router, *b_router, *exp_w1, *exp_w3, *exp_w2, *final_g;
    float* out;
    unsigned char* ws;
    int wv, pad;
};

__device__ __forceinline__ unsigned f2bf(float f) { unsigned u = __builtin_bit_cast(unsigned, f); return (u + 0x7fffu + ((u >> 16) & 1u)) >> 16; }
__device__ __forceinline__ unsigned pk2(float lo, float hi) { return f2bf(lo) | (f2bf(hi) << 16); }
__device__ __forceinline__ float bf_lo(unsigned w) { return __builtin_bit_cast(float, w << 16); }
__device__ __forceinline__ float bf_hi(unsigned w) { return __builtin_bit_cast(float, w & 0xffff0000u); }
__device__ __forceinline__ float bf2f(bf16 h) { return __builtin_bit_cast(float, (unsigned)h << 16); }
#ifndef XLANE_OLD
#define XLANE_OLD 0
#endif
#if XLANE_OLD
template <int M> __device__ __forceinline__ float swz_xor(float v) { return __shfl_xor(v, M); }
__device__ __forceinline__ float hsum32(float v) { return v + __shfl_xor(v, 32); }
__device__ __forceinline__ float hmax32(float v) { return fmaxf(v, __shfl_xor(v, 32)); }
__device__ __forceinline__ float wave_sum(float v) {
#pragma unroll
    for (int o = 1; o < 64; o <<= 1) v += __shfl_xor(v, o);
    return v;
}
__device__ __forceinline__ float wave_max(float v) {
#pragma unroll
    for (int o = 1; o < 64; o <<= 1) v = fmaxf(v, __shfl_xor(v, o));
    return v;
}
__device__ __forceinline__ float lane_bcast(float v, int src) { return __shfl(v, src); }
template <int OFF> __device__ __forceinline__ float xchg_xor(float v, bool) { return __shfl_xor(v, OFF); }
template <bool MAXOP> __device__ __forceinline__ float dpp_scan(float v) {
    const int lane = (int)__builtin_amdgcn_mbcnt_hi(~0u, __builtin_amdgcn_mbcnt_lo(~0u, 0u));
#pragma unroll
    for (int o = 1; o < 64; o <<= 1) { const float y = __shfl_up(v, o); if (lane >= o) v = MAXOP ? fmaxf(v, y) : v + y; }
    return v;
}
#else
template <int M> __device__ __forceinline__ float swz_xor(float v) { return __builtin_bit_cast(float, __builtin_amdgcn_ds_swizzle(__builtin_bit_cast(int, v), 0x1f | (M << 10))); }
struct HalfSwap { float a, b; };
__device__ __forceinline__ HalfSwap half_swap(float v) {
    float x = v, y = v;
    asm volatile("s_nop 1\n\tv_permlane32_swap_b32 %0, %1\n\ts_nop 0" : "+v"(x), "+v"(y));
    return HalfSwap{x, y};
}
__device__ __forceinline__ float hsum32(float v) { const HalfSwap r = half_swap(v); return r.a + r.b; }
__device__ __forceinline__ float hmax32(float v) { const HalfSwap r = half_swap(v); return fmaxf(r.a, r.b); }
__device__ __forceinline__ float wave_sum(float v) { v += swz_xor<1>(v); v += swz_xor<2>(v); v += swz_xor<4>(v); v += swz_xor<8>(v); v += swz_xor<16>(v); return hsum32(v); }
__device__ __forceinline__ float wave_max(float v) { v = fmaxf(v, swz_xor<1>(v)); v = fmaxf(v, swz_xor<2>(v)); v = fmaxf(v, swz_xor<4>(v)); v = fmaxf(v, swz_xor<8>(v)); v = fmaxf(v, swz_xor<16>(v)); return hmax32(v); }
__device__ __forceinline__ float lane_bcast(float v, int src) { return __builtin_bit_cast(float, __builtin_amdgcn_readlane(__builtin_bit_cast(int, v), src)); }
template <int OFF> __device__ __forceinline__ float xchg_xor(float v, bool up) {
    if constexpr (OFF == 32) { const HalfSwap r = half_swap(v); return up ? r.a : r.b; }
    else return swz_xor<OFF>(v);
}
#define DPP_STEP(ctrl, rm) { const float t_ = __builtin_bit_cast(float, __builtin_amdgcn_update_dpp(__builtin_bit_cast(int, idv), __builtin_bit_cast(int, v), ctrl, rm, 0xf, false)); v = MAXOP ? fmaxf(v, t_) : v + t_; }
template <bool MAXOP> __device__ __forceinline__ float dpp_scan(float v) {
    const float idv = MAXOP ? -3.0e38f : 0.f;
    DPP_STEP(0x111, 0xf) DPP_STEP(0x112, 0xf) DPP_STEP(0x114, 0xf) DPP_STEP(0x118, 0xf) DPP_STEP(0x142, 0xa) DPP_STEP(0x143, 0xc)
    return v;
}
#endif
template <int N, int OFF> struct RS { static __device__ __forceinline__ float run(float (&v)[N], int lane) {
    constexpr int H = N / 2; float w[H]; const bool up = (lane & OFF) != 0;
#pragma unroll
    for (int i = 0; i < H; ++i) { const float keep = up ? v[i + H] : v[i], send = up ? v[i] : v[i + H]; w[i] = keep + xchg_xor<OFF>(send, up); }
    return RS<H, OFF / 2>::run(w, lane); } };
template <int OFF> struct RS<1, OFF> { static __device__ __forceinline__ float run(float (&v)[1], int lane) { float x = v[0];
    if constexpr (OFF >= 16) x += swz_xor<16>(x);
    if constexpr (OFF >= 8) x += swz_xor<8>(x);
    if constexpr (OFF >= 4) x += swz_xor<4>(x);
    if constexpr (OFF >= 2) x += swz_xor<2>(x);
    if constexpr (OFF >= 1) x += swz_xor<1>(x);
    return x; } };
__device__ __forceinline__ float silu_f(float x) { return x / (1.f + __expf(-x)); }
__device__ __forceinline__ float sigmoid_f(float x) { return 1.f / (1.f + __expf(-x)); }
__device__ __forceinline__ float logsigmoid_f(float x) { return fminf(x, 0.f) - log1pf(__expf(-fabsf(x))); }
__device__ __forceinline__ int tk_modrow(int tk) { const int b = tk / TPB, p = tk - b * TPB; return p < CTX ? NB : b; }
__device__ __forceinline__ const float* in_row(const P& a, int tk) {
    const int b = tk / TPB, p = tk - b * TPB;
    return p < CTX ? a.ctx + ((size_t)b * CTX + p) * D : a.x + ((size_t)b * SEQ + (p - CTX)) * D;
}

__device__ __forceinline__ int otid_w(int wv) { int t; asm volatile("v_mbcnt_lo_u32_b32 %0, -1, 0\n\tv_mbcnt_hi_u32_b32 %0, -1, %0\n\ts_nop 0\n\tv_lshl_add_u32 %0, %1, 6, %0" : "=&v"(t) : "s"(wv)); return t; }
#define otid() otid_w(a.wv)
#define PHASE_ENTRY(a_in) P a = a_in; { unsigned char* w_ = a.ws; asm volatile("" : "+s"(w_)); a.ws = w_; }
__device__ __forceinline__ void tr_item(const float* W, int K, int ld, int N, bf16* WT, int mode, float* scr, int item, int lane) {
    const int nblk = N / 32, kb = item / nblk, nb = item % nblk, k0 = 64 * kb, n0 = 32 * nb;
#pragma unroll 8
    for (int i = 0; i < 32; ++i) { const int kk = 2 * i + (lane >> 5); scr[kk * 33 + (lane & 31)] = W[(size_t)(k0 + kk) * ld + n0 + (lane & 31)]; }
    __builtin_amdgcn_s_waitcnt(0xC07F); asm volatile("" ::: "memory");
    const int c = lane & 7;
    const int d0 = mode == 0 ? n0 : ((n0 >> 7) * 256 + (mode == 2 ? 128 : 0) + (n0 & 127));
#pragma unroll
    for (int j = 0; j < 4; ++j) { const int n = (lane >> 3) + 8 * j; const float* s = scr + (8 * c) * 33 + n;
        v4u o; o.x = pk2(s[0 * 33], s[1 * 33]); o.y = pk2(s[2 * 33], s[3 * 33]); o.z = pk2(s[4 * 33], s[5 * 33]); o.w = pk2(s[6 * 33], s[7 * 33]);
        *(v4u*)(WT + (size_t)(d0 + n) * K + k0 + 8 * c) = o; }
    __builtin_amdgcn_s_waitcnt(0xC07F); asm volatile("" ::: "memory");
}
__device__ __forceinline__ void tr_matrix(const float* W, int K, int ld, int N, bf16* WT, int mode, float* scr, int gw, int ngw, int lane) {
    const int items = (K / 64) * (N / 32);
    for (int it = gw; it < items; it += ngw) tr_item(W, K, ld, N, WT, mode, scr, it, lane);
}
__global__ void __launch_bounds__(256) k_transpose(const float* W, int K, int ld, int N, bf16* WT, int mode) {
    __shared__ float scr[4][64 * 33];
    const int wave = threadIdx.x >> 6, lane = threadIdx.x & 63;
    tr_matrix(W, K, ld, N, WT, mode, scr[wave], blockIdx.x * 4 + wave, gridDim.x * 4, lane);
}
__global__ void __launch_bounds__(256) k_modvec(P a) {
    __shared__ float cond[MODR][D];
    __shared__ float red[4][MODR][64];
    const int l = blockIdx.x / 96, nc = blockIdx.x % 96, t = threadIdx.x, kg = t >> 6, n = nc * 64 + (t & 63);
    for (int i = t; i < MODR * D; i += 256) { const int r = i / D, k = i % D; const float v = r < NB ? a.c[r * D + k] : a.c_ctx[k]; cond[r][k] = silu_f(v); }
    __syncthreads();
    float acc[MODR];
#pragma unroll
    for (int r = 0; r < MODR; ++r) acc[r] = 0.f;
    const float* w = a.w_mod + (size_t)l * D * MODW + n;
    for (int k = kg * 256; k < kg * 256 + 256; ++k) { const float wv = w[(size_t)k * MODW];
#pragma unroll
        for (int r = 0; r < MODR; ++r) acc[r] += cond[r][k] * wv; }
#pragma unroll
    for (int r = 0; r < MODR; ++r) red[kg][r][t & 63] = acc[r];
    __syncthreads();
    float* mod = (float*)(a.ws + WS_MOD);
    for (int i = t; i < MODR * 64; i += 256) { const int r = i / 64, j = i % 64; const int nn = nc * 64 + j;
        mod[((size_t)l * MODR + r) * MODW + nn] = red[0][r][j] + red[1][r][j] + red[2][r][j] + red[3][r][j] + a.b_mod[l * MODW + nn]; }
}
__global__ void k_rope_table(P a) {
    const int i = blockIdx.x * blockDim.x + threadIdx.x; if (i >= 64 * 16) return;
    const int pos = i / 16, f = i % 16; const float inv = powf(10000.0f, -(float)f / 16.0f); const float ang = (float)pos * inv;
    float* t = (float*)(a.ws + WS_ROPE); t[2 * i] = cosf(ang); t[2 * i + 1] = sinf(ang);
}

template <int MODE, bool SRC_IN, bool COMBINE>
__device__ __forceinline__ void norm_phase(const P& a_in, int l, int wg, float* lds) {
    PHASE_ENTRY(a_in)
    const int tid = otid(), lane = tid & 63, wave = tid >> 6;
    float* X = (float*)(a.ws + WS_X); bf16* HX = (bf16*)(a.ws + WS_HX); const float* MOD = (const float*)(a.ws + WS_MOD);
    float* wl = lds; unsigned* wlu = (unsigned*)lds;
    float* scratch = lds + 8192;
    int* cnt_l = (int*)(lds + 8192 + 8 * 32);
    if (MODE == 0) {
        for (int i = tid; i < D * 2; i += NTHR) { const int c = i >> 1, hf = i & 1; const float* wp = a.w_in + ((size_t)l * D + c) * INW + UW + 8 * hf;
            const f32x4 w0 = *(const f32x4*)wp, w1 = *(const f32x4*)(wp + 4);
            const int j = c >> 8, ln = (c >> 2) & 63, ii = c & 3; v4u o; o.x = pk2(w0.x, w0.y); o.y = pk2(w0.z, w0.w); o.z = pk2(w1.x, w1.y); o.w = pk2(w1.z, w1.w);
            *(v4u*)(wlu + ((((j * 4 + ii) * 2 + hf) * 64 + ln) * 4)) = o; }
    }
    if (MODE == 2) {
        for (int i = tid; i < D * 2; i += NTHR) { const int c = i >> 1, g4 = i & 1; const f32x4 w = *(const f32x4*)(a.w_router + ((size_t)(l >> 1) * D + c) * NE + 4 * g4);
            const int j = c >> 8, ln = (c >> 2) & 63, ii = c & 3; *(f32x4*)(wl + ((((j * 4 + ii) * 2 + g4) * 64 + ln) * 4)) = w; }
        if (tid < NE) cnt_l[tid] = 0;
    }
    if (MODE == 0 || MODE == 2) __syncthreads();
    const float* gvec = MODE == 0 ? a.norm1_g + l * D : (MODE == 3 ? a.final_g : a.norm2_g + l * D);
    f32x4 gv[4];
#pragma unroll
    for (int j = 0; j < 4; ++j) gv[j] = *(const f32x4*)(gvec + 256 * j + 4 * lane);
    const int row0 = wg * ROWS_PER_WG + wave * 17;
#pragma unroll 1
    for (int grp = 0; grp < 9; ++grp) {
        f32x4 h[2][4];
        int tks[2]; bool valid[2];
#pragma unroll
        for (int r = 0; r < 2; ++r) {
            const int ri = grp * 2 + r; valid[r] = ri < 17; const int tk = row0 + (valid[r] ? ri : 0); tks[r] = tk;
            const int b = tk / TPB, p = tk - b * TPB, mr = p < CTX ? NB : b;
            const float* xr = SRC_IN ? in_row(a, tk) : X + (size_t)tk * D;
            f32x4 xv[4];
#pragma unroll
            for (int j = 0; j < 4; ++j) xv[j] = *(const f32x4*)(xr + 256 * j + 4 * lane);
            if (COMBINE) {
                const int* tp = (const int*)(a.ws + WS_TOKP) + 2 * tk; const int p0 = min(max(tp[0], 0), MOE_ROWS - 1), p1 = min(max(tp[1], 0), MOE_ROWS - 1);
                const bf16* ys = (const bf16*)(a.ws + WS_YS); const float* m5 = MOD + ((size_t)(l - 1) * MODR + mr) * MODW + 5 * D;
#pragma unroll
                for (int j = 0; j < 4; ++j) { const v2u y0 = *(const v2u*)(ys + (size_t)p0 * D + 256 * j + 4 * lane), y1 = *(const v2u*)(ys + (size_t)p1 * D + 256 * j + 4 * lane);
                    const f32x4 mv = *(const f32x4*)(m5 + 256 * j + 4 * lane);
                    xv[j].x += mv.x * (bf_lo(y0.x) + bf_lo(y1.x)); xv[j].y += mv.y * (bf_hi(y0.x) + bf_hi(y1.x));
                    xv[j].z += mv.z * (bf_lo(y0.y) + bf_lo(y1.y)); xv[j].w += mv.w * (bf_hi(y0.y) + bf_hi(y1.y));
                    if (valid[r] && MODE != 3) *(f32x4*)(X + (size_t)tk * D + 256 * j + 4 * lane) = xv[j]; }
            }
            float ss = 0.f;
#pragma unroll
            for (int j = 0; j < 4; ++j) ss += (xv[j].x * xv[j].x + xv[j].y * xv[j].y) + (xv[j].z * xv[j].z + xv[j].w * xv[j].w);
            const float rstd = rsqrtf(wave_sum(ss) * (1.f / D) + EPS);
            if (MODE == 3) {
                if (valid[r] && p >= CTX) { float* o = a.out + ((size_t)b * SEQ + (p - CTX)) * D;
#pragma unroll
                    for (int j = 0; j < 4; ++j) *(f32x4*)(o + 256 * j + 4 * lane) = xv[j] * rstd * gv[j]; }
            } else {
                const float* mrow = MOD + ((size_t)l * MODR + mr) * MODW;
                const float* shp = mrow + (MODE == 0 ? 0 : 3) * D; const float* scp = mrow + (MODE == 0 ? 1 : 4) * D;
#pragma unroll
                for (int j = 0; j < 4; ++j) { const f32x4 sh = *(const f32x4*)(shp + 256 * j + 4 * lane), sc = *(const f32x4*)(scp + 256 * j + 4 * lane);
                    h[r][j] = xv[j] * rstd * gv[j] * (sc + 1.f) + sh;
                    if (valid[r]) { v2u o; o.x = pk2(h[r][j].x, h[r][j].y); o.y = pk2(h[r][j].z, h[r][j].w); *(v2u*)(HX + (size_t)tk * D + 256 * j + 4 * lane) = o; } }
            }
        }
        if (MODE == 0) {
            float acc[2][16];
#pragma unroll
            for (int r = 0; r < 2; ++r)
#pragma unroll
                for (int g = 0; g < 16; ++g) acc[r][g] = 0.f;
#pragma unroll
            for (int j = 0; j < 4; ++j)
#pragma unroll
                for (int ii = 0; ii < 4; ++ii) {
#pragma unroll
                    for (int hf = 0; hf < 2; ++hf) { const v4u w = *(const v4u*)(wlu + ((((j * 4 + ii) * 2 + hf) * 64 + lane) * 4));
#pragma unroll
                        for (int r = 0; r < 2; ++r) { const float hv = h[r][j][ii];
                            acc[r][8 * hf + 0] += hv * bf_lo(w.x); acc[r][8 * hf + 1] += hv * bf_hi(w.x); acc[r][8 * hf + 2] += hv * bf_lo(w.y); acc[r][8 * hf + 3] += hv * bf_hi(w.y);
                            acc[r][8 * hf + 4] += hv * bf_lo(w.z); acc[r][8 * hf + 5] += hv * bf_hi(w.z); acc[r][8 * hf + 6] += hv * bf_lo(w.w); acc[r][8 * hf + 7] += hv * bf_hi(w.w); } }
                    asm volatile("" ::: "memory"); }
            float flat[32];
#pragma unroll
            for (int r = 0; r < 2; ++r)
#pragma unroll
                for (int g = 0; g < 16; ++g) flat[r * 16 + g] = acc[r][g];
            const float sum = RS<32, 32>::run(flat, lane);
            { const int idx = (lane >> 1) & 31, r = idx >> 4, g = idx & 15;
              float v = sum + a.b_gates[l * 16 + g]; v = 15.f * tanhf(v * (1.f / 15.f));
              const int ri = grp * 2 + r;
              if ((lane & 1) == 0 && ri < 17) ((float*)(a.ws + WS_GATES))[(size_t)(row0 + ri) * 16 + g] = v; }
        }
        if (MODE == 2) {
            float acc[2][8];
#pragma unroll
            for (int r = 0; r < 2; ++r)
#pragma unroll
                for (int g = 0; g < 8; ++g) acc[r][g] = 0.f;
#pragma unroll
            for (int j = 0; j < 4; ++j)
#pragma unroll
                for (int ii = 0; ii < 4; ++ii) {
#pragma unroll
                    for (int g4 = 0; g4 < 2; ++g4) { const f32x4 w = *(const f32x4*)(wl + ((((j * 4 + ii) * 2 + g4) * 64 + lane) * 4));
#pragma unroll
                        for (int r = 0; r < 2; ++r) { const float hv = h[r][j][ii]; acc[r][4 * g4 + 0] += hv * w.x; acc[r][4 * g4 + 1] += hv * w.y; acc[r][4 * g4 + 2] += hv * w.z; acc[r][4 * g4 + 3] += hv * w.w; } }
                    asm volatile("" ::: "memory"); }
            float flat[16];
#pragma unroll
            for (int r = 0; r < 2; ++r)
#pragma unroll
                for (int g = 0; g < 8; ++g) flat[r * 8 + g] = acc[r][g];
            const float sum = RS<16, 32>::run(flat, lane);
#pragma unroll
            for (int r = 0; r < 2; ++r) {
                float lg[8];
#pragma unroll
                for (int g = 0; g < 8; ++g) { const float v = lane_bcast(sum, (r * 8 + g) << 2) + a.b_router[(l >> 1) * NE + g]; lg[g] = (v == v) ? fminf(fmaxf(v, -1.0e30f), 1.0e30f) : -1.0e30f; }
                int e0 = 0; float v0 = lg[0];
#pragma unroll
                for (int g = 1; g < 8; ++g) if (lg[g] > v0) { v0 = lg[g]; e0 = g; }
                int e1 = (e0 + 1) & 7; float v1 = -3.0e38f;
#pragma unroll
                for (int g = 0; g < 8; ++g) if (g != e0 && lg[g] > v1) { v1 = lg[g]; e1 = g; }
                const float w0 = 1.f / (1.f + __expf(v1 - v0)), w1 = 1.f - w0;
                if (lane == 0 && valid[r]) { const int tk = tks[r];
                    int* te = (int*)(a.ws + WS_TOKE) + 2 * tk; te[0] = e0; te[1] = e1;
                    float* tw = (float*)(a.ws + WS_TOKW) + 2 * tk; tw[0] = w0; tw[1] = w1;
                    atomicAdd(&cnt_l[e0], 1); atomicAdd(&cnt_l[e1], 1); }
            }
        }
    }
    if (MODE == 2) { __syncthreads(); if (tid < NE) ((int*)(a.ws + WS_CNT))[wg * NE + tid] = cnt_l[tid]; }
}
template <int MODE, bool SRC_IN, bool COMBINE>
__global__ void __launch_bounds__(NTHR, 2) k_norm(P a, int l) {
    extern __shared__ __attribute__((aligned(16))) unsigned char smem[];
    a.wv = __builtin_amdgcn_readfirstlane(threadIdx.x >> 6);
    norm_phase<MODE, SRC_IN, COMBINE>(a, l, blockIdx.x, (float*)smem);
}

__device__ __forceinline__ void moe_pos_phase(const P& a_in, int wg, int* lds) {
    PHASE_ENTRY(a_in)
    const int tid = otid();
    int* cnt = lds;
    int* tot = lds + 2048;
    const int* gc = (const int*)(a.ws + WS_CNT);
    for (int i = tid; i < NWG * NE; i += NTHR) cnt[i] = gc[i];
    __syncthreads();
    if (tid < NE) { int t = 0, pre = 0; for (int w = 0; w < NWG; ++w) { if (w == wg) pre = t; t += cnt[w * NE + tid]; } tot[tid] = t; tot[16 + tid] = pre; }
    __syncthreads();
    if (tid == 0) { int s = 0; for (int e = 0; e < NE; ++e) { tot[8 + e] = s; s += (tot[e] + 255) & ~255; } tot[24] = s; }
    __syncthreads();
    const int* te = (const int*)(a.ws + WS_TOKE); const float* tw = (const float*)(a.ws + WS_TOKW);
    int* tp = (int*)(a.ws + WS_TOKP); int* rowt = (int*)(a.ws + WS_ROWT); float* roww = (float*)(a.ws + WS_ROWW);
    if (tid < NE) {
        int pos = tot[8 + tid] + tot[16 + tid];
        for (int i = 0; i < ROWS_PER_WG; ++i) { const int tk = wg * ROWS_PER_WG + i;
#pragma unroll
            for (int s = 0; s < 2; ++s) if (te[2 * tk + s] == tid) { tp[2 * tk + s] = pos; rowt[pos] = tk; roww[pos] = tw[2 * tk + s]; ++pos; } }
    }
    if (wg < NE) { const int s0 = tot[8 + wg] + tot[wg], s1 = tot[8 + wg] + ((tot[wg] + 255) & ~255); for (int r = s0 + tid; r < s1; r += NTHR) { rowt[r] = 0; roww[r] = 0.f; } }
    if (wg == 0) { int* tile_e = (int*)(a.ws + WS_TILEE); const int nt = tot[24] >> 8;
        for (int t = tid; t < MOE_TILES; t += NTHR) { int e = 0; for (int q = 1; q < NE; ++q) if (t * 256 >= tot[8 + q]) e = q; tile_e[t] = t < nt ? e : 0; }
        if (tid == 0) tile_e[MOE_TILES] = nt; }
}
__global__ void __launch_bounds__(NTHR, 2) k_moe_pos(P a) {
    extern __shared__ __attribute__((aligned(16))) unsigned char smem[];
    a.wv = __builtin_amdgcn_readfirstlane(threadIdx.x >> 6);
    moe_pos_phase(a, blockIdx.x, (int*)smem);
}

enum { EM_IN = 0, EM_OUT = 1, EM_F1 = 2, EM_F2D = 3, EM_F1M = 4, EM_F2M = 5 };
template <int EM>
__global__ void __launch_bounds__(256) k_ngemm(P a, int l, const bf16* A, const bf16* Bt, int M, int N, int K) {
    constexpr bool DUAL = (EM == EM_F1 || EM == EM_F1M), MOE = (EM == EM_F1M || EM == EM_F2M);
    __shared__ __attribute__((aligned(16))) float As[32][64], Bs[32][64], Bs2[DUAL ? 32 : 1][64];
    const int t = threadIdx.x, tx = t & 15, ty = t >> 4;
    const int row0 = blockIdx.y * 64, col0 = blockIdx.x * 64;
    const int* tile_e = (const int*)(a.ws + WS_TILEE); const int* rowt = (const int*)(a.ws + WS_ROWT);
    if (MOE) { if (row0 >= tile_e[MOE_TILES] * 256) return; }
    const int e = MOE ? tile_e[row0 >> 8] : 0;
    const bf16* B = Bt + (MOE ? (size_t)e * (DUAL ? 2 * FFN : D) * K : 0);
    const int lr = t >> 2, kc = (t & 3) * 8;
    const int arow = (EM == EM_F1M) ? rowt[row0 + lr] : row0 + lr;
    const int brow = DUAL ? ((col0 >> 7) * 256 + (col0 & 127) + lr) : col0 + lr;
    float acc[4][4], acc2[4][4];
#pragma unroll
    for (int i = 0; i < 4; ++i)
#pragma unroll
        for (int j = 0; j < 4; ++j) { acc[i][j] = 0.f; acc2[i][j] = 0.f; }
    for (int k0 = 0; k0 < K; k0 += 32) {
        const v4u av = *(const v4u*)(A + (size_t)arow * K + k0 + kc);
        const v4u bv = *(const v4u*)(B + (size_t)brow * K + k0 + kc);
        v4u bv2 = bv; if (DUAL) bv2 = *(const v4u*)(B + (size_t)(brow + 128) * K + k0 + kc);
        __syncthreads();
        As[kc + 0][lr] = bf_lo(av.x); As[kc + 1][lr] = bf_hi(av.x); As[kc + 2][lr] = bf_lo(av.y); As[kc + 3][lr] = bf_hi(av.y);
        As[kc + 4][lr] = bf_lo(av.z); As[kc + 5][lr] = bf_hi(av.z); As[kc + 6][lr] = bf_lo(av.w); As[kc + 7][lr] = bf_hi(av.w);
        Bs[kc + 0][lr] = bf_lo(bv.x); Bs[kc + 1][lr] = bf_hi(bv.x); Bs[kc + 2][lr] = bf_lo(bv.y); Bs[kc + 3][lr] = bf_hi(bv.y);
        Bs[kc + 4][lr] = bf_lo(bv.z); Bs[kc + 5][lr] = bf_hi(bv.z); Bs[kc + 6][lr] = bf_lo(bv.w); Bs[kc + 7][lr] = bf_hi(bv.w);
        if (DUAL) { Bs2[kc + 0][lr] = bf_lo(bv2.x); Bs2[kc + 1][lr] = bf_hi(bv2.x); Bs2[kc + 2][lr] = bf_lo(bv2.y); Bs2[kc + 3][lr] = bf_hi(bv2.y);
            Bs2[kc + 4][lr] = bf_lo(bv2.z); Bs2[kc + 5][lr] = bf_hi(bv2.z); Bs2[kc + 6][lr] = bf_lo(bv2.w); Bs2[kc + 7][lr] = bf_hi(bv2.w); }
        __syncthreads();
#pragma unroll 8
        for (int k = 0; k < 32; ++k) {
            const f32x4 av4 = *(const f32x4*)&As[k][ty * 4], bv4 = *(const f32x4*)&Bs[k][tx * 4];
#pragma unroll
            for (int i = 0; i < 4; ++i)
#pragma unroll
                for (int j = 0; j < 4; ++j) acc[i][j] += av4[i] * bv4[j];
            if (DUAL) { const f32x4 b2 = *(const f32x4*)&Bs2[k][tx * 4];
#pragma unroll
                for (int i = 0; i < 4; ++i)
#pragma unroll
                    for (int j = 0; j < 4; ++j) acc2[i][j] += av4[i] * b2[j]; }
        }
    }
    const float* MOD = (const float*)(a.ws + WS_MOD); float* X = (float*)(a.ws + WS_X);
#pragma unroll
    for (int i = 0; i < 4; ++i) {
        const int r = row0 + ty * 4 + i;
#pragma unroll
        for (int j = 0; j < 4; ++j) {
            const int c = col0 + tx * 4 + j; const float v = acc[i][j];
            if (EM == EM_IN) ((bf16*)(a.ws + WS_U))[(size_t)r * UW + c] = (bf16)f2bf(v);
            if (EM == EM_OUT) { const float* base = (l == 0) ? in_row(a, r) : X + (size_t)r * D; X[(size_t)r * D + c] = base[c] + MOD[((size_t)l * MODR + tk_modrow(r)) * MODW + 2 * D + c] * v; }
            if (EM == EM_F1) ((bf16*)(a.ws + WS_HID))[(size_t)r * FFN + c] = (bf16)f2bf(silu_f(v) * acc2[i][j]);
            if (EM == EM_F1M) ((bf16*)(a.ws + WS_HID))[(size_t)r * FFN + c] = (bf16)f2bf(silu_f(v) * acc2[i][j] * ((const float*)(a.ws + WS_ROWW))[r]);
            if (EM == EM_F2D) X[(size_t)r * D + c] += MOD[((size_t)l * MODR + tk_modrow(r)) * MODW + 5 * D + c] * v;
            if (EM == EM_F2M) ((bf16*)(a.ws + WS_YS))[(size_t)r * D + c] = (bf16)f2bf(v);
        }
    }
}
__global__ void __launch_bounds__(256) k_rope_apply(P a) {
    const size_t i = (size_t)blockIdx.x * 256 + threadIdx.x; if (i >= (size_t)T_ALL * 20 * 16) return;
    const int tk = (int)(i / 320), rem = (int)(i % 320), grp = rem / 16, f = rem % 16;
    const int b = tk / TPB, p = tk - b * TPB; bf16* u = (bf16*)(a.ws + WS_U) + (size_t)tk * UW + grp * 32;
    float x1 = bf2f(u[f]), x2 = bf2f(u[f + 16]);
    const float sc = grp < 16 ? 0.125f : 1.f;
    if (p >= CTX) { const int s = p - CTX, pos = (grp & 1) ? (s & 63) : (s >> 6); const float* t = (const float*)(a.ws + WS_ROPE) + 2 * (pos * 16 + f);
        const float cs = t[0], sn = t[1]; const float y1 = x1 * cs - x2 * sn, y2 = x2 * cs + x1 * sn; x1 = y1; x2 = y2; }
    u[f] = (bf16)f2bf(x1 * sc); u[f + 16] = (bf16)f2bf(x2 * sc);
}

__global__ void __launch_bounds__(512, 2) k_attn_naive(P a, int l) {
    __shared__ float ssq[8];
    const int tk = blockIdx.x, h = threadIdx.x >> 6, lane = threadIdx.x & 63, kvh = h >> 2;
    const int b = tk / TPB, p = tk - b * TPB; const bool isctx = p < CTX;
    const bf16* U = (const bf16*)(a.ws + WS_U);
    float q[64];
    { const v4u* qp = (const v4u*)(U + (size_t)tk * UW + U_QA + h * 64);
#pragma unroll
      for (int i = 0; i < 8; ++i) { const v4u w = qp[i]; q[8 * i + 0] = bf_lo(w.x); q[8 * i + 1] = bf_hi(w.x); q[8 * i + 2] = bf_lo(w.y); q[8 * i + 3] = bf_hi(w.y); q[8 * i + 4] = bf_lo(w.z); q[8 * i + 5] = bf_hi(w.z); q[8 * i + 6] = bf_lo(w.w); q[8 * i + 7] = bf_hi(w.w); } }
    const int s = p - CTX; const int j0 = isctx ? 0 : (s - 128 < 0 ? 0 : s - 128), j1 = isctx ? -1 : (s + 128 > SEQ - 1 ? SEQ - 1 : s + 128);
    const int nlat = j1 - j0 + 1, nk = CTX + (isctx ? 0 : nlat);
    const int tb = b * TPB;
    float sc[9];
#pragma unroll
    for (int it = 0; it < 9; ++it) { const int idx = lane + 64 * it; sc[it] = -3.0e38f;
        if (idx < nk) { const int kt = idx < CTX ? tb + idx : tb + CTX + j0 + (idx - CTX); const v4u* kp = (const v4u*)(U + (size_t)kt * UW + U_KA + kvh * 64); float d = 0.f;
#pragma unroll
            for (int i = 0; i < 8; ++i) { const v4u w = kp[i]; d += q[8 * i + 0] * bf_lo(w.x) + q[8 * i + 1] * bf_hi(w.x) + q[8 * i + 2] * bf_lo(w.y) + q[8 * i + 3] * bf_hi(w.y) + q[8 * i + 4] * bf_lo(w.z) + q[8 * i + 5] * bf_hi(w.z) + q[8 * i + 6] * bf_lo(w.w) + q[8 * i + 7] * bf_hi(w.w); }
            sc[it] = d; } }
    const float sink = a.attn_sink[l * 8 + h];
    float m = sink;
#pragma unroll
    for (int it = 0; it < 9; ++it) m = fmaxf(m, sc[it]);
    m = wave_max(m);
    float o[64];
#pragma unroll
    for (int d = 0; d < 64; ++d) o[d] = 0.f;
    float den = 0.f;
#pragma unroll
    for (int it = 0; it < 9; ++it) { const int idx = lane + 64 * it;
        if (idx < nk) { const float pr = __expf(sc[it] - m); den += pr; const int kt = idx < CTX ? tb + idx : tb + CTX + j0 + (idx - CTX); const v4u* vp = (const v4u*)(U + (size_t)kt * UW + U_VA + kvh * 64);
#pragma unroll
            for (int i = 0; i < 8; ++i) { const v4u w = vp[i]; o[8 * i + 0] += pr * bf_lo(w.x); o[8 * i + 1] += pr * bf_hi(w.x); o[8 * i + 2] += pr * bf_lo(w.y); o[8 * i + 3] += pr * bf_hi(w.y); o[8 * i + 4] += pr * bf_lo(w.z); o[8 * i + 5] += pr * bf_hi(w.z); o[8 * i + 6] += pr * bf_lo(w.w); o[8 * i + 7] += pr * bf_hi(w.w); } } }
    den = wave_sum(den) + __expf(sink - m);
    float mine = 0.f;
#pragma unroll
    for (int d = 0; d < 64; ++d) { const float sd = wave_sum(o[d]); mine = (lane == d) ? sd : mine; }
    mine /= den;
    const float sq = wave_sum(mine * mine);
    if (lane == 0) ssq[h] = sq;
    __syncthreads();
    float tot = 0.f;
#pragma unroll
    for (int i = 0; i < 8; ++i) tot += ssq[i];
    const float rstd = rsqrtf(tot * (1.f / 512.f) + EPS);
    ((bf16*)(a.ws + WS_MIX))[(size_t)tk * D + h * 64 + lane] = (bf16)f2bf(mine * rstd * a.g_att[l * 512 + h * 64 + lane]);
}

__device__ __forceinline__ float conv_qk(const P& a, int l, const bf16* U, int tk, int ch) {
    const int b = tk / TPB, p = tk - b * TPB; const int lo = p < CTX ? 0 : CTX, hi = p < CTX ? CTX : TPB;
    float y = a.conv_b[l * 512 + ch];
#pragma unroll
    for (int j = 0; j < 5; ++j) { const int pp = p + j - 2; if (pp >= lo && pp < hi) y += a.conv_w[(l * 5 + j) * 512 + ch] * bf2f(U[(size_t)(b * TPB + pp) * UW + U_QM + ch]); }
    return silu_f(y);
}
__global__ void __launch_bounds__(256) k_mlstm_naive(P a, int l) {
    __shared__ float qs[2][64], ks[2][64], part[2][2][128], sc[2][4];
    const int t = threadIdx.x, dir = blockIdx.x & 1, hd = (blockIdx.x >> 1) & 3, b = blockIdx.x >> 3;
    const bf16* U = (const bf16*)(a.ws + WS_U); const float* G = (const float*)(a.ws + WS_GATES);
    float* HD = (float*)(a.ws + WS_HDIR) + (size_t)dir * T_ALL * 512;
    const int e = t & 127, half = t >> 7;
    float C[32];
#pragma unroll
    for (int i = 0; i < 32; ++i) C[i] = 0.f;
    float nst = 0.f, m = 0.f;
    for (int tau = 0; tau < TPB; ++tau) {
        const int pb = tau & 1;
        const int p = dir == 0 ? tau : (tau < CTX ? CTX - 1 - tau : CTX + (SEQ - 1) - (tau - CTX));
        const int tk = b * TPB + p;
        if (t < 64) qs[pb][t] = 0.125f * conv_qk(a, l, U, tk, hd * 64 + t);
        else if (t < 128) ks[pb][t - 64] = conv_qk(a, l, U, tk, 256 + hd * 64 + (t - 64));
        const float li = G[(size_t)tk * 16 + dir * 8 + hd], lf = logsigmoid_f(G[(size_t)tk * 16 + dir * 8 + 4 + hd]);
        const float mn = fmaxf(lf + m, li), fd = __expf(lf + m - mn), iw = __expf(li - mn);
        m = mn;
        const float v = bf2f(U[(size_t)tk * UW + U_VM + hd * 128 + e]);
        __syncthreads();
        float ph = 0.f;
#pragma unroll
        for (int i = 0; i < 32; ++i) { const int dk = half * 32 + i; C[i] = fd * C[i] + iw * ks[pb][dk] * v; ph += qs[pb][dk] * C[i]; }
        part[pb][half][e] = ph;
        if (t < 64) { nst = fd * nst + iw * ks[pb][t]; const float qn = wave_sum(qs[pb][t] * nst); if (t == 0) sc[pb][0] = qn; }
        __syncthreads();
        if (t < 128) { const float num = part[pb][0][t] + part[pb][1][t]; const float den = fmaxf(fabsf(sc[pb][0]), __expf(-mn)); HD[(size_t)tk * 512 + hd * 128 + t] = num / den; }
    }
}
__global__ void __launch_bounds__(256) k_merge_naive(P a, int l) {
    const int tk = blockIdx.x, hd = threadIdx.x >> 6, lane = threadIdx.x & 63;
    const float* H0 = (const float*)(a.ws + WS_HDIR); const float* H1 = H0 + (size_t)T_ALL * 512; const bf16* U = (const bf16*)(a.ws + WS_U);
    const int c0 = hd * 128 + lane, c1 = c0 + 64;
    const float h0 = H0[(size_t)tk * 512 + c0] + H1[(size_t)tk * 512 + c0], h1 = H0[(size_t)tk * 512 + c1] + H1[(size_t)tk * 512 + c1];
    const float rstd = rsqrtf(wave_sum(h0 * h0 + h1 * h1) * (1.f / 128.f) + EPS);
    bf16* mx = (bf16*)(a.ws + WS_MIX) + (size_t)tk * D + 512;
    mx[c0] = (bf16)f2bf(h0 * rstd * a.g_ml[l * 512 + c0] * sigmoid_f(bf2f(U[(size_t)tk * UW + U_OM + c0])));
    mx[c1] = (bf16)f2bf(h1 * rstd * a.g_ml[l * 512 + c1] * sigmoid_f(bf2f(U[(size_t)tk * UW + U_OM + c1])));
}

namespace pg {
#define PG_LAS __attribute__((address_space(3)))
typedef short bf16x8 __attribute__((ext_vector_type(8)));
constexpr int BM = 256, BK = 64, HALF = 128, HTB = HALF * BK * 2, STAGE_BYTES = 8 * HTB, NXCD = 8, WGM = 8;
__host__ __device__ __forceinline__ int lds_byte(int r, int c) { const int st = (r >> 4) * 2 + (c >> 5), rr = r & 15, cc = c & 31, ob = rr * 64 + cc * 2; return st * 1024 + (ob ^ (((ob >> 9) & 1) << 5)); }
__host__ __device__ __forceinline__ void stage_rc(int b, int& R, int& C) { const int st = b / 1024, sb = b % 1024, swz = sb ^ (((sb >> 9) & 1) << 5); R = (st >> 1) * 16 + swz / 64; C = (st & 1) * 32 + (swz % 64) / 2; }
__host__ __device__ __forceinline__ int perm32(int rho) { const int n = rho >> 4, i = rho & 15; return 8 * (i >> 2) + 4 * n + (i & 3); }
struct Unit { int pm, pn, e; };
struct Order {
    int nM, nN, nwg, G, c;
    __device__ void init(int nM_, int nN_, int G_, int c_) { nM = nM_; nN = nN_; nwg = nM * nN; G = G_; c = c_; }
    __device__ bool next(int i, Unit& u) const {
        const long L = (long)i * G + c; if (L >= nwg) return false;
        int wgid = (int)L; { const int q = nwg / NXCD, r = nwg % NXCD, xcd = wgid % NXCD, off = wgid / NXCD; wgid = (xcd < r ? xcd * (q + 1) : r * (q + 1) + (xcd - r) * q) + off; }
        const int nig = WGM * nN, gid = wgid / nig, fm = gid * WGM, gsz = (nM - fm) < WGM ? (nM - fm) : WGM;
        u.pm = fm + ((wgid % nig) % gsz); u.pn = (wgid % nig) / gsz; u.e = 0; return true;
    }
};
struct Gemm { const bf16* A; const bf16* Bt; int K; int brows; const int* rowt; const int* tile_e; int wv; };

template <class Epi, bool GATHER, bool MOE>
__device__ __forceinline__ void gemm_phase(PG_LAS unsigned char* lds, const Gemm g, const Order& S, const Epi& E) {
    const int tid = otid_w(g.wv), wid = __builtin_amdgcn_readfirstlane(tid >> 6), lane = tid & 63, wr = wid >> 2, wc = wid & 3, fr = lane & 15, fq = lane >> 4;
    const int K = g.K, nt = K / BK;
    int Rr[2], Cc[2]; unsigned voffB[2];
#pragma unroll
    for (int i = 0; i < 2; ++i) { int R, C; stage_rc(tid * 16 + i * 8192, R, C); Rr[i] = R; Cc[i] = C; const int Rb = Epi::PERM ? ((R & ~31) + perm32(R & 31)) : R; voffB[i] = (unsigned)(Rb * K + C) * 2u; }
    const size_t hstep = (size_t)HALF * K * 2;
    const unsigned ldsw = (unsigned)wid * 1024u;
    const int aoff = lds_byte(wr * 64 + fr, fq * 8), boff = lds_byte(wc * 32 + fr, fq * 8);
    const char* Ab = (const char*)g.A;
#define PG_SA(b, h) (((b) * 2 + (h)) * HTB)
#define PG_SB(b, h) ((4 + (b) * 2 + (h)) * HTB)
#define PG_STAGE_B(bufoff, gbase) do { _Pragma("unroll") for (int _i = 0; _i < 2; ++_i) \
        __builtin_amdgcn_global_load_lds((const unsigned*)((const char*)(gbase) + voffB[_i]), (PG_LAS unsigned*)(lds + (bufoff) + ldsw + _i * 8192), 16, 0, 0); } while (0)
#define PG_STAGE_A(bufoff, offs, h, kb) do { _Pragma("unroll") for (int _i = 0; _i < 2; ++_i) \
        __builtin_amdgcn_global_load_lds((const unsigned*)(Ab + (size_t)(offs)[h][_i] + (size_t)(kb)), (PG_LAS unsigned*)(lds + (bufoff) + ldsw + _i * 8192), 16, 0, 0); } while (0)
#define PG_LDA(dst, b, h) do { _Pragma("unroll") for (int m = 0; m < 4; ++m) _Pragma("unroll") for (int k = 0; k < 2; ++k) dst[m][k] = *(const PG_LAS bf16x8*)(lds + PG_SA(b, h) + aoff + m * 2048 + k * 1024); } while (0)
#define PG_LDB(dst, b, h) do { _Pragma("unroll") for (int n = 0; n < 2; ++n) _Pragma("unroll") for (int k = 0; k < 2; ++k) dst[n][k] = *(const PG_LAS bf16x8*)(lds + PG_SB(b, h) + boff + n * 2048 + k * 1024); } while (0)
#define PG_MMA(ai, bj, At, Bt) do { __builtin_amdgcn_s_setprio(1); _Pragma("unroll") for (int m = 0; m < 4; ++m) _Pragma("unroll") for (int n = 0; n < 2; ++n) _Pragma("unroll") for (int k = 0; k < 2; ++k) \
        acc[ai][bj][m][n] = __builtin_amdgcn_mfma_f32_16x16x32_bf16(Bt[n][k], At[m][k], acc[ai][bj][m][n], 0, 0, 0); __builtin_amdgcn_s_setprio(0); } while (0)
#define PG_WAIT_V(n) asm volatile("s_waitcnt vmcnt(" #n ")" ::: "memory")
#define PG_WAIT_L(n) asm volatile("s_waitcnt lgkmcnt(" #n ")" ::: "memory")
#define PG_BAR __builtin_amdgcn_s_barrier()
#define PG_SCHED __builtin_amdgcn_sched_barrier(0)
#define PG_AOFFS(dst, u) do { _Pragma("unroll") for (int _h = 0; _h < 2; ++_h) _Pragma("unroll") for (int _i = 0; _i < 2; ++_i) { \
        const int _r = (u).pm * BM + _h * HALF + Rr[_i]; const int _row = GATHER ? g.rowt[_r] : _r; dst[_h][_i] = (unsigned)_row * (unsigned)(K * 2) + (unsigned)(Cc[_i] * 2); } } while (0)
#define PG_BBASE(u) ((const char*)g.Bt + ((size_t)(u).e * g.brows + (size_t)(u).pn * BM) * (size_t)K * 2)
    Unit cur, nxt; int ui = 0;
    if (!S.next(0, cur)) return;
    if (MOE) cur.e = g.tile_e[cur.pm];
    f32x4 acc[2][2][4][2];
#pragma unroll
    for (int a = 0; a < 2; ++a)
#pragma unroll
        for (int b = 0; b < 2; ++b)
#pragma unroll
            for (int m = 0; m < 4; ++m)
#pragma unroll
                for (int n = 0; n < 2; ++n) acc[a][b][m][n] = (f32x4){0.f, 0.f, 0.f, 0.f};
    bf16x8 At[4][2], B0[2][2], B1[2][2];
    unsigned offC[2][2], offN[2][2];
    PG_AOFFS(offC, cur);
    const char* cB = PG_BBASE(cur);
    const size_t kstep = (size_t)(BK * 2);
    PG_STAGE_B(PG_SB(0, 0), cB); PG_STAGE_B(PG_SB(0, 1), cB + hstep); PG_STAGE_A(PG_SA(0, 0), offC, 0, 0); PG_STAGE_A(PG_SA(0, 1), offC, 1, 0);
    if (wr == 1) PG_BAR;
    PG_WAIT_V(2); PG_BAR;
    PG_STAGE_B(PG_SB(1, 0), cB + kstep); PG_STAGE_A(PG_SA(1, 0), offC, 0, kstep); PG_STAGE_B(PG_SB(1, 1), cB + hstep + kstep);
    PG_WAIT_V(6); PG_BAR;
    for (;;) {
        bool has_next = S.next(ui + 1, nxt);
        if (has_next) { if (MOE) nxt.e = g.tile_e[nxt.pm]; PG_AOFFS(offN, nxt); }
        else {
#pragma unroll
            for (int h = 0; h < 2; ++h)
#pragma unroll
                for (int i = 0; i < 2; ++i) offN[h][i] = offC[h][i]; }
        const char* nB = has_next ? PG_BBASE(nxt) : cB;
        for (int t = 0; t < nt; t += 2) {
            const bool last = (t == nt - 2);
            const size_t k1 = (size_t)(t + 1) * kstep;
            const size_t k2 = last ? 0 : (size_t)(t + 2) * kstep;
            const char* b2 = last ? nB : cB + (size_t)(t + 2) * kstep; const char* b3 = b2 + kstep;
            PG_LDB(B0, 0, 0); PG_LDB(B1, 0, 1); PG_SCHED; PG_LDA(At, 0, 0); PG_STAGE_A(PG_SA(1, 1), offC, 1, k1);
            PG_WAIT_V(8); PG_WAIT_L(0); PG_BAR; PG_MMA(0, 0, At, B0); PG_MMA(0, 1, At, B1); PG_BAR; PG_SCHED;
            if (last) {
#pragma unroll
                for (int h = 0; h < 2; ++h)
#pragma unroll
                    for (int i = 0; i < 2; ++i) offC[h][i] = offN[h][i]; }
            PG_LDA(At, 0, 1); PG_STAGE_B(PG_SB(0, 0), b2); PG_STAGE_B(PG_SB(0, 1), b2 + hstep); PG_STAGE_A(PG_SA(0, 0), offC, 0, k2);
            PG_WAIT_V(8); PG_WAIT_L(0); PG_BAR; PG_MMA(1, 0, At, B0); PG_MMA(1, 1, At, B1); PG_BAR; PG_SCHED;
            PG_LDB(B0, 1, 0); PG_LDB(B1, 1, 1); PG_SCHED; PG_LDA(At, 1, 0); PG_STAGE_A(PG_SA(0, 1), offC, 1, k2);
            PG_WAIT_V(8); PG_WAIT_L(0); PG_BAR; PG_MMA(0, 0, At, B0); PG_MMA(0, 1, At, B1); PG_BAR; PG_SCHED;
            PG_LDA(At, 1, 1); PG_STAGE_B(PG_SB(1, 0), b3); PG_STAGE_B(PG_SB(1, 1), b3 + hstep); PG_STAGE_A(PG_SA(1, 0), offC, 0, k2 + kstep);
            PG_WAIT_V(8); PG_WAIT_L(0); PG_BAR; PG_MMA(1, 0, At, B0); PG_MMA(1, 1, At, B1); PG_BAR; PG_SCHED;
        }
        if (wr == 0) PG_BAR;
        E(acc, cur, wr, wc, fr, fq);
        if (!has_next) break;
#pragma unroll
        for (int a = 0; a < 2; ++a)
#pragma unroll
            for (int b = 0; b < 2; ++b)
#pragma unroll
                for (int m = 0; m < 4; ++m)
#pragma unroll
                    for (int n = 0; n < 2; ++n) acc[a][b][m][n] = (f32x4){0.f, 0.f, 0.f, 0.f};
        cur = nxt; cB = nB; ++ui;
        if (wr == 1) PG_BAR;
    }
    PG_WAIT_V(0);
    PG_BAR;
#undef PG_SA
#undef PG_SB
#undef PG_STAGE_A
#undef PG_STAGE_B
#undef PG_LDA
#undef PG_LDB
#undef PG_MMA
#undef PG_WAIT_V
#undef PG_WAIT_L
#undef PG_BAR
#undef PG_SCHED
#undef PG_AOFFS
#undef PG_BBASE
}
}

typedef float f32x2v __attribute__((ext_vector_type(2)));
typedef __bf16 bf16x2v __attribute__((ext_vector_type(2)));
__device__ __forceinline__ unsigned cvt_pk_bf16(float lo, float hi) { const f32x2v v = {lo, hi}; return __builtin_bit_cast(unsigned, __builtin_convertvector(v, bf16x2v)); }
struct EpiIn {
    static constexpr bool PERM = false;
    bf16* U; const PG_LAS float* rope;
    __device__ __forceinline__ void operator()(const f32x4 (&acc)[2][2][4][2], const pg::Unit& u, int wr, int wc, int fr, int fq) const {
        const int tb = (u.pm * 256) / TPB, p0 = u.pm * 256 - tb * TPB; const bool latent = p0 >= CTX;
#pragma unroll
        for (int ai = 0; ai < 2; ++ai)
#pragma unroll
            for (int m = 0; m < 4; ++m) {
                const int rl = ai * 128 + wr * 64 + m * 16 + fr; const int r = u.pm * 256 + rl; const int s = p0 + rl - CTX;
                bf16* rowp = U + (size_t)r * UW + u.pn * 256 + wc * 32 + 4 * fq;
#pragma unroll
                for (int bj = 0; bj < 2; ++bj) {
                    const int G = (u.pn * 256 + bj * 128 + wc * 32) >> 5;
                    f32x4 x1 = acc[ai][bj][m][0], x2 = acc[ai][bj][m][1];
                    if (G < 20) {
                        if (latent) { const int pos = (G & 1) ? (s & 63) : (s >> 6); const PG_LAS float* t = rope + (pos * 16 + 4 * fq) * 2;
                            const f32x4 t0 = *(const PG_LAS f32x4*)t, t1 = *(const PG_LAS f32x4*)(t + 4);
                            const f32x4 cs = (f32x4){t0.x, t0.z, t1.x, t1.z}, sn = (f32x4){t0.y, t0.w, t1.y, t1.w};
                            const f32x4 y1 = x1 * cs - x2 * sn, y2 = x2 * cs + x1 * sn; x1 = y1; x2 = y2; }
                        if (G < 16) { x1 = x1 * 0.125f; x2 = x2 * 0.125f; }
                    }
                    v2u o1, o2; o1.x = cvt_pk_bf16(x1.x, x1.y); o1.y = cvt_pk_bf16(x1.z, x1.w); o2.x = cvt_pk_bf16(x2.x, x2.y); o2.y = cvt_pk_bf16(x2.z, x2.w);
                    *(v2u*)(rowp + bj * 128) = o1; *(v2u*)(rowp + bj * 128 + 16) = o2;
                }
            }
    }
};
template <int CHUNK, bool INPLACE> struct EpiRes {
    static constexpr bool PERM = false;
    float* X; const float* modl; const float* xin; const float* cin; int l;
    __device__ __forceinline__ void operator()(const f32x4 (&acc)[2][2][4][2], const pg::Unit& u, int wr, int wc, int fr, int fq) const {
        const int tb = (u.pm * 256) / TPB, p0 = u.pm * 256 - tb * TPB; const int mr = p0 < CTX ? NB : tb;
        const float* mv = modl + (size_t)mr * MODW + CHUNK * D + u.pn * 256 + wc * 32 + 4 * fq;
        f32x4 mod[2][2];
#pragma unroll
        for (int bj = 0; bj < 2; ++bj)
#pragma unroll
            for (int n = 0; n < 2; ++n) mod[bj][n] = *(const f32x4*)(mv + bj * 128 + n * 16);
        const bool from_in = (!INPLACE) && l == 0;
        const int co = u.pn * 256 + wc * 32 + 4 * fq;
#pragma unroll
        for (int ai = 0; ai < 2; ++ai) {
            f32x4 bs[4][2][2];
#pragma unroll
            for (int m = 0; m < 4; ++m) {
                const int rl = ai * 128 + wr * 64 + m * 16 + fr; const int r = u.pm * 256 + rl; const int p = p0 + rl;
                const float* bp = from_in ? (p < CTX ? cin + ((size_t)tb * CTX + p) * D : xin + ((size_t)tb * SEQ + (p - CTX)) * D) : X + (size_t)r * D;
#pragma unroll
                for (int bj = 0; bj < 2; ++bj)
#pragma unroll
                    for (int n = 0; n < 2; ++n) bs[m][bj][n] = *(const f32x4*)(bp + co + bj * 128 + n * 16);
            }
#pragma unroll
            for (int m = 0; m < 4; ++m) {
                const int r = u.pm * 256 + ai * 128 + wr * 64 + m * 16 + fr;
#pragma unroll
                for (int bj = 0; bj < 2; ++bj)
#pragma unroll
                    for (int n = 0; n < 2; ++n) *(f32x4*)(X + (size_t)r * D + co + bj * 128 + n * 16) = bs[m][bj][n] + mod[bj][n] * acc[ai][bj][m][n];
            }
        }
    }
};
template <bool MOE> struct EpiSwiglu {
    static constexpr bool PERM = true;
    bf16* H; const float* roww;
    __device__ __forceinline__ void operator()(const f32x4 (&acc)[2][2][4][2], const pg::Unit& u, int wr, int wc, int fr, int fq) const {
        float rws[2][4];
#pragma unroll
        for (int ai = 0; ai < 2; ++ai)
#pragma unroll
            for (int m = 0; m < 4; ++m) rws[ai][m] = MOE ? roww[u.pm * 256 + ai * 128 + wr * 64 + m * 16 + fr] : 1.f;
#pragma unroll
        for (int ai = 0; ai < 2; ++ai)
#pragma unroll
            for (int m = 0; m < 4; ++m) {
                const int r = u.pm * 256 + ai * 128 + wr * 64 + m * 16 + fr;
                const float rw = rws[ai][m];
                f32x4 h0, h1;
#pragma unroll
                for (int j = 0; j < 4; ++j) { const float g0 = acc[ai][0][m][0][j], g1 = acc[ai][0][m][1][j];
                    h0[j] = g0 / (1.f + __expf(-g0)) * acc[ai][1][m][0][j] * rw; h1[j] = g1 / (1.f + __expf(-g1)) * acc[ai][1][m][1][j] * rw; }
                v4u w; w.x = cvt_pk_bf16(h0.x, h0.y); w.y = cvt_pk_bf16(h0.z, h0.w); w.z = cvt_pk_bf16(h1.x, h1.y); w.w = cvt_pk_bf16(h1.z, h1.w);
                *(v4u*)(H + (size_t)r * FFN + u.pn * 128 + wc * 32 + 8 * fq) = w;
            }
    }
};
struct EpiYs {
    static constexpr bool PERM = true;
    bf16* Y;
    __device__ __forceinline__ void operator()(const f32x4 (&acc)[2][2][4][2], const pg::Unit& u, int wr, int wc, int fr, int fq) const {
#pragma unroll
        for (int ai = 0; ai < 2; ++ai)
#pragma unroll
            for (int m = 0; m < 4; ++m) {
                bf16* rowp = Y + (size_t)(u.pm * 256 + ai * 128 + wr * 64 + m * 16 + fr) * D + u.pn * 256 + wc * 32 + 8 * fq;
#pragma unroll
                for (int bj = 0; bj < 2; ++bj) { const f32x4 v0 = acc[ai][bj][m][0], v1 = acc[ai][bj][m][1];
                    v4u w; w.x = cvt_pk_bf16(v0.x, v0.y); w.y = cvt_pk_bf16(v0.z, v0.w); w.z = cvt_pk_bf16(v1.x, v1.y); w.w = cvt_pk_bf16(v1.z, v1.w);
                    *(v4u*)(rowp + bj * 128) = w; }
            }
    }
};
template <int WHICH> __device__ __forceinline__ void gemm_run(const P& a_in, int l, PG_LAS unsigned char* lds, int G, int c) {
    PHASE_ENTRY(a_in)
    unsigned char* ws = a.ws; pg::Order S;
    if (WHICH == EM_IN) { S.init(T_ALL / 256, UW / 256, G, c); pg::Gemm g{(const bf16*)(ws + WS_HX), (const bf16*)(ws + WS_WIN) + (size_t)l * UW * D, D, 0, nullptr, nullptr, a.wv};
        PG_LAS float* rl = (PG_LAS float*)(lds + 131072 + 1024); const float* rg = (const float*)(ws + WS_ROPE);
        for (int i = otid(); i < 2048; i += NTHR) rl[i] = rg[i];
        __syncthreads();
        EpiIn E{(bf16*)(ws + WS_U), rl}; pg::gemm_phase<EpiIn, false, false>(lds, g, S, E); }
    if (WHICH == EM_OUT) { S.init(T_ALL / 256, D / 256, G, c); pg::Gemm g{(const bf16*)(ws + WS_MIX), (const bf16*)(ws + WS_WOUT) + (size_t)l * D * D, D, 0, nullptr, nullptr, a.wv};
        EpiRes<2, false> E{(float*)(ws + WS_X), (const float*)(ws + WS_MOD) + (size_t)l * MODR * MODW, a.x, a.ctx, l}; pg::gemm_phase<EpiRes<2, false>, false, false>(lds, g, S, E); }
    if (WHICH == EM_F1) { S.init(T_ALL / 256, 2 * FFN / 256, G, c); pg::Gemm g{(const bf16*)(ws + WS_HX), (const bf16*)(ws + WS_WF13) + (size_t)(l >> 1) * 2 * FFN * D, D, 0, nullptr, nullptr, a.wv};
        EpiSwiglu<false> E{(bf16*)(ws + WS_HID), nullptr}; pg::gemm_phase<EpiSwiglu<false>, false, false>(lds, g, S, E); }
    if (WHICH == EM_F2D) { S.init(T_ALL / 256, D / 256, G, c); pg::Gemm g{(const bf16*)(ws + WS_HID), (const bf16*)(ws + WS_WF2) + (size_t)(l >> 1) * D * FFN, FFN, 0, nullptr, nullptr, a.wv};
        EpiRes<5, true> E{(float*)(ws + WS_X), (const float*)(ws + WS_MOD) + (size_t)l * MODR * MODW, a.x, a.ctx, l}; pg::gemm_phase<EpiRes<5, true>, false, false>(lds, g, S, E); }
    if (WHICH == EM_F1M) { const int* te = (const int*)(ws + WS_TILEE); const int nt = __builtin_amdgcn_readfirstlane(te[MOE_TILES]); S.init(nt, 2 * FFN / 256, G, c);
        pg::Gemm g{(const bf16*)(ws + WS_HX), (const bf16*)(ws + WS_WE13), D, 2 * FFN, (const int*)(ws + WS_ROWT), te, a.wv};
        EpiSwiglu<true> E{(bf16*)(ws + WS_HID), (const float*)(ws + WS_ROWW)}; pg::gemm_phase<EpiSwiglu<true>, true, true>(lds, g, S, E); }
    if (WHICH == EM_F2M) { const int* te = (const int*)(ws + WS_TILEE); const int nt = __builtin_amdgcn_readfirstlane(te[MOE_TILES]); S.init(nt, D / 256, G, c);
        pg::Gemm g{(const bf16*)(ws + WS_HID), (const bf16*)(ws + WS_WE2), FFN, D, nullptr, te, a.wv};
        EpiYs E{(bf16*)(ws + WS_YS)}; pg::gemm_phase<EpiYs, false, true>(lds, g, S, E); }
}
template <int WHICH> __global__ void __launch_bounds__(NTHR, 2) k_gemm(P a, int l) {
    extern __shared__ __attribute__((aligned(16))) unsigned char smem[];
    a.wv = __builtin_amdgcn_readfirstlane(threadIdx.x >> 6);
    gemm_run<WHICH>(a, l, (PG_LAS unsigned char*)smem, (int)gridDim.x, (int)blockIdx.x);
}

typedef float f32x16 __attribute__((ext_vector_type(16)));
typedef short v4s __attribute__((ext_vector_type(4)));
constexpr int ATT_ITEMS = NB * (SEQ / 32) + NB * (CTX / 32);
constexpr int ATT_LDS = 2 * 16384 + 1024;
__device__ __forceinline__ void attn_phase(const P& a_in, int l, PG_LAS unsigned char* lds, int G, int c) {
    PHASE_ENTRY(a_in)
    const int tid = otid(), lane = tid & 63, h = __builtin_amdgcn_readfirstlane(tid >> 6), kvh = h >> 2;
    const int qr = lane & 31, hh = lane >> 5;
    const bf16* U = (const bf16*)(a.ws + WS_U); bf16* MIX = (bf16*)(a.ws + WS_MIX);
    PG_LAS float* ssq = (PG_LAS float*)(lds + 32768);
    const float sink = a.attn_sink[l * 8 + h];
    const int st_isv = (tid >> 8) & 1, st_key = (tid >> 3) & 31, st_ch = tid & 7;
    const int st_off = st_isv * 4096 + st_key * 128 + (st_isv ? ((st_ch * 16) ^ (((st_key >> 1) & 1) << 6)) : (16 * (st_ch ^ ((st_key >> 1) & 7))));
    const int st_col = (st_isv ? U_VA : U_KA) + st_ch * 8;
    const int k_row = qr * 128, k_sw = (qr >> 1) & 7;
    const int tr_q = (lane & 15) >> 2, tr_p = lane & 3, tr_g = (lane >> 4) & 1;
    for (int it = c; it < ATT_ITEMS; it += G) {
        int b, tq0, nt, ilo = 0; bool isctx;
        if (it < NB * (SEQ / 32)) { b = it >> 7; const int s0 = (it & 127) * 32; isctx = false; tq0 = b * TPB + CTX + s0;
            ilo = s0 >= 128 ? 0 : (128 - s0) / 32; int ihi = (SEQ + 96 - s0) / 32; ihi = ihi > 8 ? 8 : ihi; nt = 8 + (ihi - ilo + 1); }
        else { const int j = it - NB * (SEQ / 32); b = j >> 3; isctx = true; tq0 = b * TPB + (j & 7) * 32; nt = 8; }
        const int tb = b * TPB;
        pg::bf16x8 qf[4];
#pragma unroll
        for (int s4 = 0; s4 < 4; ++s4) qf[s4] = *(const pg::bf16x8*)(U + (size_t)(tq0 + qr) * UW + U_QA + h * 64 + 16 * s4 + 8 * hh);
        float m = sink, lsum = 0.f;
        f32x16 o0 = {}, o1 = {};
#define ATT_TILE_TOK(t) ((t) < 8 ? tb + 32 * (t) : tq0 - 128 + 32 * (ilo + (t) - 8))
        v4u g0, g1;
        { const int kt = ATT_TILE_TOK(0) + st_key; g0 = *(const v4u*)(U + (size_t)kt * UW + st_col); g1 = *(const v4u*)(U + (size_t)kt * UW + st_col + 64); }
        *(PG_LAS v4u*)(lds + st_off) = g0; *(PG_LAS v4u*)(lds + 8192 + st_off) = g1;
        __syncthreads();
        for (int t = 0; t < nt; ++t) {
            if (t + 1 < nt) { const int kt = ATT_TILE_TOK(t + 1) + st_key; g0 = *(const v4u*)(U + (size_t)kt * UW + st_col); g1 = *(const v4u*)(U + (size_t)kt * UW + st_col + 64); }
            PG_LAS unsigned char* kb = lds + (t & 1) * 16384 + kvh * 8192; PG_LAS unsigned char* vb = kb + 4096;
            f32x16 sacc = {};
#pragma unroll
            for (int s4 = 0; s4 < 4; ++s4) { const pg::bf16x8 kf = *(const PG_LAS pg::bf16x8*)(kb + k_row + 16 * ((2 * s4 + hh) ^ k_sw));
                sacc = __builtin_amdgcn_mfma_f32_32x32x16_bf16(kf, qf[s4], sacc, 0, 0, 0); }
            const int ti = (t < 8) ? -1 : ilo + t - 8;
            if (ti == 0 || ti == 8) {
#pragma unroll
                for (int i = 0; i < 16; ++i) { const int kk = (i & 3) + 8 * (i >> 2) + 4 * hh; const bool ok = (ti == 0) ? (kk >= qr) : (kk <= qr); sacc[i] = ok ? sacc[i] : -1.0e30f; }
            }
            float mt = sacc[0];
#pragma unroll
            for (int i = 1; i < 16; ++i) mt = fmaxf(mt, sacc[i]);
            mt = hmax32(mt);
            const float mn = fmaxf(m, mt), alpha = __expf(m - mn); m = mn;
            float ps = 0.f;
#pragma unroll
            for (int i = 0; i < 16; ++i) { sacc[i] = __expf(sacc[i] - mn); ps += sacc[i]; }
            lsum = lsum * alpha + ps;
#pragma unroll
            for (int i = 0; i < 16; ++i) { o0[i] *= alpha; o1[i] *= alpha; }
#pragma unroll
            for (int s2 = 0; s2 < 2; ++s2) {
                v4u pw; pw.x = cvt_pk_bf16(sacc[8 * s2 + 0], sacc[8 * s2 + 1]); pw.y = cvt_pk_bf16(sacc[8 * s2 + 2], sacc[8 * s2 + 3]);
                pw.z = cvt_pk_bf16(sacc[8 * s2 + 4], sacc[8 * s2 + 5]); pw.w = cvt_pk_bf16(sacc[8 * s2 + 6], sacc[8 * s2 + 7]);
                const pg::bf16x8 pf = __builtin_bit_cast(pg::bf16x8, pw);
#pragma unroll
                for (int dt = 0; dt < 2; ++dt) {
                    const int dbyte = 2 * (32 * dt + 16 * tr_g + 4 * tr_p);
                    const int r1 = 16 * s2 + 4 * hh + tr_q, r2 = r1 + 8;
                    const v4s v1 = __builtin_amdgcn_ds_read_tr16_b64_v4i16((PG_LAS v4s*)(vb + r1 * 128 + (dbyte ^ (((r1 >> 1) & 1) << 6))));
                    const v4s v2 = __builtin_amdgcn_ds_read_tr16_b64_v4i16((PG_LAS v4s*)(vb + r2 * 128 + (dbyte ^ (((r2 >> 1) & 1) << 6))));
                    const pg::bf16x8 vf = {v1[0], v1[1], v1[2], v1[3], v2[0], v2[1], v2[2], v2[3]};
                    if (dt == 0) o0 = __builtin_amdgcn_mfma_f32_32x32x16_bf16(vf, pf, o0, 0, 0, 0);
                    else o1 = __builtin_amdgcn_mfma_f32_32x32x16_bf16(vf, pf, o1, 0, 0, 0);
                }
            }
            if (t + 1 < nt) { PG_LAS unsigned char* nb = lds + ((t + 1) & 1) * 16384; *(PG_LAS v4u*)(nb + st_off) = g0; *(PG_LAS v4u*)(nb + 8192 + st_off) = g1; }
            __syncthreads();
        }
#undef ATT_TILE_TOK
        const float ltot = hsum32(lsum);
        const float inv = 1.f / (ltot + __expf(sink - m));
        float sq = 0.f;
#pragma unroll
        for (int i = 0; i < 16; ++i) { o0[i] *= inv; o1[i] *= inv; sq += o0[i] * o0[i] + o1[i] * o1[i]; }
        sq = hsum32(sq);
        if (hh == 0) ssq[h * 32 + qr] = sq;
        __syncthreads();
        float tot = 0.f;
#pragma unroll
        for (int w = 0; w < 8; ++w) tot += ssq[w * 32 + qr];
        const float rstd = rsqrtf(tot * (1.f / 512.f) + EPS);
        const float* ga = a.g_att + l * 512 + h * 64;
        bf16* orow = MIX + (size_t)(tq0 + qr) * D + h * 64;
#pragma unroll
        for (int dt = 0; dt < 2; ++dt)
#pragma unroll
            for (int i4 = 0; i4 < 4; ++i4) { const int d = 32 * dt + 8 * i4 + 4 * hh; const f32x4 gg = *(const f32x4*)(ga + d);
                const f32x16& oo = dt == 0 ? o0 : o1;
                v2u w; w.x = cvt_pk_bf16(oo[4 * i4 + 0] * rstd * gg.x, oo[4 * i4 + 1] * rstd * gg.y); w.y = cvt_pk_bf16(oo[4 * i4 + 2] * rstd * gg.z, oo[4 * i4 + 3] * rstd * gg.w);
                *(v2u*)(orow + d) = w; }
        __syncthreads();
    }
}
__global__ void __launch_bounds__(NTHR, 2) k_attn(P a, int l) {
    extern __shared__ __attribute__((aligned(16))) unsigned char smem[];
    a.wv = __builtin_amdgcn_readfirstlane(threadIdx.x >> 6);
    attn_phase(a, l, (PG_LAS unsigned char*)smem, (int)gridDim.x, (int)blockIdx.x);
}

__device__ __forceinline__ float scan_sum(float v, int) { return dpp_scan<false>(v); }
__device__ __forceinline__ float scan_max(float v, int) { return dpp_scan<true>(v); }
constexpr int ML_ITEMS = NB * NCHUNK;
constexpr int ML_LDS = 65536 + 65536 + 8192;
__device__ __forceinline__ void ml_load_v(const bf16* U, int tk0, PG_LAS unsigned char* lds, int tid) {
#pragma unroll
    for (int i = 0; i < 8; ++i) { const int cid = tid + 512 * i, sg = cid >> 6, r = cid & 63, hv = r >> 4, ch = r & 15;
        const v4u v = *(const v4u*)(U + (size_t)(tk0 + sg) * UW + U_VM + hv * 128 + ch * 8);
        *(PG_LAS v4u*)(lds + hv * 16384 + sg * 256 + ((ch * 16) ^ ((sg & 3) << 6))) = v; }
}
__device__ __forceinline__ float ml_tok(const bf16* U, int tk, int lo, int hi, int col) { return (tk >= lo && tk < hi) ? bf2f(U[(size_t)tk * UW + col]) : 0.f; }

__device__ __forceinline__ void ml_d1_phase(const P& a_in, int l, PG_LAS unsigned char* lds, int G, int c0) {
    PHASE_ENTRY(a_in)
    const int tid = otid(), lane = tid & 63, wave = __builtin_amdgcn_readfirstlane(tid >> 6), hd = wave >> 1, dir = wave & 1;
    const int hh = lane >> 5, lr = lane & 31, tr_q = (lane & 15) >> 2, tr_p = lane & 3, tr_g = (lane >> 4) & 1;
    const bf16* U = (const bf16*)(a.ws + WS_U); const float* GT = (const float*)(a.ws + WS_GATES);
    bf16* ST = (bf16*)(a.ws + WS_ST); float* NL = (float*)(a.ws + WS_NL); float* SC = (float*)(a.ws + WS_SC);
    PG_LAS unsigned char* kw = lds + 65536 + wave * 8192;
    const int ch = 256 + hd * 64 + lane;
    float cw[5];
#pragma unroll
    for (int j = 0; j < 5; ++j) cw[j] = a.conv_w[(l * 5 + j) * 512 + ch];
    const float cb = a.conv_b[l * 512 + ch];
    for (int item = c0; item < ML_ITEMS; item += G) {
        const int b = item / NCHUNK, c = item - b * NCHUNK, tk0 = b * TPB + 64 * c;
        const int lo = c < 4 ? b * TPB : b * TPB + CTX, hi = c < 4 ? b * TPB + CTX : (b + 1) * TPB;
        const int cc = ((b * 4 + hd) * 2 + dir) * NCHUNK + c;
        ml_load_v(U, tk0, lds, tid);
        const int t = dir ? 63 - lane : lane;
        const float li = GT[(size_t)(tk0 + t) * 16 + dir * 8 + hd], lf = logsigmoid_f(GT[(size_t)(tk0 + t) * 16 + dir * 8 + 4 + hd]);
        const float bc = scan_sum(lf, lane), bend = lane_bcast(bc, 63);
        const float g = bend - bc + li, mloc = wave_max(g), w = __expf(g - mloc);
        float xm2 = ml_tok(U, tk0 - 2, lo, hi, U_QM + ch), xm1 = ml_tok(U, tk0 - 1, lo, hi, U_QM + ch), x0 = ml_tok(U, tk0, lo, hi, U_QM + ch), x1 = ml_tok(U, tk0 + 1, lo, hi, U_QM + ch);
        float nacc = 0.f;
#pragma unroll 1
        for (int s8 = 0; s8 < 8; ++s8) {
            float kv[8];
#pragma unroll
            for (int j = 0; j < 8; ++j) { const int sg = s8 * 8 + j; const float x2 = ml_tok(U, tk0 + sg + 2, lo, hi, U_QM + ch);
                const float y = cb + cw[0] * xm2 + cw[1] * xm1 + cw[2] * x0 + cw[3] * x1 + cw[4] * x2;
                const float ws = lane_bcast(w, dir ? 63 - sg : sg);
                kv[j] = silu_f(y) * ws; nacc += kv[j]; xm2 = xm1; xm1 = x0; x0 = x1; x1 = x2; }
            v4u o; o.x = pk2(kv[0], kv[1]); o.y = pk2(kv[2], kv[3]); o.z = pk2(kv[4], kv[5]); o.w = pk2(kv[6], kv[7]);
            *(PG_LAS v4u*)(kw + lane * 128 + 16 * (s8 ^ ((lane >> 1) & 7))) = o;
        }
        NL[(size_t)cc * 64 + lane] = nacc;
        if (lane == 0) { SC[(size_t)cc * 4 + 0] = bend; SC[(size_t)cc * 4 + 1] = mloc; }
        __syncthreads();
        pg::bf16x8 af[2][4];
#pragma unroll
        for (int dt = 0; dt < 2; ++dt)
#pragma unroll
            for (int s4 = 0; s4 < 4; ++s4) { const int d = 32 * dt + lr; af[dt][s4] = *(const PG_LAS pg::bf16x8*)(kw + d * 128 + 16 * ((2 * s4 + hh) ^ ((d >> 1) & 7))); }
        PG_LAS unsigned char* vb = lds + hd * 16384;
#pragma unroll
        for (int et = 0; et < 4; ++et) {
            pg::bf16x8 bfr[4];
            const int ebyte = 2 * (32 * et + 16 * tr_g + 4 * tr_p);
#pragma unroll
            for (int s4 = 0; s4 < 4; ++s4) { const int r1 = 16 * s4 + 8 * hh + tr_q, r2 = r1 + 4;
                const v4s v1 = __builtin_amdgcn_ds_read_tr16_b64_v4i16((PG_LAS v4s*)(vb + r1 * 256 + (ebyte ^ ((r1 & 3) << 6))));
                const v4s v2 = __builtin_amdgcn_ds_read_tr16_b64_v4i16((PG_LAS v4s*)(vb + r2 * 256 + (ebyte ^ ((r2 & 3) << 6))));
                bfr[s4] = (pg::bf16x8){v1[0], v1[1], v1[2], v1[3], v2[0], v2[1], v2[2], v2[3]}; }
#pragma unroll
            for (int dt = 0; dt < 2; ++dt) {
                f32x16 acc = {};
#pragma unroll
                for (int s4 = 0; s4 < 4; ++s4) acc = __builtin_amdgcn_mfma_f32_32x32x16_bf16(af[dt][s4], bfr[s4], acc, 0, 0, 0);
                v4u o0, o1;
                o0.x = cvt_pk_bf16(acc[0], acc[1]); o0.y = cvt_pk_bf16(acc[2], acc[3]); o0.z = cvt_pk_bf16(acc[4], acc[5]); o0.w = cvt_pk_bf16(acc[6], acc[7]);
                o1.x = cvt_pk_bf16(acc[8], acc[9]); o1.y = cvt_pk_bf16(acc[10], acc[11]); o1.z = cvt_pk_bf16(acc[12], acc[13]); o1.w = cvt_pk_bf16(acc[14], acc[15]);
                bf16* dst = ST + ((size_t)cc * 8 + dt * 4 + et) * 1024 + lane * 16;
                *(v4u*)dst = o0; *(v4u*)(dst + 8) = o1;
            }
        }
        __syncthreads();
    }
}
__device__ __forceinline__ void ml_d2_phase(const P& a_in, int wg) {
    PHASE_ENTRY(a_in)
    const int tid = otid(), chain = wg >> 2, quarter = wg & 3, dir = chain & 1;
    bf16* ST = (bf16*)(a.ws + WS_ST); float* NL = (float*)(a.ws + WS_NL); float* SC = (float*)(a.ws + WS_SC);
    const bool cw = tid < 256, nw = (quarter == 0 && tid >= 256 && tid < 320);
    if (cw || nw) {
    float st[8];
#pragma unroll
    for (int j = 0; j < 8; ++j) st[j] = 0.f;
    float nst = 0.f, m = 0.f;
    const size_t unit = (size_t)(quarter * 256 + tid) * 8;
#pragma unroll 1
    for (int i0 = 0; i0 < NCHUNK; i0 += 4) {
        v4u x[4]; float nx[4], be[4], ml[4]; int cidx[4];
#pragma unroll
        for (int k = 0; k < 4; ++k) { const int i = i0 + k; const int c = dir == 0 ? i : (i < 4 ? 3 - i : 71 - i); cidx[k] = chain * NCHUNK + c;
            be[k] = SC[(size_t)cidx[k] * 4]; ml[k] = SC[(size_t)cidx[k] * 4 + 1];
            if (cw) x[k] = *(const v4u*)(ST + (size_t)cidx[k] * 8192 + unit); else nx[k] = NL[(size_t)cidx[k] * 64 + (tid - 256)]; }
#pragma unroll
        for (int k = 0; k < 4; ++k) {
            const float mn = fmaxf(be[k] + m, ml[k]), fa = __expf(be[k] + m - mn), fb = __expf(ml[k] - mn);
            if (cw) {
                v4u o; o.x = pk2(st[0], st[1]); o.y = pk2(st[2], st[3]); o.z = pk2(st[4], st[5]); o.w = pk2(st[6], st[7]);
                *(v4u*)(ST + (size_t)cidx[k] * 8192 + unit) = o;
                st[0] = fa * st[0] + fb * bf_lo(x[k].x); st[1] = fa * st[1] + fb * bf_hi(x[k].x); st[2] = fa * st[2] + fb * bf_lo(x[k].y); st[3] = fa * st[3] + fb * bf_hi(x[k].y);
                st[4] = fa * st[4] + fb * bf_lo(x[k].z); st[5] = fa * st[5] + fb * bf_hi(x[k].z); st[6] = fa * st[6] + fb * bf_lo(x[k].w); st[7] = fa * st[7] + fb * bf_hi(x[k].w);
            } else {
                NL[(size_t)cidx[k] * 64 + (tid - 256)] = nst; nst = fa * nst + fb * nx[k];
                if (tid == 256) SC[(size_t)cidx[k] * 4 + 2] = m;
            }
            m = mn;
        }
    }
    }
}
__device__ __forceinline__ void ml_d3_phase(const P& a_in, int l, PG_LAS unsigned char* lds, int G, int c0) {
    PHASE_ENTRY(a_in)
    const int tid = otid(), wave = __builtin_amdgcn_readfirstlane(tid >> 6), hd = wave >> 1, qt = wave & 1;
    const bf16* U = (const bf16*)(a.ws + WS_U); const float* GT = (const float*)(a.ws + WS_GATES);
    const bf16* ST = (const bf16*)(a.ws + WS_ST); const float* NL = (const float*)(a.ws + WS_NL); const float* SC = (const float*)(a.ws + WS_SC);
    bf16* MIX = (bf16*)(a.ws + WS_MIX);
    PG_LAS unsigned char* qtile = lds + 65536 + hd * 16384;
    PG_LAS unsigned char* ktile = qtile + 8192;
    PG_LAS float* aarr = (PG_LAS float*)(lds + 131072 + wave * 1024);
    for (int item = c0; item < ML_ITEMS; item += G) {
        int lane = tid & 63; asm volatile("" : "+v"(lane));
        const int hh = lane >> 5, lr = lane & 31, tr_q = (lane & 15) >> 2, tr_p = lane & 3, tr_g = (lane >> 4) & 1;
        const int ch = (qt ? 256 : 0) + hd * 64 + lane;
        const int tq = 32 * qt + lr;
        const int b = item / NCHUNK, c = item - b * NCHUNK, tk0 = b * TPB + 64 * c;
        const int lo = c < 4 ? b * TPB : b * TPB + CTX, hi = c < 4 ? b * TPB + CTX : (b + 1) * TPB;
        ml_load_v(U, tk0, lds, tid);
        {
            PG_LAS unsigned char* dstt = qt ? ktile : qtile;
            float cw[5];
#pragma unroll
            for (int j = 0; j < 5; ++j) cw[j] = a.conv_w[(l * 5 + j) * 512 + ch];
            const float cb = a.conv_b[l * 512 + ch], qsc = qt ? 1.f : 0.125f;
            float xm2 = ml_tok(U, tk0 - 2, lo, hi, U_QM + ch), xm1 = ml_tok(U, tk0 - 1, lo, hi, U_QM + ch), x0 = ml_tok(U, tk0, lo, hi, U_QM + ch), x1 = ml_tok(U, tk0 + 1, lo, hi, U_QM + ch);
#pragma unroll 4
            for (int sg = 0; sg < 64; ++sg) { const float x2 = ml_tok(U, tk0 + sg + 2, lo, hi, U_QM + ch);
                const float y = cb + cw[0] * xm2 + cw[1] * xm1 + cw[2] * x0 + cw[3] * x1 + cw[4] * x2;
                *(PG_LAS bf16*)(dstt + sg * 128 + 16 * ((lane >> 3) ^ ((sg >> 1) & 7)) + 2 * (lane & 7)) = (bf16)f2bf(silu_f(y) * qsc);
                xm2 = xm1; xm1 = x0; x0 = x1; x1 = x2; }
        }
        __syncthreads();
#define D3_QF(s4) ({ const int sw_ = (tq >> 1) & 7; \
            const v2u lo2_ = *(const PG_LAS v2u*)(qtile + tq * 128 + 16 * ((2 * (s4)) ^ sw_) + 8 * hh), hi2_ = *(const PG_LAS v2u*)(qtile + tq * 128 + 16 * ((2 * (s4) + 1) ^ sw_) + 8 * hh); \
            __builtin_bit_cast(pg::bf16x8, (v4u){lo2_.x, lo2_.y, hi2_.x, hi2_.y}); })
        f32x16 hs[4];
#pragma unroll
        for (int et = 0; et < 4; ++et) hs[et] = (f32x16){};
#pragma unroll 1
        for (int dir = 0; dir < 2; ++dir) {
            const int cc = ((b * 4 + hd) * 2 + dir) * NCHUNK + c;
            const float mprev = SC[(size_t)cc * 4 + 2];
            {
                const int t = dir ? 63 - lane : lane;
                const float li = GT[(size_t)(tk0 + t) * 16 + dir * 8 + hd], lf = logsigmoid_f(GT[(size_t)(tk0 + t) * 16 + dir * 8 + 4 + hd]);
                const float bc = scan_sum(lf, lane), av = li - bc, pm = scan_max(av, lane), Mv = fmaxf(mprev, pm);
                aarr[t] = av; aarr[64 + t] = Mv; aarr[128 + t] = bc;
            }
            const float Mq = aarr[64 + tq], bq = aarr[128 + tq];
            const float wq = __expf(mprev - Mq);
            float qn = 0.f;
#pragma unroll
            for (int s4 = 0; s4 < 4; ++s4) { const f32x4 n0 = *(const f32x4*)(NL + (size_t)cc * 64 + 16 * s4 + 4 * hh), n1 = *(const f32x4*)(NL + (size_t)cc * 64 + 16 * s4 + 8 + 4 * hh);
                const v4u qw = __builtin_bit_cast(v4u, D3_QF(s4));
                qn += bf_lo(qw.x) * n0.x + bf_hi(qw.x) * n0.y + bf_lo(qw.y) * n0.z + bf_hi(qw.y) * n0.w + bf_lo(qw.z) * n1.x + bf_hi(qw.z) * n1.y + bf_lo(qw.w) * n1.z + bf_hi(qw.w) * n1.w; }
            qn = hsum32(qn);
            pg::bf16x8 pf[2][2]; float psum = 0.f;
#pragma unroll
            for (int st = 0; st < 2; ++st) {
                f32x16 acc = {}; const int sg = 32 * st + lr, sw = (sg >> 1) & 7;
#pragma unroll
                for (int s4 = 0; s4 < 4; ++s4) {
                    const v2u lo2 = *(const PG_LAS v2u*)(ktile + sg * 128 + 16 * ((2 * s4) ^ sw) + 8 * hh), hi2 = *(const PG_LAS v2u*)(ktile + sg * 128 + 16 * ((2 * s4 + 1) ^ sw) + 8 * hh);
                    const pg::bf16x8 kf = __builtin_bit_cast(pg::bf16x8, (v4u){lo2.x, lo2.y, hi2.x, hi2.y});
                    acc = __builtin_amdgcn_mfma_f32_32x32x16_bf16(kf, D3_QF(s4), acc, 0, 0, 0); }
#pragma unroll
                for (int i4 = 0; i4 < 4; ++i4) { const f32x4 av = *(const PG_LAS f32x4*)(aarr + 32 * st + 8 * i4 + 4 * hh);
#pragma unroll
                    for (int j = 0; j < 4; ++j) { const int sgk = 32 * st + 8 * i4 + 4 * hh + j; const bool ok = dir ? (sgk >= tq) : (sgk <= tq);
                        const float p = ok ? acc[4 * i4 + j] * __expf(av[j] - Mq) : 0.f; acc[4 * i4 + j] = p; psum += p; } }
#pragma unroll
                for (int s2 = 0; s2 < 2; ++s2) { v4u pw; pw.x = cvt_pk_bf16(acc[8 * s2 + 0], acc[8 * s2 + 1]); pw.y = cvt_pk_bf16(acc[8 * s2 + 2], acc[8 * s2 + 3]);
                    pw.z = cvt_pk_bf16(acc[8 * s2 + 4], acc[8 * s2 + 5]); pw.w = cvt_pk_bf16(acc[8 * s2 + 6], acc[8 * s2 + 7]); pf[st][s2] = __builtin_bit_cast(pg::bf16x8, pw); }
            }
            psum = hsum32(psum);
            const float den = psum + wq * qn;
            const float rden = 1.f / fmaxf(fabsf(den), __expf(-(bq + Mq)));
            PG_LAS unsigned char* vb = lds + hd * 16384;
#pragma unroll
            for (int et = 0; et < 4; ++et) {
                f32x16 acc = {};
#pragma unroll
                for (int dt = 0; dt < 2; ++dt) { const bf16* src = ST + ((size_t)cc * 8 + dt * 4 + et) * 1024 + lane * 16;
                    const pg::bf16x8 c0f = *(const pg::bf16x8*)src, c1f = *(const pg::bf16x8*)(src + 8);
                    acc = __builtin_amdgcn_mfma_f32_32x32x16_bf16(c0f, D3_QF(2 * dt), acc, 0, 0, 0);
                    acc = __builtin_amdgcn_mfma_f32_32x32x16_bf16(c1f, D3_QF(2 * dt + 1), acc, 0, 0, 0); }
#pragma unroll
                for (int i = 0; i < 16; ++i) acc[i] *= wq;
                const int ebyte = 2 * (32 * et + 16 * tr_g + 4 * tr_p);
#pragma unroll
                for (int st = 0; st < 2; ++st)
#pragma unroll
                    for (int s2 = 0; s2 < 2; ++s2) { const int r1 = 32 * st + 16 * s2 + 4 * hh + tr_q, r2 = r1 + 8;
                        const v4s v1 = __builtin_amdgcn_ds_read_tr16_b64_v4i16((PG_LAS v4s*)(vb + r1 * 256 + (ebyte ^ ((r1 & 3) << 6))));
                        const v4s v2 = __builtin_amdgcn_ds_read_tr16_b64_v4i16((PG_LAS v4s*)(vb + r2 * 256 + (ebyte ^ ((r2 & 3) << 6))));
                        const pg::bf16x8 vf = {v1[0], v1[1], v1[2], v1[3], v2[0], v2[1], v2[2], v2[3]};
                        acc = __builtin_amdgcn_mfma_f32_32x32x16_bf16(vf, pf[st][s2], acc, 0, 0, 0); }
                hs[et] += acc * rden;
                asm volatile("" ::: "memory");
            }
        }
        float sq = 0.f;
#pragma unroll
        for (int et = 0; et < 4; ++et)
#pragma unroll
            for (int i = 0; i < 16; ++i) sq += hs[et][i] * hs[et][i];
        sq = hsum32(sq);
        const float rstd = rsqrtf(sq * (1.f / 128.f) + EPS);
        const float* gm = a.g_ml + l * 512 + hd * 128;
        const bf16* om = U + (size_t)(tk0 + tq) * UW + U_OM + hd * 128;
        bf16* orow = MIX + (size_t)(tk0 + tq) * D + 512 + hd * 128;
#pragma unroll
        for (int et = 0; et < 4; ++et)
#pragma unroll
            for (int i4 = 0; i4 < 4; ++i4) { const int e = 32 * et + 8 * i4 + 4 * hh; const f32x4 gg = *(const f32x4*)(gm + e); const v2u ov = *(const v2u*)(om + e);
                const float y0 = hs[et][4 * i4 + 0] * rstd * gg.x * sigmoid_f(bf_lo(ov.x)), y1 = hs[et][4 * i4 + 1] * rstd * gg.y * sigmoid_f(bf_hi(ov.x));
                const float y2 = hs[et][4 * i4 + 2] * rstd * gg.z * sigmoid_f(bf_lo(ov.y)), y3 = hs[et][4 * i4 + 3] * rstd * gg.w * sigmoid_f(bf_hi(ov.y));
                v2u w; w.x = cvt_pk_bf16(y0, y1); w.y = cvt_pk_bf16(y2, y3); *(v2u*)(orow + e) = w;
                if (i4 == 3) asm volatile("" ::: "memory"); }
        __syncthreads();
    }
}
__global__ void __launch_bounds__(NTHR, 2) k_ml_d1(P a, int l) { a.wv = __builtin_amdgcn_readfirstlane(threadIdx.x >> 6); extern __shared__ __attribute__((aligned(16))) unsigned char smem[]; ml_d1_phase(a, l, (PG_LAS unsigned char*)smem, (int)gridDim.x, (int)blockIdx.x); }
__global__ void __launch_bounds__(NTHR, 2) k_ml_d2(P a) { a.wv = __builtin_amdgcn_readfirstlane(threadIdx.x >> 6); ml_d2_phase(a, (int)blockIdx.x); }
__global__ void __launch_bounds__(NTHR, 2) k_ml_d3(P a, int l) { a.wv = __builtin_amdgcn_readfirstlane(threadIdx.x >> 6); extern __shared__ __attribute__((aligned(16))) unsigned char smem[]; ml_d3_phase(a, l, (PG_LAS unsigned char*)smem, (int)gridDim.x, (int)blockIdx.x); }

#define XB_TMO      128
#define XB_XCNT(j)  (256  + 64 * (j))
#define XB_XSUB(j)  (1280 + 64 * (j))
#define XB_XGEN(j)  (2304 + 64 * (j))
#define XB_TOP      3328
#define XB_TOPGEN   3392
#define XCD_BAR_WORDS 3456
#define XB_SPIN_CAP (1u << 20)
__device__ __forceinline__ unsigned xb_ld(unsigned* p)              { return __hip_atomic_load(p, __ATOMIC_RELAXED, __HIP_MEMORY_SCOPE_AGENT); }
__device__ __forceinline__ unsigned xb_add(unsigned* p, unsigned v) { return __hip_atomic_fetch_add(p, v, __ATOMIC_RELAXED, __HIP_MEMORY_SCOPE_AGENT); }
__device__ __forceinline__ unsigned xb_xcc_id() { return (unsigned)__builtin_amdgcn_s_getreg((3 << 11) | 20) & 0xFu; }
#define XB_SPIN(cond, bar) do { unsigned _sp = 0; while (cond) { __builtin_amdgcn_s_sleep(1); \
    if ((++_sp & 255u) == 0u) { if (xb_ld(&(bar)[XB_TMO])) break; if (_sp > XB_SPIN_CAP) { atomicAdd(&(bar)[XB_TMO], 1u); break; } } } } while (0)
struct XcdBarrier { unsigned* bar; unsigned x; volatile PG_LAS unsigned* st; };
__device__ __forceinline__ XcdBarrier xcd_barrier_post(unsigned* bar, volatile PG_LAS unsigned* st, int tid) {
    XcdBarrier b; b.bar = bar; b.x = xb_xcc_id(); b.st = st;
    if (tid == 0) (void)xb_add(&bar[XB_XCNT(b.x)], 1u);
    return b;
}
__device__ __forceinline__ void xcd_barrier_complete(unsigned* bar, unsigned x, unsigned& nloc, unsigned& nx) {
    const unsigned G = gridDim.x * gridDim.y * gridDim.z;
    unsigned sum, cnt, mine, sp = 0u;
    for (;;) {
        sum = 0u; cnt = 0u; mine = 0u;
#pragma unroll
        for (unsigned j = 0; j < 16; ++j) { const unsigned c = xb_ld(&bar[XB_XCNT(j)]); sum += c; cnt += (c > 0u) ? 1u : 0u; mine = (j == x) ? c : mine; }
        if (sum == G) break;
        __builtin_amdgcn_s_sleep(1);
        if ((++sp & 255u) == 0u) { if (xb_ld(&bar[XB_TMO])) break; if (sp > XB_SPIN_CAP) { atomicAdd(&bar[XB_TMO], 1u); break; } }
    }
    nloc = mine > 0u ? mine : 1u; nx = cnt > 0u ? cnt : 1u;
}
__device__ __forceinline__ void xcd_barrier(const XcdBarrier& b, int tid) {
    asm volatile("s_waitcnt vmcnt(0)" ::: "memory");
    __syncthreads();
    if (tid == 0) {
        unsigned* bar = b.bar; asm volatile("" : "+s"(bar)); unsigned bx = b.x; asm volatile("" : "+s"(bx));
        __builtin_amdgcn_s_waitcnt(0);
        unsigned nloc = b.st[0], nx = b.st[1];
        if (nloc == 0u) { xcd_barrier_complete(bar, bx, nloc, nx); b.st[0] = nloc; b.st[1] = nx; }
        const unsigned old = xb_add(&bar[XB_XSUB(bx)], 1u);
        const unsigned gen = old / nloc;
        if (old + 1u == (gen + 1u) * nloc) {
            __builtin_amdgcn_fence(__ATOMIC_RELEASE, "agent");
            asm volatile("s_waitcnt vmcnt(0)" ::: "memory");
            const unsigned og = xb_add(&bar[XB_TOP], 1u);
            const unsigned tg = og / nx;
            if (og + 1u == (tg + 1u) * nx) xb_add(&bar[XB_TOPGEN], 1u);
            else XB_SPIN(xb_ld(&bar[XB_TOPGEN]) == tg, bar);
            __builtin_amdgcn_fence(__ATOMIC_ACQUIRE, "agent");
            xb_add(&bar[XB_XGEN(bx)], 1u);
            asm volatile("s_waitcnt vmcnt(0)" ::: "memory");
        } else {
            XB_SPIN(xb_ld(&bar[XB_XGEN(bx)]) == gen, bar);
            __builtin_amdgcn_fence(__ATOMIC_ACQUIRE, "agent");
            asm volatile("s_waitcnt vmcnt(0)" ::: "memory");
        }
    }
    __syncthreads();
}
__device__ __forceinline__ void modvec_phase(const P& a_in, float* lds, int G, int c) {
    PHASE_ENTRY(a_in)
    float* cond = lds;
    float* red = lds + MODR * D;
    const int t = otid(), kg = t >> 6;
    for (int i = t; i < MODR * D; i += NTHR) { const int r = i / D, k = i % D; const float v = r < NB ? a.c[r * D + k] : a.c_ctx[k]; cond[i] = silu_f(v); }
    __syncthreads();
    float* mod = (float*)(a.ws + WS_MOD);
    for (int item = c; item < DEPTH * 96; item += G) {
        const int l = item / 96, nc = item % 96, n = nc * 64 + (t & 63);
        float acc[MODR];
#pragma unroll
        for (int r = 0; r < MODR; ++r) acc[r] = 0.f;
        const float* w = a.w_mod + (size_t)l * D * MODW + n;
#pragma unroll 4
        for (int k = kg * 128; k < kg * 128 + 128; ++k) { const float wv = w[(size_t)k * MODW];
#pragma unroll
            for (int r = 0; r < MODR; ++r) acc[r] += cond[r * D + k] * wv; }
#pragma unroll
        for (int r = 0; r < MODR; ++r) red[(kg * MODR + r) * 64 + (t & 63)] = acc[r];
        __syncthreads();
        for (int i = t; i < MODR * 64; i += NTHR) { const int r = i / 64, j = i % 64, nn = nc * 64 + j; float sacc = a.b_mod[l * MODW + nn];
#pragma unroll
            for (int q = 0; q < 8; ++q) sacc += red[(q * MODR + r) * 64 + j];
            mod[((size_t)l * MODR + r) * MODW + nn] = sacc; }
        __syncthreads();
    }
}
__device__ __forceinline__ void conv_dense_weights(const P& a_in, float* scr, int gw, int ngw, int lane) {
    PHASE_ENTRY(a_in)
    unsigned char* ws = a.ws;
#pragma unroll 1
    for (int l = 0; l < DEPTH; ++l) {
        tr_matrix(a.w_in + (size_t)l * D * INW, D, INW, UW, (bf16*)(ws + WS_WIN) + (size_t)l * UW * D, 0, scr, gw, ngw, lane);
        tr_matrix(a.w_out + (size_t)l * D * D, D, D, D, (bf16*)(ws + WS_WOUT) + (size_t)l * D * D, 0, scr, gw, ngw, lane);
    }
#pragma unroll 1
    for (int i = 0; i < 2; ++i) {
        tr_matrix(a.ffn_w1 + (size_t)i * D * FFN, D, FFN, FFN, (bf16*)(ws + WS_WF13) + (size_t)i * 2 * FFN * D, 1, scr, gw, ngw, lane);
        tr_matrix(a.ffn_w3 + (size_t)i * D * FFN, D, FFN, FFN, (bf16*)(ws + WS_WF13) + (size_t)i * 2 * FFN * D, 2, scr, gw, ngw, lane);
        tr_matrix(a.ffn_w2 + (size_t)i * FFN * D, FFN, D, D, (bf16*)(ws + WS_WF2) + (size_t)i * D * FFN, 0, scr, gw, ngw, lane);
    }
}
__device__ __forceinline__ void conv_expert_weights(const P& a_in, int li, float* scr, int gw, int ngw, int lane) {
    PHASE_ENTRY(a_in)
    unsigned char* ws = a.ws;
#pragma unroll 1
    for (int e = 0; e < NE; ++e) {
        tr_matrix(a.exp_w1 + ((size_t)li * NE + e) * D * FFN, D, FFN, FFN, (bf16*)(ws + WS_WE13) + (size_t)e * 2 * FFN * D, 1, scr, gw, ngw, lane);
        tr_matrix(a.exp_w3 + ((size_t)li * NE + e) * D * FFN, D, FFN, FFN, (bf16*)(ws + WS_WE13) + (size_t)e * 2 * FFN * D, 2, scr, gw, ngw, lane);
        tr_matrix(a.exp_w2 + ((size_t)li * NE + e) * FFN * D, FFN, D, D, (bf16*)(ws + WS_WE2) + (size_t)e * D * FFN, 0, scr, gw, ngw, lane);
    }
}
#if MEGA
constexpr int MEGA_LDS = 147456;
__global__ void __launch_bounds__(NTHR, 2) k_mega(P a_k) {
    extern __shared__ __attribute__((aligned(16))) unsigned char smem[];
    PG_LAS unsigned char* lds = (PG_LAS unsigned char*)smem;
    P a = a_k; a.wv = __builtin_amdgcn_readfirstlane(threadIdx.x >> 6);
    const int G = (int)gridDim.x, wg = (int)blockIdx.x;
    volatile PG_LAS unsigned* bst = (volatile PG_LAS unsigned*)(lds + MEGA_LDS - 16);
    if (otid() == 0) { bst[0] = 0u; bst[1] = 0u; bst[2] = 0u; bst[3] = 0u; }
    __syncthreads();
    const XcdBarrier bar = xcd_barrier_post((unsigned*)(a.ws + WS_CTL) + 1024, bst, otid());
    { const int t_ = otid(); conv_dense_weights(a, (float*)smem + (t_ >> 6) * (64 * 33), wg * 8 + (t_ >> 6), G * 8, t_ & 63); }
    __syncthreads();
    modvec_phase(a, (float*)smem, G, wg);
      { for (int i = otid(); i < 64 * 16; i += NTHR) { const int pos = i / 16, f = i % 16; const float ang = (float)pos * powf(10000.0f, -(float)f / 16.0f);
        float* t = (float*)(a.ws + WS_ROPE); t[2 * i] = cosf(ang); t[2 * i + 1] = sinf(ang); } }
    xcd_barrier(bar, otid());
#pragma unroll 1
    for (int l = 0; l < DEPTH; ++l) {
        if (l == 0) norm_phase<0, true, false>(a, l, wg, (float*)smem);
        else if (l == 2) norm_phase<0, false, true>(a, l, wg, (float*)smem);
        else norm_phase<0, false, false>(a, l, wg, (float*)smem);
        xcd_barrier(bar, otid());
        gemm_run<EM_IN>(a, l, lds, G, wg);
        xcd_barrier(bar, otid());
        attn_phase(a, l, lds, G, wg);
        ml_d1_phase(a, l, lds, G, wg);
        xcd_barrier(bar, otid());
        ml_d2_phase(a, wg);
        if ((l & 1) == 0) { __syncthreads(); const int t_ = otid(); conv_expert_weights(a, l >> 1, (float*)smem + (t_ >> 6) * (64 * 33), wg * 8 + (t_ >> 6), G * 8, t_ & 63); }
        xcd_barrier(bar, otid());
        ml_d3_phase(a, l, lds, G, wg);
        xcd_barrier(bar, otid());
        gemm_run<EM_OUT>(a, l, lds, G, wg);
        xcd_barrier(bar, otid());
        if ((l & 1) == 0) {
            norm_phase<1, false, false>(a, l, wg, (float*)smem);
            xcd_barrier(bar, otid());
            gemm_run<EM_F1>(a, l, lds, G, wg);
            xcd_barrier(bar, otid());
            gemm_run<EM_F2D>(a, l, lds, G, wg);
            xcd_barrier(bar, otid());
        } else {
            norm_phase<2, false, false>(a, l, wg, (float*)smem);
            xcd_barrier(bar, otid());
            moe_pos_phase(a, wg, (int*)smem);
            xcd_barrier(bar, otid());
            gemm_run<EM_F1M>(a, l, lds, G, wg);
            xcd_barrier(bar, otid());
            gemm_run<EM_F2M>(a, l, lds, G, wg);
            xcd_barrier(bar, otid());
        }
    }
    norm_phase<3, false, true>(a, DEPTH, wg, (float*)smem);
}
#endif

#ifndef FAST_IN
#define FAST_IN 1
#endif
#ifndef FAST_OUT
#define FAST_OUT 1
#endif
#ifndef FAST_F1
#define FAST_F1 1
#endif
#ifndef FAST_F2
#define FAST_F2 1
#endif
#ifndef FAST_F1M
#define FAST_F1M 1
#endif
#ifndef FAST_F2M
#define FAST_F2M 1
#endif
constexpr int GEMM_LDS = 131072 + 1024 + 8192;
template <int WHICH> static void launch_gemm(hipStream_t s, const P& a, int l) {
    static bool once = false;
    if (!once) { (void)hipFuncSetAttribute((const void*)k_gemm<WHICH>, hipFuncAttributeMaxDynamicSharedMemorySize, GEMM_LDS); once = true; }
    hipLaunchKernelGGL((k_gemm<WHICH>), dim3(NWG), dim3(NTHR), GEMM_LDS, s, a, l);
}
static void launch_tr(hipStream_t s, const float* W, int K, int ld, int N, bf16* WT, int mode) {
    hipLaunchKernelGGL(k_transpose, dim3(512), dim3(256), 0, s, W, K, ld, N, WT, mode);
}
extern "C" void kernel_launch(void* const* d_in, const int* in_sizes, int n_in, void* d_out, int out_size, void* d_ws, size_t ws_size, hipStream_t stream) {
    if (n_in != 25 || ws_size < WS_END) { fprintf(stderr, "kernel_launch: bad args n_in %d ws %zu need %zu\n", n_in, ws_size, (size_t)WS_END); return; }
    static bool init = false;
    constexpr int NORM_LDS = 8192 * 4 + 8 * 32 * 4 + 64;
    if (!init) {
        hipFuncSetAttribute((const void*)k_norm<0, true, false>, hipFuncAttributeMaxDynamicSharedMemorySize, NORM_LDS);
        hipFuncSetAttribute((const void*)k_norm<0, false, false>, hipFuncAttributeMaxDynamicSharedMemorySize, NORM_LDS);
        hipFuncSetAttribute((const void*)k_norm<0, false, true>, hipFuncAttributeMaxDynamicSharedMemorySize, NORM_LDS);
        hipFuncSetAttribute((const void*)k_norm<1, false, false>, hipFuncAttributeMaxDynamicSharedMemorySize, NORM_LDS);
        hipFuncSetAttribute((const void*)k_norm<2, false, false>, hipFuncAttributeMaxDynamicSharedMemorySize, NORM_LDS);
        hipFuncSetAttribute((const void*)k_norm<3, false, true>, hipFuncAttributeMaxDynamicSharedMemorySize, NORM_LDS);
        init = true;
    }
    P a{};
    const float** f = (const float**)&a;
    for (int i = 0; i < 25; ++i) f[i] = (const float*)d_in[i];
    a.out = (float*)d_out; a.ws = (unsigned char*)d_ws;
    unsigned char* ws = a.ws;
    hipMemsetAsync(ws + WS_CTL, 0, 1 * MiB, stream);
#if MEGA
    {
        static bool once = false;
        if (!once) { (void)hipFuncSetAttribute((const void*)k_mega, hipFuncAttributeMaxDynamicSharedMemorySize, MEGA_LDS); once = true; }
        hipLaunchKernelGGL(k_mega, dim3(NWG), dim3(NTHR), MEGA_LDS, stream, a);
        return;
    }
#endif
    for (int l = 0; l < DEPTH; ++l) {
        launch_tr(stream, a.w_in + (size_t)l * D * INW, D, INW, UW, (bf16*)(ws + WS_WIN) + (size_t)l * UW * D, 0);
        launch_tr(stream, a.w_out + (size_t)l * D * D, D, D, D, (bf16*)(ws + WS_WOUT) + (size_t)l * D * D, 0);
    }
    for (int i = 0; i < 2; ++i) {
        launch_tr(stream, a.ffn_w1 + (size_t)i * D * FFN, D, FFN, FFN, (bf16*)(ws + WS_WF13) + (size_t)i * 2 * FFN * D, 1);
        launch_tr(stream, a.ffn_w3 + (size_t)i * D * FFN, D, FFN, FFN, (bf16*)(ws + WS_WF13) + (size_t)i * 2 * FFN * D, 2);
        launch_tr(stream, a.ffn_w2 + (size_t)i * FFN * D, FFN, D, D, (bf16*)(ws + WS_WF2) + (size_t)i * D * FFN, 0);
    }
    hipLaunchKernelGGL(k_modvec, dim3(DEPTH * 96), dim3(256), 0, stream, a);
    hipLaunchKernelGGL(k_rope_table, dim3(4), dim3(256), 0, stream, a);
    for (int l = 0; l < DEPTH; ++l) {
        const bool moe = l & 1;
        if (l == 0) hipLaunchKernelGGL((k_norm<0, true, false>), dim3(NWG), dim3(NTHR), NORM_LDS, stream, a, l);
        else if (l == 2) hipLaunchKernelGGL((k_norm<0, false, true>), dim3(NWG), dim3(NTHR), NORM_LDS, stream, a, l);
        else hipLaunchKernelGGL((k_norm<0, false, false>), dim3(NWG), dim3(NTHR), NORM_LDS, stream, a, l);
        if (FAST_IN) launch_gemm<EM_IN>(stream, a, l);
        else {
        hipLaunchKernelGGL((k_ngemm<EM_IN>), dim3(UW / 64, T_ALL / 64), dim3(256), 0, stream, a, l, (const bf16*)(ws + WS_HX), (const bf16*)(ws + WS_WIN) + (size_t)l * UW * D, T_ALL, UW, D);
        hipLaunchKernelGGL(k_rope_apply, dim3((T_ALL * 320 + 255) / 256), dim3(256), 0, stream, a); }
#ifndef FAST_ATT
#define FAST_ATT 1
#endif
        if (FAST_ATT) hipLaunchKernelGGL(k_attn, dim3(NWG), dim3(NTHR), ATT_LDS, stream, a, l);
        else hipLaunchKernelGGL(k_attn_naive, dim3(T_ALL), dim3(512), 0, stream, a, l);
#ifndef FAST_ML
#define FAST_ML 1
#endif
        if (FAST_ML) {
            static bool once = false;
            if (!once) { (void)hipFuncSetAttribute((const void*)k_ml_d1, hipFuncAttributeMaxDynamicSharedMemorySize, ML_LDS); (void)hipFuncSetAttribute((const void*)k_ml_d3, hipFuncAttributeMaxDynamicSharedMemorySize, ML_LDS); once = true; }
            hipLaunchKernelGGL(k_ml_d1, dim3(NWG), dim3(NTHR), ML_LDS, stream, a, l);
            hipLaunchKernelGGL(k_ml_d2, dim3(NWG), dim3(NTHR), 0, stream, a);
            hipLaunchKernelGGL(k_ml_d3, dim3(NWG), dim3(NTHR), ML_LDS, stream, a, l);
        } else {
        hipLaunchKernelGGL(k_mlstm_naive, dim3(64), dim3(256), 0, stream, a, l);
        hipLaunchKernelGGL(k_merge_naive, dim3(T_ALL), dim3(256), 0, stream, a, l); }
        if (FAST_OUT) launch_gemm<EM_OUT>(stream, a, l);
        else hipLaunchKernelGGL((k_ngemm<EM_OUT>), dim3(D / 64, T_ALL / 64), dim3(256), 0, stream, a, l, (const bf16*)(ws + WS_MIX), (const bf16*)(ws + WS_WOUT) + (size_t)l * D * D, T_ALL, D, D);
        if (!moe) {
            hipLaunchKernelGGL((k_norm<1, false, false>), dim3(NWG), dim3(NTHR), NORM_LDS, stream, a, l);
            if (FAST_F1) launch_gemm<EM_F1>(stream, a, l);
            else hipLaunchKernelGGL((k_ngemm<EM_F1>), dim3(FFN / 64, T_ALL / 64), dim3(256), 0, stream, a, l, (const bf16*)(ws + WS_HX), (const bf16*)(ws + WS_WF13) + (size_t)(l >> 1) * 2 * FFN * D, T_ALL, FFN, D);
            if (FAST_F2) launch_gemm<EM_F2D>(stream, a, l);
            else hipLaunchKernelGGL((k_ngemm<EM_F2D>), dim3(D / 64, T_ALL / 64), dim3(256), 0, stream, a, l, (const bf16*)(ws + WS_HID), (const bf16*)(ws + WS_WF2) + (size_t)(l >> 1) * D * FFN, T_ALL, D, FFN);
        } else {
            const int li = l >> 1;
            for (int e = 0; e < NE; ++e) {
                launch_tr(stream, a.exp_w1 + ((size_t)li * NE + e) * D * FFN, D, FFN, FFN, (bf16*)(ws + WS_WE13) + (size_t)e * 2 * FFN * D, 1);
                launch_tr(stream, a.exp_w3 + ((size_t)li * NE + e) * D * FFN, D, FFN, FFN, (bf16*)(ws + WS_WE13) + (size_t)e * 2 * FFN * D, 2);
                launch_tr(stream, a.exp_w2 + ((size_t)li * NE + e) * FFN * D, FFN, D, D, (bf16*)(ws + WS_WE2) + (size_t)e * D * FFN, 0);
            }
            hipLaunchKernelGGL((k_norm<2, false, false>), dim3(NWG), dim3(NTHR), NORM_LDS, stream, a, l);
            hipLaunchKernelGGL(k_moe_pos, dim3(NWG), dim3(NTHR), 16384, stream, a);
            if (FAST_F1M) launch_gemm<EM_F1M>(stream, a, l);
            else hipLaunchKernelGGL((k_ngemm<EM_F1M>), dim3(FFN / 64, MOE_ROWS / 64), dim3(256), 0, stream, a, l, (const bf16*)(ws + WS_HX), (const bf16*)(ws + WS_WE13), MOE_ROWS, FFN, D);
            if (FAST_F2M) launch_gemm<EM_F2M>(stream, a, l);
            else hipLaunchKernelGGL((k_ngemm<EM_F2M>), dim3(D / 64, MOE_ROWS / 64), dim3(256), 0, stream, a, l, (const bf16*)(ws + WS_HID), (const bf16*)(ws + WS_WE2), MOE_ROWS, D, FFN);
        }
    }
    hipLaunchKernelGGL((k_norm<3, false, true>), dim3(NWG), dim3(NTHR), NORM_LDS, stream, a, DEPTH);
}
```

```cpp
#include <hip/hip_runtime.h>
#include <cstdio>
#include <cstdint>

#ifndef MEGA
#define MEGA 1
#endif
#ifndef PROBE
#define PROBE 0
#endif
typedef unsigned short bf16;
#define PG_LAS __attribute__((address_space(3)))
typedef unsigned v4u __attribute__((ext_vector_type(4)));
typedef unsigned v2u __attribute__((ext_vector_type(2)));
typedef float f32x4 __attribute__((ext_vector_type(4)));

constexpr int D = 1024, NB = 8, SEQ = 4096, CTX = 256, TPB = SEQ + CTX, T_ALL = NB * TPB, DEPTH = 4;
constexpr int INW = 2320, UW = 2304, FFN = 2816, NE = 8;
constexpr int U_QA = 0, U_KA = 512, U_VA = 640, U_QM = 768, U_KM = 1024, U_VM = 1280, U_OM = 1792;
constexpr int MODW = 6 * D, MODR = NB + 1;
constexpr int MOE_ROWS = 2 * T_ALL + NE * 256;
constexpr int MOE_TILES = MOE_ROWS / 256;
constexpr float EPS = 1e-6f;
constexpr int NWG = 256, NTHR = 512;
constexpr int ROWS_PER_WG = T_ALL / NWG;

constexpr size_t MiB = 1u << 20;
constexpr size_t al(size_t x) { return (x + 255) & ~(size_t)255; }
constexpr size_t WS_CTL = 0;
constexpr size_t WS_ROPE = 1 * MiB;
constexpr size_t WS_MOD = WS_ROPE + 65536;
constexpr size_t WS_TOKE = al(WS_MOD + (size_t)DEPTH * MODR * MODW * 4);
constexpr size_t WS_TOKW = al(WS_TOKE + (size_t)T_ALL * 8);
constexpr size_t WS_TOKP = al(WS_TOKW + (size_t)T_ALL * 8);
constexpr size_t WS_ROWT = al(WS_TOKP + (size_t)T_ALL * 8);
constexpr size_t WS_ROWW = al(WS_ROWT + (size_t)MOE_ROWS * 4);
constexpr size_t WS_TILEE = al(WS_ROWW + (size_t)MOE_ROWS * 4);
constexpr size_t WS_CNT = al(WS_TILEE + 4096);
constexpr size_t WS_GATES = al(WS_CNT + (size_t)NWG * 8 * 4);
constexpr size_t WS_WIN = al(WS_GATES + (size_t)T_ALL * 16 * 4);
constexpr size_t WS_WOUT = al(WS_WIN + (size_t)DEPTH * UW * D * 2);
constexpr size_t WS_WF13 = al(WS_WOUT + (size_t)DEPTH * D * D * 2);
constexpr size_t WS_WF2 = al(WS_WF13 + (size_t)2 * 2 * FFN * D * 2);
constexpr size_t WS_WE2 = al(WS_WF2 + (size_t)2 * D * FFN * 2);
constexpr size_t WS_WE13 = al(WS_WE2 + (size_t)NE * D * FFN * 2);
constexpr size_t WS_YS = WS_WE13;
constexpr size_t WS_HX = al(WS_YS + (size_t)MOE_ROWS * D * 2);
constexpr size_t WS_X = al(WS_HX + (size_t)T_ALL * D * 2);
constexpr size_t WS_BIG = al(WS_X + (size_t)T_ALL * D * 4);
static_assert(WS_YS + (size_t)MOE_ROWS * D * 2 <= WS_HX && WS_WE13 + (size_t)NE * 2 * FFN * D * 2 <= WS_HX, "YS overlay");
constexpr size_t WS_U = WS_BIG;
constexpr size_t WS_MIX = al(WS_U + (size_t)T_ALL * UW * 2);
constexpr size_t WS_HDIR = al(WS_MIX + (size_t)T_ALL * D * 2);
constexpr int NCHUNK = TPB / 64, NCHAIN = NB * 4 * 2;
constexpr size_t WS_ST = WS_HDIR;
constexpr size_t WS_NL = al(WS_ST + (size_t)NCHAIN * NCHUNK * 16384);
constexpr size_t WS_SC = al(WS_NL + (size_t)NCHAIN * NCHUNK * 64 * 4);
constexpr size_t WS_HID = WS_BIG;
constexpr size_t WS_END = al(WS_BIG + (size_t)MOE_ROWS * FFN * 2);
static_assert(WS_HDIR + (size_t)2 * T_ALL * 512 * 4 <= WS_END && WS_SC + (size_t)NCHAIN * NCHUNK * 16 <= WS_END, "HDIR / state buffers fit");

struct P {
    const float *x, *c, *ctx, *c_ctx, *norm1_g, *norm2_g, *w_mod, *b_mod, *w_in, *conv_w, *conv_b, *b_gates, *attn_sink, *g_att, *g_ml, *w_out,
        *ffn_w1, *ffn_w3, *ffn_w2, *w_router, *b_router, *exp_w1, *exp_w3, *exp_w2, *final_g;
    float* out;
    unsigned char* ws;
    int wv, pad;
};

__device__ __forceinline__ unsigned f2bf(float f) { unsigned u = __builtin_bit_cast(unsigned, f); return (u + 0x7fffu + ((u >> 16) & 1u)) >> 16; }
__device__ __forceinline__ unsigned pk2(float lo, float hi) { return f2bf(lo) | (f2bf(hi) << 16); }
typedef float f32x2v __attribute__((ext_vector_type(2)));
typedef __bf16 bf16x2v __attribute__((ext_vector_type(2)));
__device__ __forceinline__ unsigned cvt_pk_bf16(float lo, float hi) { const f32x2v v = {lo, hi}; return __builtin_bit_cast(unsigned, __builtin_convertvector(v, bf16x2v)); }
__device__ __forceinline__ float bf_lo(unsigned w) { return __builtin_bit_cast(float, w << 16); }
__device__ __forceinline__ float bf_hi(unsigned w) { return __builtin_bit_cast(float, w & 0xffff0000u); }
__device__ __forceinline__ float bf2f(bf16 h) { return __builtin_bit_cast(float, (unsigned)h << 16); }
#ifndef XLANE_OLD
#define XLANE_OLD 0
#endif
#if XLANE_OLD
template <int M> __device__ __forceinline__ float swz_xor(float v) { return __shfl_xor(v, M); }
__device__ __forceinline__ float hsum32(float v) { return v + __shfl_xor(v, 32); }
__device__ __forceinline__ float hmax32(float v) { return fmaxf(v, __shfl_xor(v, 32)); }
__device__ __forceinline__ float wave_sum(float v) {
#pragma unroll
    for (int o = 1; o < 64; o <<= 1) v += __shfl_xor(v, o);
    return v;
}
__device__ __forceinline__ float wave_max(float v) {
#pragma unroll
    for (int o = 1; o < 64; o <<= 1) v = fmaxf(v, __shfl_xor(v, o));
    return v;
}
__device__ __forceinline__ float lane_bcast(float v, int src) { return __shfl(v, src); }
template <int OFF> __device__ __forceinline__ float xchg_xor(float v, bool) { return __shfl_xor(v, OFF); }
template <bool MAXOP> __device__ __forceinline__ float dpp_scan(float v) {
    const int lane = (int)__builtin_amdgcn_mbcnt_hi(~0u, __builtin_amdgcn_mbcnt_lo(~0u, 0u));
#pragma unroll
    for (int o = 1; o < 64; o <<= 1) { const float y = __shfl_up(v, o); if (lane >= o) v = MAXOP ? fmaxf(v, y) : v + y; }
    return v;
}
#else
template <int M> __device__ __forceinline__ float swz_xor(float v) { return __builtin_bit_cast(float, __builtin_amdgcn_ds_swizzle(__builtin_bit_cast(int, v), 0x1f | (M << 10))); }
struct HalfSwap { float a, b; };
__device__ __forceinline__ HalfSwap half_swap(float v) {
    float x = v, y = v;
    asm volatile("s_nop 1\n\tv_permlane32_swap_b32 %0, %1\n\ts_nop 0" : "+v"(x), "+v"(y));
    return HalfSwap{x, y};
}
__device__ __forceinline__ float hsum32(float v) { const HalfSwap r = half_swap(v); return r.a + r.b; }
__device__ __forceinline__ float hmax32(float v) { const HalfSwap r = half_swap(v); return fmaxf(r.a, r.b); }
__device__ __forceinline__ float wave_sum(float v) { v += swz_xor<1>(v); v += swz_xor<2>(v); v += swz_xor<4>(v); v += swz_xor<8>(v); v += swz_xor<16>(v); return hsum32(v); }
__device__ __forceinline__ float wave_max(float v) { v = fmaxf(v, swz_xor<1>(v)); v = fmaxf(v, swz_xor<2>(v)); v = fmaxf(v, swz_xor<4>(v)); v = fmaxf(v, swz_xor<8>(v)); v = fmaxf(v, swz_xor<16>(v)); return hmax32(v); }
__device__ __forceinline__ float lane_bcast(float v, int src) { return __builtin_bit_cast(float, __builtin_amdgcn_readlane(__builtin_bit_cast(int, v), src)); }
template <int OFF> __device__ __forceinline__ float xchg_xor(float v, bool up) {
    if constexpr (OFF == 32) { const HalfSwap r = half_swap(v); return up ? r.a : r.b; }
    else return swz_xor<OFF>(v);
}
#define DPP_STEP(ctrl, rm) { const float t_ = __builtin_bit_cast(float, __builtin_amdgcn_update_dpp(__builtin_bit_cast(int, idv), __builtin_bit_cast(int, v), ctrl, rm, 0xf, false)); v = MAXOP ? fmaxf(v, t_) : v + t_; }
template <bool MAXOP> __device__ __forceinline__ float dpp_scan(float v) {
    const float idv = MAXOP ? -3.0e38f : 0.f;
    DPP_STEP(0x111, 0xf) DPP_STEP(0x112, 0xf) DPP_STEP(0x114, 0xf) DPP_STEP(0x118, 0xf) DPP_STEP(0x142, 0xa) DPP_STEP(0x143, 0xc)
    return v;
}
#endif
template <int N, int OFF> struct RS { static __device__ __forceinline__ float run(float (&v)[N], int lane) {
    constexpr int H = N / 2; float w[H]; const bool up = (lane & OFF) != 0;
#pragma unroll
    for (int i = 0; i < H; ++i) { const float keep = up ? v[i + H] : v[i], send = up ? v[i] : v[i + H]; w[i] = keep + xchg_xor<OFF>(send, up); }
    return RS<H, OFF / 2>::run(w, lane); } };
template <int OFF> struct RS<1, OFF> { static __device__ __forceinline__ float run(float (&v)[1], int lane) { float x = v[0];
    if constexpr (OFF >= 16) x += swz_xor<16>(x);
    if constexpr (OFF >= 8) x += swz_xor<8>(x);
    if constexpr (OFF >= 4) x += swz_xor<4>(x);
    if constexpr (OFF >= 2) x += swz_xor<2>(x);
    if constexpr (OFF >= 1) x += swz_xor<1>(x);
    return x; } };
__device__ __forceinline__ float silu_f(float x) { return x * __builtin_amdgcn_rcpf(1.f + __expf(-x)); }
__device__ __forceinline__ float sigmoid_f(float x) { return __builtin_amdgcn_rcpf(1.f + __expf(-x)); }
__device__ __forceinline__ float logsigmoid_f(float x) { return fminf(x, 0.f) - log1pf(__expf(-fabsf(x))); }
__device__ __forceinline__ int tk_modrow(int tk) { const int b = tk / TPB, p = tk - b * TPB; return p < CTX ? NB : b; }
__device__ __forceinline__ const float* in_row(const P& a, int tk) {
    const int b = tk / TPB, p = tk - b * TPB;
    return p < CTX ? a.ctx + ((size_t)b * CTX + p) * D : a.x + ((size_t)b * SEQ + (p - CTX)) * D;
}

__device__ __forceinline__ int otid_w(int wv) { int t; asm volatile("v_mbcnt_lo_u32_b32 %0, -1, 0\n\tv_mbcnt_hi_u32_b32 %0, -1, %0\n\ts_nop 0\n\tv_lshl_add_u32 %0, %1, 6, %0" : "=&v"(t) : "s"(wv)); return t; }
#define otid() otid_w(a.wv)
#define PHASE_ENTRY(a_in) P a = a_in; { unsigned long long z_ = 0; asm volatile("" : "+s"(z_)); a.ws = a_in.ws + z_; }
__device__ __forceinline__ void tr_item(const float* W, int K, int ld, int N, bf16* WT, int mode, float* scr, int item, int lane) {
    const int nblk = N / 32, kb = item / nblk, nb = item % nblk, k0 = 64 * kb, n0 = 32 * nb;
#pragma unroll
    for (int i = 0; i < 8; ++i) { const int kk = 8 * i + (lane >> 3), nn = 4 * (lane & 7);
        const f32x4 v = *(const f32x4*)(W + (size_t)(k0 + kk) * ld + n0 + nn);
        float* d = scr + kk * 33 + nn; d[0] = v.x; d[1] = v.y; d[2] = v.z; d[3] = v.w; }
    __builtin_amdgcn_s_waitcnt(0xC07F); asm volatile("" ::: "memory");
    const int c = lane & 7;
    const int d0 = mode == 0 ? n0 : ((n0 >> 7) * 256 + (mode == 2 ? 128 : 0) + (n0 & 127));
#pragma unroll
    for (int j = 0; j < 4; ++j) { const int n = (lane >> 3) + 8 * j; const float* s = scr + (8 * c) * 33 + n;
        v4u o; o.x = pk2(s[0 * 33], s[1 * 33]); o.y = pk2(s[2 * 33], s[3 * 33]); o.z = pk2(s[4 * 33], s[5 * 33]); o.w = pk2(s[6 * 33], s[7 * 33]);
        *(v4u*)(WT + (size_t)(d0 + n) * K + k0 + 8 * c) = o; }
    __builtin_amdgcn_s_waitcnt(0xC07F); asm volatile("" ::: "memory");
}
__device__ __forceinline__ void tr_matrix(const float* W, int K, int ld, int N, bf16* WT, int mode, float* scr, int gw, int ngw, int lane) {
    const int items = (K / 64) * (N / 32);
    for (int it = gw; it < items; it += ngw) tr_item(W, K, ld, N, WT, mode, scr, it, lane);
}
__global__ void __launch_bounds__(256) k_transpose(const float* W, int K, int ld, int N, bf16* WT, int mode) {
    __shared__ float scr[4][64 * 33];
    const int wave = threadIdx.x >> 6, lane = threadIdx.x & 63;
    tr_matrix(W, K, ld, N, WT, mode, scr[wave], blockIdx.x * 4 + wave, gridDim.x * 4, lane);
}
__global__ void __launch_bounds__(256) k_modvec(P a) {
    __shared__ float cond[MODR][D];
    __shared__ float red[4][MODR][64];
    const int l = blockIdx.x / 96, nc = blockIdx.x % 96, t = threadIdx.x, kg = t >> 6, n = nc * 64 + (t & 63);
    for (int i = t; i < MODR * D; i += 256) { const int r = i / D, k = i % D; const float v = r < NB ? a.c[r * D + k] : a.c_ctx[k]; cond[r][k] = silu_f(v); }
    __syncthreads();
    float acc[MODR];
#pragma unroll
    for (int r = 0; r < MODR; ++r) acc[r] = 0.f;
    const float* w = a.w_mod + (size_t)l * D * MODW + n;
    for (int k = kg * 256; k < kg * 256 + 256; ++k) { const float wv = w[(size_t)k * MODW];
#pragma unroll
        for (int r = 0; r < MODR; ++r) acc[r] += cond[r][k] * wv; }
#pragma unroll
    for (int r = 0; r < MODR; ++r) red[kg][r][t & 63] = acc[r];
    __syncthreads();
    float* mod = (float*)(a.ws + WS_MOD);
    for (int i = t; i < MODR * 64; i += 256) { const int r = i / 64, j = i % 64; const int nn = nc * 64 + j;
        mod[((size_t)l * MODR + r) * MODW + nn] = red[0][r][j] + red[1][r][j] + red[2][r][j] + red[3][r][j] + a.b_mod[l * MODW + nn]; }
}
__global__ void k_rope_table(P a) {
    const int i = blockIdx.x * blockDim.x + threadIdx.x; if (i >= 64 * 16) return;
    const int pos = i / 16, f = i % 16; const float inv = powf(10000.0f, -(float)f / 16.0f); const float ang = (float)pos * inv;
    float* t = (float*)(a.ws + WS_ROPE); t[2 * i] = cosf(ang); t[2 * i + 1] = sinf(ang);
}

template <int MODE, bool SRC_IN, bool COMBINE>
__device__ __forceinline__ void norm_phase(const P& a_in, int l, int wg, PG_LAS float* lds) {
    PHASE_ENTRY(a_in)
    const int tid = otid(), lane = tid & 63, wave = tid >> 6;
    float* X = (float*)(a.ws + WS_X); bf16* HX = (bf16*)(a.ws + WS_HX); const float* MOD = (const float*)(a.ws + WS_MOD);
    PG_LAS float* wl = lds; PG_LAS unsigned* wlu = (PG_LAS unsigned*)lds;
    PG_LAS int* cnt_l = (PG_LAS int*)(lds + 8192 + 8 * 32);
    if (MODE == 0) {
        for (int i = tid; i < D * 2; i += NTHR) { const int c = i >> 1, hf = i & 1; const float* wp = a.w_in + ((size_t)l * D + c) * INW + UW + 8 * hf;
            const f32x4 w0 = *(const f32x4*)wp, w1 = *(const f32x4*)(wp + 4);
            const int j = c >> 8, ln = (c >> 2) & 63, ii = c & 3; v4u o; o.x = pk2(w0.x, w0.y); o.y = pk2(w0.z, w0.w); o.z = pk2(w1.x, w1.y); o.w = pk2(w1.z, w1.w);
            *(PG_LAS v4u*)(wlu + ((((j * 4 + ii) * 2 + hf) * 64 + ln) * 4)) = o; }
    }
    if (MODE == 2) {
        for (int i = tid; i < D * 2; i += NTHR) { const int c = i >> 1, g4 = i & 1; const f32x4 w = *(const f32x4*)(a.w_router + ((size_t)(l >> 1) * D + c) * NE + 4 * g4);
            const int j = c >> 8, ln = (c >> 2) & 63, ii = c & 3; *(PG_LAS f32x4*)(wl + ((((j * 4 + ii) * 2 + g4) * 64 + ln) * 4)) = w; }
        if (tid < NE) cnt_l[tid] = 0;
    }
    if (MODE == 0 || MODE == 2) __syncthreads();
    const float* gvec = MODE == 0 ? a.norm1_g + l * D : (MODE == 3 ? a.final_g : a.norm2_g + l * D);
    f32x4 gv[4];
#pragma unroll
    for (int j = 0; j < 4; ++j) gv[j] = *(const f32x4*)(gvec + 256 * j + 4 * lane);
    const int row0 = wg * ROWS_PER_WG + wave * 17;
    int mr_c = -1; f32x4 cA[4], cB[4];
#pragma unroll
    for (int j = 0; j < 4; ++j) { cA[j] = (f32x4){0.f, 0.f, 0.f, 0.f}; cB[j] = cA[j]; }
#pragma unroll 1
    for (int grp = 0; grp < 9; ++grp) {
        f32x4 h[2][4];
        int tks[2]; bool valid[2], dead[2];
#pragma unroll
        for (int r = 0; r < 2; ++r) {
            const int ri = grp * 2 + r; valid[r] = ri < 17; const int tk = row0 + (valid[r] ? ri : 0); tks[r] = tk;
            const int b = tk / TPB, p = tk - b * TPB, mr = p < CTX ? NB : b; dead[r] = (MODE == 2 && l == DEPTH - 1 && p < CTX);
            const float* xr = SRC_IN ? in_row(a, tk) : X + (size_t)tk * D;
            f32x4 xv[4];
#pragma unroll
            for (int j = 0; j < 4; ++j) xv[j] = *(const f32x4*)(xr + 256 * j + 4 * lane);
            if (COMBINE) {
                const int* tp = (const int*)(a.ws + WS_TOKP) + 2 * tk; const int p0 = min(max(tp[0], 0), MOE_ROWS - 1), p1 = min(max(tp[1], 0), MOE_ROWS - 1);
                const bf16* ys = (const bf16*)(a.ws + WS_YS); const float* m5 = MOD + ((size_t)(l - 1) * MODR + mr) * MODW + 5 * D;
#pragma unroll
                for (int j = 0; j < 4; ++j) { const v2u y0 = *(const v2u*)(ys + (size_t)p0 * D + 256 * j + 4 * lane), y1 = *(const v2u*)(ys + (size_t)p1 * D + 256 * j + 4 * lane);
                    const f32x4 mv = *(const f32x4*)(m5 + 256 * j + 4 * lane);
                    xv[j].x += mv.x * (bf_lo(y0.x) + bf_lo(y1.x)); xv[j].y += mv.y * (bf_hi(y0.x) + bf_hi(y1.x));
                    xv[j].z += mv.z * (bf_lo(y0.y) + bf_lo(y1.y)); xv[j].w += mv.w * (bf_hi(y0.y) + bf_hi(y1.y));
                    if (valid[r] && MODE != 3) *(f32x4*)(X + (size_t)tk * D + 256 * j + 4 * lane) = xv[j]; }
            }
            float ss = 0.f;
#pragma unroll
            for (int j = 0; j < 4; ++j) ss += (xv[j].x * xv[j].x + xv[j].y * xv[j].y) + (xv[j].z * xv[j].z + xv[j].w * xv[j].w);
            const float rstd = rsqrtf(wave_sum(ss) * (1.f / D) + EPS);
            if (MODE == 3) {
                if (valid[r] && p >= CTX) { float* o = a.out + ((size_t)b * SEQ + (p - CTX)) * D;
#pragma unroll
                    for (int j = 0; j < 4; ++j) *(f32x4*)(o + 256 * j + 4 * lane) = xv[j] * rstd * gv[j]; }
            } else {
                if (mr != mr_c) {
                    mr_c = mr; const float* mrow = MOD + ((size_t)l * MODR + mr) * MODW;
                    const float* shp = mrow + (MODE == 0 ? 0 : 3) * D; const float* scp = mrow + (MODE == 0 ? 1 : 4) * D;
#pragma unroll
                    for (int j = 0; j < 4; ++j) { const f32x4 sh = *(const f32x4*)(shp + 256 * j + 4 * lane), sc = *(const f32x4*)(scp + 256 * j + 4 * lane); cA[j] = gv[j] * (sc + 1.f); cB[j] = sh; }
                }
#pragma unroll
                for (int j = 0; j < 4; ++j) {
                    h[r][j] = xv[j] * rstd * cA[j] + cB[j];
                    if (valid[r]) { v2u o; o.x = cvt_pk_bf16(h[r][j].x, h[r][j].y); o.y = cvt_pk_bf16(h[r][j].z, h[r][j].w); *(v2u*)(HX + (size_t)tk * D + 256 * j + 4 * lane) = o; } }
            }
        }
        if (MODE == 0) {
            float acc[2][16];
#pragma unroll
            for (int r = 0; r < 2; ++r)
#pragma unroll
                for (int g = 0; g < 16; ++g) acc[r][g] = 0.f;
#pragma unroll
            for (int j = 0; j < 4; ++j)
#pragma unroll
                for (int ii = 0; ii < 4; ++ii) {
#pragma unroll
                    for (int hf = 0; hf < 2; ++hf) { const v4u w = *(const PG_LAS v4u*)(wlu + ((((j * 4 + ii) * 2 + hf) * 64 + lane) * 4));
#pragma unroll
                        for (int r = 0; r < 2; ++r) { const float hv = h[r][j][ii];
                            acc[r][8 * hf + 0] += hv * bf_lo(w.x); acc[r][8 * hf + 1] += hv * bf_hi(w.x); acc[r][8 * hf + 2] += hv * bf_lo(w.y); acc[r][8 * hf + 3] += hv * bf_hi(w.y);
                            acc[r][8 * hf + 4] += hv * bf_lo(w.z); acc[r][8 * hf + 5] += hv * bf_hi(w.z); acc[r][8 * hf + 6] += hv * bf_lo(w.w); acc[r][8 * hf + 7] += hv * bf_hi(w.w); } }
                    asm volatile("" ::: "memory"); }
            float flat[32];
#pragma unroll
            for (int r = 0; r < 2; ++r)
#pragma unroll
                for (int g = 0; g < 16; ++g) flat[r * 16 + g] = acc[r][g];
            const float sum = RS<32, 32>::run(flat, lane);
            { const int idx = (lane >> 1) & 31, r = idx >> 4, g = idx & 15;
              float v = sum + a.b_gates[l * 16 + g]; v = 15.f * tanhf(v * (1.f / 15.f));
              const int ri = grp * 2 + r;
              if ((lane & 1) == 0 && ri < 17) ((float*)(a.ws + WS_GATES))[(size_t)(row0 + ri) * 16 + g] = v; }
        }
        if (MODE == 2) {
            float acc[2][8];
#pragma unroll
            for (int r = 0; r < 2; ++r)
#pragma unroll
                for (int g = 0; g < 8; ++g) acc[r][g] = 0.f;
#pragma unroll
            for (int j = 0; j < 4; ++j)
#pragma unroll
                for (int ii = 0; ii < 4; ++ii) {
#pragma unroll
                    for (int g4 = 0; g4 < 2; ++g4) { const f32x4 w = *(const PG_LAS f32x4*)(wl + ((((j * 4 + ii) * 2 + g4) * 64 + lane) * 4));
#pragma unroll
                        for (int r = 0; r < 2; ++r) { const float hv = h[r][j][ii]; acc[r][4 * g4 + 0] += hv * w.x; acc[r][4 * g4 + 1] += hv * w.y; acc[r][4 * g4 + 2] += hv * w.z; acc[r][4 * g4 + 3] += hv * w.w; } }
                    asm volatile("" ::: "memory"); }
            float flat[16];
#pragma unroll
            for (int r = 0; r < 2; ++r)
#pragma unroll
                for (int g = 0; g < 8; ++g) flat[r * 8 + g] = acc[r][g];
            const float sum = RS<16, 32>::run(flat, lane);
#pragma unroll
            for (int r = 0; r < 2; ++r) {
                float lg[8];
#pragma unroll
                for (int g = 0; g < 8; ++g) { const float v = lane_bcast(sum, (r * 8 + g) << 2) + a.b_router[(l >> 1) * NE + g]; lg[g] = (v == v) ? fminf(fmaxf(v, -1.0e30f), 1.0e30f) : -1.0e30f; }
                int e0 = 0; float v0 = lg[0];
#pragma unroll
                for (int g = 1; g < 8; ++g) if (lg[g] > v0) { v0 = lg[g]; e0 = g; }
                int e1 = (e0 + 1) & 7; float v1 = -3.0e38f;
#pragma unroll
                for (int g = 0; g < 8; ++g) if (g != e0 && lg[g] > v1) { v1 = lg[g]; e1 = g; }
                const float w0 = 1.f / (1.f + __expf(v1 - v0)), w1 = 1.f - w0;
                if (lane == 0 && valid[r]) { const int tk = tks[r];
                    int* te = (int*)(a.ws + WS_TOKE) + 2 * tk; te[0] = dead[r] ? -1 : e0; te[1] = dead[r] ? -1 : e1; }
                if (lane == 0 && valid[r] && !dead[r]) { const int tk = tks[r];
                    float* tw = (float*)(a.ws + WS_TOKW) + 2 * tk; tw[0] = w0; tw[1] = w1;
                    __hip_atomic_fetch_add(&cnt_l[e0], 1, __ATOMIC_RELAXED, __HIP_MEMORY_SCOPE_WORKGROUP); __hip_atomic_fetch_add(&cnt_l[e1], 1, __ATOMIC_RELAXED, __HIP_MEMORY_SCOPE_WORKGROUP); }
            }
        }
    }
    if (MODE == 2) { __syncthreads(); if (tid < NE) ((int*)(a.ws + WS_CNT))[wg * NE + tid] = cnt_l[tid]; }
}
template <int MODE, bool SRC_IN, bool COMBINE>
__global__ void __launch_bounds__(NTHR, 2) k_norm(P a, int l) {
    extern __shared__ __attribute__((aligned(16))) unsigned char smem[];
    a.wv = __builtin_amdgcn_readfirstlane(threadIdx.x >> 6);
    norm_phase<MODE, SRC_IN, COMBINE>(a, l, blockIdx.x, (PG_LAS float*)smem);
}

__device__ __forceinline__ void moe_pos_phase(const P& a_in, int wg, int* lds) {
    PHASE_ENTRY(a_in)
    const int tid = otid();
    int* cnt = lds;
    int* tot = lds + 2048;
    const int* gc = (const int*)(a.ws + WS_CNT);
    for (int i = tid; i < NWG * NE; i += NTHR) cnt[i] = gc[i];
    __syncthreads();
    if (tid < NE) { int t = 0, pre = 0; for (int w = 0; w < NWG; ++w) { if (w == wg) pre = t; t += cnt[w * NE + tid]; } tot[tid] = t; tot[16 + tid] = pre; }
    __syncthreads();
    if (tid == 0) { int s = 0; for (int e = 0; e < NE; ++e) { tot[8 + e] = s; s += (tot[e] + 255) & ~255; } tot[24] = s; }
    __syncthreads();
    const int* te = (const int*)(a.ws + WS_TOKE); const float* tw = (const float*)(a.ws + WS_TOKW);
    int* tp = (int*)(a.ws + WS_TOKP); int* rowt = (int*)(a.ws + WS_ROWT); float* roww = (float*)(a.ws + WS_ROWW);
    if (tid < NE) {
        int pos = tot[8 + tid] + tot[16 + tid];
        for (int i = 0; i < ROWS_PER_WG; ++i) { const int tk = wg * ROWS_PER_WG + i;
#pragma unroll
            for (int s = 0; s < 2; ++s) if (te[2 * tk + s] == tid) { tp[2 * tk + s] = pos; rowt[pos] = tk; roww[pos] = tw[2 * tk + s]; ++pos; } }
    }
    if (wg < NE) { const int s0 = tot[8 + wg] + tot[wg], s1 = tot[8 + wg] + ((tot[wg] + 255) & ~255); for (int r = s0 + tid; r < s1; r += NTHR) { rowt[r] = 0; roww[r] = 0.f; } }
    if (wg == 0) { int* tile_e = (int*)(a.ws + WS_TILEE); const int nt = tot[24] >> 8;
        for (int t = tid; t < MOE_TILES; t += NTHR) { int e = 0; for (int q = 1; q < NE; ++q) if (t * 256 >= tot[8 + q]) e = q; tile_e[t] = t < nt ? e : 0; }
        if (tid == 0) tile_e[MOE_TILES] = nt; }
}
__global__ void __launch_bounds__(NTHR, 2) k_moe_pos(P a) {
    extern __shared__ __attribute__((aligned(16))) unsigned char smem[];
    a.wv = __builtin_amdgcn_readfirstlane(threadIdx.x >> 6);
    moe_pos_phase(a, blockIdx.x, (int*)smem);
}

enum { EM_IN = 0, EM_OUT = 1, EM_F1 = 2, EM_F2D = 3, EM_F1M = 4, EM_F2M = 5 };
template <int EM>
__global__ void __launch_bounds__(256) k_ngemm(P a, int l, const bf16* A, const bf16* Bt, int M, int N, int K) {
    constexpr bool DUAL = (EM == EM_F1 || EM == EM_F1M), MOE = (EM == EM_F1M || EM == EM_F2M);
    __shared__ __attribute__((aligned(16))) float As[32][64], Bs[32][64], Bs2[DUAL ? 32 : 1][64];
    const int t = threadIdx.x, tx = t & 15, ty = t >> 4;
    const int row0 = blockIdx.y * 64, col0 = blockIdx.x * 64;
    const int* tile_e = (const int*)(a.ws + WS_TILEE); const int* rowt = (const int*)(a.ws + WS_ROWT);
    if (MOE) { if (row0 >= tile_e[MOE_TILES] * 256) return; }
    const int e = MOE ? tile_e[row0 >> 8] : 0;
    const bf16* B = Bt + (MOE ? (size_t)e * (DUAL ? 2 * FFN : D) * K : 0);
    const int lr = t >> 2, kc = (t & 3) * 8;
    const int arow = (EM == EM_F1M) ? rowt[row0 + lr] : row0 + lr;
    const int brow = DUAL ? ((col0 >> 7) * 256 + (col0 & 127) + lr) : col0 + lr;
    float acc[4][4], acc2[4][4];
#pragma unroll
    for (int i = 0; i < 4; ++i)
#pragma unroll
        for (int j = 0; j < 4; ++j) { acc[i][j] = 0.f; acc2[i][j] = 0.f; }
    for (int k0 = 0; k0 < K; k0 += 32) {
        const v4u av = *(const v4u*)(A + (size_t)arow * K + k0 + kc);
        const v4u bv = *(const v4u*)(B + (size_t)brow * K + k0 + kc);
        v4u bv2 = bv; if (DUAL) bv2 = *(const v4u*)(B + (size_t)(brow + 128) * K + k0 + kc);
        __syncthreads();
        As[kc + 0][lr] = bf_lo(av.x); As[kc + 1][lr] = bf_hi(av.x); As[kc + 2][lr] = bf_lo(av.y); As[kc + 3][lr] = bf_hi(av.y);
        As[kc + 4][lr] = bf_lo(av.z); As[kc + 5][lr] = bf_hi(av.z); As[kc + 6][lr] = bf_lo(av.w); As[kc + 7][lr] = bf_hi(av.w);
        Bs[kc + 0][lr] = bf_lo(bv.x); Bs[kc + 1][lr] = bf_hi(bv.x); Bs[kc + 2][lr] = bf_lo(bv.y); Bs[kc + 3][lr] = bf_hi(bv.y);
        Bs[kc + 4][lr] = bf_lo(bv.z); Bs[kc + 5][lr] = bf_hi(bv.z); Bs[kc + 6][lr] = bf_lo(bv.w); Bs[kc + 7][lr] = bf_hi(bv.w);
        if (DUAL) { Bs2[kc + 0][lr] = bf_lo(bv2.x); Bs2[kc + 1][lr] = bf_hi(bv2.x); Bs2[kc + 2][lr] = bf_lo(bv2.y); Bs2[kc + 3][lr] = bf_hi(bv2.y);
            Bs2[kc + 4][lr] = bf_lo(bv2.z); Bs2[kc + 5][lr] = bf_hi(bv2.z); Bs2[kc + 6][lr] = bf_lo(bv2.w); Bs2[kc + 7][lr] = bf_hi(bv2.w); }
        __syncthreads();
#pragma unroll 8
        for (int k = 0; k < 32; ++k) {
            const f32x4 av4 = *(const f32x4*)&As[k][ty * 4], bv4 = *(const f32x4*)&Bs[k][tx * 4];
#pragma unroll
            for (int i = 0; i < 4; ++i)
#pragma unroll
                for (int j = 0; j < 4; ++j) acc[i][j] += av4[i] * bv4[j];
            if (DUAL) { const f32x4 b2 = *(const f32x4*)&Bs2[k][tx * 4];
#pragma unroll
                for (int i = 0; i < 4; ++i)
#pragma unroll
                    for (int j = 0; j < 4; ++j) acc2[i][j] += av4[i] * b2[j]; }
        }
    }
    const float* MOD = (const float*)(a.ws + WS_MOD); float* X = (float*)(a.ws + WS_X);
#pragma unroll
    for (int i = 0; i < 4; ++i) {
        const int r = row0 + ty * 4 + i;
#pragma unroll
        for (int j = 0; j < 4; ++j) {
            const int c = col0 + tx * 4 + j; const float v = acc[i][j];
            if (EM == EM_IN) ((bf16*)(a.ws + WS_U))[(size_t)r * UW + c] = (bf16)f2bf(v);
            if (EM == EM_OUT) { const float* base = (l == 0) ? in_row(a, r) : X + (size_t)r * D; X[(size_t)r * D + c] = base[c] + MOD[((size_t)l * MODR + tk_modrow(r)) * MODW + 2 * D + c] * v; }
            if (EM == EM_F1) ((bf16*)(a.ws + WS_HID))[(size_t)r * FFN + c] = (bf16)f2bf(silu_f(v) * acc2[i][j]);
            if (EM == EM_F1M) ((bf16*)(a.ws + WS_HID))[(size_t)r * FFN + c] = (bf16)f2bf(silu_f(v) * acc2[i][j] * ((const float*)(a.ws + WS_ROWW))[r]);
            if (EM == EM_F2D) X[(size_t)r * D + c] += MOD[((size_t)l * MODR + tk_modrow(r)) * MODW + 5 * D + c] * v;
            if (EM == EM_F2M) ((bf16*)(a.ws + WS_YS))[(size_t)r * D + c] = (bf16)f2bf(v);
        }
    }
}
__global__ void __launch_bounds__(256) k_rope_apply(P a) {
    const size_t i = (size_t)blockIdx.x * 256 + threadIdx.x; if (i >= (size_t)T_ALL * 20 * 16) return;
    const int tk = (int)(i / 320), rem = (int)(i % 320), grp = rem / 16, f = rem % 16;
    const int b = tk / TPB, p = tk - b * TPB; bf16* u = (bf16*)(a.ws + WS_U) + (size_t)tk * UW + grp * 32;
    float x1 = bf2f(u[f]), x2 = bf2f(u[f + 16]);
    const float sc = grp < 16 ? 0.125f : 1.f;
    if (p >= CTX) { const int s = p - CTX, pos = (grp & 1) ? (s & 63) : (s >> 6); const float* t = (const float*)(a.ws + WS_ROPE) + 2 * (pos * 16 + f);
        const float cs = t[0], sn = t[1]; const float y1 = x1 * cs - x2 * sn, y2 = x2 * cs + x1 * sn; x1 = y1; x2 = y2; }
    u[f] = (bf16)f2bf(x1 * sc); u[f + 16] = (bf16)f2bf(x2 * sc);
}

__global__ void __launch_bounds__(512, 2) k_attn_naive(P a, int l) {
    __shared__ float ssq[8];
    const int tk = blockIdx.x, h = threadIdx.x >> 6, lane = threadIdx.x & 63, kvh = h >> 2;
    const int b = tk / TPB, p = tk - b * TPB; const bool isctx = p < CTX;
    const bf16* U = (const bf16*)(a.ws + WS_U);
    float q[64];
    { const v4u* qp = (const v4u*)(U + (size_t)tk * UW + U_QA + h * 64);
#pragma unroll
      for (int i = 0; i < 8; ++i) { const v4u w = qp[i]; q[8 * i + 0] = bf_lo(w.x); q[8 * i + 1] = bf_hi(w.x); q[8 * i + 2] = bf_lo(w.y); q[8 * i + 3] = bf_hi(w.y); q[8 * i + 4] = bf_lo(w.z); q[8 * i + 5] = bf_hi(w.z); q[8 * i + 6] = bf_lo(w.w); q[8 * i + 7] = bf_hi(w.w); } }
    const int s = p - CTX; const int j0 = isctx ? 0 : (s - 128 < 0 ? 0 : s - 128), j1 = isctx ? -1 : (s + 128 > SEQ - 1 ? SEQ - 1 : s + 128);
    const int nlat = j1 - j0 + 1, nk = CTX + (isctx ? 0 : nlat);
    const int tb = b * TPB;
    float sc[9];
#pragma unroll
    for (int it = 0; it < 9; ++it) { const int idx = lane + 64 * it; sc[it] = -3.0e38f;
        if (idx < nk) { const int kt = idx < CTX ? tb + idx : tb + CTX + j0 + (idx - CTX); const v4u* kp = (const v4u*)(U + (size_t)kt * UW + U_KA + kvh * 64); float d = 0.f;
#pragma unroll
            for (int i = 0; i < 8; ++i) { const v4u w = kp[i]; d += q[8 * i + 0] * bf_lo(w.x) + q[8 * i + 1] * bf_hi(w.x) + q[8 * i + 2] * bf_lo(w.y) + q[8 * i + 3] * bf_hi(w.y) + q[8 * i + 4] * bf_lo(w.z) + q[8 * i + 5] * bf_hi(w.z) + q[8 * i + 6] * bf_lo(w.w) + q[8 * i + 7] * bf_hi(w.w); }
            sc[it] = d; } }
    const float sink = a.attn_sink[l * 8 + h];
    float m = sink;
#pragma unroll
    for (int it = 0; it < 9; ++it) m = fmaxf(m, sc[it]);
    m = wave_max(m);
    float o[64];
#pragma unroll
    for (int d = 0; d < 64; ++d) o[d] = 0.f;
    float den = 0.f;
#pragma unroll
    for (int it = 0; it < 9; ++it) { const int idx = lane + 64 * it;
        if (idx < nk) { const float pr = __expf(sc[it] - m); den += pr; const int kt = idx < CTX ? tb + idx : tb + CTX + j0 + (idx - CTX); const v4u* vp = (const v4u*)(U + (size_t)kt * UW + U_VA + kvh * 64);
#pragma unroll
            for (int i = 0; i < 8; ++i) { const v4u w = vp[i]; o[8 * i + 0] += pr * bf_lo(w.x); o[8 * i + 1] += pr * bf_hi(w.x); o[8 * i + 2] += pr * bf_lo(w.y); o[8 * i + 3] += pr * bf_hi(w.y); o[8 * i + 4] += pr * bf_lo(w.z); o[8 * i + 5] += pr * bf_hi(w.z); o[8 * i + 6] += pr * bf_lo(w.w); o[8 * i + 7] += pr * bf_hi(w.w); } } }
    den = wave_sum(den) + __expf(sink - m);
    float mine = 0.f;
#pragma unroll
    for (int d = 0; d < 64; ++d) { const float sd = wave_sum(o[d]); mine = (lane == d) ? sd : mine; }
    mine /= den;
    const float sq = wave_sum(mine * mine);
    if (lane == 0) ssq[h] = sq;
    __syncthreads();
    float tot = 0.f;
#pragma unroll
    for (int i = 0; i < 8; ++i) tot += ssq[i];
    const float rstd = rsqrtf(tot * (1.f / 512.f) + EPS);
    ((bf16*)(a.ws + WS_MIX))[(size_t)tk * D + h * 64 + lane] = (bf16)f2bf(mine * rstd * a.g_att[l * 512 + h * 64 + lane]);
}

__device__ __forceinline__ float conv_qk(const P& a, int l, const bf16* U, int tk, int ch) {
    const int b = tk / TPB, p = tk - b * TPB; const int lo = p < CTX ? 0 : CTX, hi = p < CTX ? CTX : TPB;
    float y = a.conv_b[l * 512 + ch];
#pragma unroll
    for (int j = 0; j < 5; ++j) { const int pp = p + j - 2; if (pp >= lo && pp < hi) y += a.conv_w[(l * 5 + j) * 512 + ch] * bf2f(U[(size_t)(b * TPB + pp) * UW + U_QM + ch]); }
    return silu_f(y);
}
__global__ void __launch_bounds__(256) k_mlstm_naive(P a, int l) {
    __shared__ float qs[2][64], ks[2][64], part[2][2][128], sc[2][4];
    const int t = threadIdx.x, dir = blockIdx.x & 1, hd = (blockIdx.x >> 1) & 3, b = blockIdx.x >> 3;
    const bf16* U = (const bf16*)(a.ws + WS_U); const float* G = (const float*)(a.ws + WS_GATES);
    float* HD = (float*)(a.ws + WS_HDIR) + (size_t)dir * T_ALL * 512;
    const int e = t & 127, half = t >> 7;
    float C[32];
#pragma unroll
    for (int i = 0; i < 32; ++i) C[i] = 0.f;
    float nst = 0.f, m = 0.f;
    for (int tau = 0; tau < TPB; ++tau) {
        const int pb = tau & 1;
        const int p = dir == 0 ? tau : (tau < CTX ? CTX - 1 - tau : CTX + (SEQ - 1) - (tau - CTX));
        const int tk = b * TPB + p;
        if (t < 64) qs[pb][t] = 0.125f * conv_qk(a, l, U, tk, hd * 64 + t);
        else if (t < 128) ks[pb][t - 64] = conv_qk(a, l, U, tk, 256 + hd * 64 + (t - 64));
        const float li = G[(size_t)tk * 16 + dir * 8 + hd], lf = logsigmoid_f(G[(size_t)tk * 16 + dir * 8 + 4 + hd]);
        const float mn = fmaxf(lf + m, li), fd = __expf(lf + m - mn), iw = __expf(li - mn);
        m = mn;
        const float v = bf2f(U[(size_t)tk * UW + U_VM + hd * 128 + e]);
        __syncthreads();
        float ph = 0.f;
#pragma unroll
        for (int i = 0; i < 32; ++i) { const int dk = half * 32 + i; C[i] = fd * C[i] + iw * ks[pb][dk] * v; ph += qs[pb][dk] * C[i]; }
        part[pb][half][e] = ph;
        if (t < 64) { nst = fd * nst + iw * ks[pb][t]; const float qn = wave_sum(qs[pb][t] * nst); if (t == 0) sc[pb][0] = qn; }
        __syncthreads();
        if (t < 128) { const float num = part[pb][0][t] + part[pb][1][t]; const float den = fmaxf(fabsf(sc[pb][0]), __expf(-mn)); HD[(size_t)tk * 512 + hd * 128 + t] = num / den; }
    }
}
__global__ void __launch_bounds__(256) k_merge_naive(P a, int l) {
    const int tk = blockIdx.x, hd = threadIdx.x >> 6, lane = threadIdx.x & 63;
    const float* H0 = (const float*)(a.ws + WS_HDIR); const float* H1 = H0 + (size_t)T_ALL * 512; const bf16* U = (const bf16*)(a.ws + WS_U);
    const int c0 = hd * 128 + lane, c1 = c0 + 64;
    const float h0 = H0[(size_t)tk * 512 + c0] + H1[(size_t)tk * 512 + c0], h1 = H0[(size_t)tk * 512 + c1] + H1[(size_t)tk * 512 + c1];
    const float rstd = rsqrtf(wave_sum(h0 * h0 + h1 * h1) * (1.f / 128.f) + EPS);
    bf16* mx = (bf16*)(a.ws + WS_MIX) + (size_t)tk * D + 512;
    mx[c0] = (bf16)f2bf(h0 * rstd * a.g_ml[l * 512 + c0] * sigmoid_f(bf2f(U[(size_t)tk * UW + U_OM + c0])));
    mx[c1] = (bf16)f2bf(h1 * rstd * a.g_ml[l * 512 + c1] * sigmoid_f(bf2f(U[(size_t)tk * UW + U_OM + c1])));
}

namespace pg {
#define PG_LAS __attribute__((address_space(3)))
typedef short bf16x8 __attribute__((ext_vector_type(8)));
constexpr int BM = 256, BK = 64, HALF = 128, HTB = HALF * BK * 2, STAGE_BYTES = 8 * HTB, NXCD = 8, WGM = 8;
__host__ __device__ __forceinline__ int lds_byte(int r, int c) { const int st = (r >> 4) * 2 + (c >> 5), rr = r & 15, cc = c & 31, ob = rr * 64 + cc * 2; return st * 1024 + (ob ^ (((ob >> 9) & 1) << 5)); }
__host__ __device__ __forceinline__ void stage_rc(int b, int& R, int& C) { const int st = b / 1024, sb = b % 1024, swz = sb ^ (((sb >> 9) & 1) << 5); R = (st >> 1) * 16 + swz / 64; C = (st & 1) * 32 + (swz % 64) / 2; }
__host__ __device__ __forceinline__ int perm32(int rho) { const int n = rho >> 4, i = rho & 15; return 8 * (i >> 2) + 4 * n + (i & 3); }
struct Unit { int pm, pn, e; };
struct Order {
    int nM, nN, nwg, G, c, lat;
    __device__ void init(int nM_, int nN_, int G_, int c_) { nM = nM_; nN = nN_; nwg = nM * nN; G = G_; c = c_; lat = 0; }
    __device__ bool next(int i, Unit& u) const {
        const long L = (long)i * G + c; if (L >= nwg) return false;
        int wgid = (int)L; { const int q = nwg / NXCD, r = nwg % NXCD, xcd = wgid % NXCD, off = wgid / NXCD; wgid = (xcd < r ? xcd * (q + 1) : r * (q + 1) + (xcd - r) * q) + off; }
        const int nig = WGM * nN, gid = wgid / nig, fm = gid * WGM, gsz = (nM - fm) < WGM ? (nM - fm) : WGM;
        u.pm = fm + ((wgid % nig) % gsz); u.pn = (wgid % nig) / gsz; u.e = 0; if (lat) u.pm = (u.pm >> 4) * 17 + 1 + (u.pm & 15); return true;
    }
};
struct Gemm { const bf16* A; const bf16* Bt; int K; int brows; const int* rowt; const int* tile_e; int wv; };

template <class Epi, bool GATHER, bool MOE>
__device__ __forceinline__ void gemm_phase(PG_LAS unsigned char* lds, const Gemm g, const Order& S, const Epi& E) {
    const int tid = otid_w(g.wv), wid = __builtin_amdgcn_readfirstlane(tid >> 6), lane = tid & 63, wr = wid >> 2, wc = wid & 3, fr = lane & 15, fq = lane >> 4;
    const int K = g.K, nt = K / BK;
    int Rr[2], Cc[2]; unsigned voffB[2];
#pragma unroll
    for (int i = 0; i < 2; ++i) { int R, C; stage_rc(tid * 16 + i * 8192, R, C); Rr[i] = R; Cc[i] = C; const int Rb = Epi::PERM ? ((R & ~31) + perm32(R & 31)) : R; voffB[i] = (unsigned)(Rb * K + C) * 2u; }
    const size_t hstep = (size_t)HALF * K * 2;
    const unsigned ldsw = (unsigned)wid * 1024u;
    const int aoff = lds_byte(wr * 64 + fr, fq * 8), boff = lds_byte(wc * 32 + fr, fq * 8);
    const char* Ab = (const char*)g.A;
#define PG_SA(b, h) (((b) * 2 + (h)) * HTB)
#define PG_SB(b, h) ((4 + (b) * 2 + (h)) * HTB)
#define PG_STAGE_B(bufoff, gbase) do { _Pragma("unroll") for (int _i = 0; _i < 2; ++_i) \
        __builtin_amdgcn_global_load_lds((const unsigned*)((const char*)(gbase) + voffB[_i]), (PG_LAS unsigned*)(lds + (bufoff) + ldsw + _i * 8192), 16, 0, 0); } while (0)
#define PG_STAGE_A(bufoff, offs, h, kb) do { _Pragma("unroll") for (int _i = 0; _i < 2; ++_i) \
        __builtin_amdgcn_global_load_lds((const unsigned*)(Ab + (size_t)(offs)[h][_i] + (size_t)(kb)), (PG_LAS unsigned*)(lds + (bufoff) + ldsw + _i * 8192), 16, 0, 0); } while (0)
#define PG_LDA(dst, b, h) do { _Pragma("unroll") for (int m = 0; m < 4; ++m) _Pragma("unroll") for (int k = 0; k < 2; ++k) dst[m][k] = *(const PG_LAS bf16x8*)(lds + PG_SA(b, h) + aoff + m * 2048 + k * 1024); } while (0)
#define PG_LDB(dst, b, h) do { _Pragma("unroll") for (int n = 0; n < 2; ++n) _Pragma("unroll") for (int k = 0; k < 2; ++k) dst[n][k] = *(const PG_LAS bf16x8*)(lds + PG_SB(b, h) + boff + n * 2048 + k * 1024); } while (0)
#define PG_MMA(ai, bj, At, Bt) do { __builtin_amdgcn_s_setprio(1); _Pragma("unroll") for (int m = 0; m < 4; ++m) _Pragma("unroll") for (int n = 0; n < 2; ++n) _Pragma("unroll") for (int k = 0; k < 2; ++k) \
        acc[ai][bj][m][n] = __builtin_amdgcn_mfma_f32_16x16x32_bf16(Bt[n][k], At[m][k], acc[ai][bj][m][n], 0, 0, 0); __builtin_amdgcn_s_setprio(0); } while (0)
#define PG_WAIT_V(n) asm volatile("s_waitcnt vmcnt(" #n ")" ::: "memory")
#define PG_WAIT_L(n) asm volatile("s_waitcnt lgkmcnt(" #n ")" ::: "memory")
#define PG_BAR __builtin_amdgcn_s_barrier()
#define PG_SCHED __builtin_amdgcn_sched_barrier(0)
#define PG_AOFFS(dst, u) do { _Pragma("unroll") for (int _h = 0; _h < 2; ++_h) _Pragma("unroll") for (int _i = 0; _i < 2; ++_i) { \
        const int _r = (u).pm * BM + _h * HALF + Rr[_i]; const int _row = GATHER ? g.rowt[_r] : _r; dst[_h][_i] = (unsigned)_row * (unsigned)(K * 2) + (unsigned)(Cc[_i] * 2); } } while (0)
#define PG_BBASE(u) ((const char*)g.Bt + ((size_t)(u).e * g.brows + (size_t)(u).pn * BM) * (size_t)K * 2)
    Unit cur, nxt; int ui = 0;
    if (!S.next(0, cur)) return;
    if (MOE) cur.e = g.tile_e[cur.pm];
    f32x4 acc[2][2][4][2];
#pragma unroll
    for (int a = 0; a < 2; ++a)
#pragma unroll
        for (int b = 0; b < 2; ++b)
#pragma unroll
            for (int m = 0; m < 4; ++m)
#pragma unroll
                for (int n = 0; n < 2; ++n) acc[a][b][m][n] = (f32x4){0.f, 0.f, 0.f, 0.f};
    bf16x8 At[4][2], B0[2][2], B1[2][2];
    unsigned offC[2][2], offN[2][2];
    PG_AOFFS(offC, cur);
    const char* cB = PG_BBASE(cur);
    const size_t kstep = (size_t)(BK * 2);
    PG_STAGE_B(PG_SB(0, 0), cB); PG_STAGE_B(PG_SB(0, 1), cB + hstep); PG_STAGE_A(PG_SA(0, 0), offC, 0, 0); PG_STAGE_A(PG_SA(0, 1), offC, 1, 0);
    if (wr == 1) PG_BAR;
    PG_WAIT_V(2); PG_BAR;
    PG_STAGE_B(PG_SB(1, 0), cB + kstep); PG_STAGE_A(PG_SA(1, 0), offC, 0, kstep); PG_STAGE_B(PG_SB(1, 1), cB + hstep + kstep);
    PG_WAIT_V(6); PG_BAR;
    for (;;) {
        bool has_next = S.next(ui + 1, nxt);
        if (has_next) { if (MOE) nxt.e = g.tile_e[nxt.pm]; if (GATHER) PG_AOFFS(offN, nxt); }
        else if (GATHER) {
#pragma unroll
            for (int h = 0; h < 2; ++h)
#pragma unroll
                for (int i = 0; i < 2; ++i) offN[h][i] = offC[h][i]; }
        const char* nB = has_next ? PG_BBASE(nxt) : cB;
        for (int t = 0; t < nt; t += 2) {
            const bool last = (t == nt - 2);
            const size_t k1 = (size_t)(t + 1) * kstep;
            const size_t k2 = last ? 0 : (size_t)(t + 2) * kstep;
            const char* b2 = last ? nB : cB + (size_t)(t + 2) * kstep; const char* b3 = b2 + kstep;
            PG_LDB(B0, 0, 0); PG_LDB(B1, 0, 1); PG_SCHED; PG_LDA(At, 0, 0); PG_STAGE_A(PG_SA(1, 1), offC, 1, k1);
            PG_WAIT_V(8); PG_WAIT_L(0); PG_BAR; PG_MMA(0, 0, At, B0); PG_MMA(0, 1, At, B1); PG_BAR; PG_SCHED;
            if (last) {
                if (GATHER) {
#pragma unroll
                    for (int h = 0; h < 2; ++h)
#pragma unroll
                        for (int i = 0; i < 2; ++i) offC[h][i] = offN[h][i];
                } else if (has_next) { PG_AOFFS(offC, nxt); }
            }
            PG_LDA(At, 0, 1); PG_STAGE_B(PG_SB(0, 0), b2); PG_STAGE_B(PG_SB(0, 1), b2 + hstep); PG_STAGE_A(PG_SA(0, 0), offC, 0, k2);
            PG_WAIT_V(8); PG_WAIT_L(0); PG_BAR; PG_MMA(1, 0, At, B0); PG_MMA(1, 1, At, B1); PG_BAR; PG_SCHED;
            PG_LDB(B0, 1, 0); PG_LDB(B1, 1, 1); PG_SCHED; PG_LDA(At, 1, 0); PG_STAGE_A(PG_SA(0, 1), offC, 1, k2);
            PG_WAIT_V(8); PG_WAIT_L(0); PG_BAR; PG_MMA(0, 0, At, B0); PG_MMA(0, 1, At, B1); PG_BAR; PG_SCHED;
            PG_LDA(At, 1, 1); PG_STAGE_B(PG_SB(1, 0), b3); PG_STAGE_B(PG_SB(1, 1), b3 + hstep); PG_STAGE_A(PG_SA(1, 0), offC, 0, k2 + kstep);
            PG_WAIT_V(8); PG_WAIT_L(0); PG_BAR; PG_MMA(1, 0, At, B0); PG_MMA(1, 1, At, B1); PG_BAR; PG_SCHED;
        }
        if (wr == 0) PG_BAR;
        E(acc, cur, wr, wc, fr, fq);
        if (!has_next) break;
#pragma unroll
        for (int a = 0; a < 2; ++a)
#pragma unroll
            for (int b = 0; b < 2; ++b)
#pragma unroll
                for (int m = 0; m < 4; ++m)
#pragma unroll
                    for (int n = 0; n < 2; ++n) acc[a][b][m][n] = (f32x4){0.f, 0.f, 0.f, 0.f};
        cur = nxt; cB = nB; ++ui;
        if (wr == 1) PG_BAR;
    }
    PG_WAIT_V(0);
    PG_BAR;
#undef PG_SA
#undef PG_SB
#undef PG_STAGE_A
#undef PG_STAGE_B
#undef PG_LDA
#undef PG_LDB
#undef PG_MMA
#undef PG_WAIT_V
#undef PG_WAIT_L
#undef PG_BAR
#undef PG_SCHED
#undef PG_AOFFS
#undef PG_BBASE
}
}


struct EpiIn {
    static constexpr bool PERM = false;
    bf16* U; const PG_LAS float* rope;
    __device__ __forceinline__ void operator()(const f32x4 (&acc)[2][2][4][2], const pg::Unit& u, int wr, int wc, int fr, int fq) const {
        const int tb = (u.pm * 256) / TPB, p0 = u.pm * 256 - tb * TPB; const bool latent = p0 >= CTX;
#pragma unroll
        for (int ai = 0; ai < 2; ++ai)
#pragma unroll
            for (int m = 0; m < 4; ++m) {
                const int rl = ai * 128 + wr * 64 + m * 16 + fr; const int r = u.pm * 256 + rl; const int s = p0 + rl - CTX;
                bf16* rowp = U + (size_t)r * UW + u.pn * 256 + wc * 32 + 4 * fq;
#pragma unroll
                for (int bj = 0; bj < 2; ++bj) {
                    const int G = (u.pn * 256 + bj * 128 + wc * 32) >> 5;
                    f32x4 x1 = acc[ai][bj][m][0], x2 = acc[ai][bj][m][1];
                    if (G < 20) {
                        if (latent) { const int pos = (G & 1) ? (s & 63) : (s >> 6); const PG_LAS float* t = rope + (pos * 16 + 4 * fq) * 2;
                            const f32x4 t0 = *(const PG_LAS f32x4*)t, t1 = *(const PG_LAS f32x4*)(t + 4);
                            const f32x4 cs = (f32x4){t0.x, t0.z, t1.x, t1.z}, sn = (f32x4){t0.y, t0.w, t1.y, t1.w};
                            const f32x4 y1 = x1 * cs - x2 * sn, y2 = x2 * cs + x1 * sn; x1 = y1; x2 = y2; }
                        if (G < 16) { x1 = x1 * 0.125f; x2 = x2 * 0.125f; }
                    }
                    v2u o1, o2; o1.x = cvt_pk_bf16(x1.x, x1.y); o1.y = cvt_pk_bf16(x1.z, x1.w); o2.x = cvt_pk_bf16(x2.x, x2.y); o2.y = cvt_pk_bf16(x2.z, x2.w);
                    *(v2u*)(rowp + bj * 128) = o1; *(v2u*)(rowp + bj * 128 + 16) = o2;
                }
            }
    }
};
template <int CHUNK, bool INPLACE> struct EpiRes {
    static constexpr bool PERM = false;
    float* X; const float* modl; const float* xin; const float* cin; int l;
    __device__ __forceinline__ void operator()(const f32x4 (&acc)[2][2][4][2], const pg::Unit& u, int wr, int wc, int fr, int fq) const {
        const int tb = (u.pm * 256) / TPB, p0 = u.pm * 256 - tb * TPB; const int mr = p0 < CTX ? NB : tb;
        const float* mv = modl + (size_t)mr * MODW + CHUNK * D + u.pn * 256 + wc * 32 + 4 * fq;
        f32x4 mod[2][2];
#pragma unroll
        for (int bj = 0; bj < 2; ++bj)
#pragma unroll
            for (int n = 0; n < 2; ++n) mod[bj][n] = *(const f32x4*)(mv + bj * 128 + n * 16);
        const bool from_in = (!INPLACE) && l == 0;
        const int co = u.pn * 256 + wc * 32 + 4 * fq;
#pragma unroll
        for (int ai = 0; ai < 2; ++ai) {
            f32x4 bs[4][2][2];
#pragma unroll
            for (int m = 0; m < 4; ++m) {
                const int rl = ai * 128 + wr * 64 + m * 16 + fr; const int r = u.pm * 256 + rl; const int p = p0 + rl;
                const float* bp = from_in ? (p < CTX ? cin + ((size_t)tb * CTX + p) * D : xin + ((size_t)tb * SEQ + (p - CTX)) * D) : X + (size_t)r * D;
#pragma unroll
                for (int bj = 0; bj < 2; ++bj)
#pragma unroll
                    for (int n = 0; n < 2; ++n) bs[m][bj][n] = *(const f32x4*)(bp + co + bj * 128 + n * 16);
            }
#pragma unroll
            for (int m = 0; m < 4; ++m) {
                const int r = u.pm * 256 + ai * 128 + wr * 64 + m * 16 + fr;
#pragma unroll
                for (int bj = 0; bj < 2; ++bj)
#pragma unroll
                    for (int n = 0; n < 2; ++n) *(f32x4*)(X + (size_t)r * D + co + bj * 128 + n * 16) = bs[m][bj][n] + mod[bj][n] * acc[ai][bj][m][n];
            }
        }
    }
};
template <bool MOE> struct EpiSwiglu {
    static constexpr bool PERM = true;
    bf16* H; const float* roww;
    __device__ __forceinline__ void operator()(const f32x4 (&acc)[2][2][4][2], const pg::Unit& u, int wr, int wc, int fr, int fq) const {
        float rws[2][4];
#pragma unroll
        for (int ai = 0; ai < 2; ++ai)
#pragma unroll
            for (int m = 0; m < 4; ++m) rws[ai][m] = MOE ? roww[u.pm * 256 + ai * 128 + wr * 64 + m * 16 + fr] : 1.f;
#pragma unroll
        for (int ai = 0; ai < 2; ++ai)
#pragma unroll
            for (int m = 0; m < 4; ++m) {
                const int r = u.pm * 256 + ai * 128 + wr * 64 + m * 16 + fr;
                const float rw = rws[ai][m];
                f32x4 h0, h1;
#pragma unroll
                for (int j = 0; j < 4; ++j) { const float g0 = acc[ai][0][m][0][j], g1 = acc[ai][0][m][1][j];
                    h0[j] = g0 * __builtin_amdgcn_rcpf(1.f + __expf(-g0)) * acc[ai][1][m][0][j] * rw; h1[j] = g1 * __builtin_amdgcn_rcpf(1.f + __expf(-g1)) * acc[ai][1][m][1][j] * rw; }
                v4u w; w.x = cvt_pk_bf16(h0.x, h0.y); w.y = cvt_pk_bf16(h0.z, h0.w); w.z = cvt_pk_bf16(h1.x, h1.y); w.w = cvt_pk_bf16(h1.z, h1.w);
                *(v4u*)(H + (size_t)r * FFN + u.pn * 128 + wc * 32 + 8 * fq) = w;
            }
    }
};
struct EpiYs {
    static constexpr bool PERM = true;
    bf16* Y;
    __device__ __forceinline__ void operator()(const f32x4 (&acc)[2][2][4][2], const pg::Unit& u, int wr, int wc, int fr, int fq) const {
#pragma unroll
        for (int ai = 0; ai < 2; ++ai)
#pragma unroll
            for (int m = 0; m < 4; ++m) {
                bf16* rowp = Y + (size_t)(u.pm * 256 + ai * 128 + wr * 64 + m * 16 + fr) * D + u.pn * 256 + wc * 32 + 8 * fq;
#pragma unroll
                for (int bj = 0; bj < 2; ++bj) { const f32x4 v0 = acc[ai][bj][m][0], v1 = acc[ai][bj][m][1];
                    v4u w; w.x = cvt_pk_bf16(v0.x, v0.y); w.y = cvt_pk_bf16(v0.z, v0.w); w.z = cvt_pk_bf16(v1.x, v1.y); w.w = cvt_pk_bf16(v1.z, v1.w);
                    *(v4u*)(rowp + bj * 128) = w; }
            }
    }
};
template <int WHICH> __device__ __forceinline__ void gemm_run(const P& a_in, int l, PG_LAS unsigned char* lds, int G, int c) {
    PHASE_ENTRY(a_in)
    unsigned char* ws = a.ws; pg::Order S;
    if (WHICH == EM_IN) { S.init(T_ALL / 256, UW / 256, G, c); pg::Gemm g{(const bf16*)(ws + WS_HX), (const bf16*)(ws + WS_WIN) + (size_t)l * UW * D, D, 0, nullptr, nullptr, a.wv};
        PG_LAS float* rl = (PG_LAS float*)(lds + 131072 + 1024); const float* rg = (const float*)(ws + WS_ROPE);
        for (int i = otid(); i < 2048; i += NTHR) rl[i] = rg[i];
        __syncthreads();
        EpiIn E{(bf16*)(ws + WS_U), rl}; pg::gemm_phase<EpiIn, false, false>(lds, g, S, E); }
    if (WHICH == EM_OUT) { if (l == DEPTH - 1) { S.init(NB * SEQ / 256, D / 256, G, c); S.lat = 1; } else S.init(T_ALL / 256, D / 256, G, c); pg::Gemm g{(const bf16*)(ws + WS_MIX), (const bf16*)(ws + WS_WOUT) + (size_t)l * D * D, D, 0, nullptr, nullptr, a.wv};
        EpiRes<2, false> E{(float*)(ws + WS_X), (const float*)(ws + WS_MOD) + (size_t)l * MODR * MODW, a.x, a.ctx, l}; pg::gemm_phase<EpiRes<2, false>, false, false>(lds, g, S, E); }
    if (WHICH == EM_F1) { S.init(T_ALL / 256, 2 * FFN / 256, G, c); pg::Gemm g{(const bf16*)(ws + WS_HX), (const bf16*)(ws + WS_WF13) + (size_t)(l >> 1) * 2 * FFN * D, D, 0, nullptr, nullptr, a.wv};
        EpiSwiglu<false> E{(bf16*)(ws + WS_HID), nullptr}; pg::gemm_phase<EpiSwiglu<false>, false, false>(lds, g, S, E); }
    if (WHICH == EM_F2D) { S.init(T_ALL / 256, D / 256, G, c); pg::Gemm g{(const bf16*)(ws + WS_HID), (const bf16*)(ws + WS_WF2) + (size_t)(l >> 1) * D * FFN, FFN, 0, nullptr, nullptr, a.wv};
        EpiRes<5, true> E{(float*)(ws + WS_X), (const float*)(ws + WS_MOD) + (size_t)l * MODR * MODW, a.x, a.ctx, l}; pg::gemm_phase<EpiRes<5, true>, false, false>(lds, g, S, E); }
    if (WHICH == EM_F1M) { const int* te = (const int*)(ws + WS_TILEE); const int nt = __builtin_amdgcn_readfirstlane(te[MOE_TILES]); S.init(nt, 2 * FFN / 256, G, c);
        pg::Gemm g{(const bf16*)(ws + WS_HX), (const bf16*)(ws + WS_WE13), D, 2 * FFN, (const int*)(ws + WS_ROWT), te, a.wv};
        EpiSwiglu<true> E{(bf16*)(ws + WS_HID), (const float*)(ws + WS_ROWW)}; pg::gemm_phase<EpiSwiglu<true>, true, true>(lds, g, S, E); }
    if (WHICH == EM_F2M) { const int* te = (const int*)(ws + WS_TILEE); const int nt = __builtin_amdgcn_readfirstlane(te[MOE_TILES]); S.init(nt, D / 256, G, c);
        pg::Gemm g{(const bf16*)(ws + WS_HID), (const bf16*)(ws + WS_WE2), FFN, D, nullptr, te, a.wv};
        EpiYs E{(bf16*)(ws + WS_YS)}; pg::gemm_phase<EpiYs, false, true>(lds, g, S, E); }
}
template <int WHICH> __global__ void __launch_bounds__(NTHR, 2) k_gemm(P a, int l) {
    extern __shared__ __attribute__((aligned(16))) unsigned char smem[];
    a.wv = __builtin_amdgcn_readfirstlane(threadIdx.x >> 6);
    gemm_run<WHICH>(a, l, (PG_LAS unsigned char*)smem, (int)gridDim.x, (int)blockIdx.x);
}

typedef float f32x16 __attribute__((ext_vector_type(16)));
typedef short v4s __attribute__((ext_vector_type(4)));
constexpr int ATT_ITEMS = NB * (SEQ / 32) + NB * (CTX / 32);
constexpr int ATT_LDS = 2 * 16384 + 1024;
__device__ __forceinline__ void attn_phase(const P& a_in, int l, PG_LAS unsigned char* lds, int G, int c) {
    PHASE_ENTRY(a_in)
    const int tid = otid(), lane = tid & 63, h = __builtin_amdgcn_readfirstlane(tid >> 6), kvh = h >> 2;
    const int qr = lane & 31, hh = lane >> 5;
    const bf16* U = (const bf16*)(a.ws + WS_U); bf16* MIX = (bf16*)(a.ws + WS_MIX);
    PG_LAS float* ssq = (PG_LAS float*)(lds + 32768);
    const float sink = a.attn_sink[l * 8 + h];
    const int st_isv = (tid >> 8) & 1, st_key = (tid >> 3) & 31, st_ch = tid & 7;
    const int st_off = st_isv * 4096 + st_key * 128 + (st_isv ? ((st_ch * 16) ^ (((st_key >> 1) & 1) << 6)) : (16 * (st_ch ^ ((st_key >> 1) & 7))));
    const int st_col = (st_isv ? U_VA : U_KA) + st_ch * 8;
    const int k_row = qr * 128, k_sw = (qr >> 1) & 7;
    const int tr_q = (lane & 15) >> 2, tr_p = lane & 3, tr_g = (lane >> 4) & 1;
    for (int it = c; it < ATT_ITEMS; it += G) {
        int b, tq0, nt, ilo = 0; bool isctx;
        if (it < NB * (SEQ / 32)) { b = it >> 7; const int s0 = (it & 127) * 32; isctx = false; tq0 = b * TPB + CTX + s0;
            ilo = s0 >= 128 ? 0 : (128 - s0) / 32; int ihi = (SEQ + 96 - s0) / 32; ihi = ihi > 8 ? 8 : ihi; nt = 8 + (ihi - ilo + 1); }
        else { const int j = it - NB * (SEQ / 32); b = j >> 3; isctx = true; tq0 = b * TPB + (j & 7) * 32; nt = 8; }
        const int tb = b * TPB;
        pg::bf16x8 qf[4];
#pragma unroll
        for (int s4 = 0; s4 < 4; ++s4) qf[s4] = *(const pg::bf16x8*)(U + (size_t)(tq0 + qr) * UW + U_QA + h * 64 + 16 * s4 + 8 * hh);
        float m = sink, lsum = 0.f;
        f32x16 o0 = {}, o1 = {};
#define ATT_TILE_TOK(t) ((t) < 8 ? tb + 32 * (t) : tq0 - 128 + 32 * (ilo + (t) - 8))
        v4u g0, g1;
        { const int kt = ATT_TILE_TOK(0) + st_key; g0 = *(const v4u*)(U + (size_t)kt * UW + st_col); g1 = *(const v4u*)(U + (size_t)kt * UW + st_col + 64); }
        *(PG_LAS v4u*)(lds + st_off) = g0; *(PG_LAS v4u*)(lds + 8192 + st_off) = g1;
        __syncthreads();
        for (int t = 0; t < nt; ++t) {
            if (t + 1 < nt) { const int kt = ATT_TILE_TOK(t + 1) + st_key; g0 = *(const v4u*)(U + (size_t)kt * UW + st_col); g1 = *(const v4u*)(U + (size_t)kt * UW + st_col + 64); }
            PG_LAS unsigned char* kb = lds + (t & 1) * 16384 + kvh * 8192; PG_LAS unsigned char* vb = kb + 4096;
            f32x16 sacc = {};
#pragma unroll
            for (int s4 = 0; s4 < 4; ++s4) { const pg::bf16x8 kf = *(const PG_LAS pg::bf16x8*)(kb + k_row + 16 * ((2 * s4 + hh) ^ k_sw));
                sacc = __builtin_amdgcn_mfma_f32_32x32x16_bf16(kf, qf[s4], sacc, 0, 0, 0); }
            const int ti = (t < 8) ? -1 : ilo + t - 8;
            if (ti == 0 || ti == 8) {
#pragma unroll
                for (int i = 0; i < 16; ++i) { const int kk = (i & 3) + 8 * (i >> 2) + 4 * hh; const bool ok = (ti == 0) ? (kk >= qr) : (kk <= qr); sacc[i] = ok ? sacc[i] : -1.0e30f; }
            }
            float mt = sacc[0];
#pragma unroll
            for (int i = 1; i < 16; ++i) mt = fmaxf(mt, sacc[i]);
            mt = hmax32(mt);
            const float mn = fmaxf(m, mt), alpha = __expf(m - mn); m = mn;
            float ps = 0.f;
#pragma unroll
            for (int i = 0; i < 16; ++i) { sacc[i] = __expf(sacc[i] - mn); ps += sacc[i]; }
            lsum = lsum * alpha + ps;
#pragma unroll
            for (int i = 0; i < 16; ++i) { o0[i] *= alpha; o1[i] *= alpha; }
#pragma unroll
            for (int s2 = 0; s2 < 2; ++s2) {
                v4u pw; pw.x = cvt_pk_bf16(sacc[8 * s2 + 0], sacc[8 * s2 + 1]); pw.y = cvt_pk_bf16(sacc[8 * s2 + 2], sacc[8 * s2 + 3]);
                pw.z = cvt_pk_bf16(sacc[8 * s2 + 4], sacc[8 * s2 + 5]); pw.w = cvt_pk_bf16(sacc[8 * s2 + 6], sacc[8 * s2 + 7]);
                const pg::bf16x8 pf = __builtin_bit_cast(pg::bf16x8, pw);
#pragma unroll
                for (int dt = 0; dt < 2; ++dt) {
                    const int dbyte = 2 * (32 * dt + 16 * tr_g + 4 * tr_p);
                    const int r1 = 16 * s2 + 4 * hh + tr_q, r2 = r1 + 8;
                    const v4s v1 = __builtin_amdgcn_ds_read_tr16_b64_v4i16((PG_LAS v4s*)(vb + r1 * 128 + (dbyte ^ (((r1 >> 1) & 1) << 6))));
                    const v4s v2 = __builtin_amdgcn_ds_read_tr16_b64_v4i16((PG_LAS v4s*)(vb + r2 * 128 + (dbyte ^ (((r2 >> 1) & 1) << 6))));
                    const pg::bf16x8 vf = {v1[0], v1[1], v1[2], v1[3], v2[0], v2[1], v2[2], v2[3]};
                    if (dt == 0) o0 = __builtin_amdgcn_mfma_f32_32x32x16_bf16(vf, pf, o0, 0, 0, 0);
                    else o1 = __builtin_amdgcn_mfma_f32_32x32x16_bf16(vf, pf, o1, 0, 0, 0);
                }
            }
            if (t + 1 < nt) { PG_LAS unsigned char* nb = lds + ((t + 1) & 1) * 16384; *(PG_LAS v4u*)(nb + st_off) = g0; *(PG_LAS v4u*)(nb + 8192 + st_off) = g1; }
            __syncthreads();
        }
#undef ATT_TILE_TOK
        const float ltot = hsum32(lsum);
        const float inv = __builtin_amdgcn_rcpf(ltot + __expf(sink - m));
        float sq = 0.f;
#pragma unroll
        for (int i = 0; i < 16; ++i) { o0[i] *= inv; o1[i] *= inv; sq += o0[i] * o0[i] + o1[i] * o1[i]; }
        sq = hsum32(sq);
        if (hh == 0) ssq[h * 32 + qr] = sq;
        __syncthreads();
        float tot = 0.f;
#pragma unroll
        for (int w = 0; w < 8; ++w) tot += ssq[w * 32 + qr];
        const float rstd = rsqrtf(tot * (1.f / 512.f) + EPS);
        const float* ga = a.g_att + l * 512 + h * 64;
        bf16* orow = MIX + (size_t)(tq0 + qr) * D + h * 64;
#pragma unroll
        for (int dt = 0; dt < 2; ++dt)
#pragma unroll
            for (int i4 = 0; i4 < 4; ++i4) { const int d = 32 * dt + 8 * i4 + 4 * hh; const f32x4 gg = *(const f32x4*)(ga + d);
                const f32x16& oo = dt == 0 ? o0 : o1;
                v2u w; w.x = cvt_pk_bf16(oo[4 * i4 + 0] * rstd * gg.x, oo[4 * i4 + 1] * rstd * gg.y); w.y = cvt_pk_bf16(oo[4 * i4 + 2] * rstd * gg.z, oo[4 * i4 + 3] * rstd * gg.w);
                *(v2u*)(orow + d) = w; }
        __syncthreads();
    }
}
__global__ void __launch_bounds__(NTHR, 2) k_attn(P a, int l) {
    extern __shared__ __attribute__((aligned(16))) unsigned char smem[];
    a.wv = __builtin_amdgcn_readfirstlane(threadIdx.x >> 6);
    attn_phase(a, l, (PG_LAS unsigned char*)smem, (int)gridDim.x, (int)blockIdx.x);
}

__device__ __forceinline__ float scan_sum(float v, int) { return dpp_scan<false>(v); }
__device__ __forceinline__ float scan_max(float v, int) { return dpp_scan<true>(v); }
constexpr int ML_ITEMS = NB * NCHUNK;
constexpr int ML_LDS = 65536 + 65536 + 8192;
__device__ __forceinline__ void ml_load_v(const bf16* U, int tk0, PG_LAS unsigned char* lds, int tid) {
#pragma unroll
    for (int i = 0; i < 8; ++i) { const int cid = tid + 512 * i, sg = cid >> 6, r = cid & 63, hv = r >> 4, ch = r & 15;
        const v4u v = *(const v4u*)(U + (size_t)(tk0 + sg) * UW + U_VM + hv * 128 + ch * 8);
        *(PG_LAS v4u*)(lds + hv * 16384 + sg * 256 + ((ch * 16) ^ ((sg & 3) << 6))) = v; }
}
__device__ __forceinline__ float ml_tok(const bf16* U, int tk, int lo, int hi, int col) { return (tk >= lo && tk < hi) ? bf2f(U[(size_t)tk * UW + col]) : 0.f; }

template <int NT> __device__ __forceinline__ void conv8(const P& a, int l, const bf16* U, int tk0, int s0, int lo, int hi, int ch0, float (&out)[NT][8]) {
    float cw[5][8], cb[8];
#pragma unroll
    for (int j = 0; j < 5; ++j) { const f32x4 w0 = *(const f32x4*)(a.conv_w + (l * 5 + j) * 512 + ch0), w1 = *(const f32x4*)(a.conv_w + (l * 5 + j) * 512 + ch0 + 4);
        cw[j][0] = w0.x; cw[j][1] = w0.y; cw[j][2] = w0.z; cw[j][3] = w0.w; cw[j][4] = w1.x; cw[j][5] = w1.y; cw[j][6] = w1.z; cw[j][7] = w1.w; }
    { const f32x4 b0 = *(const f32x4*)(a.conv_b + l * 512 + ch0), b1 = *(const f32x4*)(a.conv_b + l * 512 + ch0 + 4);
      cb[0] = b0.x; cb[1] = b0.y; cb[2] = b0.z; cb[3] = b0.w; cb[4] = b1.x; cb[5] = b1.y; cb[6] = b1.z; cb[7] = b1.w; }
    v4u rows[NT + 4];
#pragma unroll
    for (int r = 0; r < NT + 4; ++r) { const int tk = tk0 + s0 + r - 2; const bool ok = tk >= lo && tk < hi; const int tkc = tk < lo ? lo : (tk >= hi ? hi - 1 : tk);
        const v4u v = *(const v4u*)(U + (size_t)tkc * UW + U_QM + ch0); rows[r] = ok ? v : (v4u){0u, 0u, 0u, 0u}; }
#pragma unroll
    for (int i = 0; i < NT; ++i) {
        float y[8];
#pragma unroll
        for (int c = 0; c < 8; ++c) y[c] = cb[c];
#pragma unroll
        for (int j = 0; j < 5; ++j) { const v4u x = rows[i + j];
            y[0] += cw[j][0] * bf_lo(x.x); y[1] += cw[j][1] * bf_hi(x.x); y[2] += cw[j][2] * bf_lo(x.y); y[3] += cw[j][3] * bf_hi(x.y);
            y[4] += cw[j][4] * bf_lo(x.z); y[5] += cw[j][5] * bf_hi(x.z); y[6] += cw[j][6] * bf_lo(x.w); y[7] += cw[j][7] * bf_hi(x.w); }
#pragma unroll
        for (int c = 0; c < 8; ++c) out[i][c] = silu_f(y[c]);
    }
}

__device__ __forceinline__ void ml_d1_phase(const P& a_in, int l, PG_LAS unsigned char* lds, int G, int c0) {
    PHASE_ENTRY(a_in)
    const int tid = otid(), lane = tid & 63, wave = __builtin_amdgcn_readfirstlane(tid >> 6), hd = wave >> 1, dir = wave & 1;
    const int hh = lane >> 5, lr = lane & 31, tr_q = (lane & 15) >> 2, tr_p = lane & 3, tr_g = (lane >> 4) & 1;
    const bf16* U = (const bf16*)(a.ws + WS_U); const float* GT = (const float*)(a.ws + WS_GATES);
    bf16* ST = (bf16*)(a.ws + WS_ST); float* NL = (float*)(a.ws + WS_NL); float* SC = (float*)(a.ws + WS_SC);
    PG_LAS unsigned char* kwt = lds + 65536;
    PG_LAS float* wts = (PG_LAS float*)(lds + 131072);
    for (int item = c0; item < ML_ITEMS; item += G) {
        const int b = item / NCHUNK, c = item - b * NCHUNK, tk0 = b * TPB + 64 * c;
        const int lo = c < 4 ? b * TPB : b * TPB + CTX, hi = c < 4 ? b * TPB + CTX : (b + 1) * TPB;
        const int cc = ((b * 4 + hd) * 2 + dir) * NCHUNK + c;
        ml_load_v(U, tk0, lds, tid);
        {
            const int t = dir ? 63 - lane : lane;
            const float li = GT[(size_t)(tk0 + t) * 16 + dir * 8 + hd], lf = logsigmoid_f(GT[(size_t)(tk0 + t) * 16 + dir * 8 + 4 + hd]);
            const float bc = scan_sum(lf, lane), bend = lane_bcast(bc, 63);
            const float g = bend - bc + li, mloc = wave_max(g);
            wts[wave * 64 + t] = __expf(g - mloc);
            if (lane == 0) { SC[(size_t)cc * 4 + 0] = bend; SC[(size_t)cc * 4 + 1] = mloc; }
        }
        __syncthreads();
        {
            const int chg = tid & 31, sb = tid >> 5, s0 = 4 * sb, khd = chg >> 3, d0 = (chg & 7) * 8;
            float kv[4][8];
            conv8<4>(a, l, U, tk0, s0, lo, hi, 256 + 8 * chg, kv);
#pragma unroll
            for (int i = 0; i < 4; ++i) { const int sg = s0 + i;
#pragma unroll
                for (int dd = 0; dd < 2; ++dd) { const float w = wts[(khd * 2 + dd) * 64 + sg];
                    v4u o; o.x = cvt_pk_bf16(kv[i][0] * w, kv[i][1] * w); o.y = cvt_pk_bf16(kv[i][2] * w, kv[i][3] * w); o.z = cvt_pk_bf16(kv[i][4] * w, kv[i][5] * w); o.w = cvt_pk_bf16(kv[i][6] * w, kv[i][7] * w);
                    *(PG_LAS v4u*)(kwt + (khd * 2 + dd) * 8192 + sg * 128 + ((2 * d0) ^ (((sg >> 1) & 1) << 6))) = o; } }
        }
        __syncthreads();
        PG_LAS unsigned char* kw = kwt + wave * 8192;
        {
            float ns = 0.f;
#pragma unroll 8
            for (int sg = 0; sg < 64; ++sg) ns += bf2f(*(const PG_LAS bf16*)(kw + sg * 128 + ((2 * lane) ^ (((sg >> 1) & 1) << 6))));
            NL[(size_t)cc * 64 + lane] = ns;
        }
        pg::bf16x8 af[2][4];
#pragma unroll
        for (int dt = 0; dt < 2; ++dt)
#pragma unroll
            for (int s4 = 0; s4 < 4; ++s4) { const int r1 = 16 * s4 + 8 * hh + tr_q, r2 = r1 + 4; const int dbyte = 2 * (32 * dt + 16 * tr_g + 4 * tr_p);
                const v4s v1 = __builtin_amdgcn_ds_read_tr16_b64_v4i16((PG_LAS v4s*)(kw + r1 * 128 + (dbyte ^ (((r1 >> 1) & 1) << 6))));
                const v4s v2 = __builtin_amdgcn_ds_read_tr16_b64_v4i16((PG_LAS v4s*)(kw + r2 * 128 + (dbyte ^ (((r2 >> 1) & 1) << 6))));
                af[dt][s4] = (pg::bf16x8){v1[0], v1[1], v1[2], v1[3], v2[0], v2[1], v2[2], v2[3]}; }
        PG_LAS unsigned char* vb = lds + hd * 16384;
#pragma unroll
        for (int et = 0; et < 4; ++et) {
            pg::bf16x8 bfr[4];
            const int ebyte = 2 * (32 * et + 16 * tr_g + 4 * tr_p);
#pragma unroll
            for (int s4 = 0; s4 < 4; ++s4) { const int r1 = 16 * s4 + 8 * hh + tr_q, r2 = r1 + 4;
                const v4s v1 = __builtin_amdgcn_ds_read_tr16_b64_v4i16((PG_LAS v4s*)(vb + r1 * 256 + (ebyte ^ ((r1 & 3) << 6))));
                const v4s v2 = __builtin_amdgcn_ds_read_tr16_b64_v4i16((PG_LAS v4s*)(vb + r2 * 256 + (ebyte ^ ((r2 & 3) << 6))));
                bfr[s4] = (pg::bf16x8){v1[0], v1[1], v1[2], v1[3], v2[0], v2[1], v2[2], v2[3]}; }
#pragma unroll
            for (int dt = 0; dt < 2; ++dt) {
                f32x16 acc = {};
#pragma unroll
                for (int s4 = 0; s4 < 4; ++s4) acc = __builtin_amdgcn_mfma_f32_32x32x16_bf16(af[dt][s4], bfr[s4], acc, 0, 0, 0);
                v4u o0, o1;
                o0.x = cvt_pk_bf16(acc[0], acc[1]); o0.y = cvt_pk_bf16(acc[2], acc[3]); o0.z = cvt_pk_bf16(acc[4], acc[5]); o0.w = cvt_pk_bf16(acc[6], acc[7]);
                o1.x = cvt_pk_bf16(acc[8], acc[9]); o1.y = cvt_pk_bf16(acc[10], acc[11]); o1.z = cvt_pk_bf16(acc[12], acc[13]); o1.w = cvt_pk_bf16(acc[14], acc[15]);
                bf16* dst = ST + ((size_t)cc * 8 + dt * 4 + et) * 1024 + lane * 16;
                *(v4u*)dst = o0; *(v4u*)(dst + 8) = o1;
            }
        }
        __syncthreads();
    }
}
__device__ __forceinline__ void ml_d2_phase(const P& a_in, int wg) {
    PHASE_ENTRY(a_in)
    const int tid = otid(), chain = wg >> 2, quarter = wg & 3, dir = chain & 1;
    bf16* ST = (bf16*)(a.ws + WS_ST); float* NL = (float*)(a.ws + WS_NL); float* SC = (float*)(a.ws + WS_SC);
    const bool cw = tid < 256, nw = (quarter == 0 && tid >= 256 && tid < 320);
    if (cw || nw) {
    float st[8];
#pragma unroll
    for (int j = 0; j < 8; ++j) st[j] = 0.f;
    float nst = 0.f, m = 0.f;
    const size_t unit = (size_t)(quarter * 256 + tid) * 8;
#pragma unroll 1
    for (int i0 = 0; i0 < NCHUNK; i0 += 4) {
        v4u x[4]; float nx[4], be[4], ml[4]; int cidx[4];
#pragma unroll
        for (int k = 0; k < 4; ++k) { const int i = i0 + k; const int c = dir == 0 ? i : (i < 4 ? 3 - i : 71 - i); cidx[k] = chain * NCHUNK + c;
            be[k] = SC[(size_t)cidx[k] * 4]; ml[k] = SC[(size_t)cidx[k] * 4 + 1];
            if (cw) x[k] = *(const v4u*)(ST + (size_t)cidx[k] * 8192 + unit); else nx[k] = NL[(size_t)cidx[k] * 64 + (tid - 256)]; }
#pragma unroll
        for (int k = 0; k < 4; ++k) {
            const float mn = fmaxf(be[k] + m, ml[k]), fa = __expf(be[k] + m - mn), fb = __expf(ml[k] - mn);
            if (cw) {
                v4u o; o.x = pk2(st[0], st[1]); o.y = pk2(st[2], st[3]); o.z = pk2(st[4], st[5]); o.w = pk2(st[6], st[7]);
                *(v4u*)(ST + (size_t)cidx[k] * 8192 + unit) = o;
                st[0] = fa * st[0] + fb * bf_lo(x[k].x); st[1] = fa * st[1] + fb * bf_hi(x[k].x); st[2] = fa * st[2] + fb * bf_lo(x[k].y); st[3] = fa * st[3] + fb * bf_hi(x[k].y);
                st[4] = fa * st[4] + fb * bf_lo(x[k].z); st[5] = fa * st[5] + fb * bf_hi(x[k].z); st[6] = fa * st[6] + fb * bf_lo(x[k].w); st[7] = fa * st[7] + fb * bf_hi(x[k].w);
            } else {
                NL[(size_t)cidx[k] * 64 + (tid - 256)] = nst; nst = fa * nst + fb * nx[k];
                if (tid == 256) SC[(size_t)cidx[k] * 4 + 2] = m;
            }
            m = mn;
        }
    }
    }
}
__device__ __forceinline__ void ml_d3_phase(const P& a_in, int l, PG_LAS unsigned char* lds, int G, int c0) {
    PHASE_ENTRY(a_in)
    const int tid = otid(), wave = __builtin_amdgcn_readfirstlane(tid >> 6), hd = wave >> 1, qt = wave & 1;
    const bf16* U = (const bf16*)(a.ws + WS_U); const float* GT = (const float*)(a.ws + WS_GATES);
    const bf16* ST = (const bf16*)(a.ws + WS_ST); const float* NL = (const float*)(a.ws + WS_NL); const float* SC = (const float*)(a.ws + WS_SC);
    bf16* MIX = (bf16*)(a.ws + WS_MIX);
    PG_LAS unsigned char* qtile = lds + 65536 + hd * 16384;
    PG_LAS unsigned char* ktile = qtile + 8192;
    PG_LAS float* aarr = (PG_LAS float*)(lds + 131072 + wave * 1024);
    for (int item = c0; item < ML_ITEMS; item += G) {
        int lane = tid & 63; asm volatile("" : "+v"(lane));
        const int hh = lane >> 5, lr = lane & 31, tr_q = (lane & 15) >> 2, tr_p = lane & 3, tr_g = (lane >> 4) & 1;
        const int tq = 32 * qt + lr;
        const int b = item / NCHUNK, c = item - b * NCHUNK, tk0 = b * TPB + 64 * c;
        const int lo = c < 4 ? b * TPB : b * TPB + CTX, hi = c < 4 ? b * TPB + CTX : (b + 1) * TPB;
        ml_load_v(U, tk0, lds, tid);
        {
            const int chg = tid & 63, s0 = 8 * (tid >> 6), ch0 = 8 * chg;
            float kv[8][8];
            conv8<8>(a, l, U, tk0, s0, lo, hi, ch0, kv);
            PG_LAS unsigned char* dstt = lds + 65536 + ((ch0 & 255) >> 6) * 16384 + (ch0 >> 8) * 8192;
            const float qsc = ch0 < 256 ? 0.125f : 1.f; const int chunk = (ch0 & 63) >> 3;
#pragma unroll
            for (int i = 0; i < 8; ++i) { const int sg = s0 + i;
                v4u o; o.x = cvt_pk_bf16(kv[i][0] * qsc, kv[i][1] * qsc); o.y = cvt_pk_bf16(kv[i][2] * qsc, kv[i][3] * qsc); o.z = cvt_pk_bf16(kv[i][4] * qsc, kv[i][5] * qsc); o.w = cvt_pk_bf16(kv[i][6] * qsc, kv[i][7] * qsc);
                *(PG_LAS v4u*)(dstt + sg * 128 + 16 * (chunk ^ ((sg >> 1) & 7))) = o; }
        }
        __syncthreads();
#define D3_QF(s4) ({ const int sw_ = (tq >> 1) & 7; \
            const v2u lo2_ = *(const PG_LAS v2u*)(qtile + tq * 128 + 16 * ((2 * (s4)) ^ sw_) + 8 * hh), hi2_ = *(const PG_LAS v2u*)(qtile + tq * 128 + 16 * ((2 * (s4) + 1) ^ sw_) + 8 * hh); \
            __builtin_bit_cast(pg::bf16x8, (v4u){lo2_.x, lo2_.y, hi2_.x, hi2_.y}); })
        f32x16 hs[4];
#pragma unroll
        for (int et = 0; et < 4; ++et) hs[et] = (f32x16){};
#pragma unroll 1
        for (int dir = 0; dir < 2; ++dir) {
            const int cc = ((b * 4 + hd) * 2 + dir) * NCHUNK + c;
            const float mprev = SC[(size_t)cc * 4 + 2];
            {
                const int t = dir ? 63 - lane : lane;
                const float li = GT[(size_t)(tk0 + t) * 16 + dir * 8 + hd], lf = logsigmoid_f(GT[(size_t)(tk0 + t) * 16 + dir * 8 + 4 + hd]);
                const float bc = scan_sum(lf, lane), av = li - bc, pm = scan_max(av, lane), Mv = fmaxf(mprev, pm);
                aarr[t] = av; aarr[64 + t] = Mv; aarr[128 + t] = bc;
            }
            const float Mq = aarr[64 + tq], bq = aarr[128 + tq];
            const float wq = __expf(mprev - Mq);
            float qn = 0.f;
#pragma unroll
            for (int s4 = 0; s4 < 4; ++s4) { const f32x4 n0 = *(const f32x4*)(NL + (size_t)cc * 64 + 16 * s4 + 4 * hh), n1 = *(const f32x4*)(NL + (size_t)cc * 64 + 16 * s4 + 8 + 4 * hh);
                const v4u qw = __builtin_bit_cast(v4u, D3_QF(s4));
                qn += bf_lo(qw.x) * n0.x + bf_hi(qw.x) * n0.y + bf_lo(qw.y) * n0.z + bf_hi(qw.y) * n0.w + bf_lo(qw.z) * n1.x + bf_hi(qw.z) * n1.y + bf_lo(qw.w) * n1.z + bf_hi(qw.w) * n1.w; }
            qn = hsum32(qn);
            pg::bf16x8 pf[2][2]; float psum = 0.f;
#pragma unroll
            for (int st = 0; st < 2; ++st) {
                f32x16 acc = {}; const int sg = 32 * st + lr, sw = (sg >> 1) & 7;
#pragma unroll
                for (int s4 = 0; s4 < 4; ++s4) {
                    const v2u lo2 = *(const PG_LAS v2u*)(ktile + sg * 128 + 16 * ((2 * s4) ^ sw) + 8 * hh), hi2 = *(const PG_LAS v2u*)(ktile + sg * 128 + 16 * ((2 * s4 + 1) ^ sw) + 8 * hh);
                    const pg::bf16x8 kf = __builtin_bit_cast(pg::bf16x8, (v4u){lo2.x, lo2.y, hi2.x, hi2.y});
                    acc = __builtin_amdgcn_mfma_f32_32x32x16_bf16(kf, D3_QF(s4), acc, 0, 0, 0); }
#pragma unroll
                for (int i4 = 0; i4 < 4; ++i4) { const f32x4 av = *(const PG_LAS f32x4*)(aarr + 32 * st + 8 * i4 + 4 * hh);
#pragma unroll
                    for (int j = 0; j < 4; ++j) { const int sgk = 32 * st + 8 * i4 + 4 * hh + j; const bool ok = dir ? (sgk >= tq) : (sgk <= tq);
                        const float p = ok ? acc[4 * i4 + j] * __expf(av[j] - Mq) : 0.f; acc[4 * i4 + j] = p; psum += p; } }
#pragma unroll
                for (int s2 = 0; s2 < 2; ++s2) { v4u pw; pw.x = cvt_pk_bf16(acc[8 * s2 + 0], acc[8 * s2 + 1]); pw.y = cvt_pk_bf16(acc[8 * s2 + 2], acc[8 * s2 + 3]);
                    pw.z = cvt_pk_bf16(acc[8 * s2 + 4], acc[8 * s2 + 5]); pw.w = cvt_pk_bf16(acc[8 * s2 + 6], acc[8 * s2 + 7]); pf[st][s2] = __builtin_bit_cast(pg::bf16x8, pw); }
            }
            psum = hsum32(psum);
            const float den = psum + wq * qn;
            const float rden = __builtin_amdgcn_rcpf(fmaxf(fabsf(den), __expf(-(bq + Mq))));
            PG_LAS unsigned char* vb = lds + hd * 16384;
#pragma unroll
            for (int et = 0; et < 4; ++et) {
                f32x16 acc = {};
#pragma unroll
                for (int dt = 0; dt < 2; ++dt) { const bf16* src = ST + ((size_t)cc * 8 + dt * 4 + et) * 1024 + lane * 16;
                    const pg::bf16x8 c0f = *(const pg::bf16x8*)src, c1f = *(const pg::bf16x8*)(src + 8);
                    acc = __builtin_amdgcn_mfma_f32_32x32x16_bf16(c0f, D3_QF(2 * dt), acc, 0, 0, 0);
                    acc = __builtin_amdgcn_mfma_f32_32x32x16_bf16(c1f, D3_QF(2 * dt + 1), acc, 0, 0, 0); }
#pragma unroll
                for (int i = 0; i < 16; ++i) acc[i] *= wq;
                const int ebyte = 2 * (32 * et + 16 * tr_g + 4 * tr_p);
#pragma unroll
                for (int st = 0; st < 2; ++st)
#pragma unroll
                    for (int s2 = 0; s2 < 2; ++s2) { const int r1 = 32 * st + 16 * s2 + 4 * hh + tr_q, r2 = r1 + 8;
                        const v4s v1 = __builtin_amdgcn_ds_read_tr16_b64_v4i16((PG_LAS v4s*)(vb + r1 * 256 + (ebyte ^ ((r1 & 3) << 6))));
                        const v4s v2 = __builtin_amdgcn_ds_read_tr16_b64_v4i16((PG_LAS v4s*)(vb + r2 * 256 + (ebyte ^ ((r2 & 3) << 6))));
                        const pg::bf16x8 vf = {v1[0], v1[1], v1[2], v1[3], v2[0], v2[1], v2[2], v2[3]};
                        acc = __builtin_amdgcn_mfma_f32_32x32x16_bf16(vf, pf[st][s2], acc, 0, 0, 0); }
                hs[et] += acc * rden;
                asm volatile("" ::: "memory");
            }
        }
        float sq = 0.f;
#pragma unroll
        for (int et = 0; et < 4; ++et)
#pragma unroll
            for (int i = 0; i < 16; ++i) sq += hs[et][i] * hs[et][i];
        sq = hsum32(sq);
        const float rstd = rsqrtf(sq * (1.f / 128.f) + EPS);
        const float* gm = a.g_ml + l * 512 + hd * 128;
        const bf16* om = U + (size_t)(tk0 + tq) * UW + U_OM + hd * 128;
        bf16* orow = MIX + (size_t)(tk0 + tq) * D + 512 + hd * 128;
#pragma unroll
        for (int et = 0; et < 4; ++et)
#pragma unroll
            for (int i4 = 0; i4 < 4; ++i4) { const int e = 32 * et + 8 * i4 + 4 * hh; const f32x4 gg = *(const f32x4*)(gm + e); const v2u ov = *(const v2u*)(om + e);
                const float y0 = hs[et][4 * i4 + 0] * rstd * gg.x * sigmoid_f(bf_lo(ov.x)), y1 = hs[et][4 * i4 + 1] * rstd * gg.y * sigmoid_f(bf_hi(ov.x));
                const float y2 = hs[et][4 * i4 + 2] * rstd * gg.z * sigmoid_f(bf_lo(ov.y)), y3 = hs[et][4 * i4 + 3] * rstd * gg.w * sigmoid_f(bf_hi(ov.y));
                v2u w; w.x = cvt_pk_bf16(y0, y1); w.y = cvt_pk_bf16(y2, y3); *(v2u*)(orow + e) = w;
                if (i4 == 3) asm volatile("" ::: "memory"); }
        __syncthreads();
    }
}
__global__ void __launch_bounds__(NTHR, 2) k_ml_d1(P a, int l) { a.wv = __builtin_amdgcn_readfirstlane(threadIdx.x >> 6); extern __shared__ __attribute__((aligned(16))) unsigned char smem[]; ml_d1_phase(a, l, (PG_LAS unsigned char*)smem, (int)gridDim.x, (int)blockIdx.x); }
__global__ void __launch_bounds__(NTHR, 2) k_ml_d2(P a) { a.wv = __builtin_amdgcn_readfirstlane(threadIdx.x >> 6); ml_d2_phase(a, (int)blockIdx.x); }
__global__ void __launch_bounds__(NTHR, 2) k_ml_d3(P a, int l) { a.wv = __builtin_amdgcn_readfirstlane(threadIdx.x >> 6); extern __shared__ __attribute__((aligned(16))) unsigned char smem[]; ml_d3_phase(a, l, (PG_LAS unsigned char*)smem, (int)gridDim.x, (int)blockIdx.x); }

#define XB_TMO      128
#define XB_XCNT(j)  (256  + 64 * (j))
#define XB_XSUB(j)  (1280 + 64 * (j))
#define XB_XGEN(j)  (2304 + 64 * (j))
#define XB_TOP      3328
#define XB_TOPGEN   3392
#define XCD_BAR_WORDS 3456
#define XB_SPIN_CAP (1u << 20)
__device__ __forceinline__ unsigned xb_ld(unsigned* p)              { return __hip_atomic_load(p, __ATOMIC_RELAXED, __HIP_MEMORY_SCOPE_AGENT); }
__device__ __forceinline__ unsigned xb_add(unsigned* p, unsigned v) { return __hip_atomic_fetch_add(p, v, __ATOMIC_RELAXED, __HIP_MEMORY_SCOPE_AGENT); }
__device__ __forceinline__ unsigned xb_xcc_id() { return (unsigned)__builtin_amdgcn_s_getreg((3 << 11) | 20) & 0xFu; }
#define XB_SPIN(cond, bar) do { unsigned _sp = 0; while (cond) { __builtin_amdgcn_s_sleep(1); \
    if ((++_sp & 255u) == 0u) { if (xb_ld(&(bar)[XB_TMO])) break; if (_sp > XB_SPIN_CAP) { atomicAdd(&(bar)[XB_TMO], 1u); break; } } } } while (0)
struct XcdBarrier { unsigned* bar; unsigned x; volatile PG_LAS unsigned* st; };
__device__ __forceinline__ XcdBarrier xcd_barrier_post(unsigned* bar, volatile PG_LAS unsigned* st, int tid) {
    XcdBarrier b; b.bar = bar; b.x = xb_xcc_id(); b.st = st;
    if (tid == 0) (void)xb_add(&bar[XB_XCNT(b.x)], 1u);
    return b;
}
__device__ __forceinline__ void xcd_barrier_complete(unsigned* bar, unsigned x, unsigned& nloc, unsigned& nx) {
    const unsigned G = gridDim.x * gridDim.y * gridDim.z;
    unsigned sum, cnt, mine, sp = 0u;
    for (;;) {
        sum = 0u; cnt = 0u; mine = 0u;
#pragma unroll
        for (unsigned j = 0; j < 16; ++j) { const unsigned c = xb_ld(&bar[XB_XCNT(j)]); sum += c; cnt += (c > 0u) ? 1u : 0u; mine = (j == x) ? c : mine; }
        if (sum == G) break;
        __builtin_amdgcn_s_sleep(1);
        if ((++sp & 255u) == 0u) { if (xb_ld(&bar[XB_TMO])) break; if (sp > XB_SPIN_CAP) { atomicAdd(&bar[XB_TMO], 1u); break; } }
    }
    nloc = mine > 0u ? mine : 1u; nx = cnt > 0u ? cnt : 1u;
}
__device__ __forceinline__ void xcd_barrier(const XcdBarrier& b, int tid) {
    asm volatile("s_waitcnt vmcnt(0)" ::: "memory");
    __syncthreads();
    if (tid == 0) {
        unsigned* bar = b.bar; asm volatile("" : "+s"(bar)); unsigned bx = b.x; asm volatile("" : "+s"(bx));
        __builtin_amdgcn_s_waitcnt(0);
        unsigned nloc = b.st[0], nx = b.st[1];
        if (nloc == 0u) { xcd_barrier_complete(bar, bx, nloc, nx); b.st[0] = nloc; b.st[1] = nx; }
        const unsigned old = xb_add(&bar[XB_XSUB(bx)], 1u);
        const unsigned gen = old / nloc;
        if (old + 1u == (gen + 1u) * nloc) {
            __builtin_amdgcn_fence(__ATOMIC_RELEASE, "agent");
            asm volatile("s_waitcnt vmcnt(0)" ::: "memory");
            const unsigned og = xb_add(&bar[XB_TOP], 1u);
            const unsigned tg = og / nx;
            if (og + 1u == (tg + 1u) * nx) xb_add(&bar[XB_TOPGEN], 1u);
            else XB_SPIN(xb_ld(&bar[XB_TOPGEN]) == tg, bar);
            __builtin_amdgcn_fence(__ATOMIC_ACQUIRE, "agent");
            xb_add(&bar[XB_XGEN(bx)], 1u);
            asm volatile("s_waitcnt vmcnt(0)" ::: "memory");
        } else {
            XB_SPIN(xb_ld(&bar[XB_XGEN(bx)]) == gen, bar);
            __builtin_amdgcn_fence(__ATOMIC_ACQUIRE, "agent");
            asm volatile("s_waitcnt vmcnt(0)" ::: "memory");
        }
    }
    __syncthreads();
}
__device__ __forceinline__ void modvec_phase(const P& a_in, float* lds, int G, int c) {
    PHASE_ENTRY(a_in)
    float* cond = lds;
    float* red = lds + MODR * D;
    const int t = otid(), kg = t >> 6;
    for (int i = t; i < MODR * D; i += NTHR) { const int r = i / D, k = i % D; const float v = r < NB ? a.c[r * D + k] : a.c_ctx[k]; cond[i] = silu_f(v); }
    __syncthreads();
    float* mod = (float*)(a.ws + WS_MOD);
    for (int item = c; item < DEPTH * 96; item += G) {
        const int l = item / 96, nc = item % 96, n = nc * 64 + (t & 63);
        float acc[MODR];
#pragma unroll
        for (int r = 0; r < MODR; ++r) acc[r] = 0.f;
        const float* w = a.w_mod + (size_t)l * D * MODW + n;
#pragma unroll 4
        for (int k = kg * 128; k < kg * 128 + 128; ++k) { const float wv = w[(size_t)k * MODW];
#pragma unroll
            for (int r = 0; r < MODR; ++r) acc[r] += cond[r * D + k] * wv; }
#pragma unroll
        for (int r = 0; r < MODR; ++r) red[(kg * MODR + r) * 64 + (t & 63)] = acc[r];
        __syncthreads();
        for (int i = t; i < MODR * 64; i += NTHR) { const int r = i / 64, j = i % 64, nn = nc * 64 + j; float sacc = a.b_mod[l * MODW + nn];
#pragma unroll
            for (int q = 0; q < 8; ++q) sacc += red[(q * MODR + r) * 64 + j];
            mod[((size_t)l * MODR + r) * MODW + nn] = sacc; }
        __syncthreads();
    }
}
__device__ __forceinline__ void conv_dense_weights(const P& a_in, float* scr, int gw, int ngw, int lane) {
    PHASE_ENTRY(a_in)
    unsigned char* ws = a.ws;
#pragma unroll 1
    for (int l = 0; l < DEPTH; ++l) {
        tr_matrix(a.w_in + (size_t)l * D * INW, D, INW, UW, (bf16*)(ws + WS_WIN) + (size_t)l * UW * D, 0, scr, gw, ngw, lane);
        tr_matrix(a.w_out + (size_t)l * D * D, D, D, D, (bf16*)(ws + WS_WOUT) + (size_t)l * D * D, 0, scr, gw, ngw, lane);
    }
#pragma unroll 1
    for (int i = 0; i < 2; ++i) {
        tr_matrix(a.ffn_w1 + (size_t)i * D * FFN, D, FFN, FFN, (bf16*)(ws + WS_WF13) + (size_t)i * 2 * FFN * D, 1, scr, gw, ngw, lane);
        tr_matrix(a.ffn_w3 + (size_t)i * D * FFN, D, FFN, FFN, (bf16*)(ws + WS_WF13) + (size_t)i * 2 * FFN * D, 2, scr, gw, ngw, lane);
        tr_matrix(a.ffn_w2 + (size_t)i * FFN * D, FFN, D, D, (bf16*)(ws + WS_WF2) + (size_t)i * D * FFN, 0, scr, gw, ngw, lane);
    }
}
__device__ __forceinline__ void conv_expert_weights(const P& a_in, int li, float* scr, int gw, int ngw, int lane) {
    PHASE_ENTRY(a_in)
    unsigned char* ws = a.ws;
#pragma unroll 1
    for (int e = 0; e < NE; ++e) {
        tr_matrix(a.exp_w1 + ((size_t)li * NE + e) * D * FFN, D, FFN, FFN, (bf16*)(ws + WS_WE13) + (size_t)e * 2 * FFN * D, 1, scr, gw, ngw, lane);
        tr_matrix(a.exp_w3 + ((size_t)li * NE + e) * D * FFN, D, FFN, FFN, (bf16*)(ws + WS_WE13) + (size_t)e * 2 * FFN * D, 2, scr, gw, ngw, lane);
        tr_matrix(a.exp_w2 + ((size_t)li * NE + e) * FFN * D, FFN, D, D, (bf16*)(ws + WS_WE2) + (size_t)e * D * FFN, 0, scr, gw, ngw, lane);
    }
}
#if MEGA
constexpr int MEGA_LDS = 147456;
__global__ void __launch_bounds__(NTHR, 2) k_mega(P a_k) {
    extern __shared__ __attribute__((aligned(16))) unsigned char smem[];
    PG_LAS unsigned char* lds = (PG_LAS unsigned char*)smem;
    P a = a_k; a.wv = __builtin_amdgcn_readfirstlane(threadIdx.x >> 6);
    const int G = (int)gridDim.x, wg = (int)blockIdx.x;
    volatile PG_LAS unsigned* bst = (volatile PG_LAS unsigned*)(lds + MEGA_LDS - 16);
    if (otid() == 0) { bst[0] = 0u; bst[1] = 0u; bst[2] = 0u; bst[3] = 0u; }
    __syncthreads();
    const XcdBarrier bar = xcd_barrier_post((unsigned*)(a.ws + WS_CTL) + 1024, bst, otid());
    { const int t_ = otid(); conv_dense_weights(a, (float*)smem + (t_ >> 6) * (64 * 33), wg * 8 + (t_ >> 6), G * 8, t_ & 63); }
    __syncthreads();
    modvec_phase(a, (float*)smem, G, wg);
      { for (int i = otid(); i < 64 * 16; i += NTHR) { const int pos = i / 16, f = i % 16; const float ang = (float)pos * powf(10000.0f, -(float)f / 16.0f);
        float* t = (float*)(a.ws + WS_ROPE); t[2 * i] = cosf(ang); t[2 * i + 1] = sinf(ang); } }
    xcd_barrier(bar, otid());
#pragma unroll 1
    for (int l = 0; l < DEPTH; ++l) {
        if (l == 0) norm_phase<0, true, false>(a, l, wg, (PG_LAS float*)smem);
        else if (l == 2) norm_phase<0, false, true>(a, l, wg, (PG_LAS float*)smem);
        else norm_phase<0, false, false>(a, l, wg, (PG_LAS float*)smem);
        xcd_barrier(bar, otid());
        gemm_run<EM_IN>(a, l, lds, G, wg);
        xcd_barrier(bar, otid());
        if (PROBE == 6) { gemm_run<EM_IN>(a, l, lds, G, wg); xcd_barrier(bar, otid()); }
        attn_phase(a, l, lds, G, wg);
        ml_d1_phase(a, l, lds, G, wg);
        xcd_barrier(bar, otid());
        if (PROBE == 1) { attn_phase(a, l, lds, G, wg); xcd_barrier(bar, otid()); }
        if (PROBE == 5) { ml_d1_phase(a, l, lds, G, wg); xcd_barrier(bar, otid()); }
        ml_d2_phase(a, wg);
        if ((l & 1) == 0) { __syncthreads(); const int t_ = otid(); conv_expert_weights(a, l >> 1, (float*)smem + (t_ >> 6) * (64 * 33), wg * 8 + (t_ >> 6), G * 8, t_ & 63); }
        xcd_barrier(bar, otid());
        ml_d3_phase(a, l, lds, G, wg);
        xcd_barrier(bar, otid());
        if (PROBE == 2) { ml_d3_phase(a, l, lds, G, wg); xcd_barrier(bar, otid()); }
        if (PROBE == 4) { xcd_barrier(bar, otid()); xcd_barrier(bar, otid()); xcd_barrier(bar, otid()); xcd_barrier(bar, otid()); }
        gemm_run<EM_OUT>(a, l, lds, G, wg);
        xcd_barrier(bar, otid());
        if ((l & 1) == 0) {
            norm_phase<1, false, false>(a, l, wg, (PG_LAS float*)smem);
            xcd_barrier(bar, otid());
            if (PROBE == 3) { norm_phase<1, false, false>(a, l, wg, (PG_LAS float*)smem); xcd_barrier(bar, otid()); }
            gemm_run<EM_F1>(a, l, lds, G, wg);
            xcd_barrier(bar, otid());
            if (PROBE == 7) { gemm_run<EM_F1>(a, l, lds, G, wg); xcd_barrier(bar, otid()); }
            gemm_run<EM_F2D>(a, l, lds, G, wg);
            xcd_barrier(bar, otid());
        } else {
            norm_phase<2, false, false>(a, l, wg, (PG_LAS float*)smem);
            xcd_barrier(bar, otid());
            if (PROBE == 3) { norm_phase<2, false, false>(a, l, wg, (PG_LAS float*)smem); xcd_barrier(bar, otid()); }
            moe_pos_phase(a, wg, (int*)smem);
            xcd_barrier(bar, otid());
            gemm_run<EM_F1M>(a, l, lds, G, wg);
            xcd_barrier(bar, otid());
            if (PROBE == 8) { gemm_run<EM_F1M>(a, l, lds, G, wg); xcd_barrier(bar, otid()); }
            gemm_run<EM_F2M>(a, l, lds, G, wg);
            xcd_barrier(bar, otid());
            if (PROBE == 9) { gemm_run<EM_F2M>(a, l, lds, G, wg); xcd_barrier(bar, otid()); }
        }
    }
    norm_phase<3, false, true>(a, DEPTH, wg, (PG_LAS float*)smem);
}
#endif

#ifndef FAST_IN
#define FAST_IN 1
#endif
#ifndef FAST_OUT
#define FAST_OUT 1
#endif
#ifndef FAST_F1
#define FAST_F1 1
#endif
#ifndef FAST_F2
#define FAST_F2 1
#endif
#ifndef FAST_F1M
#define FAST_F1M 1
#endif
#ifndef FAST_F2M
#define FAST_F2M 1
#endif
constexpr int GEMM_LDS = 131072 + 1024 + 8192;
template <int WHICH> static void launch_gemm(hipStream_t s, const P& a, int l) {
    static bool once = false;
    if (!once) { (void)hipFuncSetAttribute((const void*)k_gemm<WHICH>, hipFuncAttributeMaxDynamicSharedMemorySize, GEMM_LDS); once = true; }
    hipLaunchKernelGGL((k_gemm<WHICH>), dim3(NWG), dim3(NTHR), GEMM_LDS, s, a, l);
}
static void launch_tr(hipStream_t s, const float* W, int K, int ld, int N, bf16* WT, int mode) {
    hipLaunchKernelGGL(k_transpose, dim3(512), dim3(256), 0, s, W, K, ld, N, WT, mode);
}
extern "C" void kernel_launch(void* const* d_in, const int* in_sizes, int n_in, void* d_out, int out_size, void* d_ws, size_t ws_size, hipStream_t stream) {
    if (n_in != 25 || ws_size < WS_END) { fprintf(stderr, "kernel_launch: bad args n_in %d ws %zu need %zu\n", n_in, ws_size, (size_t)WS_END); return; }
    static bool init = false;
    constexpr int NORM_LDS = 8192 * 4 + 8 * 32 * 4 + 64;
    if (!init) {
        hipFuncSetAttribute((const void*)k_norm<0, true, false>, hipFuncAttributeMaxDynamicSharedMemorySize, NORM_LDS);
        hipFuncSetAttribute((const void*)k_norm<0, false, false>, hipFuncAttributeMaxDynamicSharedMemorySize, NORM_LDS);
        hipFuncSetAttribute((const void*)k_norm<0, false, true>, hipFuncAttributeMaxDynamicSharedMemorySize, NORM_LDS);
        hipFuncSetAttribute((const void*)k_norm<1, false, false>, hipFuncAttributeMaxDynamicSharedMemorySize, NORM_LDS);
        hipFuncSetAttribute((const void*)k_norm<2, false, false>, hipFuncAttributeMaxDynamicSharedMemorySize, NORM_LDS);
        hipFuncSetAttribute((const void*)k_norm<3, false, true>, hipFuncAttributeMaxDynamicSharedMemorySize, NORM_LDS);
        init = true;
    }
    P a{};
    const float** f = (const float**)&a;
    for (int i = 0; i < 25; ++i) f[i] = (const float*)d_in[i];
    a.out = (float*)d_out; a.ws = (unsigned char*)d_ws;
    unsigned char* ws = a.ws;
    hipMemsetAsync(ws + WS_CTL, 0, 1 * MiB, stream);
#if MEGA
    {
        static bool once = false;
        if (!once) { (void)hipFuncSetAttribute((const void*)k_mega, hipFuncAttributeMaxDynamicSharedMemorySize, MEGA_LDS); once = true; }
        hipLaunchKernelGGL(k_mega, dim3(NWG), dim3(NTHR), MEGA_LDS, stream, a);
        return;
    }
#endif
    for (int l = 0; l < DEPTH; ++l) {
        launch_tr(stream, a.w_in + (size_t)l * D * INW, D, INW, UW, (bf16*)(ws + WS_WIN) + (size_t)l * UW * D, 0);
        launch_tr(stream, a.w_out + (size_t)l * D * D, D, D, D, (bf16*)(ws + WS_WOUT) + (size_t)l * D * D, 0);
    }
    for (int i = 0; i < 2; ++i) {
        launch_tr(stream, a.ffn_w1 + (size_t)i * D * FFN, D, FFN, FFN, (bf16*)(ws + WS_WF13) + (size_t)i * 2 * FFN * D, 1);
        launch_tr(stream, a.ffn_w3 + (size_t)i * D * FFN, D, FFN, FFN, (bf16*)(ws + WS_WF13) + (size_t)i * 2 * FFN * D, 2);
        launch_tr(stream, a.ffn_w2 + (size_t)i * FFN * D, FFN, D, D, (bf16*)(ws + WS_WF2) + (size_t)i * D * FFN, 0);
    }
    hipLaunchKernelGGL(k_modvec, dim3(DEPTH * 96), dim3(256), 0, stream, a);
    hipLaunchKernelGGL(k_rope_table, dim3(4), dim3(256), 0, stream, a);
    for (int l = 0; l < DEPTH; ++l) {
        const bool moe = l & 1;
        if (l == 0) hipLaunchKernelGGL((k_norm<0, true, false>), dim3(NWG), dim3(NTHR), NORM_LDS, stream, a, l);
        else if (l == 2) hipLaunchKernelGGL((k_norm<0, false, true>), dim3(NWG), dim3(NTHR), NORM_LDS, stream, a, l);
        else hipLaunchKernelGGL((k_norm<0, false, false>), dim3(NWG), dim3(NTHR), NORM_LDS, stream, a, l);
        if (FAST_IN) launch_gemm<EM_IN>(stream, a, l);
        else {
        hipLaunchKernelGGL((k_ngemm<EM_IN>), dim3(UW / 64, T_ALL / 64), dim3(256), 0, stream, a, l, (const bf16*)(ws + WS_HX), (const bf16*)(ws + WS_WIN) + (size_t)l * UW * D, T_ALL, UW, D);
        hipLaunchKernelGGL(k_rope_apply, dim3((T_ALL * 320 + 255) / 256), dim3(256), 0, stream, a); }
#ifndef FAST_ATT
#define FAST_ATT 1
#endif
        if (FAST_ATT) hipLaunchKernelGGL(k_attn, dim3(NWG), dim3(NTHR), ATT_LDS, stream, a, l);
        else hipLaunchKernelGGL(k_attn_naive, dim3(T_ALL), dim3(512), 0, stream, a, l);
#ifndef FAST_ML
#define FAST_ML 1
#endif
        if (FAST_ML) {
            static bool once = false;
            if (!once) { (void)hipFuncSetAttribute((const void*)k_ml_d1, hipFuncAttributeMaxDynamicSharedMemorySize, ML_LDS); (void)hipFuncSetAttribute((const void*)k_ml_d3, hipFuncAttributeMaxDynamicSharedMemorySize, ML_LDS); once = true; }
            hipLaunchKernelGGL(k_ml_d1, dim3(NWG), dim3(NTHR), ML_LDS, stream, a, l);
            hipLaunchKernelGGL(k_ml_d2, dim3(NWG), dim3(NTHR), 0, stream, a);
            hipLaunchKernelGGL(k_ml_d3, dim3(NWG), dim3(NTHR), ML_LDS, stream, a, l);
        } else {
        hipLaunchKernelGGL(k_mlstm_naive, dim3(64), dim3(256), 0, stream, a, l);
        hipLaunchKernelGGL(k_merge_naive, dim3(T_ALL), dim3(256), 0, stream, a, l); }
        if (FAST_OUT) launch_gemm<EM_OUT>(stream, a, l);
        else hipLaunchKernelGGL((k_ngemm<EM_OUT>), dim3(D / 64, T_ALL / 64), dim3(256), 0, stream, a, l, (const bf16*)(ws + WS_MIX), (const bf16*)(ws + WS_WOUT) + (size_t)l * D * D, T_ALL, D, D);
        if (!moe) {
            hipLaunchKernelGGL((k_norm<1, false, false>), dim3(NWG), dim3(NTHR), NORM_LDS, stream, a, l);
            if (FAST_F1) launch_gemm<EM_F1>(stream, a, l);
            else hipLaunchKernelGGL((k_ngemm<EM_F1>), dim3(FFN / 64, T_ALL / 64), dim3(256), 0, stream, a, l, (const bf16*)(ws + WS_HX), (const bf16*)(ws + WS_WF13) + (size_t)(l >> 1) * 2 * FFN * D, T_ALL, FFN, D);
            if (FAST_F2) launch_gemm<EM_F2D>(stream, a, l);
            else hipLaunchKernelGGL((k_ngemm<EM_F2D>), dim3(D / 64, T_ALL / 64), dim3(256), 0, stream, a, l, (const bf16*)(ws + WS_HID), (const bf16*)(ws + WS_WF2) + (size_t)(l >> 1) * D * FFN, T_ALL, D, FFN);
        } else {
            const int li = l >> 1;
            for (int e = 0; e < NE; ++e) {
                launch_tr(stream, a.exp_w1 + ((size_t)li * NE + e) * D * FFN, D, FFN, FFN, (bf16*)(ws + WS_WE13) + (size_t)e * 2 * FFN * D, 1);
                launch_tr(stream, a.exp_w3 + ((size_t)li * NE + e) * D * FFN, D, FFN, FFN, (bf16*)(ws + WS_WE13) + (size_t)e * 2 * FFN * D, 2);
                launch_tr(stream, a.exp_w2 + ((size_t)li * NE + e) * FFN * D, FFN, D, D, (bf16*)(ws + WS_WE2) + (size_t)e * D * FFN, 0);
            }
            hipLaunchKernelGGL((k_norm<2, false, false>), dim3(NWG), dim3(NTHR), NORM_LDS, stream, a, l);
            hipLaunchKernelGGL(k_moe_pos, dim3(NWG), dim3(NTHR), 16384, stream, a);
            if (FAST_F1M) launch_gemm<EM_F1M>(stream, a, l);
            else hipLaunchKernelGGL((k_ngemm<EM_F1M>), dim3(FFN / 64, MOE_ROWS / 64), dim3(256), 0, stream, a, l, (const bf16*)(ws + WS_HX), (const bf16*)(ws + WS_WE13), MOE_ROWS, FFN, D);
            if (FAST_F2M) launch_gemm<EM_F2M>(stream, a, l);
            else hipLaunchKernelGGL((k_ngemm<EM_F2M>), dim3(D / 64, MOE_ROWS / 64), dim3(256), 0, stream, a, l, (const bf16*)(ws + WS_HID), (const bf16*)(ws + WS_WE2), MOE_ROWS, D, FFN);
        }
    }
    hipLaunchKernelGGL((k_norm<3, false, true>), dim3(NWG), dim3(NTHR), NORM_LDS, stream, a, DEPTH);
}
```

```cpp
#include <hip/hip_runtime.h>
#include <cstdio>
#include <cstdint>

#ifndef MEGA
#define MEGA 1
#endif
#ifndef PROBE
#define PROBE 0
#endif
typedef unsigned short bf16;
#define PG_LAS __attribute__((address_space(3)))
typedef unsigned v4u __attribute__((ext_vector_type(4)));
typedef unsigned v2u __attribute__((ext_vector_type(2)));
typedef float f32x4 __attribute__((ext_vector_type(4)));

constexpr int D = 1024, NB = 8, SEQ = 4096, CTX = 256, TPB = SEQ + CTX, T_ALL = NB * TPB, DEPTH = 4;
constexpr int INW = 2320, UW = 2304, FFN = 2816, NE = 8;
constexpr int U_QA = 0, U_KA = 512, U_VA = 640, U_QM = 768, U_KM = 1024, U_VM = 1280, U_OM = 1792;
constexpr int MODW = 6 * D, MODR = NB + 1;
constexpr int MOE_ROWS = 2 * T_ALL + NE * 256;
constexpr int MOE_TILES = MOE_ROWS / 256;
constexpr float EPS = 1e-6f;
constexpr int NWG = 256, NTHR = 512;
constexpr int ROWS_PER_WG = T_ALL / NWG;

constexpr size_t MiB = 1u << 20;
constexpr size_t al(size_t x) { return (x + 255) & ~(size_t)255; }
constexpr size_t WS_CTL = 0;
constexpr size_t WS_ROPE = 1 * MiB;
constexpr size_t WS_MOD = WS_ROPE + 65536;
constexpr size_t WS_TOKE = al(WS_MOD + (size_t)DEPTH * MODR * MODW * 4);
constexpr size_t WS_TOKW = al(WS_TOKE + (size_t)T_ALL * 8);
constexpr size_t WS_TOKP = al(WS_TOKW + (size_t)T_ALL * 8);
constexpr size_t WS_ROWT = al(WS_TOKP + (size_t)T_ALL * 8);
constexpr size_t WS_ROWW = al(WS_ROWT + (size_t)MOE_ROWS * 4);
constexpr size_t WS_TILEE = al(WS_ROWW + (size_t)MOE_ROWS * 4);
constexpr size_t WS_CNT = al(WS_TILEE + 4096);
constexpr size_t WS_GATES = al(WS_CNT + (size_t)NWG * 8 * 4);
constexpr size_t WS_WIN = al(WS_GATES + (size_t)T_ALL * 16 * 4);
constexpr size_t WS_WOUT = al(WS_WIN + (size_t)DEPTH * UW * D * 2);
constexpr size_t WS_WF13 = al(WS_WOUT + (size_t)DEPTH * D * D * 2);
constexpr size_t WS_WF2 = al(WS_WF13 + (size_t)2 * 2 * FFN * D * 2);
constexpr size_t WS_WE2 = al(WS_WF2 + (size_t)2 * D * FFN * 2);
constexpr size_t WS_WE13 = al(WS_WE2 + (size_t)NE * D * FFN * 2);
constexpr size_t WS_YS = WS_WE13;
constexpr size_t WS_HX = al(WS_YS + (size_t)MOE_ROWS * D * 2);
constexpr size_t WS_X = al(WS_HX + (size_t)T_ALL * D * 2);
constexpr size_t WS_BIG = al(WS_X + (size_t)T_ALL * D * 2);
static_assert(WS_YS + (size_t)MOE_ROWS * D * 2 <= WS_HX && WS_WE13 + (size_t)NE * 2 * FFN * D * 2 <= WS_HX, "YS overlay");
constexpr size_t WS_U = WS_BIG;
constexpr size_t WS_MIX = al(WS_U + (size_t)T_ALL * UW * 2);
constexpr size_t WS_HDIR = al(WS_MIX + (size_t)T_ALL * D * 2);
constexpr int NCHUNK = TPB / 64, NCHAIN = NB * 4 * 2;
constexpr size_t WS_ST = WS_HDIR;
constexpr size_t WS_NL = al(WS_ST + (size_t)NCHAIN * NCHUNK * 16384);
constexpr size_t WS_SC = al(WS_NL + (size_t)NCHAIN * NCHUNK * 64 * 4);
constexpr size_t WS_DELTA = WS_BIG + 250 * MiB;
constexpr size_t WS_HID = WS_BIG;
constexpr size_t WS_END = al(WS_BIG + (size_t)MOE_ROWS * FFN * 2);
static_assert(WS_HDIR + (size_t)2 * T_ALL * 512 * 4 <= WS_END && WS_SC + (size_t)NCHAIN * NCHUNK * 16 <= WS_END, "HDIR / state buffers fit");

struct P {
    const float *x, *c, *ctx, *c_ctx, *norm1_g, *norm2_g, *w_mod, *b_mod, *w_in, *conv_w, *conv_b, *b_gates, *attn_sink, *g_att, *g_ml, *w_out,
        *ffn_w1, *ffn_w3, *ffn_w2, *w_router, *b_router, *exp_w1, *exp_w3, *exp_w2, *final_g;
    float* out;
    unsigned char* ws;
    int wv, pad;
};

__device__ __forceinline__ unsigned f2bf(float f) { unsigned u = __builtin_bit_cast(unsigned, f); return (u + 0x7fffu + ((u >> 16) & 1u)) >> 16; }
__device__ __forceinline__ unsigned pk2(float lo, float hi) { return f2bf(lo) | (f2bf(hi) << 16); }
typedef float f32x2v __attribute__((ext_vector_type(2)));
typedef __bf16 bf16x2v __attribute__((ext_vector_type(2)));
__device__ __forceinline__ unsigned cvt_pk_bf16(float lo, float hi) { const f32x2v v = {lo, hi}; return __builtin_bit_cast(unsigned, __builtin_convertvector(v, bf16x2v)); }
__device__ __forceinline__ float bf_lo(unsigned w) { return __builtin_bit_cast(float, w << 16); }
__device__ __forceinline__ float bf_hi(unsigned w) { return __builtin_bit_cast(float, w & 0xffff0000u); }
__device__ __forceinline__ float bf2f(bf16 h) { return __builtin_bit_cast(float, (unsigned)h << 16); }
#ifndef XLANE_OLD
#define XLANE_OLD 0
#endif
#if XLANE_OLD
template <int M> __device__ __forceinline__ float swz_xor(float v) { return __shfl_xor(v, M); }
__device__ __forceinline__ float hsum32(float v) { return v + __shfl_xor(v, 32); }
__device__ __forceinline__ float hmax32(float v) { return fmaxf(v, __shfl_xor(v, 32)); }
__device__ __forceinline__ float wave_sum(float v) {
#pragma unroll
    for (int o = 1; o < 64; o <<= 1) v += __shfl_xor(v, o);
    return v;
}
__device__ __forceinline__ float wave_max(float v) {
#pragma unroll
    for (int o = 1; o < 64; o <<= 1) v = fmaxf(v, __shfl_xor(v, o));
    return v;
}
__device__ __forceinline__ float lane_bcast(float v, int src) { return __shfl(v, src); }
template <int OFF> __device__ __forceinline__ float xchg_xor(float v, bool) { return __shfl_xor(v, OFF); }
template <bool MAXOP> __device__ __forceinline__ float dpp_scan(float v) {
    const int lane = (int)__builtin_amdgcn_mbcnt_hi(~0u, __builtin_amdgcn_mbcnt_lo(~0u, 0u));
#pragma unroll
    for (int o = 1; o < 64; o <<= 1) { const float y = __shfl_up(v, o); if (lane >= o) v = MAXOP ? fmaxf(v, y) : v + y; }
    return v;
}
#else
template <int M> __device__ __forceinline__ float swz_xor(float v) { return __builtin_bit_cast(float, __builtin_amdgcn_ds_swizzle(__builtin_bit_cast(int, v), 0x1f | (M << 10))); }
struct HalfSwap { float a, b; };
__device__ __forceinline__ HalfSwap half_swap(float v) {
    float x = v, y = v;
    asm volatile("s_nop 1\n\tv_permlane32_swap_b32 %0, %1\n\ts_nop 0" : "+v"(x), "+v"(y));
    return HalfSwap{x, y};
}
__device__ __forceinline__ float hsum32(float v) { const HalfSwap r = half_swap(v); return r.a + r.b; }
__device__ __forceinline__ float hmax32(float v) { const HalfSwap r = half_swap(v); return fmaxf(r.a, r.b); }
__device__ __forceinline__ float wave_sum(float v) { v += swz_xor<1>(v); v += swz_xor<2>(v); v += swz_xor<4>(v); v += swz_xor<8>(v); v += swz_xor<16>(v); return hsum32(v); }
__device__ __forceinline__ float wave_max(float v) { v = fmaxf(v, swz_xor<1>(v)); v = fmaxf(v, swz_xor<2>(v)); v = fmaxf(v, swz_xor<4>(v)); v = fmaxf(v, swz_xor<8>(v)); v = fmaxf(v, swz_xor<16>(v)); return hmax32(v); }
__device__ __forceinline__ float lane_bcast(float v, int src) { return __builtin_bit_cast(float, __builtin_amdgcn_readlane(__builtin_bit_cast(int, v), src)); }
template <int OFF> __device__ __forceinline__ float xchg_xor(float v, bool up) {
    if constexpr (OFF == 32) { const HalfSwap r = half_swap(v); return up ? r.a : r.b; }
    else return swz_xor<OFF>(v);
}
#define DPP_STEP(ctrl, rm) { const float t_ = __builtin_bit_cast(float, __builtin_amdgcn_update_dpp(__builtin_bit_cast(int, idv), __builtin_bit_cast(int, v), ctrl, rm, 0xf, false)); v = MAXOP ? fmaxf(v, t_) : v + t_; }
template <bool MAXOP> __device__ __forceinline__ float dpp_scan(float v) {
    const float idv = MAXOP ? -3.0e38f : 0.f;
    DPP_STEP(0x111, 0xf) DPP_STEP(0x112, 0xf) DPP_STEP(0x114, 0xf) DPP_STEP(0x118, 0xf) DPP_STEP(0x142, 0xa) DPP_STEP(0x143, 0xc)
    return v;
}
#endif
template <int N, int OFF> struct RS { static __device__ __forceinline__ float run(float (&v)[N], int lane) {
    constexpr int H = N / 2; float w[H]; const bool up = (lane & OFF) != 0;
#pragma unroll
    for (int i = 0; i < H; ++i) { const float keep = up ? v[i + H] : v[i], send = up ? v[i] : v[i + H]; w[i] = keep + xchg_xor<OFF>(send, up); }
    return RS<H, OFF / 2>::run(w, lane); } };
template <int OFF> struct RS<1, OFF> { static __device__ __forceinline__ float run(float (&v)[1], int lane) { float x = v[0];
    if constexpr (OFF >= 16) x += swz_xor<16>(x);
    if constexpr (OFF >= 8) x += swz_xor<8>(x);
    if constexpr (OFF >= 4) x += swz_xor<4>(x);
    if constexpr (OFF >= 2) x += swz_xor<2>(x);
    if constexpr (OFF >= 1) x += swz_xor<1>(x);
    return x; } };
__device__ __forceinline__ float silu_f(float x) { return x * __builtin_amdgcn_rcpf(1.f + __expf(-x)); }
__device__ __forceinline__ float sigmoid_f(float x) { return __builtin_amdgcn_rcpf(1.f + __expf(-x)); }
__device__ __forceinline__ float logsigmoid_f(float x) { return fminf(x, 0.f) - log1pf(__expf(-fabsf(x))); }
__device__ __forceinline__ int tk_modrow(int tk) { const int b = tk / TPB, p = tk - b * TPB; return p < CTX ? NB : b; }
__device__ __forceinline__ const float* in_row(const P& a, int tk) {
    const int b = tk / TPB, p = tk - b * TPB;
    return p < CTX ? a.ctx + ((size_t)b * CTX + p) * D : a.x + ((size_t)b * SEQ + (p - CTX)) * D;
}

__device__ __forceinline__ int otid_w(int wv) { int t; asm volatile("v_mbcnt_lo_u32_b32 %0, -1, 0\n\tv_mbcnt_hi_u32_b32 %0, -1, %0\n\ts_nop 0\n\tv_lshl_add_u32 %0, %1, 6, %0" : "=&v"(t) : "s"(wv)); return t; }
#define otid() otid_w(a.wv)
#define PHASE_ENTRY(a_in) P a = a_in; { unsigned long long z_ = 0; asm volatile("" : "+s"(z_)); a.ws = a_in.ws + z_; }
__device__ __forceinline__ void tr_load(const float* W, int ld, int N, int item, int lane, f32x4 (&v)[8]) {
    const int nblk = N / 32, kb = item / nblk, nb = item % nblk, k0 = 64 * kb, n0 = 32 * nb;
#pragma unroll
    for (int i = 0; i < 8; ++i) { const int kk = 8 * i + (lane >> 3), nn = 4 * (lane & 7);
        v[i] = __builtin_nontemporal_load((const f32x4*)(W + (size_t)(k0 + kk) * ld + n0 + nn)); }
}
__device__ __forceinline__ void tr_store(const f32x4 (&v)[8], int K, int N, bf16* WT, int mode, PG_LAS float* scr, int item, int lane) {
    const int nblk = N / 32, kb = item / nblk, nb = item % nblk, k0 = 64 * kb, n0 = 32 * nb;
#pragma unroll
    for (int i = 0; i < 8; ++i) { const int kk = 8 * i + (lane >> 3), nn = 4 * (lane & 7);
        PG_LAS float* d = scr + kk * 33 + nn; d[0] = v[i].x; d[1] = v[i].y; d[2] = v[i].z; d[3] = v[i].w; }
    __builtin_amdgcn_s_waitcnt(0xC07F); asm volatile("" ::: "memory");
    const int c = lane & 7;
    const int d0 = mode == 0 ? n0 : ((n0 >> 7) * 256 + (mode == 2 ? 128 : 0) + (n0 & 127));
#pragma unroll
    for (int j = 0; j < 4; ++j) { const int n = (lane >> 3) + 8 * j; const PG_LAS float* s = scr + (8 * c) * 33 + n;
        v4u o; o.x = cvt_pk_bf16(s[0 * 33], s[1 * 33]); o.y = cvt_pk_bf16(s[2 * 33], s[3 * 33]); o.z = cvt_pk_bf16(s[4 * 33], s[5 * 33]); o.w = cvt_pk_bf16(s[6 * 33], s[7 * 33]);
        __builtin_nontemporal_store(o, (v4u*)(WT + (size_t)(d0 + n) * K + k0 + 8 * c)); }
    __builtin_amdgcn_s_waitcnt(0xC07F); asm volatile("" ::: "memory");
}
__device__ __forceinline__ void tr_matrix(const float* W, int K, int ld, int N, bf16* WT, int mode, PG_LAS float* scr, int gw, int ngw, int lane) {
    const int items = (K / 64) * (N / 32);
    f32x4 cur[8], nxt[8];
    int it = gw;
    if (it < items) tr_load(W, ld, N, it, lane, cur);
    for (; it < items; it += ngw) {
        const int nit = it + ngw;
        if (nit < items) tr_load(W, ld, N, nit, lane, nxt);
        tr_store(cur, K, N, WT, mode, scr, it, lane);
#pragma unroll
        for (int i = 0; i < 8; ++i) cur[i] = nxt[i];
    }
}
constexpr int EXP_ITEMS_M = (D / 64) * (FFN / 32), EXP_ITEMS_E = 3 * EXP_ITEMS_M, EXP_ITEMS = NE * EXP_ITEMS_E;
struct TrJob { const float* W; bf16* WT; int K, ld, N, mode, it; };
__device__ __forceinline__ TrJob expert_job(const P& a, int li, int j) {
    const int e = j / EXP_ITEMS_E, r = j - e * EXP_ITEMS_E, m = r / EXP_ITEMS_M, it = r - m * EXP_ITEMS_M;
    TrJob t; t.it = it;
    if (m < 2) { t.W = (m == 0 ? a.exp_w1 : a.exp_w3) + ((size_t)li * NE + e) * D * FFN; t.K = D; t.ld = FFN; t.N = FFN; t.WT = (bf16*)(a.ws + WS_WE13) + (size_t)e * 2 * FFN * D; t.mode = 1 + m; }
    else { t.W = a.exp_w2 + ((size_t)li * NE + e) * FFN * D; t.K = FFN; t.ld = D; t.N = D; t.WT = (bf16*)(a.ws + WS_WE2) + (size_t)e * D * FFN; t.mode = 0; }
    return t;
}
__device__ __forceinline__ void conv_expert_range(const P& a, int li, int j0, int j1, int slot, int nslots, PG_LAS float* scr, int lane) {
    int j = j0 + slot; if (j >= j1) return;
    TrJob cur = expert_job(a, li, j), nxt = cur; f32x4 cv[8], nv[8];
    tr_load(cur.W, cur.ld, cur.N, cur.it, lane, cv);
    for (; j < j1; j += nslots) {
        const int jn = j + nslots;
        if (jn < j1) { nxt = expert_job(a, li, jn); tr_load(nxt.W, nxt.ld, nxt.N, nxt.it, lane, nv); }
        tr_store(cv, cur.K, cur.N, cur.WT, cur.mode, scr, cur.it, lane);
        cur = nxt;
#pragma unroll
        for (int i = 0; i < 8; ++i) cv[i] = nv[i];
    }
}
constexpr int DN_IN = (D / 64) * (UW / 32), DN_OUT = (D / 64) * (D / 32), DN_L = DN_IN + DN_OUT, DN_ITEMS = DEPTH * DN_L + 2 * EXP_ITEMS_E;
__device__ __forceinline__ TrJob dense_job(const P& a, int j) {
    TrJob t;
    if (j < DEPTH * DN_L) { const int l = j / DN_L, r = j - l * DN_L; t.K = D; t.mode = 0;
        if (r < DN_IN) { t.W = a.w_in + (size_t)l * D * INW; t.ld = INW; t.N = UW; t.WT = (bf16*)(a.ws + WS_WIN) + (size_t)l * UW * D; t.it = r; }
        else { t.W = a.w_out + (size_t)l * D * D; t.ld = D; t.N = D; t.WT = (bf16*)(a.ws + WS_WOUT) + (size_t)l * D * D; t.it = r - DN_IN; } }
    else { const int q = j - DEPTH * DN_L, i = q / EXP_ITEMS_E, r = q - i * EXP_ITEMS_E, m = r / EXP_ITEMS_M; t.it = r - m * EXP_ITEMS_M;
        if (m < 2) { t.W = (m == 0 ? a.ffn_w1 : a.ffn_w3) + (size_t)i * D * FFN; t.K = D; t.ld = FFN; t.N = FFN; t.WT = (bf16*)(a.ws + WS_WF13) + (size_t)i * 2 * FFN * D; t.mode = 1 + m; }
        else { t.W = a.ffn_w2 + (size_t)i * FFN * D; t.K = FFN; t.ld = D; t.N = D; t.WT = (bf16*)(a.ws + WS_WF2) + (size_t)i * D * FFN; t.mode = 0; } }
    return t;
}
__device__ __forceinline__ void conv_dense_range(const P& a, int j0, int j1, int slot, int nslots, PG_LAS float* scr, int lane) {
    int j = j0 + slot; if (j >= j1) return;
    TrJob cur = dense_job(a, j), nxt = cur; f32x4 cv[8], nv[8];
    tr_load(cur.W, cur.ld, cur.N, cur.it, lane, cv);
    for (; j < j1; j += nslots) {
        const int jn = j + nslots;
        if (jn < j1) { nxt = dense_job(a, jn); tr_load(nxt.W, nxt.ld, nxt.N, nxt.it, lane, nv); }
        tr_store(cv, cur.K, cur.N, cur.WT, cur.mode, scr, cur.it, lane);
        cur = nxt;
#pragma unroll
        for (int i = 0; i < 8; ++i) cv[i] = nv[i];
    }
}
__global__ void __launch_bounds__(256) k_transpose(const float* W, int K, int ld, int N, bf16* WT, int mode) {
    __shared__ float scr[4][64 * 33];
    const int wave = threadIdx.x >> 6, lane = threadIdx.x & 63;
    tr_matrix(W, K, ld, N, WT, mode, (PG_LAS float*)scr[wave], blockIdx.x * 4 + wave, gridDim.x * 4, lane);
}
__global__ void __launch_bounds__(256) k_modvec(P a) {
    __shared__ float cond[MODR][D];
    __shared__ float red[4][MODR][64];
    const int l = blockIdx.x / 96, nc = blockIdx.x % 96, t = threadIdx.x, kg = t >> 6, n = nc * 64 + (t & 63);
    for (int i = t; i < MODR * D; i += 256) { const int r = i / D, k = i % D; const float v = r < NB ? a.c[r * D + k] : a.c_ctx[k]; cond[r][k] = silu_f(v); }
    __syncthreads();
    float acc[MODR];
#pragma unroll
    for (int r = 0; r < MODR; ++r) acc[r] = 0.f;
    const float* w = a.w_mod + (size_t)l * D * MODW + n;
    for (int k = kg * 256; k < kg * 256 + 256; ++k) { const float wv = w[(size_t)k * MODW];
#pragma unroll
        for (int r = 0; r < MODR; ++r) acc[r] += cond[r][k] * wv; }
#pragma unroll
    for (int r = 0; r < MODR; ++r) red[kg][r][t & 63] = acc[r];
    __syncthreads();
    float* mod = (float*)(a.ws + WS_MOD);
    for (int i = t; i < MODR * 64; i += 256) { const int r = i / 64, j = i % 64; const int nn = nc * 64 + j;
        mod[((size_t)l * MODR + r) * MODW + nn] = red[0][r][j] + red[1][r][j] + red[2][r][j] + red[3][r][j] + a.b_mod[l * MODW + nn]; }
}
__global__ void k_rope_table(P a) {
    const int i = blockIdx.x * blockDim.x + threadIdx.x; if (i >= 64 * 16) return;
    const int pos = i / 16, f = i % 16; const float inv = powf(10000.0f, -(float)f / 16.0f); const float ang = (float)pos * inv;
    float* t = (float*)(a.ws + WS_ROPE); t[2 * i] = cosf(ang); t[2 * i + 1] = sinf(ang);
}

template <int MODE, bool SRC_IN, int PEND>
__device__ __forceinline__ void norm_phase(const P& a_in, int l, int wg, PG_LAS float* lds, int pl = 0, int pchunk = 0) {
    PHASE_ENTRY(a_in)
    const int tid = otid(), lane = tid & 63, wave = tid >> 6;
#define NCOFF(j) (512 * ((j) >> 1) + 8 * lane + 4 * ((j) & 1))
    bf16* X = (bf16*)(a.ws + WS_X); bf16* HX = (bf16*)(a.ws + WS_HX); const float* MOD = (const float*)(a.ws + WS_MOD);
    PG_LAS float* wl = lds; PG_LAS unsigned* wlu = (PG_LAS unsigned*)lds;
    PG_LAS int* cnt_l = (PG_LAS int*)(lds + 8192 + 8 * 32);
    if (MODE == 0) {
        for (int i = tid; i < D * 2; i += NTHR) { const int c = i >> 1, hf = i & 1; const float* wp = a.w_in + ((size_t)l * D + c) * INW + UW + 8 * hf;
            const f32x4 w0 = *(const f32x4*)wp, w1 = *(const f32x4*)(wp + 4);
            const int j = 2 * (c >> 9) + ((c >> 2) & 1), ln = (c >> 3) & 63, ii = c & 3; v4u o; o.x = pk2(w0.x, w0.y); o.y = pk2(w0.z, w0.w); o.z = pk2(w1.x, w1.y); o.w = pk2(w1.z, w1.w);
            *(PG_LAS v4u*)(wlu + ((((j * 4 + ii) * 2 + hf) * 64 + ln) * 4)) = o; }
    }
    if (MODE == 2) {
        for (int i = tid; i < D * 2; i += NTHR) { const int c = i >> 1, g4 = i & 1; const f32x4 w = *(const f32x4*)(a.w_router + ((size_t)(l >> 1) * D + c) * NE + 4 * g4);
            const int j = 2 * (c >> 9) + ((c >> 2) & 1), ln = (c >> 3) & 63, ii = c & 3; *(PG_LAS f32x4*)(wl + ((((j * 4 + ii) * 2 + g4) * 64 + ln) * 4)) = w; }
        if (tid < NE) cnt_l[tid] = 0;
    }
    if (MODE == 0 || MODE == 2) __syncthreads();
    const float* gvec = MODE == 0 ? a.norm1_g + l * D : (MODE == 3 ? a.final_g : a.norm2_g + l * D);
    f32x4 gv[4];
#pragma unroll
    for (int j = 0; j < 4; ++j) gv[j] = *(const f32x4*)(gvec + NCOFF(j));
    const int row0 = wg * ROWS_PER_WG + wave * 17;
    int mr_c = -1, mr_p = -1; f32x4 cA[4], cB[4], cM[4];
#pragma unroll
    for (int j = 0; j < 4; ++j) { cA[j] = (f32x4){0.f, 0.f, 0.f, 0.f}; cB[j] = cA[j]; cM[j] = cA[j]; }
    int posA = 0, posB = 0;
    if (PEND == 2) { const int* tp = (const int*)(a.ws + WS_TOKP) + 2 * (row0 + (lane < 17 ? lane : 0)); posA = min(max(tp[0], 0), MOE_ROWS - 1); posB = min(max(tp[1], 0), MOE_ROWS - 1); }
    f32x4 nx[2][4]; v4u nxb[2][2], nd0[2][2], nd1[2][2];
#define NORM_LOAD_GROUP(g) do { _Pragma("unroll") for (int r_ = 0; r_ < 2; ++r_) { const int ri_ = (g) * 2 + r_, rc_ = ri_ < 17 ? ri_ : 0, tk_ = row0 + rc_; \
        if (SRC_IN) { const float* xr_ = in_row(a, tk_); _Pragma("unroll") for (int j = 0; j < 4; ++j) nx[r_][j] = *(const f32x4*)(xr_ + NCOFF(j)); } \
        else { const bf16* xr_ = X + (size_t)tk_ * D; _Pragma("unroll") for (int J = 0; J < 2; ++J) nxb[r_][J] = *(const v4u*)(xr_ + 512 * J + 8 * lane); } \
        if (PEND == 1) { const bf16* dl_ = (const bf16*)(a.ws + WS_DELTA) + (size_t)tk_ * D; _Pragma("unroll") for (int J = 0; J < 2; ++J) nd0[r_][J] = *(const v4u*)(dl_ + 512 * J + 8 * lane); } \
        if (PEND == 2) { const int p0_ = __builtin_amdgcn_readlane(posA, rc_), p1_ = __builtin_amdgcn_readlane(posB, rc_); const bf16* ys_ = (const bf16*)(a.ws + WS_YS); \
            _Pragma("unroll") for (int J = 0; J < 2; ++J) { nd0[r_][J] = *(const v4u*)(ys_ + (size_t)p0_ * D + 512 * J + 8 * lane); nd1[r_][J] = *(const v4u*)(ys_ + (size_t)p1_ * D + 512 * J + 8 * lane); } } } } while (0)
    NORM_LOAD_GROUP(0);
#pragma unroll 1
    for (int grp = 0; grp < 9; ++grp) {
        f32x4 h[2][4], cx[2][4]; v4u cd0[2][2], cd1[2][2];
#pragma unroll
        for (int r = 0; r < 2; ++r)
#pragma unroll
            for (int J = 0; J < 2; ++J) {
                if (SRC_IN) { cx[r][2 * J] = nx[r][2 * J]; cx[r][2 * J + 1] = nx[r][2 * J + 1]; }
                else { const v4u w = nxb[r][J]; cx[r][2 * J] = (f32x4){bf_lo(w.x), bf_hi(w.x), bf_lo(w.y), bf_hi(w.y)}; cx[r][2 * J + 1] = (f32x4){bf_lo(w.z), bf_hi(w.z), bf_lo(w.w), bf_hi(w.w)}; }
                if (PEND != 0) cd0[r][J] = nd0[r][J]; if (PEND == 2) cd1[r][J] = nd1[r][J]; }
        if (grp + 1 < 9) NORM_LOAD_GROUP(grp + 1);
        int tks[2]; bool valid[2], dead[2];
#pragma unroll
        for (int r = 0; r < 2; ++r) {
            const int ri = grp * 2 + r; valid[r] = ri < 17; const int tk = row0 + (valid[r] ? ri : 0); tks[r] = tk;
            const int b = tk / TPB, p = tk - b * TPB, mr = p < CTX ? NB : b; dead[r] = (MODE == 2 && l == DEPTH - 1 && p < CTX);
            f32x4 xv[4];
#pragma unroll
            for (int j = 0; j < 4; ++j) xv[j] = cx[r][j];
            if (PEND != 0) {
                if (mr != mr_p) { mr_p = mr; const float* mp = MOD + ((size_t)pl * MODR + mr) * MODW + (PEND == 2 ? 5 : pchunk) * D;
#pragma unroll
                    for (int j = 0; j < 4; ++j) cM[j] = *(const f32x4*)(mp + NCOFF(j)); }
                if (PEND == 2) {
#pragma unroll
                    for (int j = 0; j < 4; ++j) { const v4u a0 = cd0[r][j >> 1], a1 = cd1[r][j >> 1]; const v2u y0 = (j & 1) ? (v2u){a0.z, a0.w} : (v2u){a0.x, a0.y}, y1 = (j & 1) ? (v2u){a1.z, a1.w} : (v2u){a1.x, a1.y};
                        xv[j].x += cM[j].x * (bf_lo(y0.x) + bf_lo(y1.x)); xv[j].y += cM[j].y * (bf_hi(y0.x) + bf_hi(y1.x));
                        xv[j].z += cM[j].z * (bf_lo(y0.y) + bf_lo(y1.y)); xv[j].w += cM[j].w * (bf_hi(y0.y) + bf_hi(y1.y)); }
                } else {
#pragma unroll
                    for (int j = 0; j < 4; ++j) { const v4u a0 = cd0[r][j >> 1]; const v2u y0 = (j & 1) ? (v2u){a0.z, a0.w} : (v2u){a0.x, a0.y};
                        xv[j].x += cM[j].x * bf_lo(y0.x); xv[j].y += cM[j].y * bf_hi(y0.x); xv[j].z += cM[j].z * bf_lo(y0.y); xv[j].w += cM[j].w * bf_hi(y0.y); }
                }
                if (valid[r] && MODE != 3) {
#pragma unroll
                    for (int J = 0; J < 2; ++J) { v4u o; o.x = cvt_pk_bf16(xv[2 * J].x, xv[2 * J].y); o.y = cvt_pk_bf16(xv[2 * J].z, xv[2 * J].w); o.z = cvt_pk_bf16(xv[2 * J + 1].x, xv[2 * J + 1].y); o.w = cvt_pk_bf16(xv[2 * J + 1].z, xv[2 * J + 1].w);
                        *(v4u*)(X + (size_t)tk * D + 512 * J + 8 * lane) = o; } }
            }
            float ss = 0.f;
#pragma unroll
            for (int j = 0; j < 4; ++j) ss += (xv[j].x * xv[j].x + xv[j].y * xv[j].y) + (xv[j].z * xv[j].z + xv[j].w * xv[j].w);
            const float rstd = rsqrtf(wave_sum(ss) * (1.f / D) + EPS);
            if (MODE == 3) {
                if (valid[r] && p >= CTX) { float* o = a.out + ((size_t)b * SEQ + (p - CTX)) * D;
#pragma unroll
                    for (int j = 0; j < 4; ++j) *(f32x4*)(o + NCOFF(j)) = xv[j] * rstd * gv[j]; }
            } else {
                if (mr != mr_c) {
                    mr_c = mr; const float* mrow = MOD + ((size_t)l * MODR + mr) * MODW;
                    const float* shp = mrow + (MODE == 0 ? 0 : 3) * D; const float* scp = mrow + (MODE == 0 ? 1 : 4) * D;
#pragma unroll
                    for (int j = 0; j < 4; ++j) { const f32x4 sh = *(const f32x4*)(shp + NCOFF(j)), sc = *(const f32x4*)(scp + NCOFF(j)); cA[j] = gv[j] * (sc + 1.f); cB[j] = sh; }
                }
#pragma unroll
                for (int j = 0; j < 4; ++j) h[r][j] = xv[j] * rstd * cA[j] + cB[j];
                if (valid[r]) {
#pragma unroll
                    for (int J = 0; J < 2; ++J) { v4u o; o.x = cvt_pk_bf16(h[r][2 * J].x, h[r][2 * J].y); o.y = cvt_pk_bf16(h[r][2 * J].z, h[r][2 * J].w); o.z = cvt_pk_bf16(h[r][2 * J + 1].x, h[r][2 * J + 1].y); o.w = cvt_pk_bf16(h[r][2 * J + 1].z, h[r][2 * J + 1].w);
                        *(v4u*)(HX + (size_t)tk * D + 512 * J + 8 * lane) = o; } }
            }
        }
        if (MODE == 0) {
            float acc[2][16];
#pragma unroll
            for (int r = 0; r < 2; ++r)
#pragma unroll
                for (int g = 0; g < 16; ++g) acc[r][g] = 0.f;
#pragma unroll
            for (int j = 0; j < 4; ++j)
#pragma unroll
                for (int ii = 0; ii < 4; ++ii) {
#pragma unroll
                    for (int hf = 0; hf < 2; ++hf) { const v4u w = *(const PG_LAS v4u*)(wlu + ((((j * 4 + ii) * 2 + hf) * 64 + lane) * 4));
#pragma unroll
                        for (int r = 0; r < 2; ++r) { const float hv = h[r][j][ii];
                            acc[r][8 * hf + 0] += hv * bf_lo(w.x); acc[r][8 * hf + 1] += hv * bf_hi(w.x); acc[r][8 * hf + 2] += hv * bf_lo(w.y); acc[r][8 * hf + 3] += hv * bf_hi(w.y);
                            acc[r][8 * hf + 4] += hv * bf_lo(w.z); acc[r][8 * hf + 5] += hv * bf_hi(w.z); acc[r][8 * hf + 6] += hv * bf_lo(w.w); acc[r][8 * hf + 7] += hv * bf_hi(w.w); } }
                    asm volatile("" ::: "memory"); }
            float flat[32];
#pragma unroll
            for (int r = 0; r < 2; ++r)
#pragma unroll
                for (int g = 0; g < 16; ++g) flat[r * 16 + g] = acc[r][g];
            const float sum = RS<32, 32>::run(flat, lane);
            { const int idx = (lane >> 1) & 31, r = idx >> 4, g = idx & 15;
              float v = sum + a.b_gates[l * 16 + g]; v = 15.f * tanhf(v * (1.f / 15.f));
              const int ri = grp * 2 + r;
              if ((lane & 1) == 0 && ri < 17) ((float*)(a.ws + WS_GATES))[(size_t)(row0 + ri) * 16 + g] = v; }
        }
        if (MODE == 2) {
            float acc[2][8];
#pragma unroll
            for (int r = 0; r < 2; ++r)
#pragma unroll
                for (int g = 0; g < 8; ++g) acc[r][g] = 0.f;
#pragma unroll
            for (int j = 0; j < 4; ++j)
#pragma unroll
                for (int ii = 0; ii < 4; ++ii) {
#pragma unroll
                    for (int g4 = 0; g4 < 2; ++g4) { const f32x4 w = *(const PG_LAS f32x4*)(wl + ((((j * 4 + ii) * 2 + g4) * 64 + lane) * 4));
#pragma unroll
                        for (int r = 0; r < 2; ++r) { const float hv = h[r][j][ii]; acc[r][4 * g4 + 0] += hv * w.x; acc[r][4 * g4 + 1] += hv * w.y; acc[r][4 * g4 + 2] += hv * w.z; acc[r][4 * g4 + 3] += hv * w.w; } }
                    asm volatile("" ::: "memory"); }
            float flat[16];
#pragma unroll
            for (int r = 0; r < 2; ++r)
#pragma unroll
                for (int g = 0; g < 8; ++g) flat[r * 8 + g] = acc[r][g];
            const float sum = RS<16, 32>::run(flat, lane);
#pragma unroll
            for (int r = 0; r < 2; ++r) {
                float lg[8];
#pragma unroll
                for (int g = 0; g < 8; ++g) { const float v = lane_bcast(sum, (r * 8 + g) << 2) + a.b_router[(l >> 1) * NE + g]; lg[g] = (v == v) ? fminf(fmaxf(v, -1.0e30f), 1.0e30f) : -1.0e30f; }
                int e0 = 0; float v0 = lg[0];
#pragma unroll
                for (int g = 1; g < 8; ++g) if (lg[g] > v0) { v0 = lg[g]; e0 = g; }
                int e1 = (e0 + 1) & 7; float v1 = -3.0e38f;
#pragma unroll
                for (int g = 0; g < 8; ++g) if (g != e0 && lg[g] > v1) { v1 = lg[g]; e1 = g; }
                const float w0 = 1.f / (1.f + __expf(v1 - v0)), w1 = 1.f - w0;
                if (lane == 0 && valid[r]) { const int tk = tks[r];
                    int* te = (int*)(a.ws + WS_TOKE) + 2 * tk; te[0] = dead[r] ? -1 : e0; te[1] = dead[r] ? -1 : e1; }
                if (lane == 0 && valid[r] && !dead[r]) { const int tk = tks[r];
                    float* tw = (float*)(a.ws + WS_TOKW) + 2 * tk; tw[0] = w0; tw[1] = w1;
                    __hip_atomic_fetch_add(&cnt_l[e0], 1, __ATOMIC_RELAXED, __HIP_MEMORY_SCOPE_WORKGROUP); __hip_atomic_fetch_add(&cnt_l[e1], 1, __ATOMIC_RELAXED, __HIP_MEMORY_SCOPE_WORKGROUP); }
            }
        }
    }
    if (MODE == 2) { __syncthreads(); if (tid < NE) ((int*)(a.ws + WS_CNT))[wg * NE + tid] = cnt_l[tid]; }
}
#undef NCOFF
template <int MODE, bool SRC_IN, int PEND>
__global__ void __launch_bounds__(NTHR, 2) k_norm(P a, int l) {
    extern __shared__ __attribute__((aligned(16))) unsigned char smem[];
    a.wv = __builtin_amdgcn_readfirstlane(threadIdx.x >> 6);
    norm_phase<MODE, SRC_IN, PEND>(a, l, blockIdx.x, (PG_LAS float*)smem);
}

__device__ __forceinline__ void moe_pos_phase(const P& a_in, int wg, int* lds) {
    PHASE_ENTRY(a_in)
    const int tid = otid(), lane = tid & 63, wave = __builtin_amdgcn_readfirstlane(tid >> 6);
    int* cnt = lds;
    int* tot = lds + 2048;
    int* wc = lds + 2048 + 32;
    const int* gc = (const int*)(a.ws + WS_CNT);
    for (int i = tid; i < NWG * NE; i += NTHR) cnt[i] = gc[i];
    const int* te = (const int*)(a.ws + WS_TOKE); const float* tw = (const float*)(a.ws + WS_TOKW);
    int* tp = (int*)(a.ws + WS_TOKP); int* rowt = (int*)(a.ws + WS_ROWT); float* roww = (float*)(a.ws + WS_ROWW);
    constexpr int NENT = 2 * ROWS_PER_WG;
    const int ent = tid < NENT ? te[2 * wg * ROWS_PER_WG + tid] : -1;
    const float entw = tid < NENT ? tw[2 * wg * ROWS_PER_WG + tid] : 0.f;
    int rank = 0;
#pragma unroll
    for (int e = 0; e < NE; ++e) { const unsigned long long mk = __ballot(ent == e);
        const int below = __builtin_amdgcn_mbcnt_hi((unsigned)(mk >> 32), __builtin_amdgcn_mbcnt_lo((unsigned)mk, 0u));
        if (ent == e) rank = below;
        if (lane == 0) wc[wave * NE + e] = __popcll(mk); }
    __syncthreads();
    {
        const int e = wave; int v[4], sum = 0;
#pragma unroll
        for (int q = 0; q < 4; ++q) { v[q] = cnt[(4 * lane + q) * NE + e]; sum += v[q]; }
        const int incl = (int)dpp_scan<false>((float)sum);
        const int total = __builtin_amdgcn_readlane(incl, 63);
        const int lw = wg >> 2, lq = wg & 3;
        int mine = incl - sum; if (lq > 0) mine += v[0]; if (lq > 1) mine += v[1]; if (lq > 2) mine += v[2];
        const int pre = __builtin_amdgcn_readlane(mine, lw);
        if (lane == 0) { tot[e] = total; tot[16 + e] = pre; }
    }
    __syncthreads();
    if (tid == 0) { int s = 0; for (int e = 0; e < NE; ++e) { tot[8 + e] = s; s += (tot[e] + 255) & ~255; } tot[24] = s; }
    __syncthreads();
    if (ent >= 0) {
        int off = 0;
        for (int w = 0; w < wave; ++w) off += wc[w * NE + ent];
        const int pos = tot[8 + ent] + tot[16 + ent] + off + rank;
        const int tk = wg * ROWS_PER_WG + (tid >> 1);
        tp[2 * wg * ROWS_PER_WG + tid] = pos; rowt[pos] = tk; roww[pos] = entw;
    }
    if (wg < NE) { const int s0 = tot[8 + wg] + tot[wg], s1 = tot[8 + wg] + ((tot[wg] + 255) & ~255); for (int r = s0 + tid; r < s1; r += NTHR) { rowt[r] = 0; roww[r] = 0.f; } }
    if (wg == 0) { int* tile_e = (int*)(a.ws + WS_TILEE); const int nt = tot[24] >> 8;
        for (int t = tid; t < MOE_TILES; t += NTHR) { int e = 0; for (int q = 1; q < NE; ++q) if (t * 256 >= tot[8 + q]) e = q; tile_e[t] = t < nt ? e : 0; }
        if (tid == 0) tile_e[MOE_TILES] = nt; }
}
__global__ void __launch_bounds__(NTHR, 2) k_moe_pos(P a) {
    extern __shared__ __attribute__((aligned(16))) unsigned char smem[];
    a.wv = __builtin_amdgcn_readfirstlane(threadIdx.x >> 6);
    moe_pos_phase(a, blockIdx.x, (int*)smem);
}

enum { EM_IN = 0, EM_OUT = 1, EM_F1 = 2, EM_F2D = 3, EM_F1M = 4, EM_F2M = 5 };
template <int EM>
__global__ void __launch_bounds__(256) k_ngemm(P a, int l, const bf16* A, const bf16* Bt, int M, int N, int K) {
    constexpr bool DUAL = (EM == EM_F1 || EM == EM_F1M), MOE = (EM == EM_F1M || EM == EM_F2M);
    __shared__ __attribute__((aligned(16))) float As[32][64], Bs[32][64], Bs2[DUAL ? 32 : 1][64];
    const int t = threadIdx.x, tx = t & 15, ty = t >> 4;
    const int row0 = blockIdx.y * 64, col0 = blockIdx.x * 64;
    const int* tile_e = (const int*)(a.ws + WS_TILEE); const int* rowt = (const int*)(a.ws + WS_ROWT);
    if (MOE) { if (row0 >= tile_e[MOE_TILES] * 256) return; }
    const int e = MOE ? tile_e[row0 >> 8] : 0;
    const bf16* B = Bt + (MOE ? (size_t)e * (DUAL ? 2 * FFN : D) * K : 0);
    const int lr = t >> 2, kc = (t & 3) * 8;
    const int arow = (EM == EM_F1M) ? rowt[row0 + lr] : row0 + lr;
    const int brow = DUAL ? ((col0 >> 7) * 256 + (col0 & 127) + lr) : col0 + lr;
    float acc[4][4], acc2[4][4];
#pragma unroll
    for (int i = 0; i < 4; ++i)
#pragma unroll
        for (int j = 0; j < 4; ++j) { acc[i][j] = 0.f; acc2[i][j] = 0.f; }
    for (int k0 = 0; k0 < K; k0 += 32) {
        const v4u av = *(const v4u*)(A + (size_t)arow * K + k0 + kc);
        const v4u bv = *(const v4u*)(B + (size_t)brow * K + k0 + kc);
        v4u bv2 = bv; if (DUAL) bv2 = *(const v4u*)(B + (size_t)(brow + 128) * K + k0 + kc);
        __syncthreads();
        As[kc + 0][lr] = bf_lo(av.x); As[kc + 1][lr] = bf_hi(av.x); As[kc + 2][lr] = bf_lo(av.y); As[kc + 3][lr] = bf_hi(av.y);
        As[kc + 4][lr] = bf_lo(av.z); As[kc + 5][lr] = bf_hi(av.z); As[kc + 6][lr] = bf_lo(av.w); As[kc + 7][lr] = bf_hi(av.w);
        Bs[kc + 0][lr] = bf_lo(bv.x); Bs[kc + 1][lr] = bf_hi(bv.x); Bs[kc + 2][lr] = bf_lo(bv.y); Bs[kc + 3][lr] = bf_hi(bv.y);
        Bs[kc + 4][lr] = bf_lo(bv.z); Bs[kc + 5][lr] = bf_hi(bv.z); Bs[kc + 6][lr] = bf_lo(bv.w); Bs[kc + 7][lr] = bf_hi(bv.w);
        if (DUAL) { Bs2[kc + 0][lr] = bf_lo(bv2.x); Bs2[kc + 1][lr] = bf_hi(bv2.x); Bs2[kc + 2][lr] = bf_lo(bv2.y); Bs2[kc + 3][lr] = bf_hi(bv2.y);
            Bs2[kc + 4][lr] = bf_lo(bv2.z); Bs2[kc + 5][lr] = bf_hi(bv2.z); Bs2[kc + 6][lr] = bf_lo(bv2.w); Bs2[kc + 7][lr] = bf_hi(bv2.w); }
        __syncthreads();
#pragma unroll 8
        for (int k = 0; k < 32; ++k) {
            const f32x4 av4 = *(const f32x4*)&As[k][ty * 4], bv4 = *(const f32x4*)&Bs[k][tx * 4];
#pragma unroll
            for (int i = 0; i < 4; ++i)
#pragma unroll
                for (int j = 0; j < 4; ++j) acc[i][j] += av4[i] * bv4[j];
            if (DUAL) { const f32x4 b2 = *(const f32x4*)&Bs2[k][tx * 4];
#pragma unroll
                for (int i = 0; i < 4; ++i)
#pragma unroll
                    for (int j = 0; j < 4; ++j) acc2[i][j] += av4[i] * b2[j]; }
        }
    }
    const float* MOD = (const float*)(a.ws + WS_MOD); float* X = (float*)(a.ws + WS_X);
#pragma unroll
    for (int i = 0; i < 4; ++i) {
        const int r = row0 + ty * 4 + i;
#pragma unroll
        for (int j = 0; j < 4; ++j) {
            const int c = col0 + tx * 4 + j; const float v = acc[i][j];
            if (EM == EM_IN) ((bf16*)(a.ws + WS_U))[(size_t)r * UW + c] = (bf16)f2bf(v);
            if (EM == EM_OUT) { const float* base = (l == 0) ? in_row(a, r) : X + (size_t)r * D; X[(size_t)r * D + c] = base[c] + MOD[((size_t)l * MODR + tk_modrow(r)) * MODW + 2 * D + c] * v; }
            if (EM == EM_F1) ((bf16*)(a.ws + WS_HID))[(size_t)r * FFN + c] = (bf16)f2bf(silu_f(v) * acc2[i][j]);
            if (EM == EM_F1M) ((bf16*)(a.ws + WS_HID))[(size_t)r * FFN + c] = (bf16)f2bf(silu_f(v) * acc2[i][j] * ((const float*)(a.ws + WS_ROWW))[r]);
            if (EM == EM_F2D) X[(size_t)r * D + c] += MOD[((size_t)l * MODR + tk_modrow(r)) * MODW + 5 * D + c] * v;
            if (EM == EM_F2M) ((bf16*)(a.ws + WS_YS))[(size_t)r * D + c] = (bf16)f2bf(v);
        }
    }
}
__global__ void __launch_bounds__(256) k_rope_apply(P a) {
    const size_t i = (size_t)blockIdx.x * 256 + threadIdx.x; if (i >= (size_t)T_ALL * 20 * 16) return;
    const int tk = (int)(i / 320), rem = (int)(i % 320), grp = rem / 16, f = rem % 16;
    const int b = tk / TPB, p = tk - b * TPB; bf16* u = (bf16*)(a.ws + WS_U) + (size_t)tk * UW + grp * 32;
    float x1 = bf2f(u[f]), x2 = bf2f(u[f + 16]);
    const float sc = grp < 16 ? 0.125f : 1.f;
    if (p >= CTX) { const int s = p - CTX, pos = (grp & 1) ? (s & 63) : (s >> 6); const float* t = (const float*)(a.ws + WS_ROPE) + 2 * (pos * 16 + f);
        const float cs = t[0], sn = t[1]; const float y1 = x1 * cs - x2 * sn, y2 = x2 * cs + x1 * sn; x1 = y1; x2 = y2; }
    u[f] = (bf16)f2bf(x1 * sc); u[f + 16] = (bf16)f2bf(x2 * sc);
}

__global__ void __launch_bounds__(512, 2) k_attn_naive(P a, int l) {
    __shared__ float ssq[8];
    const int tk = blockIdx.x, h = threadIdx.x >> 6, lane = threadIdx.x & 63, kvh = h >> 2;
    const int b = tk / TPB, p = tk - b * TPB; const bool isctx = p < CTX;
    const bf16* U = (const bf16*)(a.ws + WS_U);
    float q[64];
    { const v4u* qp = (const v4u*)(U + (size_t)tk * UW + U_QA + h * 64);
#pragma unroll
      for (int i = 0; i < 8; ++i) { const v4u w = qp[i]; q[8 * i + 0] = bf_lo(w.x); q[8 * i + 1] = bf_hi(w.x); q[8 * i + 2] = bf_lo(w.y); q[8 * i + 3] = bf_hi(w.y); q[8 * i + 4] = bf_lo(w.z); q[8 * i + 5] = bf_hi(w.z); q[8 * i + 6] = bf_lo(w.w); q[8 * i + 7] = bf_hi(w.w); } }
    const int s = p - CTX; const int j0 = isctx ? 0 : (s - 128 < 0 ? 0 : s - 128), j1 = isctx ? -1 : (s + 128 > SEQ - 1 ? SEQ - 1 : s + 128);
    const int nlat = j1 - j0 + 1, nk = CTX + (isctx ? 0 : nlat);
    const int tb = b * TPB;
    float sc[9];
#pragma unroll
    for (int it = 0; it < 9; ++it) { const int idx = lane + 64 * it; sc[it] = -3.0e38f;
        if (idx < nk) { const int kt = idx < CTX ? tb + idx : tb + CTX + j0 + (idx - CTX); const v4u* kp = (const v4u*)(U + (size_t)kt * UW + U_KA + kvh * 64); float d = 0.f;
#pragma unroll
            for (int i = 0; i < 8; ++i) { const v4u w = kp[i]; d += q[8 * i + 0] * bf_lo(w.x) + q[8 * i + 1] * bf_hi(w.x) + q[8 * i + 2] * bf_lo(w.y) + q[8 * i + 3] * bf_hi(w.y) + q[8 * i + 4] * bf_lo(w.z) + q[8 * i + 5] * bf_hi(w.z) + q[8 * i + 6] * bf_lo(w.w) + q[8 * i + 7] * bf_hi(w.w); }
            sc[it] = d; } }
    const float sink = a.attn_sink[l * 8 + h];
    float m = sink;
#pragma unroll
    for (int it = 0; it < 9; ++it) m = fmaxf(m, sc[it]);
    m = wave_max(m);
    float o[64];
#pragma unroll
    for (int d = 0; d < 64; ++d) o[d] = 0.f;
    float den = 0.f;
#pragma unroll
    for (int it = 0; it < 9; ++it) { const int idx = lane + 64 * it;
        if (idx < nk) { const float pr = __expf(sc[it] - m); den += pr; const int kt = idx < CTX ? tb + idx : tb + CTX + j0 + (idx - CTX); const v4u* vp = (const v4u*)(U + (size_t)kt * UW + U_VA + kvh * 64);
#pragma unroll
            for (int i = 0; i < 8; ++i) { const v4u w = vp[i]; o[8 * i + 0] += pr * bf_lo(w.x); o[8 * i + 1] += pr * bf_hi(w.x); o[8 * i + 2] += pr * bf_lo(w.y); o[8 * i + 3] += pr * bf_hi(w.y); o[8 * i + 4] += pr * bf_lo(w.z); o[8 * i + 5] += pr * bf_hi(w.z); o[8 * i + 6] += pr * bf_lo(w.w); o[8 * i + 7] += pr * bf_hi(w.w); } } }
    den = wave_sum(den) + __expf(sink - m);
    float mine = 0.f;
#pragma unroll
    for (int d = 0; d < 64; ++d) { const float sd = wave_sum(o[d]); mine = (lane == d) ? sd : mine; }
    mine /= den;
    const float sq = wave_sum(mine * mine);
    if (lane == 0) ssq[h] = sq;
    __syncthreads();
    float tot = 0.f;
#pragma unroll
    for (int i = 0; i < 8; ++i) tot += ssq[i];
    const float rstd = rsqrtf(tot * (1.f / 512.f) + EPS);
    ((bf16*)(a.ws + WS_MIX))[(size_t)tk * D + h * 64 + lane] = (bf16)f2bf(mine * rstd * a.g_att[l * 512 + h * 64 + lane]);
}

__device__ __forceinline__ float conv_qk(const P& a, int l, const bf16* U, int tk, int ch) {
    const int b = tk / TPB, p = tk - b * TPB; const int lo = p < CTX ? 0 : CTX, hi = p < CTX ? CTX : TPB;
    float y = a.conv_b[l * 512 + ch];
#pragma unroll
    for (int j = 0; j < 5; ++j) { const int pp = p + j - 2; if (pp >= lo && pp < hi) y += a.conv_w[(l * 5 + j) * 512 + ch] * bf2f(U[(size_t)(b * TPB + pp) * UW + U_QM + ch]); }
    return silu_f(y);
}
__global__ void __launch_bounds__(256) k_mlstm_naive(P a, int l) {
    __shared__ float qs[2][64], ks[2][64], part[2][2][128], sc[2][4];
    const int t = threadIdx.x, dir = blockIdx.x & 1, hd = (blockIdx.x >> 1) & 3, b = blockIdx.x >> 3;
    const bf16* U = (const bf16*)(a.ws + WS_U); const float* G = (const float*)(a.ws + WS_GATES);
    float* HD = (float*)(a.ws + WS_HDIR) + (size_t)dir * T_ALL * 512;
    const int e = t & 127, half = t >> 7;
    float C[32];
#pragma unroll
    for (int i = 0; i < 32; ++i) C[i] = 0.f;
    float nst = 0.f, m = 0.f;
    for (int tau = 0; tau < TPB; ++tau) {
        const int pb = tau & 1;
        const int p = dir == 0 ? tau : (tau < CTX ? CTX - 1 - tau : CTX + (SEQ - 1) - (tau - CTX));
        const int tk = b * TPB + p;
        if (t < 64) qs[pb][t] = 0.125f * conv_qk(a, l, U, tk, hd * 64 + t);
        else if (t < 128) ks[pb][t - 64] = conv_qk(a, l, U, tk, 256 + hd * 64 + (t - 64));
        const float li = G[(size_t)tk * 16 + dir * 8 + hd], lf = logsigmoid_f(G[(size_t)tk * 16 + dir * 8 + 4 + hd]);
        const float mn = fmaxf(lf + m, li), fd = __expf(lf + m - mn), iw = __expf(li - mn);
        m = mn;
        const float v = bf2f(U[(size_t)tk * UW + U_VM + hd * 128 + e]);
        __syncthreads();
        float ph = 0.f;
#pragma unroll
        for (int i = 0; i < 32; ++i) { const int dk = half * 32 + i; C[i] = fd * C[i] + iw * ks[pb][dk] * v; ph += qs[pb][dk] * C[i]; }
        part[pb][half][e] = ph;
        if (t < 64) { nst = fd * nst + iw * ks[pb][t]; const float qn = wave_sum(qs[pb][t] * nst); if (t == 0) sc[pb][0] = qn; }
        __syncthreads();
        if (t < 128) { const float num = part[pb][0][t] + part[pb][1][t]; const float den = fmaxf(fabsf(sc[pb][0]), __expf(-mn)); HD[(size_t)tk * 512 + hd * 128 + t] = num / den; }
    }
}
__global__ void __launch_bounds__(256) k_merge_naive(P a, int l) {
    const int tk = blockIdx.x, hd = threadIdx.x >> 6, lane = threadIdx.x & 63;
    const float* H0 = (const float*)(a.ws + WS_HDIR); const float* H1 = H0 + (size_t)T_ALL * 512; const bf16* U = (const bf16*)(a.ws + WS_U);
    const int c0 = hd * 128 + lane, c1 = c0 + 64;
    const float h0 = H0[(size_t)tk * 512 + c0] + H1[(size_t)tk * 512 + c0], h1 = H0[(size_t)tk * 512 + c1] + H1[(size_t)tk * 512 + c1];
    const float rstd = rsqrtf(wave_sum(h0 * h0 + h1 * h1) * (1.f / 128.f) + EPS);
    bf16* mx = (bf16*)(a.ws + WS_MIX) + (size_t)tk * D + 512;
    mx[c0] = (bf16)f2bf(h0 * rstd * a.g_ml[l * 512 + c0] * sigmoid_f(bf2f(U[(size_t)tk * UW + U_OM + c0])));
    mx[c1] = (bf16)f2bf(h1 * rstd * a.g_ml[l * 512 + c1] * sigmoid_f(bf2f(U[(size_t)tk * UW + U_OM + c1])));
}

namespace pg {
#define PG_LAS __attribute__((address_space(3)))
typedef short bf16x8 __attribute__((ext_vector_type(8)));
constexpr int BM = 256, BK = 64, HALF = 128, HTB = HALF * BK * 2, STAGE_BYTES = 8 * HTB, NXCD = 8, WGM = 8;
__host__ __device__ __forceinline__ int lds_byte(int r, int c) { const int st = (r >> 4) * 2 + (c >> 5), rr = r & 15, cc = c & 31, ob = rr * 64 + cc * 2; return st * 1024 + (ob ^ (((ob >> 9) & 1) << 5)); }
__host__ __device__ __forceinline__ void stage_rc(int b, int& R, int& C) { const int st = b / 1024, sb = b % 1024, swz = sb ^ (((sb >> 9) & 1) << 5); R = (st >> 1) * 16 + swz / 64; C = (st & 1) * 32 + (swz % 64) / 2; }
__host__ __device__ __forceinline__ int perm32(int rho) { const int n = rho >> 4, i = rho & 15; return 8 * (i >> 2) + 4 * n + (i & 3); }
struct Unit { int pm, pn, e; };
struct Order {
    int nM, nN, nwg, G, c, lat;
    __device__ void init(int nM_, int nN_, int G_, int c_) { nM = nM_; nN = nN_; nwg = nM * nN; G = G_; c = c_; lat = 0; }
    __device__ bool next(int i, Unit& u) const {
        const long L = (long)i * G + c; if (L >= nwg) return false;
        int wgid = (int)L; { const int q = nwg / NXCD, r = nwg % NXCD, xcd = wgid % NXCD, off = wgid / NXCD; wgid = (xcd < r ? xcd * (q + 1) : r * (q + 1) + (xcd - r) * q) + off; }
        const int nig = WGM * nN, gid = wgid / nig, fm = gid * WGM, gsz = (nM - fm) < WGM ? (nM - fm) : WGM;
        u.pm = fm + ((wgid % nig) % gsz); u.pn = (wgid % nig) / gsz; u.e = 0; if (lat) u.pm = (u.pm >> 4) * 17 + 1 + (u.pm & 15); return true;
    }
};
struct Gemm { const bf16* A; const bf16* Bt; int K; int brows; const int* rowt; const int* tile_e; int wv; };

template <class Epi, bool GATHER, bool MOE>
__device__ __forceinline__ void gemm_phase(PG_LAS unsigned char* lds, const Gemm g, const Order& S, const Epi& E) {
    const int tid = otid_w(g.wv), wid = __builtin_amdgcn_readfirstlane(tid >> 6), lane = tid & 63, wr = wid >> 2, wc = wid & 3, fr = lane & 15, fq = lane >> 4;
    const int K = g.K, nt = K / BK;
    int Rr[2], Cc[2]; unsigned voffB[2];
#pragma unroll
    for (int i = 0; i < 2; ++i) { int R, C; stage_rc(tid * 16 + i * 8192, R, C); Rr[i] = R; Cc[i] = C; const int Rb = Epi::PERM ? ((R & ~31) + perm32(R & 31)) : R; voffB[i] = (unsigned)(Rb * K + C) * 2u; }
    const size_t hstep = (size_t)HALF * K * 2;
    const unsigned ldsw = (unsigned)wid * 1024u;
    const int aoff = lds_byte(wr * 64 + fr, fq * 8), boff = lds_byte(wc * 32 + fr, fq * 8);
    const char* Ab = (const char*)g.A;
#define PG_SA(b, h) (((b) * 2 + (h)) * HTB)
#define PG_SB(b, h) ((4 + (b) * 2 + (h)) * HTB)
#define PG_STAGE_B(bufoff, gbase) do { _Pragma("unroll") for (int _i = 0; _i < 2; ++_i) \
        __builtin_amdgcn_global_load_lds((const unsigned*)((const char*)(gbase) + voffB[_i]), (PG_LAS unsigned*)(lds + (bufoff) + ldsw + _i * 8192), 16, 0, 0); } while (0)
#define PG_STAGE_A(bufoff, offs, h, kb) do { _Pragma("unroll") for (int _i = 0; _i < 2; ++_i) \
        __builtin_amdgcn_global_load_lds((const unsigned*)(Ab + (size_t)(offs)[h][_i] + (size_t)(kb)), (PG_LAS unsigned*)(lds + (bufoff) + ldsw + _i * 8192), 16, 0, 0); } while (0)
#define PG_LDA(dst, b, h) do { _Pragma("unroll") for (int m = 0; m < 4; ++m) _Pragma("unroll") for (int k = 0; k < 2; ++k) dst[m][k] = *(const PG_LAS bf16x8*)(lds + PG_SA(b, h) + aoff + m * 2048 + k * 1024); } while (0)
#define PG_LDB(dst, b, h) do { _Pragma("unroll") for (int n = 0; n < 2; ++n) _Pragma("unroll") for (int k = 0; k < 2; ++k) dst[n][k] = *(const PG_LAS bf16x8*)(lds + PG_SB(b, h) + boff + n * 2048 + k * 1024); } while (0)
#define PG_MMA(ai, bj, At, Bt) do { __builtin_amdgcn_s_setprio(1); _Pragma("unroll") for (int m = 0; m < 4; ++m) _Pragma("unroll") for (int n = 0; n < 2; ++n) _Pragma("unroll") for (int k = 0; k < 2; ++k) \
        acc[ai][bj][m][n] = __builtin_amdgcn_mfma_f32_16x16x32_bf16(Bt[n][k], At[m][k], acc[ai][bj][m][n], 0, 0, 0); __builtin_amdgcn_s_setprio(0); } while (0)
#define PG_WAIT_V(n) asm volatile("s_waitcnt vmcnt(" #n ")" ::: "memory")
#define PG_WAIT_L(n) asm volatile("s_waitcnt lgkmcnt(" #n ")" ::: "memory")
#define PG_BAR __builtin_amdgcn_s_barrier()
#define PG_SCHED __builtin_amdgcn_sched_barrier(0)
#define PG_AOFFS(dst, u) do { _Pragma("unroll") for (int _h = 0; _h < 2; ++_h) _Pragma("unroll") for (int _i = 0; _i < 2; ++_i) { \
        const int _r = (u).pm * BM + _h * HALF + Rr[_i]; const int _row = GATHER ? g.rowt[_r] : _r; dst[_h][_i] = (unsigned)_row * (unsigned)(K * 2) + (unsigned)(Cc[_i] * 2); } } while (0)
#define PG_BBASE(u) ((const char*)g.Bt + ((size_t)(u).e * g.brows + (size_t)(u).pn * BM) * (size_t)K * 2)
    Unit cur, nxt; int ui = 0;
    if (!S.next(0, cur)) return;
    if (MOE) cur.e = g.tile_e[cur.pm];
    f32x4 acc[2][2][4][2];
#pragma unroll
    for (int a = 0; a < 2; ++a)
#pragma unroll
        for (int b = 0; b < 2; ++b)
#pragma unroll
            for (int m = 0; m < 4; ++m)
#pragma unroll
                for (int n = 0; n < 2; ++n) acc[a][b][m][n] = (f32x4){0.f, 0.f, 0.f, 0.f};
    bf16x8 At[4][2], B0[2][2], B1[2][2];
    unsigned offC[2][2], offN[2][2];
    PG_AOFFS(offC, cur);
    const char* cB = PG_BBASE(cur);
    const size_t kstep = (size_t)(BK * 2);
    PG_STAGE_B(PG_SB(0, 0), cB); PG_STAGE_B(PG_SB(0, 1), cB + hstep); PG_STAGE_A(PG_SA(0, 0), offC, 0, 0); PG_STAGE_A(PG_SA(0, 1), offC, 1, 0);
    if (wr == 1) PG_BAR;
    PG_WAIT_V(2); PG_BAR;
    PG_STAGE_B(PG_SB(1, 0), cB + kstep); PG_STAGE_A(PG_SA(1, 0), offC, 0, kstep); PG_STAGE_B(PG_SB(1, 1), cB + hstep + kstep);
    PG_WAIT_V(6); PG_BAR;
    for (;;) {
        bool has_next = S.next(ui + 1, nxt);
        if (has_next) { if (MOE) nxt.e = g.tile_e[nxt.pm]; if (GATHER) PG_AOFFS(offN, nxt); }
        else if (GATHER) {
#pragma unroll
            for (int h = 0; h < 2; ++h)
#pragma unroll
                for (int i = 0; i < 2; ++i) offN[h][i] = offC[h][i]; }
        const char* nB = has_next ? PG_BBASE(nxt) : cB;
        for (int t = 0; t < nt; t += 2) {
            const bool last = (t == nt - 2);
            const size_t k1 = (size_t)(t + 1) * kstep;
            const size_t k2 = last ? 0 : (size_t)(t + 2) * kstep;
            const char* b2 = last ? nB : cB + (size_t)(t + 2) * kstep; const char* b3 = b2 + kstep;
            PG_LDB(B0, 0, 0); PG_LDB(B1, 0, 1); PG_SCHED; PG_LDA(At, 0, 0); PG_STAGE_A(PG_SA(1, 1), offC, 1, k1);
            PG_WAIT_V(8); PG_WAIT_L(0); PG_BAR; PG_MMA(0, 0, At, B0); PG_MMA(0, 1, At, B1); PG_BAR; PG_SCHED;
            if (last) {
                if (GATHER) {
#pragma unroll
                    for (int h = 0; h < 2; ++h)
#pragma unroll
                        for (int i = 0; i < 2; ++i) offC[h][i] = offN[h][i];
                } else if (has_next) { PG_AOFFS(offC, nxt); }
            }
            PG_LDA(At, 0, 1); PG_STAGE_B(PG_SB(0, 0), b2); PG_STAGE_B(PG_SB(0, 1), b2 + hstep); PG_STAGE_A(PG_SA(0, 0), offC, 0, k2);
            PG_WAIT_V(8); PG_WAIT_L(0); PG_BAR; PG_MMA(1, 0, At, B0); PG_MMA(1, 1, At, B1); PG_BAR; PG_SCHED;
            PG_LDB(B0, 1, 0); PG_LDB(B1, 1, 1); PG_SCHED; PG_LDA(At, 1, 0); PG_STAGE_A(PG_SA(0, 1), offC, 1, k2);
            PG_WAIT_V(8); PG_WAIT_L(0); PG_BAR; PG_MMA(0, 0, At, B0); PG_MMA(0, 1, At, B1); PG_BAR; PG_SCHED;
            PG_LDA(At, 1, 1); PG_STAGE_B(PG_SB(1, 0), b3); PG_STAGE_B(PG_SB(1, 1), b3 + hstep); PG_STAGE_A(PG_SA(1, 0), offC, 0, k2 + kstep);
            PG_WAIT_V(8); PG_WAIT_L(0); PG_BAR; PG_MMA(1, 0, At, B0); PG_MMA(1, 1, At, B1); PG_BAR; PG_SCHED;
        }
        if (wr == 0) PG_BAR;
        E(acc, cur, wr, wc, fr, fq);
        if (!has_next) break;
#pragma unroll
        for (int a = 0; a < 2; ++a)
#pragma unroll
            for (int b = 0; b < 2; ++b)
#pragma unroll
                for (int m = 0; m < 4; ++m)
#pragma unroll
                    for (int n = 0; n < 2; ++n) acc[a][b][m][n] = (f32x4){0.f, 0.f, 0.f, 0.f};
        cur = nxt; cB = nB; ++ui;
        if (wr == 1) PG_BAR;
    }
    PG_WAIT_V(0);
    PG_BAR;
#undef PG_SA
#undef PG_SB
#undef PG_STAGE_A
#undef PG_STAGE_B
#undef PG_LDA
#undef PG_LDB
#undef PG_MMA
#undef PG_WAIT_V
#undef PG_WAIT_L
#undef PG_BAR
#undef PG_SCHED
#undef PG_AOFFS
#undef PG_BBASE
}
}


struct EpiIn {
    static constexpr bool PERM = false;
    bf16* U; const PG_LAS float* rope;
    __device__ __forceinline__ void operator()(const f32x4 (&acc)[2][2][4][2], const pg::Unit& u, int wr, int wc, int fr, int fq) const {
        const int tb = (u.pm * 256) / TPB, p0 = u.pm * 256 - tb * TPB; const bool latent = p0 >= CTX;
#pragma unroll
        for (int ai = 0; ai < 2; ++ai)
#pragma unroll
            for (int m = 0; m < 4; ++m) {
                const int rl = ai * 128 + wr * 64 + m * 16 + fr; const int r = u.pm * 256 + rl; const int s = p0 + rl - CTX;
                bf16* rowp = U + (size_t)r * UW + u.pn * 256 + wc * 32 + ((fq & 1) ? 16 + 4 * (fq - 1) : 4 * fq);
#pragma unroll
                for (int bj = 0; bj < 2; ++bj) {
                    const int G = (u.pn * 256 + bj * 128 + wc * 32) >> 5;
                    f32x4 x1 = acc[ai][bj][m][0], x2 = acc[ai][bj][m][1];
                    if (G < 20) {
                        if (latent) { const int pos = (G & 1) ? (s & 63) : (s >> 6); const PG_LAS float* t = rope + (pos * 16 + 4 * fq) * 2;
                            const f32x4 t0 = *(const PG_LAS f32x4*)t, t1 = *(const PG_LAS f32x4*)(t + 4);
                            const f32x4 cs = (f32x4){t0.x, t0.z, t1.x, t1.z}, sn = (f32x4){t0.y, t0.w, t1.y, t1.w};
                            const f32x4 y1 = x1 * cs - x2 * sn, y2 = x2 * cs + x1 * sn; x1 = y1; x2 = y2; }
                        if (G < 16) { x1 = x1 * 0.18033688011112042f; x2 = x2 * 0.18033688011112042f; }
                    }
                    v2u o1, o2; o1.x = cvt_pk_bf16(x1.x, x1.y); o1.y = cvt_pk_bf16(x1.z, x1.w); o2.x = cvt_pk_bf16(x2.x, x2.y); o2.y = cvt_pk_bf16(x2.z, x2.w);
                    asm volatile("s_nop 1\n\tv_permlane16_swap_b32 %0, %2\n\tv_permlane16_swap_b32 %1, %3\n\ts_nop 0" : "+v"(o1.x), "+v"(o1.y), "+v"(o2.x), "+v"(o2.y));
                    *(v4u*)(rowp + bj * 128) = (v4u){o1.x, o1.y, o2.x, o2.y};
                }
            }
    }
};
template <int CHUNK, bool INPLACE> struct EpiRes {
    static constexpr bool PERM = false;
    float* X; const float* modl; const float* xin; const float* cin; int l; float* Xo;
    __device__ __forceinline__ void operator()(const f32x4 (&acc)[2][2][4][2], const pg::Unit& u, int wr, int wc, int fr, int fq) const {
        const int tb = (u.pm * 256) / TPB, p0 = u.pm * 256 - tb * TPB; const int mr = p0 < CTX ? NB : tb;
        const float* mv = modl + (size_t)mr * MODW + CHUNK * D + u.pn * 256 + wc * 32 + 4 * fq;
        f32x4 mod[2][2];
#pragma unroll
        for (int bj = 0; bj < 2; ++bj)
#pragma unroll
            for (int n = 0; n < 2; ++n) mod[bj][n] = *(const f32x4*)(mv + bj * 128 + n * 16);
        const bool from_in = (!INPLACE) && l == 0;
        const int co = u.pn * 256 + wc * 32 + 4 * fq;
#pragma unroll
        for (int ai = 0; ai < 2; ++ai) {
            f32x4 bs[4][2][2];
#pragma unroll
            for (int m = 0; m < 4; ++m) {
                const int rl = ai * 128 + wr * 64 + m * 16 + fr; const int r = u.pm * 256 + rl; const int p = p0 + rl;
                const float* bp = from_in ? (p < CTX ? cin + ((size_t)tb * CTX + p) * D : xin + ((size_t)tb * SEQ + (p - CTX)) * D) : X + (size_t)r * D;
#pragma unroll
                for (int bj = 0; bj < 2; ++bj)
#pragma unroll
                    for (int n = 0; n < 2; ++n) bs[m][bj][n] = *(const f32x4*)(bp + co + bj * 128 + n * 16);
            }
#pragma unroll
            for (int m = 0; m < 4; ++m) {
                const int r = u.pm * 256 + ai * 128 + wr * 64 + m * 16 + fr;
#pragma unroll
                for (int bj = 0; bj < 2; ++bj)
#pragma unroll
                    for (int n = 0; n < 2; ++n) *(f32x4*)(Xo + (size_t)r * D + co + bj * 128 + n * 16) = bs[m][bj][n] + mod[bj][n] * acc[ai][bj][m][n];
            }
        }
    }
};
template <bool MOE> struct EpiSwiglu {
    static constexpr bool PERM = true;
    bf16* H; const float* roww;
    __device__ __forceinline__ void operator()(const f32x4 (&acc)[2][2][4][2], const pg::Unit& u, int wr, int wc, int fr, int fq) const {
        float rws[2][4];
#pragma unroll
        for (int ai = 0; ai < 2; ++ai)
#pragma unroll
            for (int m = 0; m < 4; ++m) rws[ai][m] = MOE ? roww[u.pm * 256 + ai * 128 + wr * 64 + m * 16 + fr] : 1.f;
#pragma unroll
        for (int ai = 0; ai < 2; ++ai)
#pragma unroll
            for (int m = 0; m < 4; ++m) {
                const int r = u.pm * 256 + ai * 128 + wr * 64 + m * 16 + fr;
                const float rw = rws[ai][m];
                f32x4 h0, h1;
#pragma unroll
                for (int j = 0; j < 4; ++j) { const float g0 = acc[ai][0][m][0][j], g1 = acc[ai][0][m][1][j];
                    h0[j] = g0 * __builtin_amdgcn_rcpf(1.f + __expf(-g0)) * acc[ai][1][m][0][j] * rw; h1[j] = g1 * __builtin_amdgcn_rcpf(1.f + __expf(-g1)) * acc[ai][1][m][1][j] * rw; }
                v4u w; w.x = cvt_pk_bf16(h0.x, h0.y); w.y = cvt_pk_bf16(h0.z, h0.w); w.z = cvt_pk_bf16(h1.x, h1.y); w.w = cvt_pk_bf16(h1.z, h1.w);
                *(v4u*)(H + (size_t)r * FFN + u.pn * 128 + wc * 32 + 8 * fq) = w;
            }
    }
};
struct EpiYs {
    static constexpr bool PERM = true;
    bf16* Y;
    __device__ __forceinline__ void operator()(const f32x4 (&acc)[2][2][4][2], const pg::Unit& u, int wr, int wc, int fr, int fq) const {
#pragma unroll
        for (int ai = 0; ai < 2; ++ai)
#pragma unroll
            for (int m = 0; m < 4; ++m) {
                bf16* rowp = Y + (size_t)(u.pm * 256 + ai * 128 + wr * 64 + m * 16 + fr) * D + u.pn * 256 + wc * 32 + 8 * fq;
#pragma unroll
                for (int bj = 0; bj < 2; ++bj) { const f32x4 v0 = acc[ai][bj][m][0], v1 = acc[ai][bj][m][1];
                    v4u w; w.x = cvt_pk_bf16(v0.x, v0.y); w.y = cvt_pk_bf16(v0.z, v0.w); w.z = cvt_pk_bf16(v1.x, v1.y); w.w = cvt_pk_bf16(v1.z, v1.w);
                    *(v4u*)(rowp + bj * 128) = w; }
            }
    }
};
template <bool COMPUTE> struct EpiProbe {
    static constexpr bool PERM = true;
    __device__ __forceinline__ void operator()(const f32x4 (&acc)[2][2][4][2], const pg::Unit& u, int wr, int wc, int fr, int fq) const {
#pragma unroll
        for (int ai = 0; ai < 2; ++ai)
#pragma unroll
            for (int m = 0; m < 4; ++m) {
                if (COMPUTE) { f32x4 h0, h1;
#pragma unroll
                    for (int j = 0; j < 4; ++j) { const float g0 = acc[ai][0][m][0][j], g1 = acc[ai][0][m][1][j];
                        h0[j] = g0 * __builtin_amdgcn_rcpf(1.f + __expf(-g0)) * acc[ai][1][m][0][j]; h1[j] = g1 * __builtin_amdgcn_rcpf(1.f + __expf(-g1)) * acc[ai][1][m][1][j]; }
                    v4u w; w.x = cvt_pk_bf16(h0.x, h0.y); w.y = cvt_pk_bf16(h0.z, h0.w); w.z = cvt_pk_bf16(h1.x, h1.y); w.w = cvt_pk_bf16(h1.z, h1.w);
                    asm volatile("" :: "v"(w));
                } else {
#pragma unroll
                    for (int bj = 0; bj < 2; ++bj) { asm volatile("" :: "v"(acc[ai][bj][m][0]), "v"(acc[ai][bj][m][1])); }
                }
            }
    }
};
enum { CP_D2 = 0, CP_OUT = 1, CP_F1 = 2, CP_F2D = 3, CP_IN = 4 };
__device__ __forceinline__ bool conv_sched(int l, int phase, int& li, int& j0, int& j1) {
    li = l >> 1;
    if ((l & 1) == 0) {
        if (phase == CP_D2)  { j0 = l == 0 ? 0 : 1000; j1 = l == 0 ? 7500 : 8500; return true; }
        if (phase == CP_OUT) { j0 = l == 0 ? 7500 : 8500; j1 = l == 0 ? 12000 : 13000; return true; }
        if (phase == CP_F1)  { j0 = l == 0 ? 12000 : 13000; j1 = l == 0 ? 13500 : 14500; return true; }
        if (phase == CP_F2D) { j0 = l == 0 ? 13500 : 14500; j1 = l == 0 ? 25500 : 26500; return true; }
        if (phase == CP_IN && l == 2) { j0 = 0; j1 = 1000; return true; }
        return false;
    }
    if (phase == CP_IN) { j0 = l == 1 ? 25500 : 26500; j1 = l == 1 ? 26500 : 27500; return true; }
    if (phase == CP_D2) { j0 = l == 1 ? 26500 : 27500; j1 = EXP_ITEMS; return true; }
    return false;
}
#ifndef STAGGER_TICKS
#define STAGGER_TICKS 0
#endif
__device__ __forceinline__ void conv_tail(const P& a, int l, int phase, const pg::Order& S, PG_LAS unsigned char* lds) {
    int li, j0, j1; if (!conv_sched(l, phase, li, j0, j1)) return;
    const int rem = S.nwg % S.G; if (rem == 0 || S.c < rem) return;
    const int t_ = otid(), wv = __builtin_amdgcn_readfirstlane(t_ >> 6);
    conv_expert_range(a, li, j0, j1, (S.c - rem) * 8 + wv, (S.G - rem) * 8, (PG_LAS float*)lds + wv * (64 * 33), t_ & 63);
}
template <int WHICH> __device__ __forceinline__ void gemm_run(const P& a_in, int l, PG_LAS unsigned char* lds, int G, int c, bool probe = false) {
    PHASE_ENTRY(a_in)
    if (STAGGER_TICKS > 0 && (WHICH == EM_F1 || WHICH == EM_F1M)) {
        const unsigned long long t0 = __builtin_amdgcn_s_memrealtime(); const unsigned long long dl = (unsigned long long)((c & 3) * STAGGER_TICKS);
        while (__builtin_amdgcn_s_memrealtime() - t0 < dl) __builtin_amdgcn_s_sleep(8);
    }
    unsigned char* ws = a.ws; pg::Order S;
    if (WHICH == EM_IN) { S.init(T_ALL / 256, UW / 256, G, c); pg::Gemm g{(const bf16*)(ws + WS_HX), (const bf16*)(ws + WS_WIN) + (size_t)l * UW * D, D, 0, nullptr, nullptr, a.wv};
        PG_LAS float* rl = (PG_LAS float*)(lds + 131072 + 1024); const float* rg = (const float*)(ws + WS_ROPE);
        for (int i = otid(); i < 2048; i += NTHR) rl[i] = rg[i];
        __syncthreads();
        EpiIn E{(bf16*)(ws + WS_U), rl}; pg::gemm_phase<EpiIn, false, false>(lds, g, S, E);
        conv_tail(a, l, CP_IN, S, lds); }
    if (WHICH == EM_OUT) { if (l == DEPTH - 1) { S.init(NB * SEQ / 256, D / 256, G, c); S.lat = 1; } else S.init(T_ALL / 256, D / 256, G, c); pg::Gemm g{(const bf16*)(ws + WS_MIX), (const bf16*)(ws + WS_WOUT) + (size_t)l * D * D, D, 0, nullptr, nullptr, a.wv};
        EpiYs E{(bf16*)(ws + WS_DELTA)}; pg::gemm_phase<EpiYs, false, false>(lds, g, S, E);
        conv_tail(a, l, CP_OUT, S, lds); }
    if (WHICH == EM_F1) { S.init(T_ALL / 256, 2 * FFN / 256, G, c); pg::Gemm g{(const bf16*)(ws + WS_HX), (const bf16*)(ws + WS_WF13) + (size_t)(l >> 1) * 2 * FFN * D, D, 0, nullptr, nullptr, a.wv};
        if (PROBE == 20 && probe) { EpiProbe<false> E; pg::gemm_phase<EpiProbe<false>, false, false>(lds, g, S, E); }
        else if (PROBE == 21 && probe) { EpiProbe<true> E; pg::gemm_phase<EpiProbe<true>, false, false>(lds, g, S, E); }
        else { EpiSwiglu<false> E{(bf16*)(ws + WS_HID), nullptr}; pg::gemm_phase<EpiSwiglu<false>, false, false>(lds, g, S, E); conv_tail(a, l, CP_F1, S, lds); } }
    if (WHICH == EM_F2D) { S.init(T_ALL / 256, D / 256, G, c); pg::Gemm g{(const bf16*)(ws + WS_HID), (const bf16*)(ws + WS_WF2) + (size_t)(l >> 1) * D * FFN, FFN, 0, nullptr, nullptr, a.wv};
        EpiYs E{(bf16*)(ws + WS_DELTA)}; pg::gemm_phase<EpiYs, false, false>(lds, g, S, E);
        conv_tail(a, l, CP_F2D, S, lds); }
    if (WHICH == EM_F1M) { const int* te = (const int*)(ws + WS_TILEE); const int nt = __builtin_amdgcn_readfirstlane(te[MOE_TILES]); S.init(nt, 2 * FFN / 256, G, c);
        pg::Gemm g{(const bf16*)(ws + WS_HX), (const bf16*)(ws + WS_WE13), D, 2 * FFN, (const int*)(ws + WS_ROWT), te, a.wv};
        EpiSwiglu<true> E{(bf16*)(ws + WS_HID), (const float*)(ws + WS_ROWW)}; pg::gemm_phase<EpiSwiglu<true>, true, true>(lds, g, S, E); }
    if (WHICH == EM_F2M) { const int* te = (const int*)(ws + WS_TILEE); const int nt = __builtin_amdgcn_readfirstlane(te[MOE_TILES]); S.init(nt, D / 256, G, c);
        pg::Gemm g{(const bf16*)(ws + WS_HID), (const bf16*)(ws + WS_WE2), FFN, D, nullptr, te, a.wv};
        EpiYs E{(bf16*)(ws + WS_YS)}; pg::gemm_phase<EpiYs, false, true>(lds, g, S, E); }
}
template <int WHICH> __global__ void __launch_bounds__(NTHR, 2) k_gemm(P a, int l) {
    extern __shared__ __attribute__((aligned(16))) unsigned char smem[];
    a.wv = __builtin_amdgcn_readfirstlane(threadIdx.x >> 6);
    gemm_run<WHICH>(a, l, (PG_LAS unsigned char*)smem, (int)gridDim.x, (int)blockIdx.x);
}

typedef float f32x2 __attribute__((ext_vector_type(2)));
typedef float f32x16 __attribute__((ext_vector_type(16)));
typedef short v4s __attribute__((ext_vector_type(4)));
constexpr int ATT_ITEMS = NB * (SEQ / 32) + NB * (CTX / 32);
constexpr int ATT_LDS = 5 * 16384 + 32768 + 1024 + 2048;
__device__ __forceinline__ int att_item(int c, int kk, int sch) {
    const int x = c & 7, idx = c >> 3;
    if (sch == 0) return (idx >= 4 && kk == 0) ? x * 128 + (idx - 4) : -1;
    if (idx < 4) return -1;
    const int j = idx - 4;
    if (kk < 3) return x * 128 + 28 + 3 * j + kk;
    if (kk == 3) return j < 16 ? x * 128 + 112 + j : (j < 24 ? NB * (SEQ / 32) + x * 8 + (j - 16) : -1);
    return -1;
}
struct AttIt { int tb, tq0, ilo, nt; };
__device__ __forceinline__ AttIt att_decode(int it) {
    AttIt I;
    if (it < NB * (SEQ / 32)) { const int b = it >> 7, s0 = (it & 127) * 32; I.tb = b * TPB; I.tq0 = I.tb + CTX + s0;
        I.ilo = s0 >= 128 ? 0 : (128 - s0) / 32; int ihi = (SEQ + 96 - s0) / 32; ihi = ihi > 8 ? 8 : ihi; I.nt = 8 + (ihi - I.ilo + 1); }
    else { const int j = it - NB * (SEQ / 32), b = j >> 3; I.tb = b * TPB; I.tq0 = I.tb + (j & 7) * 32; I.ilo = 0; I.nt = 8; }
    return I;
}
__device__ __forceinline__ int att_tok(const AttIt& I, int t) { return t < 8 ? I.tb + 32 * t : I.tq0 - 128 + 32 * (I.ilo + t - 8); }
template <int PM> __device__ __forceinline__ void attn_phase(const P& a_in, int l, PG_LAS unsigned char* lds, int G, int c_in, int sch) {
    PHASE_ENTRY(a_in)
    int c = c_in; asm volatile("" : "+s"(c));
    const int tid = otid(), lane = tid & 63, h = __builtin_amdgcn_readfirstlane(tid >> 6), kvh = h >> 2;
    const int qr = lane & 31, hh = lane >> 5;
    const bf16* U = (const bf16*)(a.ws + WS_U); bf16* MIX = (bf16*)(a.ws + (PM ? WS_DELTA : WS_MIX));
    PG_LAS float* ssq = (PG_LAS float*)(lds + 114688); PG_LAS float* gl = (PG_LAS float*)(lds + 115712);
    float sink = a.attn_sink[l * 8 + h] * 1.4426950408889634f;
    asm volatile("" : "+v"(sink));
    const int st_isv = (tid >> 8) & 1, st_key = (tid >> 3) & 31, st_pos = tid & 7;
    const int st_ch = st_isv ? (st_pos ^ (((st_key >> 1) & 1) << 2)) : (st_pos ^ ((st_key >> 1) & 7));
    const int st_col = (st_isv ? U_VA : U_KA) + st_ch * 8;
    const unsigned st_lds = (unsigned)h * 1024u;
    const int q_goff = qr * UW + U_QA + h * 64 + 8 * hh;
    const int k_row = qr * 128, k_sw = (qr >> 1) & 7;
    const int tr_q = (lane & 15) >> 2, tr_p = lane & 3, tr_g = (lane >> 4) & 1;
    unsigned trv[2];
#pragma unroll
    for (int dt = 0; dt < 2; ++dt) trv[dt] = (unsigned)(kvh * 8192 + 4096 + (4 * hh + tr_q) * 128 + ((2 * (32 * dt + 16 * tr_g + 4 * tr_p)) ^ (((tr_q >> 1) & 1) << 6)));
    unsigned koff[4];
#pragma unroll
    for (int s4 = 0; s4 < 4; ++s4) koff[s4] = (unsigned)(kvh * 8192 + k_row + 16 * ((2 * s4 + hh) ^ k_sw));
    int it0 = att_item(c, 0, sch); if (it0 < 0) return;
    __syncthreads();
    for (int i = tid; i < 512; i += NTHR) gl[i] = a.g_att[l * 512 + i];
    AttIt cur = att_decode(it0);
    int tk0, tk1;
    {
        int e0 = lane, e1 = 64 + lane, r0 = -1, r1 = -1, lastt = 0;
        for (int kk = 0; kk < 5; ++kk) { const int it_ = att_item(c, kk, sch); if (it_ < 0) break; const AttIt I = att_decode(it_);
            if (r0 < 0) { if (e0 < I.nt) r0 = att_tok(I, e0); else e0 -= I.nt; }
            if (r1 < 0) { if (e1 < I.nt) r1 = att_tok(I, e1); else e1 -= I.nt; }
            lastt = att_tok(I, I.nt - 1); }
        tk0 = r0 < 0 ? lastt : r0; tk1 = r1 < 0 ? lastt : r1;
    }
#define ATT_DMA_TILE(stage, idx) do { const int i_ = (idx); const int kt_ = __builtin_amdgcn_readlane(i_ < 64 ? tk0 : tk1, i_ & 63) + st_key; const bf16* g_ = U + (size_t)kt_ * UW + st_col; \
        __builtin_amdgcn_global_load_lds((const unsigned*)g_, (PG_LAS unsigned*)(lds + (stage) * 16384 + st_lds), 16, 0, 0); \
        __builtin_amdgcn_global_load_lds((const unsigned*)(g_ + 64), (PG_LAS unsigned*)(lds + (stage) * 16384 + 8192 + st_lds), 16, 0, 0); } while (0)
#define ATT_DMA_Q(I, par) do { const bf16* g_ = U + (size_t)(I).tq0 * UW + q_goff; _Pragma("unroll") for (int i_ = 0; i_ < 4; ++i_) \
        __builtin_amdgcn_global_load_lds((const unsigned*)(g_ + 16 * i_), (PG_LAS unsigned*)(lds + 81920 + h * 4096 + i_ * 1024), 16, 0, 0); } while (0)
#define ATT_BAR do { asm volatile("s_waitcnt lgkmcnt(0)" ::: "memory"); __builtin_amdgcn_s_barrier(); asm volatile("" ::: "memory"); } while (0)
#define ATT_QK(dst, stage) do { PG_LAS unsigned char* kb_ = lds + (stage) * 16384 + kvh * 8192; dst = (f32x16){}; _Pragma("unroll") for (int s4 = 0; s4 < 4; ++s4) { \
        const pg::bf16x8 kf_ = *(const PG_LAS pg::bf16x8*)(kb_ + k_row + 16 * ((2 * s4 + hh) ^ k_sw)); dst = __builtin_amdgcn_mfma_f32_32x32x16_bf16(kf_, qf[s4], dst, 0, 0, 0); } } while (0)
    ATT_DMA_Q(cur, 0);
    ATT_DMA_TILE(0, 0); ATT_DMA_TILE(1, 1); ATT_DMA_TILE(2, 2); ATT_DMA_TILE(3, 3);
    asm volatile("s_waitcnt vmcnt(4)" ::: "memory");
    ATT_BAR;
    pg::bf16x8 qf[4];
#pragma unroll
    for (int s4 = 0; s4 < 4; ++s4) qf[s4] = *(const PG_LAS pg::bf16x8*)(lds + 81920 + h * 4096 + s4 * 1024 + lane * 16);
    f32x16 scur; ATT_QK(scur, 0);
    int j = 0, sj = 0;
    for (int kk = 0; ; ++kk) {
        const int nit = att_item(c, kk + 1, sch); const bool has_next = nit >= 0; const AttIt nxt = has_next ? att_decode(nit) : cur;
        float m = sink, lsum = 0.f;
        f32x16 o0 = {}, o1 = {};
        const int nt = cur.nt;
        for (int t = 0; t < nt; ++t, ++j) {
            const int s1 = sj == 4 ? 0 : sj + 1, s4g = sj == 0 ? 4 : sj - 1;
            if (t == 0) ATT_DMA_Q(nxt, 0);
            ATT_DMA_TILE(s4g, j + 4);
            const unsigned vbs = (unsigned)(size_t)lds + (unsigned)sj * 16384u;
            v2u va[2][2], vc[2][2];
#pragma unroll
            for (int dt = 0; dt < 2; ++dt) { const unsigned ad = vbs + trv[dt];
                asm volatile("ds_read_b64_tr_b16 %0, %1" : "=v"(va[0][dt]) : "v"(ad));
                asm volatile("ds_read_b64_tr_b16 %0, %1 offset:1024" : "=v"(vc[0][dt]) : "v"(ad));
                asm volatile("ds_read_b64_tr_b16 %0, %1 offset:2048" : "=v"(va[1][dt]) : "v"(ad));
                asm volatile("ds_read_b64_tr_b16 %0, %1 offset:3072" : "=v"(vc[1][dt]) : "v"(ad)); }
            v4u kf[4];
            { const unsigned kbs = (unsigned)(size_t)lds + (unsigned)s1 * 16384u;
#pragma unroll
              for (int s4 = 0; s4 < 4; ++s4) asm volatile("ds_read_b128 %0, %1" : "=v"(kf[s4]) : "v"(kbs + koff[s4])); }
            if (t == nt - 1) {
#pragma unroll
                for (int s4 = 0; s4 < 4; ++s4) qf[s4] = *(const PG_LAS pg::bf16x8*)(lds + 81920 + h * 4096 + s4 * 1024 + lane * 16); }
            f32x16 sacc = scur;
            const int ti = (t < 8) ? -1 : cur.ilo + t - 8;
            if (ti == 0 || ti == 8) {
#pragma unroll
                for (int i = 0; i < 16; ++i) { const int kq = (i & 3) + 8 * (i >> 2) + 4 * hh; const bool ok = (ti == 0) ? (kq >= qr) : (kq <= qr); sacc[i] = ok ? sacc[i] : -1.0e30f; }
            }
            float mt = sacc[0];
#pragma unroll
            for (int i = 1; i < 16; ++i) mt = fmaxf(mt, sacc[i]);
            mt = hmax32(mt);
            const bool grow = mt > m + 8.f;
            if (__any(grow)) {
                const float mn = grow ? mt : m, alpha = __builtin_amdgcn_exp2f(m - mn); m = mn; lsum *= alpha;
#pragma unroll
                for (int i = 0; i < 16; ++i) { o0[i] *= alpha; o1[i] *= alpha; } }
            asm volatile("s_waitcnt lgkmcnt(0)" : "+v"(kf[0]), "+v"(kf[1]), "+v"(kf[2]), "+v"(kf[3]), "+v"(va[0][0]), "+v"(vc[0][0]), "+v"(va[0][1]), "+v"(vc[0][1]), "+v"(va[1][0]), "+v"(vc[1][0]), "+v"(va[1][1]), "+v"(vc[1][1]));
            f32x16 snext = {}; f32x2 ps2 = {0.f, 0.f}; const f32x2 mm = {m, m};
#pragma unroll
            for (int g = 0; g < 4; ++g) {
                snext = __builtin_amdgcn_mfma_f32_32x32x16_bf16(__builtin_bit_cast(pg::bf16x8, kf[g]), qf[g], snext, 0, 0, 0);
#pragma unroll
                for (int i = 2 * g; i < 2 * g + 2; ++i) { const f32x2 d = (f32x2){sacc[2 * i], sacc[2 * i + 1]} - mm; const f32x2 ev = {__builtin_amdgcn_exp2f(d.x), __builtin_amdgcn_exp2f(d.y)};
                    sacc[2 * i] = ev.x; sacc[2 * i + 1] = ev.y; ps2 += ev; }
                __builtin_amdgcn_sched_barrier(0);
            }
            lsum += ps2.x + ps2.y;
#pragma unroll
            for (int s2 = 0; s2 < 2; ++s2) {
                v4u pw; pw.x = cvt_pk_bf16(sacc[8 * s2 + 0], sacc[8 * s2 + 1]); pw.y = cvt_pk_bf16(sacc[8 * s2 + 2], sacc[8 * s2 + 3]);
                pw.z = cvt_pk_bf16(sacc[8 * s2 + 4], sacc[8 * s2 + 5]); pw.w = cvt_pk_bf16(sacc[8 * s2 + 6], sacc[8 * s2 + 7]);
                const pg::bf16x8 pf = __builtin_bit_cast(pg::bf16x8, pw);
#pragma unroll
                for (int dt = 0; dt < 2; ++dt) {
                    const pg::bf16x8 vf = __builtin_bit_cast(pg::bf16x8, (v4u){va[s2][dt].x, va[s2][dt].y, vc[s2][dt].x, vc[s2][dt].y});
                    if (dt == 0) o0 = __builtin_amdgcn_mfma_f32_32x32x16_bf16(vf, pf, o0, 0, 0, 0);
                    else o1 = __builtin_amdgcn_mfma_f32_32x32x16_bf16(vf, pf, o1, 0, 0, 0);
                }
            }
            scur = snext;
            if (t == 0) asm volatile("s_waitcnt vmcnt(8)" ::: "memory"); else asm volatile("s_waitcnt vmcnt(4)" ::: "memory");
            ATT_BAR;
            sj = s1;
        }
        const float ltot = hsum32(lsum);
        const float inv = __builtin_amdgcn_rcpf(ltot + __builtin_amdgcn_exp2f(sink - m));
        float sq = 0.f;
#pragma unroll
        for (int i = 0; i < 16; ++i) { o0[i] *= inv; o1[i] *= inv; sq += o0[i] * o0[i] + o1[i] * o1[i]; }
        sq = hsum32(sq);
        if (hh == 0) ssq[h * 32 + qr] = sq;
        ATT_BAR;
        float tot = 0.f;
#pragma unroll
        for (int w = 0; w < 8; ++w) tot += ssq[w * 32 + qr];
        const float rstd = rsqrtf(tot * (1.f / 512.f) + EPS);
        bf16* orow = MIX + (size_t)(cur.tq0 + qr) * D + h * 64;
#pragma unroll
        for (int dt = 0; dt < 2; ++dt)
#pragma unroll
            for (int i4 = 0; i4 < 4; ++i4) { const int d = 32 * dt + 8 * i4 + 4 * hh; const f32x4 gg = *(const PG_LAS f32x4*)(gl + h * 64 + d);
                const f32x16& oo = dt == 0 ? o0 : o1;
                v2u w; w.x = cvt_pk_bf16(oo[4 * i4 + 0] * rstd * gg.x, oo[4 * i4 + 1] * rstd * gg.y); w.y = cvt_pk_bf16(oo[4 * i4 + 2] * rstd * gg.z, oo[4 * i4 + 3] * rstd * gg.w);
                *(v2u*)(orow + d) = w; }
        if (!has_next) break;
        cur = nxt;
    }
    asm volatile("s_waitcnt vmcnt(0)" ::: "memory");
    __syncthreads();
#undef ATT_DMA_TILE
#undef ATT_QK
#undef ATT_BAR
#undef ATT_DMA_Q
}
__global__ void __launch_bounds__(NTHR, 2) k_attn(P a, int l) {
    extern __shared__ __attribute__((aligned(16))) unsigned char smem[];
    a.wv = __builtin_amdgcn_readfirstlane(threadIdx.x >> 6);
    attn_phase<0>(a, l, (PG_LAS unsigned char*)smem, (int)gridDim.x, (int)blockIdx.x, 0); attn_phase<0>(a, l, (PG_LAS unsigned char*)smem, (int)gridDim.x, (int)blockIdx.x, 1);
}

__device__ __forceinline__ float scan_sum(float v, int) { return dpp_scan<false>(v); }
__device__ __forceinline__ float scan_max(float v, int) { return dpp_scan<true>(v); }
constexpr int ML_ITEMS = NB * NCHUNK;
constexpr int ML_LDS = 65536 + 65536 + 16384;
__device__ __forceinline__ void ml_load_v(const bf16* U, int tk0, PG_LAS unsigned char* lds, int tid) {
#pragma unroll
    for (int i = 0; i < 8; ++i) { const int cid = tid + 512 * i, sg = cid >> 6, r = cid & 63, hv = r >> 4, ch = r & 15;
        const v4u v = *(const v4u*)(U + (size_t)(tk0 + sg) * UW + U_VM + hv * 128 + ch * 8);
        *(PG_LAS v4u*)(lds + hv * 16384 + sg * 256 + ((ch * 16) ^ ((sg & 3) << 6))) = v; }
}
__device__ __forceinline__ float ml_tok(const bf16* U, int tk, int lo, int hi, int col) { return (tk >= lo && tk < hi) ? bf2f(U[(size_t)tk * UW + col]) : 0.f; }

template <int NT> __device__ __forceinline__ void conv8(const P& a, int l, const bf16* U, int tk0, int s0, int lo, int hi, int ch0, float (&out)[NT][8]) {
    float cw[5][8], cb[8];
#pragma unroll
    for (int j = 0; j < 5; ++j) { const f32x4 w0 = *(const f32x4*)(a.conv_w + (l * 5 + j) * 512 + ch0), w1 = *(const f32x4*)(a.conv_w + (l * 5 + j) * 512 + ch0 + 4);
        cw[j][0] = w0.x; cw[j][1] = w0.y; cw[j][2] = w0.z; cw[j][3] = w0.w; cw[j][4] = w1.x; cw[j][5] = w1.y; cw[j][6] = w1.z; cw[j][7] = w1.w; }
    { const f32x4 b0 = *(const f32x4*)(a.conv_b + l * 512 + ch0), b1 = *(const f32x4*)(a.conv_b + l * 512 + ch0 + 4);
      cb[0] = b0.x; cb[1] = b0.y; cb[2] = b0.z; cb[3] = b0.w; cb[4] = b1.x; cb[5] = b1.y; cb[6] = b1.z; cb[7] = b1.w; }
    v4u rows[NT + 4];
#pragma unroll
    for (int r = 0; r < NT + 4; ++r) { const int tk = tk0 + s0 + r - 2; const bool ok = tk >= lo && tk < hi; const int tkc = tk < lo ? lo : (tk >= hi ? hi - 1 : tk);
        const v4u v = *(const v4u*)(U + (size_t)tkc * UW + U_QM + ch0); rows[r] = ok ? v : (v4u){0u, 0u, 0u, 0u}; }
#pragma unroll
    for (int i = 0; i < NT; ++i) {
        float y[8];
#pragma unroll
        for (int c = 0; c < 8; ++c) y[c] = cb[c];
#pragma unroll
        for (int j = 0; j < 5; ++j) { const v4u x = rows[i + j];
            y[0] += cw[j][0] * bf_lo(x.x); y[1] += cw[j][1] * bf_hi(x.x); y[2] += cw[j][2] * bf_lo(x.y); y[3] += cw[j][3] * bf_hi(x.y);
            y[4] += cw[j][4] * bf_lo(x.z); y[5] += cw[j][5] * bf_hi(x.z); y[6] += cw[j][6] * bf_lo(x.w); y[7] += cw[j][7] * bf_hi(x.w); }
#pragma unroll
        for (int c = 0; c < 8; ++c) out[i][c] = silu_f(y[c]);
    }
}

__device__ __forceinline__ void ml_d1_phase(const P& a_in, int l, PG_LAS unsigned char* lds, int G, int c0) {
    PHASE_ENTRY(a_in)
    const int tid = otid(), lane = tid & 63, wave = __builtin_amdgcn_readfirstlane(tid >> 6), hd = wave >> 1, dir = wave & 1;
    const int hh = lane >> 5, lr = lane & 31, tr_q = (lane & 15) >> 2, tr_p = lane & 3, tr_g = (lane >> 4) & 1;
    const bf16* U = (const bf16*)(a.ws + WS_U); const float* GT = (const float*)(a.ws + WS_GATES);
    bf16* ST = (bf16*)(a.ws + WS_ST); float* NL = (float*)(a.ws + WS_NL); float* SC = (float*)(a.ws + WS_SC);
    PG_LAS unsigned char* kwt = lds + 65536;
    PG_LAS float* wts = (PG_LAS float*)(lds + 131072);
    for (int item = c0; item < ML_ITEMS; item += G) {
        const int b = item / NCHUNK, c = item - b * NCHUNK, tk0 = b * TPB + 64 * c;
        const int lo = c < 4 ? b * TPB : b * TPB + CTX, hi = c < 4 ? b * TPB + CTX : (b + 1) * TPB;
        const int cc = ((b * 4 + hd) * 2 + dir) * NCHUNK + c;
        ml_load_v(U, tk0, lds, tid);
        {
            const int t = dir ? 63 - lane : lane;
            const float li = GT[(size_t)(tk0 + t) * 16 + dir * 8 + hd], lf = logsigmoid_f(GT[(size_t)(tk0 + t) * 16 + dir * 8 + 4 + hd]);
            const float bc = scan_sum(lf, lane), bend = lane_bcast(bc, 63);
            const float g = bend - bc + li, mloc = wave_max(g);
            wts[wave * 64 + t] = __expf(g - mloc);
            if (lane == 0) { SC[(size_t)cc * 4 + 0] = bend; SC[(size_t)cc * 4 + 1] = mloc; }
        }
        __syncthreads();
        {
            const int chg = tid & 31, sb = tid >> 5, s0 = 4 * sb, khd = chg >> 3, d0 = (chg & 7) * 8;
            float kv[4][8];
            conv8<4>(a, l, U, tk0, s0, lo, hi, 256 + 8 * chg, kv);
#pragma unroll
            for (int i = 0; i < 4; ++i) { const int sg = s0 + i;
#pragma unroll
                for (int dd = 0; dd < 2; ++dd) { const float w = wts[(khd * 2 + dd) * 64 + sg];
                    v4u o; o.x = cvt_pk_bf16(kv[i][0] * w, kv[i][1] * w); o.y = cvt_pk_bf16(kv[i][2] * w, kv[i][3] * w); o.z = cvt_pk_bf16(kv[i][4] * w, kv[i][5] * w); o.w = cvt_pk_bf16(kv[i][6] * w, kv[i][7] * w);
                    *(PG_LAS v4u*)(kwt + (khd * 2 + dd) * 8192 + sg * 128 + ((2 * d0) ^ (((sg >> 1) & 1) << 6))) = o; } }
        }
        __syncthreads();
        PG_LAS unsigned char* kw = kwt + wave * 8192;
        {
            float ns = 0.f;
#pragma unroll 8
            for (int sg = 0; sg < 64; ++sg) ns += bf2f(*(const PG_LAS bf16*)(kw + sg * 128 + ((2 * lane) ^ (((sg >> 1) & 1) << 6))));
            NL[(size_t)cc * 64 + lane] = ns;
        }
        pg::bf16x8 af[2][4];
#pragma unroll
        for (int dt = 0; dt < 2; ++dt)
#pragma unroll
            for (int s4 = 0; s4 < 4; ++s4) { const int r1 = 16 * s4 + 8 * hh + tr_q, r2 = r1 + 4; const int dbyte = 2 * (32 * dt + 16 * tr_g + 4 * tr_p);
                const v4s v1 = __builtin_amdgcn_ds_read_tr16_b64_v4i16((PG_LAS v4s*)(kw + r1 * 128 + (dbyte ^ (((r1 >> 1) & 1) << 6))));
                const v4s v2 = __builtin_amdgcn_ds_read_tr16_b64_v4i16((PG_LAS v4s*)(kw + r2 * 128 + (dbyte ^ (((r2 >> 1) & 1) << 6))));
                af[dt][s4] = (pg::bf16x8){v1[0], v1[1], v1[2], v1[3], v2[0], v2[1], v2[2], v2[3]}; }
        PG_LAS unsigned char* vb = lds + hd * 16384;
#pragma unroll
        for (int et = 0; et < 4; ++et) {
            pg::bf16x8 bfr[4];
            const int ebyte = 2 * (32 * et + 16 * tr_g + 4 * tr_p);
#pragma unroll
            for (int s4 = 0; s4 < 4; ++s4) { const int r1 = 16 * s4 + 8 * hh + tr_q, r2 = r1 + 4;
                const v4s v1 = __builtin_amdgcn_ds_read_tr16_b64_v4i16((PG_LAS v4s*)(vb + r1 * 256 + (ebyte ^ ((r1 & 3) << 6))));
                const v4s v2 = __builtin_amdgcn_ds_read_tr16_b64_v4i16((PG_LAS v4s*)(vb + r2 * 256 + (ebyte ^ ((r2 & 3) << 6))));
                bfr[s4] = (pg::bf16x8){v1[0], v1[1], v1[2], v1[3], v2[0], v2[1], v2[2], v2[3]}; }
#pragma unroll
            for (int dt = 0; dt < 2; ++dt) {
                f32x16 acc = {};
#pragma unroll
                for (int s4 = 0; s4 < 4; ++s4) acc = __builtin_amdgcn_mfma_f32_32x32x16_bf16(af[dt][s4], bfr[s4], acc, 0, 0, 0);
                v4u o0, o1;
                o0.x = cvt_pk_bf16(acc[0], acc[1]); o0.y = cvt_pk_bf16(acc[2], acc[3]); o0.z = cvt_pk_bf16(acc[4], acc[5]); o0.w = cvt_pk_bf16(acc[6], acc[7]);
                o1.x = cvt_pk_bf16(acc[8], acc[9]); o1.y = cvt_pk_bf16(acc[10], acc[11]); o1.z = cvt_pk_bf16(acc[12], acc[13]); o1.w = cvt_pk_bf16(acc[14], acc[15]);
                bf16* dst = ST + ((size_t)cc * 8 + dt * 4 + et) * 1024 + lane * 16;
                *(v4u*)dst = o0; *(v4u*)(dst + 8) = o1;
            }
        }
        __syncthreads();
    }
}
__device__ __forceinline__ void ml_d2_phase(const P& a_in, int wg) {
    PHASE_ENTRY(a_in)
    const int tid = otid(), chain = wg >> 2, quarter = wg & 3, dir = chain & 1;
    bf16* ST = (bf16*)(a.ws + WS_ST); float* NL = (float*)(a.ws + WS_NL); float* SC = (float*)(a.ws + WS_SC);
    const bool cw = tid < 256, nw = (quarter == 0 && tid >= 256 && tid < 320);
    if (cw || nw) {
    float st[8];
#pragma unroll
    for (int j = 0; j < 8; ++j) st[j] = 0.f;
    float nst = 0.f, m = 0.f;
    const size_t unit = (size_t)(quarter * 256 + tid) * 8;
#pragma unroll 1
    for (int i0 = 0; i0 < NCHUNK; i0 += 4) {
        v4u x[4]; float nx[4], be[4], ml[4]; int cidx[4];
#pragma unroll
        for (int k = 0; k < 4; ++k) { const int i = i0 + k; const int c = dir == 0 ? i : (i < 4 ? 3 - i : 71 - i); cidx[k] = chain * NCHUNK + c;
            be[k] = SC[(size_t)cidx[k] * 4]; ml[k] = SC[(size_t)cidx[k] * 4 + 1];
            if (cw) x[k] = *(const v4u*)(ST + (size_t)cidx[k] * 8192 + unit); else nx[k] = NL[(size_t)cidx[k] * 64 + (tid - 256)]; }
#pragma unroll
        for (int k = 0; k < 4; ++k) {
            const float mn = fmaxf(be[k] + m, ml[k]), fa = __expf(be[k] + m - mn), fb = __expf(ml[k] - mn);
            if (cw) {
                v4u o; o.x = pk2(st[0], st[1]); o.y = pk2(st[2], st[3]); o.z = pk2(st[4], st[5]); o.w = pk2(st[6], st[7]);
                *(v4u*)(ST + (size_t)cidx[k] * 8192 + unit) = o;
                st[0] = fa * st[0] + fb * bf_lo(x[k].x); st[1] = fa * st[1] + fb * bf_hi(x[k].x); st[2] = fa * st[2] + fb * bf_lo(x[k].y); st[3] = fa * st[3] + fb * bf_hi(x[k].y);
                st[4] = fa * st[4] + fb * bf_lo(x[k].z); st[5] = fa * st[5] + fb * bf_hi(x[k].z); st[6] = fa * st[6] + fb * bf_lo(x[k].w); st[7] = fa * st[7] + fb * bf_hi(x[k].w);
            } else {
                NL[(size_t)cidx[k] * 64 + (tid - 256)] = nst; nst = fa * nst + fb * nx[k];
                if (tid == 256) SC[(size_t)cidx[k] * 4 + 2] = m;
            }
            m = mn;
        }
    }
    }
}
__device__ __forceinline__ void ml_d3_phase(const P& a_in, int l, PG_LAS unsigned char* lds, int G, int c0) {
    PHASE_ENTRY(a_in)
    const int tid = otid(), wave = __builtin_amdgcn_readfirstlane(tid >> 6), hd = wave >> 1, qt = wave & 1;
    const bf16* U = (const bf16*)(a.ws + WS_U); const float* GT = (const float*)(a.ws + WS_GATES);
    const bf16* ST = (const bf16*)(a.ws + WS_ST); const float* NL = (const float*)(a.ws + WS_NL); const float* SC = (const float*)(a.ws + WS_SC);
    bf16* MIX = (bf16*)(a.ws + WS_MIX);
    PG_LAS unsigned char* qtile = lds + 65536 + hd * 16384;
    PG_LAS unsigned char* ktile = qtile + 8192;
    PG_LAS float* aarr = (PG_LAS float*)(lds + 131072 + wave * 2048);
    for (int item = c0; item < ML_ITEMS; item += G) {
        int lane = tid & 63; asm volatile("" : "+v"(lane));
        const int hh = lane >> 5, lr = lane & 31, tr_q = (lane & 15) >> 2, tr_p = lane & 3, tr_g = (lane >> 4) & 1;
        const int tq = 32 * qt + lr;
        const int b = item / NCHUNK, c = item - b * NCHUNK, tk0 = b * TPB + 64 * c;
        const int lo = c < 4 ? b * TPB : b * TPB + CTX, hi = c < 4 ? b * TPB + CTX : (b + 1) * TPB;
        float gli[2], glf[2], gmp[2];
#pragma unroll
        for (int dd = 0; dd < 2; ++dd) { const int t = dd ? 63 - lane : lane;
            gli[dd] = GT[(size_t)(tk0 + t) * 16 + dd * 8 + hd]; glf[dd] = GT[(size_t)(tk0 + t) * 16 + dd * 8 + 4 + hd]; gmp[dd] = SC[(size_t)(((b * 4 + hd) * 2 + dd) * NCHUNK + c) * 4 + 2]; }
        ml_load_v(U, tk0, lds, tid);
#pragma unroll
        for (int dd = 0; dd < 2; ++dd) aarr[192 + dd * 64 + lane] = NL[(size_t)(((b * 4 + hd) * 2 + dd) * NCHUNK + c) * 64 + lane];
        {
            const int chg = tid & 63, s0 = 8 * (tid >> 6), ch0 = 8 * chg;
            float kv[8][8];
            conv8<8>(a, l, U, tk0, s0, lo, hi, ch0, kv);
            PG_LAS unsigned char* dstt = lds + 65536 + ((ch0 & 255) >> 6) * 16384 + (ch0 >> 8) * 8192;
            const float qsc = ch0 < 256 ? 0.125f : 1.f; const int chunk = (ch0 & 63) >> 3;
#pragma unroll
            for (int i = 0; i < 8; ++i) { const int sg = s0 + i;
                v4u o; o.x = cvt_pk_bf16(kv[i][0] * qsc, kv[i][1] * qsc); o.y = cvt_pk_bf16(kv[i][2] * qsc, kv[i][3] * qsc); o.z = cvt_pk_bf16(kv[i][4] * qsc, kv[i][5] * qsc); o.w = cvt_pk_bf16(kv[i][6] * qsc, kv[i][7] * qsc);
                *(PG_LAS v4u*)(dstt + sg * 128 + 16 * (chunk ^ ((sg >> 1) & 7))) = o; }
        }
        __syncthreads();
#define D3_QF(s4) ({ const int sw_ = (tq >> 1) & 7; \
            const v2u lo2_ = *(const PG_LAS v2u*)(qtile + tq * 128 + 16 * ((2 * (s4)) ^ sw_) + 8 * hh), hi2_ = *(const PG_LAS v2u*)(qtile + tq * 128 + 16 * ((2 * (s4) + 1) ^ sw_) + 8 * hh); \
            __builtin_bit_cast(pg::bf16x8, (v4u){lo2_.x, lo2_.y, hi2_.x, hi2_.y}); })
        f32x16 hs[4];
#pragma unroll
        for (int et = 0; et < 4; ++et) hs[et] = (f32x16){};
#pragma unroll 1
        for (int dir = 0; dir < 2; ++dir) {
            const int cc = ((b * 4 + hd) * 2 + dir) * NCHUNK + c;
            const float mprev = dir ? gmp[1] : gmp[0];
            {
                const int t = dir ? 63 - lane : lane;
                const float li = dir ? gli[1] : gli[0], lf = logsigmoid_f(dir ? glf[1] : glf[0]);
                const float bc = scan_sum(lf, lane), av = li - bc, pm = scan_max(av, lane), Mv = fmaxf(mprev, pm);
                aarr[t] = av; aarr[64 + t] = Mv; aarr[128 + t] = bc;
            }
            const float Mq = aarr[64 + tq], bq = aarr[128 + tq];
            const float wq = __expf(mprev - Mq);
            pg::bf16x8 cs[2][2][2];
#pragma unroll
            for (int dt = 0; dt < 2; ++dt) { const bf16* src = ST + ((size_t)cc * 8 + dt * 4) * 1024 + lane * 16; cs[0][dt][0] = *(const pg::bf16x8*)src; cs[0][dt][1] = *(const pg::bf16x8*)(src + 8); }
            float qn = 0.f;
#pragma unroll
            for (int s4 = 0; s4 < 4; ++s4) { const f32x4 n0 = *(const PG_LAS f32x4*)(aarr + 192 + dir * 64 + 16 * s4 + 4 * hh), n1 = *(const PG_LAS f32x4*)(aarr + 192 + dir * 64 + 16 * s4 + 8 + 4 * hh);
                const v4u qw = __builtin_bit_cast(v4u, D3_QF(s4));
                qn += bf_lo(qw.x) * n0.x + bf_hi(qw.x) * n0.y + bf_lo(qw.y) * n0.z + bf_hi(qw.y) * n0.w + bf_lo(qw.z) * n1.x + bf_hi(qw.z) * n1.y + bf_lo(qw.w) * n1.z + bf_hi(qw.w) * n1.w; }
            qn = hsum32(qn);
            pg::bf16x8 pf[2][2]; float psum = 0.f;
#pragma unroll
            for (int st = 0; st < 2; ++st) {
                f32x16 acc = {}; const int sg = 32 * st + lr, sw = (sg >> 1) & 7;
#pragma unroll
                for (int s4 = 0; s4 < 4; ++s4) {
                    const v2u lo2 = *(const PG_LAS v2u*)(ktile + sg * 128 + 16 * ((2 * s4) ^ sw) + 8 * hh), hi2 = *(const PG_LAS v2u*)(ktile + sg * 128 + 16 * ((2 * s4 + 1) ^ sw) + 8 * hh);
                    const pg::bf16x8 kf = __builtin_bit_cast(pg::bf16x8, (v4u){lo2.x, lo2.y, hi2.x, hi2.y});
                    acc = __builtin_amdgcn_mfma_f32_32x32x16_bf16(kf, D3_QF(s4), acc, 0, 0, 0); }
#pragma unroll
                for (int i4 = 0; i4 < 4; ++i4) { const f32x4 av = *(const PG_LAS f32x4*)(aarr + 32 * st + 8 * i4 + 4 * hh);
#pragma unroll
                    for (int j = 0; j < 4; ++j) { const int sgk = 32 * st + 8 * i4 + 4 * hh + j; const bool ok = dir ? (sgk >= tq) : (sgk <= tq);
                        const float p = ok ? acc[4 * i4 + j] * __expf(av[j] - Mq) : 0.f; acc[4 * i4 + j] = p; psum += p; } }
#pragma unroll
                for (int s2 = 0; s2 < 2; ++s2) { v4u pw; pw.x = cvt_pk_bf16(acc[8 * s2 + 0], acc[8 * s2 + 1]); pw.y = cvt_pk_bf16(acc[8 * s2 + 2], acc[8 * s2 + 3]);
                    pw.z = cvt_pk_bf16(acc[8 * s2 + 4], acc[8 * s2 + 5]); pw.w = cvt_pk_bf16(acc[8 * s2 + 6], acc[8 * s2 + 7]); pf[st][s2] = __builtin_bit_cast(pg::bf16x8, pw); }
            }
            psum = hsum32(psum);
            const float den = psum + wq * qn;
            const float rden = __builtin_amdgcn_rcpf(fmaxf(fabsf(den), __expf(-(bq + Mq))));
            PG_LAS unsigned char* vb = lds + hd * 16384;
#pragma unroll
            for (int dt = 0; dt < 2; ++dt) { const bf16* src = ST + ((size_t)cc * 8 + dt * 4 + 1) * 1024 + lane * 16; cs[1][dt][0] = *(const pg::bf16x8*)src; cs[1][dt][1] = *(const pg::bf16x8*)(src + 8); }
#pragma unroll
            for (int et = 0; et < 4; ++et) {
                f32x16 acc = {};
#pragma unroll
                for (int dt = 0; dt < 2; ++dt) {
                    acc = __builtin_amdgcn_mfma_f32_32x32x16_bf16(cs[et & 1][dt][0], D3_QF(2 * dt), acc, 0, 0, 0);
                    acc = __builtin_amdgcn_mfma_f32_32x32x16_bf16(cs[et & 1][dt][1], D3_QF(2 * dt + 1), acc, 0, 0, 0); }
                if (et < 2) {
#pragma unroll
                    for (int dt = 0; dt < 2; ++dt) { const bf16* src = ST + ((size_t)cc * 8 + dt * 4 + et + 2) * 1024 + lane * 16; cs[et & 1][dt][0] = *(const pg::bf16x8*)src; cs[et & 1][dt][1] = *(const pg::bf16x8*)(src + 8); } }
#pragma unroll
                for (int i = 0; i < 16; ++i) acc[i] *= wq;
                const int ebyte = 2 * (32 * et + 16 * tr_g + 4 * tr_p);
#pragma unroll
                for (int st = 0; st < 2; ++st)
#pragma unroll
                    for (int s2 = 0; s2 < 2; ++s2) { const int r1 = 32 * st + 16 * s2 + 4 * hh + tr_q, r2 = r1 + 8;
                        const v4s v1 = __builtin_amdgcn_ds_read_tr16_b64_v4i16((PG_LAS v4s*)(vb + r1 * 256 + (ebyte ^ ((r1 & 3) << 6))));
                        const v4s v2 = __builtin_amdgcn_ds_read_tr16_b64_v4i16((PG_LAS v4s*)(vb + r2 * 256 + (ebyte ^ ((r2 & 3) << 6))));
                        const pg::bf16x8 vf = {v1[0], v1[1], v1[2], v1[3], v2[0], v2[1], v2[2], v2[3]};
                        acc = __builtin_amdgcn_mfma_f32_32x32x16_bf16(vf, pf[st][s2], acc, 0, 0, 0); }
                hs[et] += acc * rden;
            }
        }
        float sq = 0.f;
#pragma unroll
        for (int et = 0; et < 4; ++et)
#pragma unroll
            for (int i = 0; i < 16; ++i) sq += hs[et][i] * hs[et][i];
        sq = hsum32(sq);
        const float rstd = rsqrtf(sq * (1.f / 128.f) + EPS);
        const float* gm = a.g_ml + l * 512 + hd * 128;
        const bf16* om = U + (size_t)(tk0 + tq) * UW + U_OM + hd * 128;
        bf16* orow = MIX + (size_t)(tk0 + tq) * D + 512 + hd * 128;
#pragma unroll
        for (int et = 0; et < 4; ++et)
#pragma unroll
            for (int i4 = 0; i4 < 4; ++i4) { const int e = 32 * et + 8 * i4 + 4 * hh; const f32x4 gg = *(const f32x4*)(gm + e); const v2u ov = *(const v2u*)(om + e);
                const float y0 = hs[et][4 * i4 + 0] * rstd * gg.x * sigmoid_f(bf_lo(ov.x)), y1 = hs[et][4 * i4 + 1] * rstd * gg.y * sigmoid_f(bf_hi(ov.x));
                const float y2 = hs[et][4 * i4 + 2] * rstd * gg.z * sigmoid_f(bf_lo(ov.y)), y3 = hs[et][4 * i4 + 3] * rstd * gg.w * sigmoid_f(bf_hi(ov.y));
                v2u w; w.x = cvt_pk_bf16(y0, y1); w.y = cvt_pk_bf16(y2, y3); *(v2u*)(orow + e) = w;
                if (i4 == 3) asm volatile("" ::: "memory"); }
        __syncthreads();
    }
}
__global__ void __launch_bounds__(NTHR, 2) k_ml_d1(P a, int l) { a.wv = __builtin_amdgcn_readfirstlane(threadIdx.x >> 6); extern __shared__ __attribute__((aligned(16))) unsigned char smem[]; ml_d1_phase(a, l, (PG_LAS unsigned char*)smem, (int)gridDim.x, (int)blockIdx.x); }
__global__ void __launch_bounds__(NTHR, 2) k_ml_d2(P a) { a.wv = __builtin_amdgcn_readfirstlane(threadIdx.x >> 6); ml_d2_phase(a, (int)blockIdx.x); }
__global__ void __launch_bounds__(NTHR, 2) k_ml_d3(P a, int l) { a.wv = __builtin_amdgcn_readfirstlane(threadIdx.x >> 6); extern __shared__ __attribute__((aligned(16))) unsigned char smem[]; ml_d3_phase(a, l, (PG_LAS unsigned char*)smem, (int)gridDim.x, (int)blockIdx.x); }

#define XB_TMO      128
#define XB_XCNT(j)  (256  + 64 * (j))
#define XB_XSUB(j)  (1280 + 64 * (j))
#define XB_XGEN(j)  (2304 + 64 * (j))
#define XB_TOP      3328
#define XB_TOPGEN   3392
#define XCD_BAR_WORDS 3456
#define XB_SPIN_CAP (1u << 20)
__device__ __forceinline__ unsigned xb_ld(unsigned* p)              { return __hip_atomic_load(p, __ATOMIC_RELAXED, __HIP_MEMORY_SCOPE_AGENT); }
__device__ __forceinline__ unsigned xb_add(unsigned* p, unsigned v) { return __hip_atomic_fetch_add(p, v, __ATOMIC_RELAXED, __HIP_MEMORY_SCOPE_AGENT); }
__device__ __forceinline__ unsigned xb_xcc_id() { return (unsigned)__builtin_amdgcn_s_getreg((3 << 11) | 20) & 0xFu; }
#define XB_SPIN(cond, bar) do { unsigned _sp = 0; while (cond) { __builtin_amdgcn_s_sleep(1); \
    if ((++_sp & 255u) == 0u) { if (xb_ld(&(bar)[XB_TMO])) break; if (_sp > XB_SPIN_CAP) { atomicAdd(&(bar)[XB_TMO], 1u); break; } } } } while (0)
struct XcdBarrier { unsigned* bar; unsigned x; volatile PG_LAS unsigned* st; };
__device__ __forceinline__ XcdBarrier xcd_barrier_post(unsigned* bar, volatile PG_LAS unsigned* st, int tid) {
    XcdBarrier b; b.bar = bar; b.x = xb_xcc_id(); b.st = st;
    if (tid == 0) (void)xb_add(&bar[XB_XCNT(b.x)], 1u);
    return b;
}
__device__ __forceinline__ void xcd_barrier_complete(unsigned* bar, unsigned x, unsigned& nloc, unsigned& nx) {
    const unsigned G = gridDim.x * gridDim.y * gridDim.z;
    unsigned sum, cnt, mine, sp = 0u;
    for (;;) {
        sum = 0u; cnt = 0u; mine = 0u;
#pragma unroll
        for (unsigned j = 0; j < 16; ++j) { const unsigned c = xb_ld(&bar[XB_XCNT(j)]); sum += c; cnt += (c > 0u) ? 1u : 0u; mine = (j == x) ? c : mine; }
        if (sum == G) break;
        __builtin_amdgcn_s_sleep(1);
        if ((++sp & 255u) == 0u) { if (xb_ld(&bar[XB_TMO])) break; if (sp > XB_SPIN_CAP) { atomicAdd(&bar[XB_TMO], 1u); break; } }
    }
    nloc = mine > 0u ? mine : 1u; nx = cnt > 0u ? cnt : 1u;
}
__device__ __forceinline__ void xcd_barrier(const XcdBarrier& b, int tid) {
    asm volatile("s_waitcnt vmcnt(0)" ::: "memory");
    __syncthreads();
    if (tid == 0) {
        unsigned* bar = b.bar; asm volatile("" : "+s"(bar)); unsigned bx = b.x; asm volatile("" : "+s"(bx));
        __builtin_amdgcn_s_waitcnt(0);
        unsigned nloc = b.st[0], nx = b.st[1];
        if (nloc == 0u) { xcd_barrier_complete(bar, bx, nloc, nx); b.st[0] = nloc; b.st[1] = nx; }
        const unsigned old = xb_add(&bar[XB_XSUB(bx)], 1u);
        const unsigned gen = old / nloc;
        if (old + 1u == (gen + 1u) * nloc) {
            __builtin_amdgcn_fence(__ATOMIC_RELEASE, "agent");
            asm volatile("s_waitcnt vmcnt(0)" ::: "memory");
            const unsigned og = xb_add(&bar[XB_TOP], 1u);
            const unsigned tg = og / nx;
            if (og + 1u == (tg + 1u) * nx) xb_add(&bar[XB_TOPGEN], 1u);
            else XB_SPIN(xb_ld(&bar[XB_TOPGEN]) == tg, bar);
            __builtin_amdgcn_fence(__ATOMIC_ACQUIRE, "agent");
            xb_add(&bar[XB_XGEN(bx)], 1u);
            asm volatile("s_waitcnt vmcnt(0)" ::: "memory");
        } else {
            XB_SPIN(xb_ld(&bar[XB_XGEN(bx)]) == gen, bar);
            __builtin_amdgcn_fence(__ATOMIC_ACQUIRE, "agent");
            asm volatile("s_waitcnt vmcnt(0)" ::: "memory");
        }
    }
    __syncthreads();
}
__device__ __forceinline__ void modvec_phase(const P& a_in, PG_LAS float* lds, int G, int c) {
    PHASE_ENTRY(a_in)
    PG_LAS float* cond = lds;
    PG_LAS float* red = lds + MODR * D;
    const int t = otid(), kg = t >> 5, cl = t & 31;
    for (int i = t; i < MODR * D; i += NTHR) { const int r = i / D, k = i % D; const float v = r < NB ? a.c[r * D + k] : a.c_ctx[k]; cond[i] = silu_f(v); }
    __syncthreads();
    float* mod = (float*)(a.ws + WS_MOD);
    for (int item = c; item < DEPTH * 192; item += G) {
        const int l = item / 192, nc = item % 192, n = nc * 32 + cl;
        float acc[MODR];
#pragma unroll
        for (int r = 0; r < MODR; ++r) acc[r] = 0.f;
        const float* w = a.w_mod + (size_t)l * D * MODW + n;
#pragma unroll 8
        for (int k = kg * 64; k < kg * 64 + 64; ++k) { const float wv = w[(size_t)k * MODW];
#pragma unroll
            for (int r = 0; r < MODR; ++r) acc[r] += cond[r * D + k] * wv; }
#pragma unroll
        for (int r = 0; r < MODR; ++r) red[(kg * MODR + r) * 32 + cl] = acc[r];
        __syncthreads();
        for (int i = t; i < MODR * 32; i += NTHR) { const int r = i / 32, j = i % 32, nn = nc * 32 + j; float sacc = a.b_mod[l * MODW + nn];
#pragma unroll
            for (int q = 0; q < 16; ++q) sacc += red[(q * MODR + r) * 32 + j];
            mod[((size_t)l * MODR + r) * MODW + nn] = sacc; }
        __syncthreads();
    }
}
__device__ __forceinline__ void conv_dense_weights(const P& a_in, PG_LAS float* scr, int gw, int ngw, int lane) {
    PHASE_ENTRY(a_in)
    conv_dense_range(a, 0, DN_ITEMS, gw, ngw, scr, lane);
}
__device__ __forceinline__ void conv_expert_weights(const P& a_in, int li, PG_LAS float* scr, int gw, int ngw, int lane) {
    PHASE_ENTRY(a_in)
    unsigned char* ws = a.ws;
#pragma unroll 1
    for (int e = 0; e < NE; ++e) {
        tr_matrix(a.exp_w1 + ((size_t)li * NE + e) * D * FFN, D, FFN, FFN, (bf16*)(ws + WS_WE13) + (size_t)e * 2 * FFN * D, 1, scr, gw, ngw, lane);
        tr_matrix(a.exp_w3 + ((size_t)li * NE + e) * D * FFN, D, FFN, FFN, (bf16*)(ws + WS_WE13) + (size_t)e * 2 * FFN * D, 2, scr, gw, ngw, lane);
        tr_matrix(a.exp_w2 + ((size_t)li * NE + e) * FFN * D, FFN, D, D, (bf16*)(ws + WS_WE2) + (size_t)e * D * FFN, 0, scr, gw, ngw, lane);
    }
}
#if MEGA
constexpr int MEGA_LDS = 147456;
__global__ void __launch_bounds__(NTHR, 2) k_mega(P a_k) {
    extern __shared__ __attribute__((aligned(16))) unsigned char smem[];
    PG_LAS unsigned char* lds = (PG_LAS unsigned char*)smem;
    P a = a_k; a.wv = __builtin_amdgcn_readfirstlane(threadIdx.x >> 6);
    const int G = (int)gridDim.x, wg = (int)blockIdx.x;
    volatile PG_LAS unsigned* bst = (volatile PG_LAS unsigned*)(lds + MEGA_LDS - 16);
    if (otid() == 0) { bst[0] = 0u; bst[1] = 0u; bst[2] = 0u; bst[3] = 0u; }
    __syncthreads();
    const XcdBarrier bar = xcd_barrier_post((unsigned*)(a.ws + WS_CTL) + 1024, bst, otid());
    { const int t_ = otid(); conv_dense_weights(a, (PG_LAS float*)smem + (t_ >> 6) * (64 * 33), wg * 8 + (t_ >> 6), G * 8, t_ & 63); }
    __syncthreads();
    modvec_phase(a, (PG_LAS float*)smem, G, wg);
      { for (int i = otid(); i < 64 * 16; i += NTHR) { const int pos = i / 16, f = i % 16; const float ang = (float)pos * powf(10000.0f, -(float)f / 16.0f);
        float* t = (float*)(a.ws + WS_ROPE); t[2 * i] = cosf(ang); t[2 * i + 1] = sinf(ang); } }
    xcd_barrier(bar, otid());
    if (PROBE == 31) { { const int t_ = otid(); conv_dense_weights(a, (PG_LAS float*)smem + (t_ >> 6) * (64 * 33), wg * 8 + (t_ >> 6), G * 8, t_ & 63); } __syncthreads(); modvec_phase(a, (PG_LAS float*)smem, G, wg); xcd_barrier(bar, otid()); }
#pragma unroll 1
    for (int l = 0; l < DEPTH; ++l) {
        if (l == 0) norm_phase<0, true, 0>(a, l, wg, (PG_LAS float*)smem);
        else if (l == 2) norm_phase<0, false, 2>(a, l, wg, (PG_LAS float*)smem, l - 1, 5);
        else norm_phase<0, false, 1>(a, l, wg, (PG_LAS float*)smem, l - 1, 5);
        xcd_barrier(bar, otid());
        gemm_run<EM_IN>(a, l, lds, G, wg);
        xcd_barrier(bar, otid());
        if (PROBE == 6) { gemm_run<EM_IN>(a, l, lds, G, wg); xcd_barrier(bar, otid()); }
        ml_d1_phase(a, l, lds, G, wg);
        attn_phase<0>(a, l, lds, G, wg, 0);
        xcd_barrier(bar, otid());
        if (PROBE == 5) { ml_d1_phase(a, l, lds, G, wg); xcd_barrier(bar, otid()); }
        ml_d2_phase(a, wg);
        { int li_, j0_, j1_; if (conv_sched(l, CP_D2, li_, j0_, j1_)) { __syncthreads(); const int t_ = otid(), wv_ = __builtin_amdgcn_readfirstlane(t_ >> 6);
            conv_expert_range(a, li_, j0_, j1_, wg * 8 + wv_, G * 8, (PG_LAS float*)smem + wv_ * (64 * 33), t_ & 63); } }
        xcd_barrier(bar, otid());
        ml_d3_phase(a, l, lds, G, wg);
        attn_phase<0>(a, l, lds, G, wg, 1);
        xcd_barrier(bar, otid());
        if (PROBE == 2) { ml_d3_phase(a, l, lds, G, wg); xcd_barrier(bar, otid()); }
        if (PROBE == 30) { attn_phase<1>(a, l, lds, G, wg, 1); xcd_barrier(bar, otid()); }
        if (PROBE == 4) { xcd_barrier(bar, otid()); xcd_barrier(bar, otid()); xcd_barrier(bar, otid()); xcd_barrier(bar, otid()); }
        gemm_run<EM_OUT>(a, l, lds, G, wg);
        xcd_barrier(bar, otid());
        if (PROBE == 10) { gemm_run<EM_OUT>(a, l, lds, G, wg); xcd_barrier(bar, otid()); }
        if ((l & 1) == 0) {
            if (l == 0) norm_phase<1, true, 1>(a, l, wg, (PG_LAS float*)smem, l, 2);
            else norm_phase<1, false, 1>(a, l, wg, (PG_LAS float*)smem, l, 2);
            xcd_barrier(bar, otid());
            gemm_run<EM_F1>(a, l, lds, G, wg);
            xcd_barrier(bar, otid());
            if (PROBE == 7) { gemm_run<EM_F1>(a, l, lds, G, wg); xcd_barrier(bar, otid()); }
            if (PROBE == 20 || PROBE == 21) { gemm_run<EM_F1>(a, l, lds, G, wg, true); xcd_barrier(bar, otid()); }
            gemm_run<EM_F2D>(a, l, lds, G, wg);
            xcd_barrier(bar, otid());
            if (PROBE == 11) { gemm_run<EM_F2D>(a, l, lds, G, wg); xcd_barrier(bar, otid()); }
        } else {
            norm_phase<2, false, 1>(a, l, wg, (PG_LAS float*)smem, l, 2);
            xcd_barrier(bar, otid());
            if (PROBE == 12) { norm_phase<2, false, 0>(a, l, wg, (PG_LAS float*)smem, l, 2); xcd_barrier(bar, otid()); }
            moe_pos_phase(a, wg, (int*)smem);
            xcd_barrier(bar, otid());
            gemm_run<EM_F1M>(a, l, lds, G, wg);
            xcd_barrier(bar, otid());
            if (PROBE == 8) { gemm_run<EM_F1M>(a, l, lds, G, wg); xcd_barrier(bar, otid()); }
            gemm_run<EM_F2M>(a, l, lds, G, wg);
            xcd_barrier(bar, otid());
            if (PROBE == 9) { gemm_run<EM_F2M>(a, l, lds, G, wg); xcd_barrier(bar, otid()); }
        }
    }
    norm_phase<3, false, 2>(a, DEPTH, wg, (PG_LAS float*)smem, DEPTH - 1, 5);
}
#endif

#ifndef FAST_IN
#define FAST_IN 1
#endif
#ifndef FAST_OUT
#define FAST_OUT 1
#endif
#ifndef FAST_F1
#define FAST_F1 1
#endif
#ifndef FAST_F2
#define FAST_F2 1
#endif
#ifndef FAST_F1M
#define FAST_F1M 1
#endif
#ifndef FAST_F2M
#define FAST_F2M 1
#endif
constexpr int GEMM_LDS = 131072 + 1024 + 8192;
template <int WHICH> static void launch_gemm(hipStream_t s, const P& a, int l) {
    static bool once = false;
    if (!once) { (void)hipFuncSetAttribute((const void*)k_gemm<WHICH>, hipFuncAttributeMaxDynamicSharedMemorySize, GEMM_LDS); once = true; }
    hipLaunchKernelGGL((k_gemm<WHICH>), dim3(NWG), dim3(NTHR), GEMM_LDS, s, a, l);
}
static void launch_tr(hipStream_t s, const float* W, int K, int ld, int N, bf16* WT, int mode) {
    hipLaunchKernelGGL(k_transpose, dim3(512), dim3(256), 0, s, W, K, ld, N, WT, mode);
}
extern "C" void kernel_launch(void* const* d_in, const int* in_sizes, int n_in, void* d_out, int out_size, void* d_ws, size_t ws_size, hipStream_t stream) {
    if (n_in != 25 || ws_size < WS_END) { fprintf(stderr, "kernel_launch: bad args n_in %d ws %zu need %zu\n", n_in, ws_size, (size_t)WS_END); return; }
    static bool init = false;
    constexpr int NORM_LDS = 8192 * 4 + 8 * 32 * 4 + 64;
    if (!init) {
        init = true;
    }
    P a{};
    const float** f = (const float**)&a;
    for (int i = 0; i < 25; ++i) f[i] = (const float*)d_in[i];
    a.out = (float*)d_out; a.ws = (unsigned char*)d_ws;
    unsigned char* ws = a.ws;
    hipMemsetAsync(ws + WS_CTL, 0, 32768, stream);
#if MEGA
    {
        static bool once = false;
        if (!once) { (void)hipFuncSetAttribute((const void*)k_mega, hipFuncAttributeMaxDynamicSharedMemorySize, MEGA_LDS); once = true; }
        hipLaunchKernelGGL(k_mega, dim3(NWG), dim3(NTHR), MEGA_LDS, stream, a);
        return;
    }
#endif
#if !MEGA
    for (int l = 0; l < DEPTH; ++l) {
        launch_tr(stream, a.w_in + (size_t)l * D * INW, D, INW, UW, (bf16*)(ws + WS_WIN) + (size_t)l * UW * D, 0);
        launch_tr(stream, a.w_out + (size_t)l * D * D, D, D, D, (bf16*)(ws + WS_WOUT) + (size_t)l * D * D, 0);
    }
    for (int i = 0; i < 2; ++i) {
        launch_tr(stream, a.ffn_w1 + (size_t)i * D * FFN, D, FFN, FFN, (bf16*)(ws + WS_WF13) + (size_t)i * 2 * FFN * D, 1);
        launch_tr(stream, a.ffn_w3 + (size_t)i * D * FFN, D, FFN, FFN, (bf16*)(ws + WS_WF13) + (size_t)i * 2 * FFN * D, 2);
        launch_tr(stream, a.ffn_w2 + (size_t)i * FFN * D, FFN, D, D, (bf16*)(ws + WS_WF2) + (size_t)i * D * FFN, 0);
    }
    hipLaunchKernelGGL(k_modvec, dim3(DEPTH * 96), dim3(256), 0, stream, a);
    hipLaunchKernelGGL(k_rope_table, dim3(4), dim3(256), 0, stream, a);
    for (int l = 0; l < DEPTH; ++l) {
        const bool moe = l & 1;
        if (l == 0) hipLaunchKernelGGL((k_norm<0, true, false>), dim3(NWG), dim3(NTHR), NORM_LDS, stream, a, l);
        else if (l == 2) hipLaunchKernelGGL((k_norm<0, false, true>), dim3(NWG), dim3(NTHR), NORM_LDS, stream, a, l);
        else hipLaunchKernelGGL((k_norm<0, false, false>), dim3(NWG), dim3(NTHR), NORM_LDS, stream, a, l);
        if (FAST_IN) launch_gemm<EM_IN>(stream, a, l);
        else {
        hipLaunchKernelGGL((k_ngemm<EM_IN>), dim3(UW / 64, T_ALL / 64), dim3(256), 0, stream, a, l, (const bf16*)(ws + WS_HX), (const bf16*)(ws + WS_WIN) + (size_t)l * UW * D, T_ALL, UW, D);
        hipLaunchKernelGGL(k_rope_apply, dim3((T_ALL * 320 + 255) / 256), dim3(256), 0, stream, a); }
#ifndef FAST_ATT
#define FAST_ATT 1
#endif
        if (FAST_ATT) hipLaunchKernelGGL(k_attn, dim3(NWG), dim3(NTHR), ATT_LDS, stream, a, l);
        else hipLaunchKernelGGL(k_attn_naive, dim3(T_ALL), dim3(512), 0, stream, a, l);
#ifndef FAST_ML
#define FAST_ML 1
#endif
        if (FAST_ML) {
            static bool once = false;
            if (!once) { (void)hipFuncSetAttribute((const void*)k_ml_d1, hipFuncAttributeMaxDynamicSharedMemorySize, ML_LDS); (void)hipFuncSetAttribute((const void*)k_ml_d3, hipFuncAttributeMaxDynamicSharedMemorySize, ML_LDS); once = true; }
            hipLaunchKernelGGL(k_ml_d1, dim3(NWG), dim3(NTHR), ML_LDS, stream, a, l);
            hipLaunchKernelGGL(k_ml_d2, dim3(NWG), dim3(NTHR), 0, stream, a);
            hipLaunchKernelGGL(k_ml_d3, dim3(NWG), dim3(NTHR), ML_LDS, stream, a, l);
        } else {
        hipLaunchKernelGGL(k_mlstm_naive, dim3(64), dim3(256), 0, stream, a, l);
        hipLaunchKernelGGL(k_merge_naive, dim3(T_ALL), dim3(256), 0, stream, a, l); }
        if (FAST_OUT) launch_gemm<EM_OUT>(stream, a, l);
        else hipLaunchKernelGGL((k_ngemm<EM_OUT>), dim3(D / 64, T_ALL / 64), dim3(256), 0, stream, a, l, (const bf16*)(ws + WS_MIX), (const bf16*)(ws + WS_WOUT) + (size_t)l * D * D, T_ALL, D, D);
        if (!moe) {
            hipLaunchKernelGGL((k_norm<1, false, false>), dim3(NWG), dim3(NTHR), NORM_LDS, stream, a, l);
            if (FAST_F1) launch_gemm<EM_F1>(stream, a, l);
            else hipLaunchKernelGGL((k_ngemm<EM_F1>), dim3(FFN / 64, T_ALL / 64), dim3(256), 0, stream, a, l, (const bf16*)(ws + WS_HX), (const bf16*)(ws + WS_WF13) + (size_t)(l >> 1) * 2 * FFN * D, T_ALL, FFN, D);
            if (FAST_F2) launch_gemm<EM_F2D>(stream, a, l);
            else hipLaunchKernelGGL((k_ngemm<EM_F2D>), dim3(D / 64, T_ALL / 64), dim3(256), 0, stream, a, l, (const bf16*)(ws + WS_HID), (const bf16*)(ws + WS_WF2) + (size_t)(l >> 1) * D * FFN, T_ALL, D, FFN);
        } else {
            const int li = l >> 1;
            for (int e = 0; e < NE; ++e) {
                launch_tr(stream, a.exp_w1 + ((size_t)li * NE + e) * D * FFN, D, FFN, FFN, (bf16*)(ws + WS_WE13) + (size_t)e * 2 * FFN * D, 1);
                launch_tr(stream, a.exp_w3 + ((size_t)li * NE + e) * D * FFN, D, FFN, FFN, (bf16*)(ws + WS_WE13) + (size_t)e * 2 * FFN * D, 2);
                launch_tr(stream, a.exp_w2 + ((size_t)li * NE + e) * FFN * D, FFN, D, D, (bf16*)(ws + WS_WE2) + (size_t)e * D * FFN, 0);
            }
            hipLaunchKernelGGL((k_norm<2, false, false>), dim3(NWG), dim3(NTHR), NORM_LDS, stream, a, l);
            hipLaunchKernelGGL(k_moe_pos, dim3(NWG), dim3(NTHR), 16384, stream, a);
            if (FAST_F1M) launch_gemm<EM_F1M>(stream, a, l);
            else hipLaunchKernelGGL((k_ngemm<EM_F1M>), dim3(FFN / 64, MOE_ROWS / 64), dim3(256), 0, stream, a, l, (const bf16*)(ws + WS_HX), (const bf16*)(ws + WS_WE13), MOE_ROWS, FFN, D);
            if (FAST_F2M) launch_gemm<EM_F2M>(stream, a, l);
            else hipLaunchKernelGGL((k_ngemm<EM_F2M>), dim3(D / 64, MOE_ROWS / 64), dim3(256), 0, stream, a, l, (const bf16*)(ws + WS_HID), (const bf16*)(ws + WS_WE2), MOE_ROWS, D, FFN);
        }
    }
    hipLaunchKernelGGL((k_norm<3, false, true>), dim3(NWG), dim3(NTHR), NORM_LDS, stream, a, DEPTH);
#endif
}
```

```cpp
#include <hip/hip_runtime.h>
#include <cstdio>
#include <cstdint>

#ifndef MEGA
#define MEGA 1
#endif
#ifndef PROBE
#define PROBE 0
#endif
typedef unsigned short bf16;
#define PG_LAS __attribute__((address_space(3)))
typedef unsigned v4u __attribute__((ext_vector_type(4)));
typedef unsigned v2u __attribute__((ext_vector_type(2)));
typedef float f32x4 __attribute__((ext_vector_type(4)));

constexpr int D = 1024, NB = 8, SEQ = 4096, CTX = 256, TPB = SEQ + CTX, T_ALL = NB * TPB, DEPTH = 4;
constexpr int INW = 2320, UW = 2304, FFN = 2816, NE = 8;
constexpr int U_QA = 0, U_KA = 512, U_VA = 640, U_QM = 768, U_KM = 1024, U_VM = 1280, U_OM = 1792;
constexpr int MODW = 6 * D, MODR = NB + 1;
constexpr int MOE_ROWS = 2 * T_ALL + NE * 256;
constexpr int MOE_TILES = MOE_ROWS / 256;
constexpr float EPS = 1e-6f;
constexpr int NWG = 256, NTHR = 512;
constexpr int ROWS_PER_WG = T_ALL / NWG;

constexpr size_t MiB = 1u << 20;
constexpr size_t al(size_t x) { return (x + 255) & ~(size_t)255; }
constexpr size_t WS_CTL = 0;
constexpr size_t WS_ROPE = 1 * MiB;
constexpr size_t WS_MOD = WS_ROPE + 65536;
constexpr size_t WS_TOKE = al(WS_MOD + (size_t)DEPTH * MODR * MODW * 4);
constexpr size_t WS_TOKW = al(WS_TOKE + (size_t)T_ALL * 8);
constexpr size_t WS_TOKP = al(WS_TOKW + (size_t)T_ALL * 8);
constexpr size_t WS_ROWT = al(WS_TOKP + (size_t)T_ALL * 8);
constexpr size_t WS_ROWW = al(WS_ROWT + (size_t)MOE_ROWS * 4);
constexpr size_t WS_TILEE = al(WS_ROWW + (size_t)MOE_ROWS * 4);
constexpr size_t WS_CNT = al(WS_TILEE + 4096);
constexpr size_t WS_GATES = al(WS_CNT + (size_t)NWG * 8 * 4);
constexpr size_t WS_WIN = al(WS_GATES + (size_t)T_ALL * 16 * 4);
constexpr size_t WS_WOUT = al(WS_WIN + (size_t)DEPTH * UW * D * 2);
constexpr size_t WS_WF13 = al(WS_WOUT + (size_t)DEPTH * D * D * 2);
constexpr size_t WS_WF2 = al(WS_WF13 + (size_t)2 * 2 * FFN * D * 2);
constexpr size_t WS_WE2 = al(WS_WF2 + (size_t)2 * D * FFN * 2);
constexpr size_t WS_WE13 = al(WS_WE2 + (size_t)NE * D * FFN * 2);
constexpr size_t WS_YS = WS_WE13;
constexpr size_t WS_HX = al(WS_YS + (size_t)MOE_ROWS * D * 2);
constexpr size_t WS_X = al(WS_HX + (size_t)T_ALL * D * 2);
constexpr size_t WS_BIG = al(WS_X + (size_t)T_ALL * D * 2);
static_assert(WS_YS + (size_t)MOE_ROWS * D * 2 <= WS_HX && WS_WE13 + (size_t)NE * 2 * FFN * D * 2 <= WS_HX, "YS overlay");
constexpr size_t WS_U = WS_BIG;
constexpr size_t WS_MIX = al(WS_U + (size_t)T_ALL * UW * 2);
constexpr size_t WS_HDIR = al(WS_MIX + (size_t)T_ALL * D * 2);
constexpr int NCHUNK = TPB / 64, NCHAIN = NB * 4 * 2;
constexpr size_t WS_ST = WS_HDIR;
constexpr size_t WS_NL = al(WS_ST + (size_t)NCHAIN * NCHUNK * 16384);
constexpr size_t WS_SC = al(WS_NL + (size_t)NCHAIN * NCHUNK * 64 * 4);
constexpr size_t WS_DELTA = WS_BIG + 250 * MiB;
constexpr size_t WS_HID = WS_BIG;
constexpr size_t WS_END = al(WS_BIG + (size_t)MOE_ROWS * FFN * 2);
static_assert(WS_HDIR + (size_t)2 * T_ALL * 512 * 4 <= WS_END && WS_SC + (size_t)NCHAIN * NCHUNK * 16 <= WS_END, "HDIR / state buffers fit");

struct P {
    const float *x, *c, *ctx, *c_ctx, *norm1_g, *norm2_g, *w_mod, *b_mod, *w_in, *conv_w, *conv_b, *b_gates, *attn_sink, *g_att, *g_ml, *w_out,
        *ffn_w1, *ffn_w3, *ffn_w2, *w_router, *b_router, *exp_w1, *exp_w3, *exp_w2, *final_g;
    float* out;
    unsigned char* ws;
    int wv, pad;
};

__device__ __forceinline__ unsigned f2bf(float f) { unsigned u = __builtin_bit_cast(unsigned, f); return (u + 0x7fffu + ((u >> 16) & 1u)) >> 16; }
__device__ __forceinline__ unsigned pk2(float lo, float hi) { return f2bf(lo) | (f2bf(hi) << 16); }
typedef float f32x2v __attribute__((ext_vector_type(2)));
typedef __bf16 bf16x2v __attribute__((ext_vector_type(2)));
__device__ __forceinline__ unsigned cvt_pk_bf16(float lo, float hi) { const f32x2v v = {lo, hi}; return __builtin_bit_cast(unsigned, __builtin_convertvector(v, bf16x2v)); }
__device__ __forceinline__ float bf_lo(unsigned w) { return __builtin_bit_cast(float, w << 16); }
__device__ __forceinline__ float bf_hi(unsigned w) { return __builtin_bit_cast(float, w & 0xffff0000u); }
__device__ __forceinline__ float bf2f(bf16 h) { return __builtin_bit_cast(float, (unsigned)h << 16); }
#ifndef XLANE_OLD
#define XLANE_OLD 0
#endif
#if XLANE_OLD
template <int M> __device__ __forceinline__ float swz_xor(float v) { return __shfl_xor(v, M); }
__device__ __forceinline__ float hsum32(float v) { return v + __shfl_xor(v, 32); }
__device__ __forceinline__ float hmax32(float v) { return fmaxf(v, __shfl_xor(v, 32)); }
__device__ __forceinline__ float wave_sum(float v) {
#pragma unroll
    for (int o = 1; o < 64; o <<= 1) v += __shfl_xor(v, o);
    return v;
}
__device__ __forceinline__ float wave_max(float v) {
#pragma unroll
    for (int o = 1; o < 64; o <<= 1) v = fmaxf(v, __shfl_xor(v, o));
    return v;
}
__device__ __forceinline__ float lane_bcast(float v, int src) { return __shfl(v, src); }
template <int OFF> __device__ __forceinline__ float xchg_xor(float v, bool) { return __shfl_xor(v, OFF); }
template <bool MAXOP> __device__ __forceinline__ float dpp_scan(float v) {
    const int lane = (int)__builtin_amdgcn_mbcnt_hi(~0u, __builtin_amdgcn_mbcnt_lo(~0u, 0u));
#pragma unroll
    for (int o = 1; o < 64; o <<= 1) { const float y = __shfl_up(v, o); if (lane >= o) v = MAXOP ? fmaxf(v, y) : v + y; }
    return v;
}
#else
template <int M> __device__ __forceinline__ float swz_xor(float v) { return __builtin_bit_cast(float, __builtin_amdgcn_ds_swizzle(__builtin_bit_cast(int, v), 0x1f | (M << 10))); }
struct HalfSwap { float a, b; };
__device__ __forceinline__ HalfSwap half_swap(float v) {
    float x = v, y = v;
    asm volatile("s_nop 1\n\tv_permlane32_swap_b32 %0, %1\n\ts_nop 0" : "+v"(x), "+v"(y));
    return HalfSwap{x, y};
}
__device__ __forceinline__ float hsum32(float v) { const HalfSwap r = half_swap(v); return r.a + r.b; }
__device__ __forceinline__ float hmax32(float v) { const HalfSwap r = half_swap(v); return fmaxf(r.a, r.b); }
__device__ __forceinline__ float wave_sum(float v) { v += swz_xor<1>(v); v += swz_xor<2>(v); v += swz_xor<4>(v); v += swz_xor<8>(v); v += swz_xor<16>(v); return hsum32(v); }
__device__ __forceinline__ float wave_max(float v) { v = fmaxf(v, swz_xor<1>(v)); v = fmaxf(v, swz_xor<2>(v)); v = fmaxf(v, swz_xor<4>(v)); v = fmaxf(v, swz_xor<8>(v)); v = fmaxf(v, swz_xor<16>(v)); return hmax32(v); }
__device__ __forceinline__ float lane_bcast(float v, int src) { return __builtin_bit_cast(float, __builtin_amdgcn_readlane(__builtin_bit_cast(int, v), src)); }
template <int OFF> __device__ __forceinline__ float xchg_xor(float v, bool up) {
    if constexpr (OFF == 32) { const HalfSwap r = half_swap(v); return up ? r.a : r.b; }
    else return swz_xor<OFF>(v);
}
#define DPP_STEP(ctrl, rm) { const float t_ = __builtin_bit_cast(float, __builtin_amdgcn_update_dpp(__builtin_bit_cast(int, idv), __builtin_bit_cast(int, v), ctrl, rm, 0xf, false)); v = MAXOP ? fmaxf(v, t_) : v + t_; }
template <bool MAXOP> __device__ __forceinline__ float dpp_scan(float v) {
    const float idv = MAXOP ? -3.0e38f : 0.f;
    DPP_STEP(0x111, 0xf) DPP_STEP(0x112, 0xf) DPP_STEP(0x114, 0xf) DPP_STEP(0x118, 0xf) DPP_STEP(0x142, 0xa) DPP_STEP(0x143, 0xc)
    return v;
}
#endif
template <int N, int OFF> struct RS { static __device__ __forceinline__ float run(float (&v)[N], int lane) {
    constexpr int H = N / 2; float w[H]; const bool up = (lane & OFF) != 0;
#pragma unroll
    for (int i = 0; i < H; ++i) { const float keep = up ? v[i + H] : v[i], send = up ? v[i] : v[i + H]; w[i] = keep + xchg_xor<OFF>(send, up); }
    return RS<H, OFF / 2>::run(w, lane); } };
template <int OFF> struct RS<1, OFF> { static __device__ __forceinline__ float run(float (&v)[1], int lane) { float x = v[0];
    if constexpr (OFF >= 16) x += swz_xor<16>(x);
    if constexpr (OFF >= 8) x += swz_xor<8>(x);
    if constexpr (OFF >= 4) x += swz_xor<4>(x);
    if constexpr (OFF >= 2) x += swz_xor<2>(x);
    if constexpr (OFF >= 1) x += swz_xor<1>(x);
    return x; } };
__device__ __forceinline__ float silu_f(float x) { return x * __builtin_amdgcn_rcpf(1.f + __expf(-x)); }
__device__ __forceinline__ float sigmoid_f(float x) { return __builtin_amdgcn_rcpf(1.f + __expf(-x)); }
__device__ __forceinline__ float logsigmoid_f(float x) { return fminf(x, 0.f) - log1pf(__expf(-fabsf(x))); }
__device__ __forceinline__ int tk_modrow(int tk) { const int b = tk / TPB, p = tk - b * TPB; return p < CTX ? NB : b; }
__device__ __forceinline__ const float* in_row(const P& a, int tk) {
    const int b = tk / TPB, p = tk - b * TPB;
    return p < CTX ? a.ctx + ((size_t)b * CTX + p) * D : a.x + ((size_t)b * SEQ + (p - CTX)) * D;
}

__device__ __forceinline__ int otid_w(int wv) { int t; asm volatile("v_mbcnt_lo_u32_b32 %0, -1, 0\n\tv_mbcnt_hi_u32_b32 %0, -1, %0\n\ts_nop 0\n\tv_lshl_add_u32 %0, %1, 6, %0" : "=&v"(t) : "s"(wv)); return t; }
#define otid() otid_w(a.wv)
#define PHASE_ENTRY(a_in) P a = a_in; { unsigned long long z_ = 0; asm volatile("" : "+s"(z_)); a.ws = a_in.ws + z_; }
__device__ __forceinline__ void tr_load(const float* W, int ld, int N, int item, int lane, f32x4 (&v)[8]) {
    const int nblk = N / 32, kb = item / nblk, nb = item % nblk, k0 = 64 * kb, n0 = 32 * nb;
#pragma unroll
    for (int i = 0; i < 8; ++i) { const int kk = 8 * i + (lane >> 3), nn = 4 * (lane & 7);
        v[i] = __builtin_nontemporal_load((const f32x4*)(W + (size_t)(k0 + kk) * ld + n0 + nn)); }
}
__device__ __forceinline__ void tr_store(const f32x4 (&v)[8], int K, int N, bf16* WT, int mode, PG_LAS float* scr, int item, int lane) {
    const int nblk = N / 32, kb = item / nblk, nb = item % nblk, k0 = 64 * kb, n0 = 32 * nb;
#pragma unroll
    for (int i = 0; i < 8; ++i) { const int kk = 8 * i + (lane >> 3), nn = 4 * (lane & 7);
        PG_LAS float* d = scr + kk * 33 + nn; d[0] = v[i].x; d[1] = v[i].y; d[2] = v[i].z; d[3] = v[i].w; }
    __builtin_amdgcn_s_waitcnt(0xC07F); asm volatile("" ::: "memory");
    const int c = lane & 7;
    const int d0 = mode == 0 ? n0 : ((n0 >> 7) * 256 + (mode == 2 ? 128 : 0) + (n0 & 127));
#pragma unroll
    for (int j = 0; j < 4; ++j) { const int n = (lane >> 3) + 8 * j; const PG_LAS float* s = scr + (8 * c) * 33 + n;
        v4u o; o.x = cvt_pk_bf16(s[0 * 33], s[1 * 33]); o.y = cvt_pk_bf16(s[2 * 33], s[3 * 33]); o.z = cvt_pk_bf16(s[4 * 33], s[5 * 33]); o.w = cvt_pk_bf16(s[6 * 33], s[7 * 33]);
        __builtin_nontemporal_store(o, (v4u*)(WT + (size_t)(d0 + n) * K + k0 + 8 * c)); }
    __builtin_amdgcn_s_waitcnt(0xC07F); asm volatile("" ::: "memory");
}
__device__ __forceinline__ void tr_matrix(const float* W, int K, int ld, int N, bf16* WT, int mode, PG_LAS float* scr, int gw, int ngw, int lane) {
    const int items = (K / 64) * (N / 32);
    f32x4 cur[8], nxt[8];
    int it = gw;
    if (it < items) tr_load(W, ld, N, it, lane, cur);
    for (; it < items; it += ngw) {
        const int nit = it + ngw;
        if (nit < items) tr_load(W, ld, N, nit, lane, nxt);
        tr_store(cur, K, N, WT, mode, scr, it, lane);
#pragma unroll
        for (int i = 0; i < 8; ++i) cur[i] = nxt[i];
    }
}
constexpr int EXP_ITEMS_M = (D / 64) * (FFN / 32), EXP_ITEMS_E = 3 * EXP_ITEMS_M, EXP_ITEMS = NE * EXP_ITEMS_E;
struct TrJob { const float* W; bf16* WT; int K, ld, N, mode, it; };
__device__ __forceinline__ TrJob expert_job(const P& a, int li, int j) {
    const int e = j / EXP_ITEMS_E, r = j - e * EXP_ITEMS_E, m = r / EXP_ITEMS_M, it = r - m * EXP_ITEMS_M;
    TrJob t; t.it = it;
    if (m < 2) { t.W = (m == 0 ? a.exp_w1 : a.exp_w3) + ((size_t)li * NE + e) * D * FFN; t.K = D; t.ld = FFN; t.N = FFN; t.WT = (bf16*)(a.ws + WS_WE13) + (size_t)e * 2 * FFN * D; t.mode = 1 + m; }
    else { t.W = a.exp_w2 + ((size_t)li * NE + e) * FFN * D; t.K = FFN; t.ld = D; t.N = D; t.WT = (bf16*)(a.ws + WS_WE2) + (size_t)e * D * FFN; t.mode = 0; }
    return t;
}
__device__ __forceinline__ void conv_expert_range(const P& a, int li, int j0, int j1, int slot, int nslots, PG_LAS float* scr, int lane) {
    int j = j0 + slot; if (j >= j1) return;
    TrJob cur = expert_job(a, li, j), nxt = cur; f32x4 cv[8], nv[8];
    tr_load(cur.W, cur.ld, cur.N, cur.it, lane, cv);
    for (; j < j1; j += nslots) {
        const int jn = j + nslots;
        if (jn < j1) { nxt = expert_job(a, li, jn); tr_load(nxt.W, nxt.ld, nxt.N, nxt.it, lane, nv); }
        tr_store(cv, cur.K, cur.N, cur.WT, cur.mode, scr, cur.it, lane);
        cur = nxt;
#pragma unroll
        for (int i = 0; i < 8; ++i) cv[i] = nv[i];
    }
}
constexpr int DN_IN = (D / 64) * (UW / 32), DN_OUT = (D / 64) * (D / 32), DN_L = DN_IN + DN_OUT, DN_ITEMS = DEPTH * DN_L + 2 * EXP_ITEMS_E;
__device__ __forceinline__ TrJob dense_job(const P& a, int j) {
    TrJob t;
    if (j < DEPTH * DN_L) { const int l = j / DN_L, r = j - l * DN_L; t.K = D; t.mode = 0;
        if (r < DN_IN) { t.W = a.w_in + (size_t)l * D * INW; t.ld = INW; t.N = UW; t.WT = (bf16*)(a.ws + WS_WIN) + (size_t)l * UW * D; t.it = r; }
        else { t.W = a.w_out + (size_t)l * D * D; t.ld = D; t.N = D; t.WT = (bf16*)(a.ws + WS_WOUT) + (size_t)l * D * D; t.it = r - DN_IN; } }
    else { const int q = j - DEPTH * DN_L, i = q / EXP_ITEMS_E, r = q - i * EXP_ITEMS_E, m = r / EXP_ITEMS_M; t.it = r - m * EXP_ITEMS_M;
        if (m < 2) { t.W = (m == 0 ? a.ffn_w1 : a.ffn_w3) + (size_t)i * D * FFN; t.K = D; t.ld = FFN; t.N = FFN; t.WT = (bf16*)(a.ws + WS_WF13) + (size_t)i * 2 * FFN * D; t.mode = 1 + m; }
        else { t.W = a.ffn_w2 + (size_t)i * FFN * D; t.K = FFN; t.ld = D; t.N = D; t.WT = (bf16*)(a.ws + WS_WF2) + (size_t)i * D * FFN; t.mode = 0; } }
    return t;
}
__device__ __forceinline__ void conv_dense_range(const P& a, int j0, int j1, int slot, int nslots, PG_LAS float* scr, int lane) {
    int j = j0 + slot; if (j >= j1) return;
    TrJob cur = dense_job(a, j), nxt = cur; f32x4 cv[8], nv[8];
    tr_load(cur.W, cur.ld, cur.N, cur.it, lane, cv);
    for (; j < j1; j += nslots) {
        const int jn = j + nslots;
        if (jn < j1) { nxt = dense_job(a, jn); tr_load(nxt.W, nxt.ld, nxt.N, nxt.it, lane, nv); }
        tr_store(cv, cur.K, cur.N, cur.WT, cur.mode, scr, cur.it, lane);
        cur = nxt;
#pragma unroll
        for (int i = 0; i < 8; ++i) cv[i] = nv[i];
    }
}
__global__ void __launch_bounds__(256) k_transpose(const float* W, int K, int ld, int N, bf16* WT, int mode) {
    __shared__ float scr[4][64 * 33];
    const int wave = threadIdx.x >> 6, lane = threadIdx.x & 63;
    tr_matrix(W, K, ld, N, WT, mode, (PG_LAS float*)scr[wave], blockIdx.x * 4 + wave, gridDim.x * 4, lane);
}
__global__ void __launch_bounds__(256) k_modvec(P a) {
    __shared__ float cond[MODR][D];
    __shared__ float red[4][MODR][64];
    const int l = blockIdx.x / 96, nc = blockIdx.x % 96, t = threadIdx.x, kg = t >> 6, n = nc * 64 + (t & 63);
    for (int i = t; i < MODR * D; i += 256) { const int r = i / D, k = i % D; const float v = r < NB ? a.c[r * D + k] : a.c_ctx[k]; cond[r][k] = silu_f(v); }
    __syncthreads();
    float acc[MODR];
#pragma unroll
    for (int r = 0; r < MODR; ++r) acc[r] = 0.f;
    const float* w = a.w_mod + (size_t)l * D * MODW + n;
    for (int k = kg * 256; k < kg * 256 + 256; ++k) { const float wv = w[(size_t)k * MODW];
#pragma unroll
        for (int r = 0; r < MODR; ++r) acc[r] += cond[r][k] * wv; }
#pragma unroll
    for (int r = 0; r < MODR; ++r) red[kg][r][t & 63] = acc[r];
    __syncthreads();
    float* mod = (float*)(a.ws + WS_MOD);
    for (int i = t; i < MODR * 64; i += 256) { const int r = i / 64, j = i % 64; const int nn = nc * 64 + j;
        mod[((size_t)l * MODR + r) * MODW + nn] = red[0][r][j] + red[1][r][j] + red[2][r][j] + red[3][r][j] + a.b_mod[l * MODW + nn]; }
}
__global__ void k_rope_table(P a) {
    const int i = blockIdx.x * blockDim.x + threadIdx.x; if (i >= 64 * 16) return;
    const int pos = i / 16, f = i % 16; const float inv = powf(10000.0f, -(float)f / 16.0f); const float ang = (float)pos * inv;
    float* t = (float*)(a.ws + WS_ROPE); t[2 * i] = cosf(ang); t[2 * i + 1] = sinf(ang);
}

template <int MODE, bool SRC_IN, int PEND>
__device__ __forceinline__ void norm_phase(const P& a_in, int l, int wg, PG_LAS float* lds, int pl = 0, int pchunk = 0) {
    PHASE_ENTRY(a_in)
    const int tid = otid(), lane = tid & 63, wave = tid >> 6;
#define NCOFF(j) (512 * ((j) >> 1) + 8 * lane + 4 * ((j) & 1))
    bf16* X = (bf16*)(a.ws + WS_X); bf16* HX = (bf16*)(a.ws + WS_HX); const float* MOD = (const float*)(a.ws + WS_MOD);
    PG_LAS float* wl = lds; PG_LAS unsigned* wlu = (PG_LAS unsigned*)lds;
    PG_LAS int* cnt_l = (PG_LAS int*)(lds + 8192 + 8 * 32);
    if (MODE == 0) {
        for (int i = tid; i < D * 2; i += NTHR) { const int c = i >> 1, hf = i & 1; const float* wp = a.w_in + ((size_t)l * D + c) * INW + UW + 8 * hf;
            const f32x4 w0 = *(const f32x4*)wp, w1 = *(const f32x4*)(wp + 4);
            const int j = 2 * (c >> 9) + ((c >> 2) & 1), ln = (c >> 3) & 63, ii = c & 3; v4u o; o.x = pk2(w0.x, w0.y); o.y = pk2(w0.z, w0.w); o.z = pk2(w1.x, w1.y); o.w = pk2(w1.z, w1.w);
            *(PG_LAS v4u*)(wlu + ((((j * 4 + ii) * 2 + hf) * 64 + ln) * 4)) = o; }
    }
    if (MODE == 2) {
        for (int i = tid; i < D * 2; i += NTHR) { const int c = i >> 1, g4 = i & 1; const f32x4 w = *(const f32x4*)(a.w_router + ((size_t)(l >> 1) * D + c) * NE + 4 * g4);
            const int j = 2 * (c >> 9) + ((c >> 2) & 1), ln = (c >> 3) & 63, ii = c & 3; *(PG_LAS f32x4*)(wl + ((((j * 4 + ii) * 2 + g4) * 64 + ln) * 4)) = w; }
        if (tid < NE) cnt_l[tid] = 0;
    }
    if (MODE == 0 || MODE == 2) __syncthreads();
    const float* gvec = MODE == 0 ? a.norm1_g + l * D : (MODE == 3 ? a.final_g : a.norm2_g + l * D);
    f32x4 gv[4];
#pragma unroll
    for (int j = 0; j < 4; ++j) gv[j] = *(const f32x4*)(gvec + NCOFF(j));
    const int row0 = wg * ROWS_PER_WG + wave * 17;
    int mr_c = -1, mr_p = -1; f32x4 cA[4], cB[4], cM[4];
#pragma unroll
    for (int j = 0; j < 4; ++j) { cA[j] = (f32x4){0.f, 0.f, 0.f, 0.f}; cB[j] = cA[j]; cM[j] = cA[j]; }
    int posA = 0, posB = 0;
    if (PEND == 2) { const int* tp = (const int*)(a.ws + WS_TOKP) + 2 * (row0 + (lane < 17 ? lane : 0)); posA = min(max(tp[0], 0), MOE_ROWS - 1); posB = min(max(tp[1], 0), MOE_ROWS - 1); }
    f32x4 nx[2][4]; v4u nxb[2][2], nd0[2][2], nd1[2][2];
#define NORM_LOAD_GROUP(g) do { _Pragma("unroll") for (int r_ = 0; r_ < 2; ++r_) { const int ri_ = (g) * 2 + r_, rc_ = ri_ < 17 ? ri_ : 0, tk_ = row0 + rc_; \
        if (SRC_IN) { const float* xr_ = in_row(a, tk_); _Pragma("unroll") for (int j = 0; j < 4; ++j) nx[r_][j] = *(const f32x4*)(xr_ + NCOFF(j)); } \
        else { const bf16* xr_ = X + (size_t)tk_ * D; _Pragma("unroll") for (int J = 0; J < 2; ++J) nxb[r_][J] = *(const v4u*)(xr_ + 512 * J + 8 * lane); } \
        if (PEND == 1) { const bf16* dl_ = (const bf16*)(a.ws + WS_DELTA) + (size_t)tk_ * D; _Pragma("unroll") for (int J = 0; J < 2; ++J) nd0[r_][J] = *(const v4u*)(dl_ + 512 * J + 8 * lane); } \
        if (PEND == 2) { const int p0_ = __builtin_amdgcn_readlane(posA, rc_), p1_ = __builtin_amdgcn_readlane(posB, rc_); const bf16* ys_ = (const bf16*)(a.ws + WS_YS); \
            _Pragma("unroll") for (int J = 0; J < 2; ++J) { nd0[r_][J] = *(const v4u*)(ys_ + (size_t)p0_ * D + 512 * J + 8 * lane); nd1[r_][J] = *(const v4u*)(ys_ + (size_t)p1_ * D + 512 * J + 8 * lane); } } } } while (0)
    NORM_LOAD_GROUP(0);
#pragma unroll 1
    for (int grp = 0; grp < 9; ++grp) {
        f32x4 h[2][4], cx[2][4]; v4u cd0[2][2], cd1[2][2];
#pragma unroll
        for (int r = 0; r < 2; ++r)
#pragma unroll
            for (int J = 0; J < 2; ++J) {
                if (SRC_IN) { cx[r][2 * J] = nx[r][2 * J]; cx[r][2 * J + 1] = nx[r][2 * J + 1]; }
                else { const v4u w = nxb[r][J]; cx[r][2 * J] = (f32x4){bf_lo(w.x), bf_hi(w.x), bf_lo(w.y), bf_hi(w.y)}; cx[r][2 * J + 1] = (f32x4){bf_lo(w.z), bf_hi(w.z), bf_lo(w.w), bf_hi(w.w)}; }
                if (PEND != 0) cd0[r][J] = nd0[r][J]; if (PEND == 2) cd1[r][J] = nd1[r][J]; }
        if (grp + 1 < 9) NORM_LOAD_GROUP(grp + 1);
        int tks[2]; bool valid[2], dead[2];
#pragma unroll
        for (int r = 0; r < 2; ++r) {
            const int ri = grp * 2 + r; valid[r] = ri < 17; const int tk = row0 + (valid[r] ? ri : 0); tks[r] = tk;
            const int b = tk / TPB, p = tk - b * TPB, mr = p < CTX ? NB : b; dead[r] = (MODE == 2 && l == DEPTH - 1 && p < CTX);
            f32x4 xv[4];
#pragma unroll
            for (int j = 0; j < 4; ++j) xv[j] = cx[r][j];
            if (PEND != 0) {
                if (mr != mr_p) { mr_p = mr; const float* mp = MOD + ((size_t)pl * MODR + mr) * MODW + (PEND == 2 ? 5 : pchunk) * D;
#pragma unroll
                    for (int j = 0; j < 4; ++j) cM[j] = *(const f32x4*)(mp + NCOFF(j)); }
                if (PEND == 2) {
#pragma unroll
                    for (int j = 0; j < 4; ++j) { const v4u a0 = cd0[r][j >> 1], a1 = cd1[r][j >> 1]; const v2u y0 = (j & 1) ? (v2u){a0.z, a0.w} : (v2u){a0.x, a0.y}, y1 = (j & 1) ? (v2u){a1.z, a1.w} : (v2u){a1.x, a1.y};
                        xv[j].x += cM[j].x * (bf_lo(y0.x) + bf_lo(y1.x)); xv[j].y += cM[j].y * (bf_hi(y0.x) + bf_hi(y1.x));
                        xv[j].z += cM[j].z * (bf_lo(y0.y) + bf_lo(y1.y)); xv[j].w += cM[j].w * (bf_hi(y0.y) + bf_hi(y1.y)); }
                } else {
#pragma unroll
                    for (int j = 0; j < 4; ++j) { const v4u a0 = cd0[r][j >> 1]; const v2u y0 = (j & 1) ? (v2u){a0.z, a0.w} : (v2u){a0.x, a0.y};
                        xv[j].x += cM[j].x * bf_lo(y0.x); xv[j].y += cM[j].y * bf_hi(y0.x); xv[j].z += cM[j].z * bf_lo(y0.y); xv[j].w += cM[j].w * bf_hi(y0.y); }
                }
                if (valid[r] && MODE != 3) {
#pragma unroll
                    for (int J = 0; J < 2; ++J) { v4u o; o.x = cvt_pk_bf16(xv[2 * J].x, xv[2 * J].y); o.y = cvt_pk_bf16(xv[2 * J].z, xv[2 * J].w); o.z = cvt_pk_bf16(xv[2 * J + 1].x, xv[2 * J + 1].y); o.w = cvt_pk_bf16(xv[2 * J + 1].z, xv[2 * J + 1].w);
                        *(v4u*)(X + (size_t)tk * D + 512 * J + 8 * lane) = o; } }
            }
            float ss = 0.f;
#pragma unroll
            for (int j = 0; j < 4; ++j) ss += (xv[j].x * xv[j].x + xv[j].y * xv[j].y) + (xv[j].z * xv[j].z + xv[j].w * xv[j].w);
            const float rstd = rsqrtf(wave_sum(ss) * (1.f / D) + EPS);
            if (MODE == 3) {
                if (valid[r] && p >= CTX) { float* o = a.out + ((size_t)b * SEQ + (p - CTX)) * D;
#pragma unroll
                    for (int j = 0; j < 4; ++j) *(f32x4*)(o + NCOFF(j)) = xv[j] * rstd * gv[j]; }
            } else {
                if (mr != mr_c) {
                    mr_c = mr; const float* mrow = MOD + ((size_t)l * MODR + mr) * MODW;
                    const float* shp = mrow + (MODE == 0 ? 0 : 3) * D; const float* scp = mrow + (MODE == 0 ? 1 : 4) * D;
#pragma unroll
                    for (int j = 0; j < 4; ++j) { const f32x4 sh = *(const f32x4*)(shp + NCOFF(j)), sc = *(const f32x4*)(scp + NCOFF(j)); cA[j] = gv[j] * (sc + 1.f); cB[j] = sh; }
                }
#pragma unroll
                for (int j = 0; j < 4; ++j) h[r][j] = xv[j] * rstd * cA[j] + cB[j];
                if (valid[r]) {
#pragma unroll
                    for (int J = 0; J < 2; ++J) { v4u o; o.x = cvt_pk_bf16(h[r][2 * J].x, h[r][2 * J].y); o.y = cvt_pk_bf16(h[r][2 * J].z, h[r][2 * J].w); o.z = cvt_pk_bf16(h[r][2 * J + 1].x, h[r][2 * J + 1].y); o.w = cvt_pk_bf16(h[r][2 * J + 1].z, h[r][2 * J + 1].w);
                        *(v4u*)(HX + (size_t)tk * D + 512 * J + 8 * lane) = o; } }
            }
        }
        if (MODE == 0) {
            float acc[2][16];
#pragma unroll
            for (int r = 0; r < 2; ++r)
#pragma unroll
                for (int g = 0; g < 16; ++g) acc[r][g] = 0.f;
#pragma unroll
            for (int j = 0; j < 4; ++j)
#pragma unroll
                for (int ii = 0; ii < 4; ++ii) {
#pragma unroll
                    for (int hf = 0; hf < 2; ++hf) { const v4u w = *(const PG_LAS v4u*)(wlu + ((((j * 4 + ii) * 2 + hf) * 64 + lane) * 4));
#pragma unroll
                        for (int r = 0; r < 2; ++r) { const float hv = h[r][j][ii];
                            acc[r][8 * hf + 0] += hv * bf_lo(w.x); acc[r][8 * hf + 1] += hv * bf_hi(w.x); acc[r][8 * hf + 2] += hv * bf_lo(w.y); acc[r][8 * hf + 3] += hv * bf_hi(w.y);
                            acc[r][8 * hf + 4] += hv * bf_lo(w.z); acc[r][8 * hf + 5] += hv * bf_hi(w.z); acc[r][8 * hf + 6] += hv * bf_lo(w.w); acc[r][8 * hf + 7] += hv * bf_hi(w.w); } }
                    asm volatile("" ::: "memory"); }
            float flat[32];
#pragma unroll
            for (int r = 0; r < 2; ++r)
#pragma unroll
                for (int g = 0; g < 16; ++g) flat[r * 16 + g] = acc[r][g];
            const float sum = RS<32, 32>::run(flat, lane);
            { const int idx = (lane >> 1) & 31, r = idx >> 4, g = idx & 15;
              float v = sum + a.b_gates[l * 16 + g]; v = 15.f * tanhf(v * (1.f / 15.f));
              const int ri = grp * 2 + r;
              if ((lane & 1) == 0 && ri < 17) ((float*)(a.ws + WS_GATES))[(size_t)(row0 + ri) * 16 + g] = v; }
        }
        if (MODE == 2) {
            float acc[2][8];
#pragma unroll
            for (int r = 0; r < 2; ++r)
#pragma unroll
                for (int g = 0; g < 8; ++g) acc[r][g] = 0.f;
#pragma unroll
            for (int j = 0; j < 4; ++j)
#pragma unroll
                for (int ii = 0; ii < 4; ++ii) {
#pragma unroll
                    for (int g4 = 0; g4 < 2; ++g4) { const f32x4 w = *(const PG_LAS f32x4*)(wl + ((((j * 4 + ii) * 2 + g4) * 64 + lane) * 4));
#pragma unroll
                        for (int r = 0; r < 2; ++r) { const float hv = h[r][j][ii]; acc[r][4 * g4 + 0] += hv * w.x; acc[r][4 * g4 + 1] += hv * w.y; acc[r][4 * g4 + 2] += hv * w.z; acc[r][4 * g4 + 3] += hv * w.w; } }
                    asm volatile("" ::: "memory"); }
            float flat[16];
#pragma unroll
            for (int r = 0; r < 2; ++r)
#pragma unroll
                for (int g = 0; g < 8; ++g) flat[r * 8 + g] = acc[r][g];
            const float sum = RS<16, 32>::run(flat, lane);
#pragma unroll
            for (int r = 0; r < 2; ++r) {
                float lg[8];
#pragma unroll
                for (int g = 0; g < 8; ++g) { const float v = lane_bcast(sum, (r * 8 + g) << 2) + a.b_router[(l >> 1) * NE + g]; lg[g] = (v == v) ? fminf(fmaxf(v, -1.0e30f), 1.0e30f) : -1.0e30f; }
                int e0 = 0; float v0 = lg[0];
#pragma unroll
                for (int g = 1; g < 8; ++g) if (lg[g] > v0) { v0 = lg[g]; e0 = g; }
                int e1 = (e0 + 1) & 7; float v1 = -3.0e38f;
#pragma unroll
                for (int g = 0; g < 8; ++g) if (g != e0 && lg[g] > v1) { v1 = lg[g]; e1 = g; }
                const float w0 = 1.f / (1.f + __expf(v1 - v0)), w1 = 1.f - w0;
                if (lane == 0 && valid[r]) { const int tk = tks[r];
                    int* te = (int*)(a.ws + WS_TOKE) + 2 * tk; te[0] = dead[r] ? -1 : e0; te[1] = dead[r] ? -1 : e1; }
                if (lane == 0 && valid[r] && !dead[r]) { const int tk = tks[r];
                    float* tw = (float*)(a.ws + WS_TOKW) + 2 * tk; tw[0] = w0; tw[1] = w1;
                    __hip_atomic_fetch_add(&cnt_l[e0], 1, __ATOMIC_RELAXED, __HIP_MEMORY_SCOPE_WORKGROUP); __hip_atomic_fetch_add(&cnt_l[e1], 1, __ATOMIC_RELAXED, __HIP_MEMORY_SCOPE_WORKGROUP); }
            }
        }
    }
    if (MODE == 2) { __syncthreads(); if (tid < NE) ((int*)(a.ws + WS_CNT))[wg * NE + tid] = cnt_l[tid]; }
}
#undef NCOFF
template <int MODE, bool SRC_IN, int PEND>
__global__ void __launch_bounds__(NTHR, 2) k_norm(P a, int l) {
    extern __shared__ __attribute__((aligned(16))) unsigned char smem[];
    a.wv = __builtin_amdgcn_readfirstlane(threadIdx.x >> 6);
    norm_phase<MODE, SRC_IN, PEND>(a, l, blockIdx.x, (PG_LAS float*)smem);
}

__device__ __forceinline__ void moe_pos_phase(const P& a_in, int wg, int* lds) {
    PHASE_ENTRY(a_in)
    const int tid = otid(), lane = tid & 63, wave = __builtin_amdgcn_readfirstlane(tid >> 6);
    int* cnt = lds;
    int* tot = lds + 2048;
    int* wc = lds + 2048 + 32;
    const int* gc = (const int*)(a.ws + WS_CNT);
    for (int i = tid; i < NWG * NE; i += NTHR) cnt[i] = gc[i];
    const int* te = (const int*)(a.ws + WS_TOKE); const float* tw = (const float*)(a.ws + WS_TOKW);
    int* tp = (int*)(a.ws + WS_TOKP); int* rowt = (int*)(a.ws + WS_ROWT); float* roww = (float*)(a.ws + WS_ROWW);
    constexpr int NENT = 2 * ROWS_PER_WG;
    const int ent = tid < NENT ? te[2 * wg * ROWS_PER_WG + tid] : -1;
    const float entw = tid < NENT ? tw[2 * wg * ROWS_PER_WG + tid] : 0.f;
    int rank = 0;
#pragma unroll
    for (int e = 0; e < NE; ++e) { const unsigned long long mk = __ballot(ent == e);
        const int below = __builtin_amdgcn_mbcnt_hi((unsigned)(mk >> 32), __builtin_amdgcn_mbcnt_lo((unsigned)mk, 0u));
        if (ent == e) rank = below;
        if (lane == 0) wc[wave * NE + e] = __popcll(mk); }
    __syncthreads();
    {
        const int e = wave; int v[4], sum = 0;
#pragma unroll
        for (int q = 0; q < 4; ++q) { v[q] = cnt[(4 * lane + q) * NE + e]; sum += v[q]; }
        const int incl = (int)dpp_scan<false>((float)sum);
        const int total = __builtin_amdgcn_readlane(incl, 63);
        const int lw = wg >> 2, lq = wg & 3;
        int mine = incl - sum; if (lq > 0) mine += v[0]; if (lq > 1) mine += v[1]; if (lq > 2) mine += v[2];
        const int pre = __builtin_amdgcn_readlane(mine, lw);
        if (lane == 0) { tot[e] = total; tot[16 + e] = pre; }
    }
    __syncthreads();
    if (tid == 0) { int s = 0; for (int e = 0; e < NE; ++e) { tot[8 + e] = s; s += (tot[e] + 255) & ~255; } tot[24] = s; }
    __syncthreads();
    if (ent >= 0) {
        int off = 0;
        for (int w = 0; w < wave; ++w) off += wc[w * NE + ent];
        const int pos = tot[8 + ent] + tot[16 + ent] + off + rank;
        const int tk = wg * ROWS_PER_WG + (tid >> 1);
        tp[2 * wg * ROWS_PER_WG + tid] = pos; rowt[pos] = tk; roww[pos] = entw;
    }
    if (wg < NE) { const int s0 = tot[8 + wg] + tot[wg], s1 = tot[8 + wg] + ((tot[wg] + 255) & ~255); for (int r = s0 + tid; r < s1; r += NTHR) { rowt[r] = 0; roww[r] = 0.f; } }
    if (wg == 0) { int* tile_e = (int*)(a.ws + WS_TILEE); const int nt = tot[24] >> 8;
        for (int t = tid; t < MOE_TILES; t += NTHR) { int e = 0; for (int q = 1; q < NE; ++q) if (t * 256 >= tot[8 + q]) e = q; tile_e[t] = t < nt ? e : 0; }
        if (tid == 0) tile_e[MOE_TILES] = nt; }
}
__global__ void __launch_bounds__(NTHR, 2) k_moe_pos(P a) {
    extern __shared__ __attribute__((aligned(16))) unsigned char smem[];
    a.wv = __builtin_amdgcn_readfirstlane(threadIdx.x >> 6);
    moe_pos_phase(a, blockIdx.x, (int*)smem);
}

enum { EM_IN = 0, EM_OUT = 1, EM_F1 = 2, EM_F2D = 3, EM_F1M = 4, EM_F2M = 5 };
template <int EM>
__global__ void __launch_bounds__(256) k_ngemm(P a, int l, const bf16* A, const bf16* Bt, int M, int N, int K) {
    constexpr bool DUAL = (EM == EM_F1 || EM == EM_F1M), MOE = (EM == EM_F1M || EM == EM_F2M);
    __shared__ __attribute__((aligned(16))) float As[32][64], Bs[32][64], Bs2[DUAL ? 32 : 1][64];
    const int t = threadIdx.x, tx = t & 15, ty = t >> 4;
    const int row0 = blockIdx.y * 64, col0 = blockIdx.x * 64;
    const int* tile_e = (const int*)(a.ws + WS_TILEE); const int* rowt = (const int*)(a.ws + WS_ROWT);
    if (MOE) { if (row0 >= tile_e[MOE_TILES] * 256) return; }
    const int e = MOE ? tile_e[row0 >> 8] : 0;
    const bf16* B = Bt + (MOE ? (size_t)e * (DUAL ? 2 * FFN : D) * K : 0);
    const int lr = t >> 2, kc = (t & 3) * 8;
    const int arow = (EM == EM_F1M) ? rowt[row0 + lr] : row0 + lr;
    const int brow = DUAL ? ((col0 >> 7) * 256 + (col0 & 127) + lr) : col0 + lr;
    float acc[4][4], acc2[4][4];
#pragma unroll
    for (int i = 0; i < 4; ++i)
#pragma unroll
        for (int j = 0; j < 4; ++j) { acc[i][j] = 0.f; acc2[i][j] = 0.f; }
    for (int k0 = 0; k0 < K; k0 += 32) {
        const v4u av = *(const v4u*)(A + (size_t)arow * K + k0 + kc);
        const v4u bv = *(const v4u*)(B + (size_t)brow * K + k0 + kc);
        v4u bv2 = bv; if (DUAL) bv2 = *(const v4u*)(B + (size_t)(brow + 128) * K + k0 + kc);
        __syncthreads();
        As[kc + 0][lr] = bf_lo(av.x); As[kc + 1][lr] = bf_hi(av.x); As[kc + 2][lr] = bf_lo(av.y); As[kc + 3][lr] = bf_hi(av.y);
        As[kc + 4][lr] = bf_lo(av.z); As[kc + 5][lr] = bf_hi(av.z); As[kc + 6][lr] = bf_lo(av.w); As[kc + 7][lr] = bf_hi(av.w);
        Bs[kc + 0][lr] = bf_lo(bv.x); Bs[kc + 1][lr] = bf_hi(bv.x); Bs[kc + 2][lr] = bf_lo(bv.y); Bs[kc + 3][lr] = bf_hi(bv.y);
        Bs[kc + 4][lr] = bf_lo(bv.z); Bs[kc + 5][lr] = bf_hi(bv.z); Bs[kc + 6][lr] = bf_lo(bv.w); Bs[kc + 7][lr] = bf_hi(bv.w);
        if (DUAL) { Bs2[kc + 0][lr] = bf_lo(bv2.x); Bs2[kc + 1][lr] = bf_hi(bv2.x); Bs2[kc + 2][lr] = bf_lo(bv2.y); Bs2[kc + 3][lr] = bf_hi(bv2.y);
            Bs2[kc + 4][lr] = bf_lo(bv2.z); Bs2[kc + 5][lr] = bf_hi(bv2.z); Bs2[kc + 6][lr] = bf_lo(bv2.w); Bs2[kc + 7][lr] = bf_hi(bv2.w); }
        __syncthreads();
#pragma unroll 8
        for (int k = 0; k < 32; ++k) {
            const f32x4 av4 = *(const f32x4*)&As[k][ty * 4], bv4 = *(const f32x4*)&Bs[k][tx * 4];
#pragma unroll
            for (int i = 0; i < 4; ++i)
#pragma unroll
                for (int j = 0; j < 4; ++j) acc[i][j] += av4[i] * bv4[j];
            if (DUAL) { const f32x4 b2 = *(const f32x4*)&Bs2[k][tx * 4];
#pragma unroll
                for (int i = 0; i < 4; ++i)
#pragma unroll
                    for (int j = 0; j < 4; ++j) acc2[i][j] += av4[i] * b2[j]; }
        }
    }
    const float* MOD = (const float*)(a.ws + WS_MOD); float* X = (float*)(a.ws + WS_X);
#pragma unroll
    for (int i = 0; i < 4; ++i) {
        const int r = row0 + ty * 4 + i;
#pragma unroll
        for (int j = 0; j < 4; ++j) {
            const int c = col0 + tx * 4 + j; const float v = acc[i][j];
            if (EM == EM_IN) ((bf16*)(a.ws + WS_U))[(size_t)r * UW + c] = (bf16)f2bf(v);
            if (EM == EM_OUT) { const float* base = (l == 0) ? in_row(a, r) : X + (size_t)r * D; X[(size_t)r * D + c] = base[c] + MOD[((size_t)l * MODR + tk_modrow(r)) * MODW + 2 * D + c] * v; }
            if (EM == EM_F1) ((bf16*)(a.ws + WS_HID))[(size_t)r * FFN + c] = (bf16)f2bf(silu_f(v) * acc2[i][j]);
            if (EM == EM_F1M) ((bf16*)(a.ws + WS_HID))[(size_t)r * FFN + c] = (bf16)f2bf(silu_f(v) * acc2[i][j] * ((const float*)(a.ws + WS_ROWW))[r]);
            if (EM == EM_F2D) X[(size_t)r * D + c] += MOD[((size_t)l * MODR + tk_modrow(r)) * MODW + 5 * D + c] * v;
            if (EM == EM_F2M) ((bf16*)(a.ws + WS_YS))[(size_t)r * D + c] = (bf16)f2bf(v);
        }
    }
}
__global__ void __launch_bounds__(256) k_rope_apply(P a) {
    const size_t i = (size_t)blockIdx.x * 256 + threadIdx.x; if (i >= (size_t)T_ALL * 20 * 16) return;
    const int tk = (int)(i / 320), rem = (int)(i % 320), grp = rem / 16, f = rem % 16;
    const int b = tk / TPB, p = tk - b * TPB; bf16* u = (bf16*)(a.ws + WS_U) + (size_t)tk * UW + grp * 32;
    float x1 = bf2f(u[f]), x2 = bf2f(u[f + 16]);
    const float sc = grp < 16 ? 0.125f : 1.f;
    if (p >= CTX) { const int s = p - CTX, pos = (grp & 1) ? (s & 63) : (s >> 6); const float* t = (const float*)(a.ws + WS_ROPE) + 2 * (pos * 16 + f);
        const float cs = t[0], sn = t[1]; const float y1 = x1 * cs - x2 * sn, y2 = x2 * cs + x1 * sn; x1 = y1; x2 = y2; }
    u[f] = (bf16)f2bf(x1 * sc); u[f + 16] = (bf16)f2bf(x2 * sc);
}

__global__ void __launch_bounds__(512, 2) k_attn_naive(P a, int l) {
    __shared__ float ssq[8];
    const int tk = blockIdx.x, h = threadIdx.x >> 6, lane = threadIdx.x & 63, kvh = h >> 2;
    const int b = tk / TPB, p = tk - b * TPB; const bool isctx = p < CTX;
    const bf16* U = (const bf16*)(a.ws + WS_U);
    float q[64];
    { const v4u* qp = (const v4u*)(U + (size_t)tk * UW + U_QA + h * 64);
#pragma unroll
      for (int i = 0; i < 8; ++i) { const v4u w = qp[i]; q[8 * i + 0] = bf_lo(w.x); q[8 * i + 1] = bf_hi(w.x); q[8 * i + 2] = bf_lo(w.y); q[8 * i + 3] = bf_hi(w.y); q[8 * i + 4] = bf_lo(w.z); q[8 * i + 5] = bf_hi(w.z); q[8 * i + 6] = bf_lo(w.w); q[8 * i + 7] = bf_hi(w.w); } }
    const int s = p - CTX; const int j0 = isctx ? 0 : (s - 128 < 0 ? 0 : s - 128), j1 = isctx ? -1 : (s + 128 > SEQ - 1 ? SEQ - 1 : s + 128);
    const int nlat = j1 - j0 + 1, nk = CTX + (isctx ? 0 : nlat);
    const int tb = b * TPB;
    float sc[9];
#pragma unroll
    for (int it = 0; it < 9; ++it) { const int idx = lane + 64 * it; sc[it] = -3.0e38f;
        if (idx < nk) { const int kt = idx < CTX ? tb + idx : tb + CTX + j0 + (idx - CTX); const v4u* kp = (const v4u*)(U + (size_t)kt * UW + U_KA + kvh * 64); float d = 0.f;
#pragma unroll
            for (int i = 0; i < 8; ++i) { const v4u w = kp[i]; d += q[8 * i + 0] * bf_lo(w.x) + q[8 * i + 1] * bf_hi(w.x) + q[8 * i + 2] * bf_lo(w.y) + q[8 * i + 3] * bf_hi(w.y) + q[8 * i + 4] * bf_lo(w.z) + q[8 * i + 5] * bf_hi(w.z) + q[8 * i + 6] * bf_lo(w.w) + q[8 * i + 7] * bf_hi(w.w); }
            sc[it] = d; } }
    const float sink = a.attn_sink[l * 8 + h];
    float m = sink;
#pragma unroll
    for (int it = 0; it < 9; ++it) m = fmaxf(m, sc[it]);
    m = wave_max(m);
    float o[64];
#pragma unroll
    for (int d = 0; d < 64; ++d) o[d] = 0.f;
    float den = 0.f;
#pragma unroll
    for (int it = 0; it < 9; ++it) { const int idx = lane + 64 * it;
        if (idx < nk) { const float pr = __expf(sc[it] - m); den += pr; const int kt = idx < CTX ? tb + idx : tb + CTX + j0 + (idx - CTX); const v4u* vp = (const v4u*)(U + (size_t)kt * UW + U_VA + kvh * 64);
#pragma unroll
            for (int i = 0; i < 8; ++i) { const v4u w = vp[i]; o[8 * i + 0] += pr * bf_lo(w.x); o[8 * i + 1] += pr * bf_hi(w.x); o[8 * i + 2] += pr * bf_lo(w.y); o[8 * i + 3] += pr * bf_hi(w.y); o[8 * i + 4] += pr * bf_lo(w.z); o[8 * i + 5] += pr * bf_hi(w.z); o[8 * i + 6] += pr * bf_lo(w.w); o[8 * i + 7] += pr * bf_hi(w.w); } } }
    den = wave_sum(den) + __expf(sink - m);
    float mine = 0.f;
#pragma unroll
    for (int d = 0; d < 64; ++d) { const float sd = wave_sum(o[d]); mine = (lane == d) ? sd : mine; }
    mine /= den;
    const float sq = wave_sum(mine * mine);
    if (lane == 0) ssq[h] = sq;
    __syncthreads();
    float tot = 0.f;
#pragma unroll
    for (int i = 0; i < 8; ++i) tot += ssq[i];
    const float rstd = rsqrtf(tot * (1.f / 512.f) + EPS);
    ((bf16*)(a.ws + WS_MIX))[(size_t)tk * D + h * 64 + lane] = (bf16)f2bf(mine * rstd * a.g_att[l * 512 + h * 64 + lane]);
}

__device__ __forceinline__ float conv_qk(const P& a, int l, const bf16* U, int tk, int ch) {
    const int b = tk / TPB, p = tk - b * TPB; const int lo = p < CTX ? 0 : CTX, hi = p < CTX ? CTX : TPB;
    float y = a.conv_b[l * 512 + ch];
#pragma unroll
    for (int j = 0; j < 5; ++j) { const int pp = p + j - 2; if (pp >= lo && pp < hi) y += a.conv_w[(l * 5 + j) * 512 + ch] * bf2f(U[(size_t)(b * TPB + pp) * UW + U_QM + ch]); }
    return silu_f(y);
}
__global__ void __launch_bounds__(256) k_mlstm_naive(P a, int l) {
    __shared__ float qs[2][64], ks[2][64], part[2][2][128], sc[2][4];
    const int t = threadIdx.x, dir = blockIdx.x & 1, hd = (blockIdx.x >> 1) & 3, b = blockIdx.x >> 3;
    const bf16* U = (const bf16*)(a.ws + WS_U); const float* G = (const float*)(a.ws + WS_GATES);
    float* HD = (float*)(a.ws + WS_HDIR) + (size_t)dir * T_ALL * 512;
    const int e = t & 127, half = t >> 7;
    float C[32];
#pragma unroll
    for (int i = 0; i < 32; ++i) C[i] = 0.f;
    float nst = 0.f, m = 0.f;
    for (int tau = 0; tau < TPB; ++tau) {
        const int pb = tau & 1;
        const int p = dir == 0 ? tau : (tau < CTX ? CTX - 1 - tau : CTX + (SEQ - 1) - (tau - CTX));
        const int tk = b * TPB + p;
        if (t < 64) qs[pb][t] = 0.125f * conv_qk(a, l, U, tk, hd * 64 + t);
        else if (t < 128) ks[pb][t - 64] = conv_qk(a, l, U, tk, 256 + hd * 64 + (t - 64));
        const float li = G[(size_t)tk * 16 + dir * 8 + hd], lf = logsigmoid_f(G[(size_t)tk * 16 + dir * 8 + 4 + hd]);
        const float mn = fmaxf(lf + m, li), fd = __expf(lf + m - mn), iw = __expf(li - mn);
        m = mn;
        const float v = bf2f(U[(size_t)tk * UW + U_VM + hd * 128 + e]);
        __syncthreads();
        float ph = 0.f;
#pragma unroll
        for (int i = 0; i < 32; ++i) { const int dk = half * 32 + i; C[i] = fd * C[i] + iw * ks[pb][dk] * v; ph += qs[pb][dk] * C[i]; }
        part[pb][half][e] = ph;
        if (t < 64) { nst = fd * nst + iw * ks[pb][t]; const float qn = wave_sum(qs[pb][t] * nst); if (t == 0) sc[pb][0] = qn; }
        __syncthreads();
        if (t < 128) { const float num = part[pb][0][t] + part[pb][1][t]; const float den = fmaxf(fabsf(sc[pb][0]), __expf(-mn)); HD[(size_t)tk * 512 + hd * 128 + t] = num / den; }
    }
}
__global__ void __launch_bounds__(256) k_merge_naive(P a, int l) {
    const int tk = blockIdx.x, hd = threadIdx.x >> 6, lane = threadIdx.x & 63;
    const float* H0 = (const float*)(a.ws + WS_HDIR); const float* H1 = H0 + (size_t)T_ALL * 512; const bf16* U = (const bf16*)(a.ws + WS_U);
    const int c0 = hd * 128 + lane, c1 = c0 + 64;
    const float h0 = H0[(size_t)tk * 512 + c0] + H1[(size_t)tk * 512 + c0], h1 = H0[(size_t)tk * 512 + c1] + H1[(size_t)tk * 512 + c1];
    const float rstd = rsqrtf(wave_sum(h0 * h0 + h1 * h1) * (1.f / 128.f) + EPS);
    bf16* mx = (bf16*)(a.ws + WS_MIX) + (size_t)tk * D + 512;
    mx[c0] = (bf16)f2bf(h0 * rstd * a.g_ml[l * 512 + c0] * sigmoid_f(bf2f(U[(size_t)tk * UW + U_OM + c0])));
    mx[c1] = (bf16)f2bf(h1 * rstd * a.g_ml[l * 512 + c1] * sigmoid_f(bf2f(U[(size_t)tk * UW + U_OM + c1])));
}

namespace pg {
#define PG_LAS __attribute__((address_space(3)))
typedef short bf16x8 __attribute__((ext_vector_type(8)));
constexpr int BM = 256, BK = 64, HALF = 128, HTB = HALF * BK * 2, STAGE_BYTES = 8 * HTB, NXCD = 8, WGM = 8;
__host__ __device__ __forceinline__ int lds_byte(int r, int c) { const int st = (r >> 4) * 2 + (c >> 5), rr = r & 15, cc = c & 31, ob = rr * 64 + cc * 2; return st * 1024 + (ob ^ (((ob >> 9) & 1) << 5)); }
__host__ __device__ __forceinline__ void stage_rc(int b, int& R, int& C) { const int st = b / 1024, sb = b % 1024, swz = sb ^ (((sb >> 9) & 1) << 5); R = (st >> 1) * 16 + swz / 64; C = (st & 1) * 32 + (swz % 64) / 2; }
__host__ __device__ __forceinline__ int perm32(int rho) { const int n = rho >> 4, i = rho & 15; return 8 * (i >> 2) + 4 * n + (i & 3); }
struct Unit { int pm, pn, e; };
struct Order {
    int nM, nN, nwg, G, c, lat;
    __device__ void init(int nM_, int nN_, int G_, int c_) { nM = nM_; nN = nN_; nwg = nM * nN; G = G_; c = c_; lat = 0; }
    __device__ bool next(int i, Unit& u) const {
        const long L = (long)i * G + c; if (L >= nwg) return false;
        int wgid = (int)L; { const int q = nwg / NXCD, r = nwg % NXCD, xcd = wgid % NXCD, off = wgid / NXCD; wgid = (xcd < r ? xcd * (q + 1) : r * (q + 1) + (xcd - r) * q) + off; }
        const int nig = WGM * nN, gid = wgid / nig, fm = gid * WGM, gsz = (nM - fm) < WGM ? (nM - fm) : WGM;
        u.pm = fm + ((wgid % nig) % gsz); u.pn = (wgid % nig) / gsz; u.e = 0; if (lat) u.pm = (u.pm >> 4) * 17 + 1 + (u.pm & 15); return true;
    }
};
struct Gemm { const bf16* A; const bf16* Bt; int K; int brows; const int* rowt; const int* tile_e; int wv; };

template <class Epi, bool GATHER, bool MOE>
__device__ __forceinline__ void gemm_phase(PG_LAS unsigned char* lds, const Gemm g, const Order& S, const Epi& E) {
    const int tid = otid_w(g.wv), wid = __builtin_amdgcn_readfirstlane(tid >> 6), lane = tid & 63, wr = wid >> 2, wc = wid & 3, fr = lane & 15, fq = lane >> 4;
    const int K = g.K, nt = K / BK;
    int Rr[2], Cc[2]; unsigned voffB[2];
#pragma unroll
    for (int i = 0; i < 2; ++i) { int R, C; stage_rc(tid * 16 + i * 8192, R, C); Rr[i] = R; Cc[i] = C; const int Rb = Epi::PERM ? ((R & ~31) + perm32(R & 31)) : R; voffB[i] = (unsigned)(Rb * K + C) * 2u; }
    const size_t hstep = (size_t)HALF * K * 2;
    const unsigned ldsw = (unsigned)wid * 1024u;
    const int aoff = lds_byte(wr * 64 + fr, fq * 8), boff = lds_byte(wc * 32 + fr, fq * 8);
    const char* Ab = (const char*)g.A;
#define PG_SA(b, h) (((b) * 2 + (h)) * HTB)
#define PG_SB(b, h) ((4 + (b) * 2 + (h)) * HTB)
#define PG_STAGE_B(bufoff, gbase) do { _Pragma("unroll") for (int _i = 0; _i < 2; ++_i) \
        __builtin_amdgcn_global_load_lds((const unsigned*)((const char*)(gbase) + voffB[_i]), (PG_LAS unsigned*)(lds + (bufoff) + ldsw + _i * 8192), 16, 0, 0); } while (0)
#define PG_STAGE_A(bufoff, offs, h, kb) do { _Pragma("unroll") for (int _i = 0; _i < 2; ++_i) \
        __builtin_amdgcn_global_load_lds((const unsigned*)(Ab + (size_t)(offs)[h][_i] + (size_t)(kb)), (PG_LAS unsigned*)(lds + (bufoff) + ldsw + _i * 8192), 16, 0, 0); } while (0)
#define PG_LDA(dst, b, h) do { _Pragma("unroll") for (int m = 0; m < 4; ++m) _Pragma("unroll") for (int k = 0; k < 2; ++k) dst[m][k] = *(const PG_LAS bf16x8*)(lds + PG_SA(b, h) + aoff + m * 2048 + k * 1024); } while (0)
#define PG_LDB(dst, b, h) do { _Pragma("unroll") for (int n = 0; n < 2; ++n) _Pragma("unroll") for (int k = 0; k < 2; ++k) dst[n][k] = *(const PG_LAS bf16x8*)(lds + PG_SB(b, h) + boff + n * 2048 + k * 1024); } while (0)
#define PG_MMA(ai, bj, At, Bt) do { __builtin_amdgcn_s_setprio(1); _Pragma("unroll") for (int m = 0; m < 4; ++m) _Pragma("unroll") for (int n = 0; n < 2; ++n) _Pragma("unroll") for (int k = 0; k < 2; ++k) \
        acc[ai][bj][m][n] = __builtin_amdgcn_mfma_f32_16x16x32_bf16(Bt[n][k], At[m][k], acc[ai][bj][m][n], 0, 0, 0); __builtin_amdgcn_s_setprio(0); } while (0)
#define PG_WAIT_V(n) asm volatile("s_waitcnt vmcnt(" #n ")" ::: "memory")
#define PG_WAIT_L(n) asm volatile("s_waitcnt lgkmcnt(" #n ")" ::: "memory")
#define PG_BAR __builtin_amdgcn_s_barrier()
#define PG_SCHED __builtin_amdgcn_sched_barrier(0)
#define PG_AOFFS(dst, u) do { _Pragma("unroll") for (int _h = 0; _h < 2; ++_h) _Pragma("unroll") for (int _i = 0; _i < 2; ++_i) { \
        const int _r = (u).pm * BM + _h * HALF + Rr[_i]; const int _row = GATHER ? g.rowt[_r] : _r; dst[_h][_i] = (unsigned)_row * (unsigned)(K * 2) + (unsigned)(Cc[_i] * 2); } } while (0)
#define PG_BBASE(u) ((const char*)g.Bt + ((size_t)(u).e * g.brows + (size_t)(u).pn * BM) * (size_t)K * 2)
    Unit cur, nxt; int ui = 0;
    if (!S.next(0, cur)) return;
    if (MOE) cur.e = g.tile_e[cur.pm];
    f32x4 acc[2][2][4][2];
#pragma unroll
    for (int a = 0; a < 2; ++a)
#pragma unroll
        for (int b = 0; b < 2; ++b)
#pragma unroll
            for (int m = 0; m < 4; ++m)
#pragma unroll
                for (int n = 0; n < 2; ++n) acc[a][b][m][n] = (f32x4){0.f, 0.f, 0.f, 0.f};
    bf16x8 At[4][2], B0[2][2], B1[2][2];
    unsigned offC[2][2], offN[2][2];
    PG_AOFFS(offC, cur);
    const char* cB = PG_BBASE(cur);
    const size_t kstep = (size_t)(BK * 2);
    PG_STAGE_B(PG_SB(0, 0), cB); PG_STAGE_B(PG_SB(0, 1), cB + hstep); PG_STAGE_A(PG_SA(0, 0), offC, 0, 0); PG_STAGE_A(PG_SA(0, 1), offC, 1, 0);
    if (wr == 1) PG_BAR;
    PG_WAIT_V(2); PG_BAR;
    PG_STAGE_B(PG_SB(1, 0), cB + kstep); PG_STAGE_A(PG_SA(1, 0), offC, 0, kstep); PG_STAGE_B(PG_SB(1, 1), cB + hstep + kstep);
    PG_WAIT_V(6); PG_BAR;
    for (;;) {
        bool has_next = S.next(ui + 1, nxt);
        if (has_next) { if (MOE) nxt.e = g.tile_e[nxt.pm]; if (GATHER) PG_AOFFS(offN, nxt); }
        else if (GATHER) {
#pragma unroll
            for (int h = 0; h < 2; ++h)
#pragma unroll
                for (int i = 0; i < 2; ++i) offN[h][i] = offC[h][i]; }
        const char* nB = has_next ? PG_BBASE(nxt) : cB;
        for (int t = 0; t < nt; t += 2) {
            const bool last = (t == nt - 2);
            const size_t k1 = (size_t)(t + 1) * kstep;
            const size_t k2 = last ? 0 : (size_t)(t + 2) * kstep;
            const char* b2 = last ? nB : cB + (size_t)(t + 2) * kstep; const char* b3 = b2 + kstep;
            PG_LDB(B0, 0, 0); PG_LDB(B1, 0, 1); PG_SCHED; PG_LDA(At, 0, 0); PG_STAGE_A(PG_SA(1, 1), offC, 1, k1);
            PG_WAIT_V(8); PG_WAIT_L(0); PG_BAR; PG_MMA(0, 0, At, B0); PG_MMA(0, 1, At, B1); PG_BAR; PG_SCHED;
            if (last) {
                if (GATHER) {
#pragma unroll
                    for (int h = 0; h < 2; ++h)
#pragma unroll
                        for (int i = 0; i < 2; ++i) offC[h][i] = offN[h][i];
                } else if (has_next) { PG_AOFFS(offC, nxt); }
            }
            PG_LDA(At, 0, 1); PG_STAGE_B(PG_SB(0, 0), b2); PG_STAGE_B(PG_SB(0, 1), b2 + hstep); PG_STAGE_A(PG_SA(0, 0), offC, 0, k2);
            PG_WAIT_V(8); PG_WAIT_L(0); PG_BAR; PG_MMA(1, 0, At, B0); PG_MMA(1, 1, At, B1); PG_BAR; PG_SCHED;
            PG_LDB(B0, 1, 0); PG_LDB(B1, 1, 1); PG_SCHED; PG_LDA(At, 1, 0); PG_STAGE_A(PG_SA(0, 1), offC, 1, k2);
            PG_WAIT_V(8); PG_WAIT_L(0); PG_BAR; PG_MMA(0, 0, At, B0); PG_MMA(0, 1, At, B1); PG_BAR; PG_SCHED;
            PG_LDA(At, 1, 1); PG_STAGE_B(PG_SB(1, 0), b3); PG_STAGE_B(PG_SB(1, 1), b3 + hstep); PG_STAGE_A(PG_SA(1, 0), offC, 0, k2 + kstep);
            PG_WAIT_V(8); PG_WAIT_L(0); PG_BAR; PG_MMA(1, 0, At, B0); PG_MMA(1, 1, At, B1); PG_BAR; PG_SCHED;
        }
        if (wr == 0) PG_BAR;
        E(acc, cur, wr, wc, fr, fq);
        if (!has_next) break;
#pragma unroll
        for (int a = 0; a < 2; ++a)
#pragma unroll
            for (int b = 0; b < 2; ++b)
#pragma unroll
                for (int m = 0; m < 4; ++m)
#pragma unroll
                    for (int n = 0; n < 2; ++n) acc[a][b][m][n] = (f32x4){0.f, 0.f, 0.f, 0.f};
        cur = nxt; cB = nB; ++ui;
        if (wr == 1) PG_BAR;
    }
    PG_WAIT_V(0);
    PG_BAR;
#undef PG_SA
#undef PG_SB
#undef PG_STAGE_A
#undef PG_STAGE_B
#undef PG_LDA
#undef PG_LDB
#undef PG_MMA
#undef PG_WAIT_V
#undef PG_WAIT_L
#undef PG_BAR
#undef PG_SCHED
#undef PG_AOFFS
#undef PG_BBASE
}
}


struct EpiIn {
    static constexpr bool PERM = false;
    bf16* U; const PG_LAS float* rope;
    __device__ __forceinline__ void operator()(const f32x4 (&acc)[2][2][4][2], const pg::Unit& u, int wr, int wc, int fr, int fq) const {
        const int tb = (u.pm * 256) / TPB, p0 = u.pm * 256 - tb * TPB; const bool latent = p0 >= CTX;
#pragma unroll
        for (int ai = 0; ai < 2; ++ai)
#pragma unroll
            for (int m = 0; m < 4; ++m) {
                const int rl = ai * 128 + wr * 64 + m * 16 + fr; const int r = u.pm * 256 + rl; const int s = p0 + rl - CTX;
                bf16* rowp = U + (size_t)r * UW + u.pn * 256 + wc * 32 + ((fq & 1) ? 16 + 4 * (fq - 1) : 4 * fq);
#pragma unroll
                for (int bj = 0; bj < 2; ++bj) {
                    const int G = (u.pn * 256 + bj * 128 + wc * 32) >> 5;
                    f32x4 x1 = acc[ai][bj][m][0], x2 = acc[ai][bj][m][1];
                    if (G < 20) {
                        if (latent) { const int pos = (G & 1) ? (s & 63) : (s >> 6); const PG_LAS float* t = rope + (pos * 16 + 4 * fq) * 2;
                            const f32x4 t0 = *(const PG_LAS f32x4*)t, t1 = *(const PG_LAS f32x4*)(t + 4);
                            const f32x4 cs = (f32x4){t0.x, t0.z, t1.x, t1.z}, sn = (f32x4){t0.y, t0.w, t1.y, t1.w};
                            const f32x4 y1 = x1 * cs - x2 * sn, y2 = x2 * cs + x1 * sn; x1 = y1; x2 = y2; }
                        if (G < 16) { x1 = x1 * 0.18033688011112042f; x2 = x2 * 0.18033688011112042f; }
                    }
                    v2u o1, o2; o1.x = cvt_pk_bf16(x1.x, x1.y); o1.y = cvt_pk_bf16(x1.z, x1.w); o2.x = cvt_pk_bf16(x2.x, x2.y); o2.y = cvt_pk_bf16(x2.z, x2.w);
                    asm volatile("s_nop 1\n\tv_permlane16_swap_b32 %0, %2\n\tv_permlane16_swap_b32 %1, %3\n\ts_nop 0" : "+v"(o1.x), "+v"(o1.y), "+v"(o2.x), "+v"(o2.y));
                    *(v4u*)(rowp + bj * 128) = (v4u){o1.x, o1.y, o2.x, o2.y};
                }
            }
    }
};
template <int CHUNK, bool INPLACE> struct EpiRes {
    static constexpr bool PERM = false;
    float* X; const float* modl; const float* xin; const float* cin; int l; float* Xo;
    __device__ __forceinline__ void operator()(const f32x4 (&acc)[2][2][4][2], const pg::Unit& u, int wr, int wc, int fr, int fq) const {
        const int tb = (u.pm * 256) / TPB, p0 = u.pm * 256 - tb * TPB; const int mr = p0 < CTX ? NB : tb;
        const float* mv = modl + (size_t)mr * MODW + CHUNK * D + u.pn * 256 + wc * 32 + 4 * fq;
        f32x4 mod[2][2];
#pragma unroll
        for (int bj = 0; bj < 2; ++bj)
#pragma unroll
            for (int n = 0; n < 2; ++n) mod[bj][n] = *(const f32x4*)(mv + bj * 128 + n * 16);
        const bool from_in = (!INPLACE) && l == 0;
        const int co = u.pn * 256 + wc * 32 + 4 * fq;
#pragma unroll
        for (int ai = 0; ai < 2; ++ai) {
            f32x4 bs[4][2][2];
#pragma unroll
            for (int m = 0; m < 4; ++m) {
                const int rl = ai * 128 + wr * 64 + m * 16 + fr; const int r = u.pm * 256 + rl; const int p = p0 + rl;
                const float* bp = from_in ? (p < CTX ? cin + ((size_t)tb * CTX + p) * D : xin + ((size_t)tb * SEQ + (p - CTX)) * D) : X + (size_t)r * D;
#pragma unroll
                for (int bj = 0; bj < 2; ++bj)
#pragma unroll
                    for (int n = 0; n < 2; ++n) bs[m][bj][n] = *(const f32x4*)(bp + co + bj * 128 + n * 16);
            }
#pragma unroll
            for (int m = 0; m < 4; ++m) {
                const int r = u.pm * 256 + ai * 128 + wr * 64 + m * 16 + fr;
#pragma unroll
                for (int bj = 0; bj < 2; ++bj)
#pragma unroll
                    for (int n = 0; n < 2; ++n) *(f32x4*)(Xo + (size_t)r * D + co + bj * 128 + n * 16) = bs[m][bj][n] + mod[bj][n] * acc[ai][bj][m][n];
            }
        }
    }
};
template <bool MOE> struct EpiSwiglu {
    static constexpr bool PERM = true;
    bf16* H; const float* roww;
    __device__ __forceinline__ void operator()(const f32x4 (&acc)[2][2][4][2], const pg::Unit& u, int wr, int wc, int fr, int fq) const {
        float rws[2][4];
#pragma unroll
        for (int ai = 0; ai < 2; ++ai)
#pragma unroll
            for (int m = 0; m < 4; ++m) rws[ai][m] = MOE ? roww[u.pm * 256 + ai * 128 + wr * 64 + m * 16 + fr] : 1.f;
#pragma unroll
        for (int ai = 0; ai < 2; ++ai)
#pragma unroll
            for (int m = 0; m < 4; ++m) {
                const int r = u.pm * 256 + ai * 128 + wr * 64 + m * 16 + fr;
                const float rw = rws[ai][m];
                f32x4 h0, h1;
#pragma unroll
                for (int j = 0; j < 4; ++j) { const float g0 = acc[ai][0][m][0][j], g1 = acc[ai][0][m][1][j];
                    h0[j] = g0 * __builtin_amdgcn_rcpf(1.f + __expf(-g0)) * acc[ai][1][m][0][j] * rw; h1[j] = g1 * __builtin_amdgcn_rcpf(1.f + __expf(-g1)) * acc[ai][1][m][1][j] * rw; }
                v4u w; w.x = cvt_pk_bf16(h0.x, h0.y); w.y = cvt_pk_bf16(h0.z, h0.w); w.z = cvt_pk_bf16(h1.x, h1.y); w.w = cvt_pk_bf16(h1.z, h1.w);
                *(v4u*)(H + (size_t)r * FFN + u.pn * 128 + wc * 32 + 8 * fq) = w;
            }
    }
};
struct EpiYs {
    static constexpr bool PERM = true;
    bf16* Y;
    __device__ __forceinline__ void operator()(const f32x4 (&acc)[2][2][4][2], const pg::Unit& u, int wr, int wc, int fr, int fq) const {
#pragma unroll
        for (int ai = 0; ai < 2; ++ai)
#pragma unroll
            for (int m = 0; m < 4; ++m) {
                bf16* rowp = Y + (size_t)(u.pm * 256 + ai * 128 + wr * 64 + m * 16 + fr) * D + u.pn * 256 + wc * 32 + 8 * fq;
#pragma unroll
                for (int bj = 0; bj < 2; ++bj) { const f32x4 v0 = acc[ai][bj][m][0], v1 = acc[ai][bj][m][1];
                    v4u w; w.x = cvt_pk_bf16(v0.x, v0.y); w.y = cvt_pk_bf16(v0.z, v0.w); w.z = cvt_pk_bf16(v1.x, v1.y); w.w = cvt_pk_bf16(v1.z, v1.w);
                    *(v4u*)(rowp + bj * 128) = w; }
            }
    }
};
template <bool COMPUTE> struct EpiProbe {
    static constexpr bool PERM = true;
    __device__ __forceinline__ void operator()(const f32x4 (&acc)[2][2][4][2], const pg::Unit& u, int wr, int wc, int fr, int fq) const {
#pragma unroll
        for (int ai = 0; ai < 2; ++ai)
#pragma unroll
            for (int m = 0; m < 4; ++m) {
                if (COMPUTE) { f32x4 h0, h1;
#pragma unroll
                    for (int j = 0; j < 4; ++j) { const float g0 = acc[ai][0][m][0][j], g1 = acc[ai][0][m][1][j];
                        h0[j] = g0 * __builtin_amdgcn_rcpf(1.f + __expf(-g0)) * acc[ai][1][m][0][j]; h1[j] = g1 * __builtin_amdgcn_rcpf(1.f + __expf(-g1)) * acc[ai][1][m][1][j]; }
                    v4u w; w.x = cvt_pk_bf16(h0.x, h0.y); w.y = cvt_pk_bf16(h0.z, h0.w); w.z = cvt_pk_bf16(h1.x, h1.y); w.w = cvt_pk_bf16(h1.z, h1.w);
                    asm volatile("" :: "v"(w));
                } else {
#pragma unroll
                    for (int bj = 0; bj < 2; ++bj) { asm volatile("" :: "v"(acc[ai][bj][m][0]), "v"(acc[ai][bj][m][1])); }
                }
            }
    }
};
enum { CP_D2 = 0, CP_OUT = 1, CP_F1 = 2, CP_F2D = 3, CP_IN = 4 };
__device__ __forceinline__ bool conv_sched(int l, int phase, int& li, int& j0, int& j1) {
    li = l >> 1;
    if ((l & 1) == 0) {
        if (phase == CP_D2)  { j0 = l == 0 ? 0 : 1000; j1 = l == 0 ? 7500 : 8500; return true; }
        if (phase == CP_OUT) { j0 = l == 0 ? 7500 : 8500; j1 = l == 0 ? 12000 : 13000; return true; }
        if (phase == CP_F1)  { j0 = l == 0 ? 12000 : 13000; j1 = l == 0 ? 13500 : 14500; return true; }
        if (phase == CP_F2D) { j0 = l == 0 ? 13500 : 14500; j1 = l == 0 ? 25500 : 26500; return true; }
        if (phase == CP_IN && l == 2) { j0 = 0; j1 = 1000; return true; }
        return false;
    }
    if (phase == CP_IN) { j0 = l == 1 ? 25500 : 26500; j1 = l == 1 ? 26500 : 27500; return true; }
    if (phase == CP_D2) { j0 = l == 1 ? 26500 : 27500; j1 = EXP_ITEMS; return true; }
    return false;
}
#ifndef STAGGER_TICKS
#define STAGGER_TICKS 0
#endif
__device__ __forceinline__ void conv_tail(const P& a, int l, int phase, const pg::Order& S, PG_LAS unsigned char* lds) {
    int li, j0, j1; if (!conv_sched(l, phase, li, j0, j1)) return;
    const int rem = S.nwg % S.G; if (rem == 0 || S.c < rem) return;
    const int t_ = otid(), wv = __builtin_amdgcn_readfirstlane(t_ >> 6);
    conv_expert_range(a, li, j0, j1, (S.c - rem) * 8 + wv, (S.G - rem) * 8, (PG_LAS float*)lds + wv * (64 * 33), t_ & 63);
}
template <int WHICH> __device__ __forceinline__ void gemm_run(const P& a_in, int l, PG_LAS unsigned char* lds, int G, int c, bool probe = false) {
    PHASE_ENTRY(a_in)
    if (STAGGER_TICKS > 0 && (WHICH == EM_F1 || WHICH == EM_F1M)) {
        const unsigned long long t0 = __builtin_amdgcn_s_memrealtime(); const unsigned long long dl = (unsigned long long)((c & 3) * STAGGER_TICKS);
        while (__builtin_amdgcn_s_memrealtime() - t0 < dl) __builtin_amdgcn_s_sleep(8);
    }
    unsigned char* ws = a.ws; pg::Order S;
    if (WHICH == EM_IN) { S.init(T_ALL / 256, UW / 256, G, c); pg::Gemm g{(const bf16*)(ws + WS_HX), (const bf16*)(ws + WS_WIN) + (size_t)l * UW * D, D, 0, nullptr, nullptr, a.wv};
        PG_LAS float* rl = (PG_LAS float*)(lds + 131072 + 1024); const float* rg = (const float*)(ws + WS_ROPE);
        for (int i = otid(); i < 2048; i += NTHR) rl[i] = rg[i];
        __syncthreads();
        EpiIn E{(bf16*)(ws + WS_U), rl}; pg::gemm_phase<EpiIn, false, false>(lds, g, S, E);
        conv_tail(a, l, CP_IN, S, lds); }
    if (WHICH == EM_OUT) { if (l == DEPTH - 1) { S.init(NB * SEQ / 256, D / 256, G, c); S.lat = 1; } else S.init(T_ALL / 256, D / 256, G, c); pg::Gemm g{(const bf16*)(ws + WS_MIX), (const bf16*)(ws + WS_WOUT) + (size_t)l * D * D, D, 0, nullptr, nullptr, a.wv};
        EpiYs E{(bf16*)(ws + WS_DELTA)}; pg::gemm_phase<EpiYs, false, false>(lds, g, S, E);
        conv_tail(a, l, CP_OUT, S, lds); }
    if (WHICH == EM_F1) { S.init(T_ALL / 256, 2 * FFN / 256, G, c); pg::Gemm g{(const bf16*)(ws + WS_HX), (const bf16*)(ws + WS_WF13) + (size_t)(l >> 1) * 2 * FFN * D, D, 0, nullptr, nullptr, a.wv};
        if (PROBE == 20 && probe) { EpiProbe<false> E; pg::gemm_phase<EpiProbe<false>, false, false>(lds, g, S, E); }
        else if (PROBE == 21 && probe) { EpiProbe<true> E; pg::gemm_phase<EpiProbe<true>, false, false>(lds, g, S, E); }
        else { EpiSwiglu<false> E{(bf16*)(ws + WS_HID), nullptr}; pg::gemm_phase<EpiSwiglu<false>, false, false>(lds, g, S, E); conv_tail(a, l, CP_F1, S, lds); } }
    if (WHICH == EM_F2D) { S.init(T_ALL / 256, D / 256, G, c); pg::Gemm g{(const bf16*)(ws + WS_HID), (const bf16*)(ws + WS_WF2) + (size_t)(l >> 1) * D * FFN, FFN, 0, nullptr, nullptr, a.wv};
        EpiYs E{(bf16*)(ws + WS_DELTA)}; pg::gemm_phase<EpiYs, false, false>(lds, g, S, E);
        conv_tail(a, l, CP_F2D, S, lds); }
    if (WHICH == EM_F1M) { const int* te = (const int*)(ws + WS_TILEE); const int nt = __builtin_amdgcn_readfirstlane(te[MOE_TILES]); S.init(nt, 2 * FFN / 256, G, c);
        pg::Gemm g{(const bf16*)(ws + WS_HX), (const bf16*)(ws + WS_WE13), D, 2 * FFN, (const int*)(ws + WS_ROWT), te, a.wv};
        EpiSwiglu<true> E{(bf16*)(ws + WS_HID), (const float*)(ws + WS_ROWW)}; pg::gemm_phase<EpiSwiglu<true>, true, true>(lds, g, S, E); }
    if (WHICH == EM_F2M) { const int* te = (const int*)(ws + WS_TILEE); const int nt = __builtin_amdgcn_readfirstlane(te[MOE_TILES]); S.init(nt, D / 256, G, c);
        pg::Gemm g{(const bf16*)(ws + WS_HID), (const bf16*)(ws + WS_WE2), FFN, D, nullptr, te, a.wv};
        EpiYs E{(bf16*)(ws + WS_YS)}; pg::gemm_phase<EpiYs, false, true>(lds, g, S, E); }
}
template <int WHICH> __global__ void __launch_bounds__(NTHR, 2) k_gemm(P a, int l) {
    extern __shared__ __attribute__((aligned(16))) unsigned char smem[];
    a.wv = __builtin_amdgcn_readfirstlane(threadIdx.x >> 6);
    gemm_run<WHICH>(a, l, (PG_LAS unsigned char*)smem, (int)gridDim.x, (int)blockIdx.x);
}

typedef float f32x2 __attribute__((ext_vector_type(2)));
typedef float f32x16 __attribute__((ext_vector_type(16)));
typedef short v4s __attribute__((ext_vector_type(4)));
constexpr int ATT_ITEMS = NB * (SEQ / 32) + NB * (CTX / 32);
constexpr int ATT_LDS = 5 * 16384 + 32768 + 1024 + 2048;
__device__ __forceinline__ int att_item(int c, int kk, int sch) {
    const int x = c & 7, idx = c >> 3;
    if (sch == 0) return (idx >= 4 && kk == 0) ? x * 128 + (idx - 4) : -1;
    if (idx < 4) return -1;
    const int j = idx - 4;
    if (kk < 3) return x * 128 + 28 + 3 * j + kk;
    if (kk == 3) return j < 16 ? x * 128 + 112 + j : (j < 24 ? NB * (SEQ / 32) + x * 8 + (j - 16) : -1);
    return -1;
}
struct AttIt { int tb, tq0, ilo, nt; };
__device__ __forceinline__ AttIt att_decode(int it) {
    AttIt I;
    if (it < NB * (SEQ / 32)) { const int b = it >> 7, s0 = (it & 127) * 32; I.tb = b * TPB; I.tq0 = I.tb + CTX + s0;
        I.ilo = s0 >= 128 ? 0 : (128 - s0) / 32; int ihi = (SEQ + 96 - s0) / 32; ihi = ihi > 8 ? 8 : ihi; I.nt = 8 + (ihi - I.ilo + 1); }
    else { const int j = it - NB * (SEQ / 32), b = j >> 3; I.tb = b * TPB; I.tq0 = I.tb + (j & 7) * 32; I.ilo = 0; I.nt = 8; }
    return I;
}
__device__ __forceinline__ int att_tok(const AttIt& I, int t) { return t < 8 ? I.tb + 32 * t : I.tq0 - 128 + 32 * (I.ilo + t - 8); }
template <int PM> __device__ __forceinline__ void attn_phase(const P& a_in, int l, PG_LAS unsigned char* lds, int G, int c_in, int sch) {
    PHASE_ENTRY(a_in)
    int c = c_in; asm volatile("" : "+s"(c));
    const int tid = otid(), lane = tid & 63, h = __builtin_amdgcn_readfirstlane(tid >> 6), kvh = h >> 2;
    const int qr = lane & 31, hh = lane >> 5;
    const bf16* U = (const bf16*)(a.ws + WS_U); bf16* MIX = (bf16*)(a.ws + (PM ? WS_DELTA : WS_MIX));
    PG_LAS float* ssq = (PG_LAS float*)(lds + 114688); PG_LAS float* gl = (PG_LAS float*)(lds + 115712);
    float sink = a.attn_sink[l * 8 + h] * 1.4426950408889634f;
    asm volatile("" : "+v"(sink));
    const int st_isv = (tid >> 8) & 1, st_key = (tid >> 3) & 31, st_pos = tid & 7;
    const int st_ch = st_isv ? (st_pos ^ (((st_key >> 1) & 1) << 2)) : (st_pos ^ ((st_key >> 1) & 7));
    const int st_col = (st_isv ? U_VA : U_KA) + st_ch * 8;
    const unsigned st_lds = (unsigned)h * 1024u;
    const int q_goff = qr * UW + U_QA + h * 64 + 8 * hh;
    const int k_row = qr * 128, k_sw = (qr >> 1) & 7;
    const int tr_q = (lane & 15) >> 2, tr_p = lane & 3, tr_g = (lane >> 4) & 1;
    unsigned trv[2];
#pragma unroll
    for (int dt = 0; dt < 2; ++dt) trv[dt] = (unsigned)(kvh * 8192 + 4096 + (4 * hh + tr_q) * 128 + ((2 * (32 * dt + 16 * tr_g + 4 * tr_p)) ^ (((tr_q >> 1) & 1) << 6)));
    unsigned koff[4];
#pragma unroll
    for (int s4 = 0; s4 < 4; ++s4) koff[s4] = (unsigned)(kvh * 8192 + k_row + 16 * ((2 * s4 + hh) ^ k_sw));
    int it0 = att_item(c, 0, sch); if (it0 < 0) return;
    __syncthreads();
    for (int i = tid; i < 512; i += NTHR) gl[i] = a.g_att[l * 512 + i];
    AttIt cur = att_decode(it0);
    int tk0, tk1;
    {
        int e0 = lane, e1 = 64 + lane, r0 = -1, r1 = -1, lastt = 0;
        for (int kk = 0; kk < 5; ++kk) { const int it_ = att_item(c, kk, sch); if (it_ < 0) break; const AttIt I = att_decode(it_);
            if (r0 < 0) { if (e0 < I.nt) r0 = att_tok(I, e0); else e0 -= I.nt; }
            if (r1 < 0) { if (e1 < I.nt) r1 = att_tok(I, e1); else e1 -= I.nt; }
            lastt = att_tok(I, I.nt - 1); }
        tk0 = r0 < 0 ? lastt : r0; tk1 = r1 < 0 ? lastt : r1;
    }
#define ATT_DMA_TILE(stage, idx) do { const int i_ = (idx); const int kt_ = __builtin_amdgcn_readlane(i_ < 64 ? tk0 : tk1, i_ & 63) + st_key; const bf16* g_ = U + (size_t)kt_ * UW + st_col; \
        __builtin_amdgcn_global_load_lds((const unsigned*)g_, (PG_LAS unsigned*)(lds + (stage) * 16384 + st_lds), 16, 0, 0); \
        __builtin_amdgcn_global_load_lds((const unsigned*)(g_ + 64), (PG_LAS unsigned*)(lds + (stage) * 16384 + 8192 + st_lds), 16, 0, 0); } while (0)
#define ATT_DMA_Q(I, par) do { const bf16* g_ = U + (size_t)(I).tq0 * UW + q_goff; _Pragma("unroll") for (int i_ = 0; i_ < 4; ++i_) \
        __builtin_amdgcn_global_load_lds((const unsigned*)(g_ + 16 * i_), (PG_LAS unsigned*)(lds + 81920 + h * 4096 + i_ * 1024), 16, 0, 0); } while (0)
#define ATT_BAR do { asm volatile("s_waitcnt lgkmcnt(0)" ::: "memory"); __builtin_amdgcn_s_barrier(); asm volatile("" ::: "memory"); } while (0)
#define ATT_QK(dst, stage) do { PG_LAS unsigned char* kb_ = lds + (stage) * 16384 + kvh * 8192; dst = (f32x16){}; _Pragma("unroll") for (int s4 = 0; s4 < 4; ++s4) { \
        const pg::bf16x8 kf_ = *(const PG_LAS pg::bf16x8*)(kb_ + k_row + 16 * ((2 * s4 + hh) ^ k_sw)); dst = __builtin_amdgcn_mfma_f32_32x32x16_bf16(kf_, qf[s4], dst, 0, 0, 0); } } while (0)
    ATT_DMA_Q(cur, 0);
    ATT_DMA_TILE(0, 0); ATT_DMA_TILE(1, 1); ATT_DMA_TILE(2, 2); ATT_DMA_TILE(3, 3);
    asm volatile("s_waitcnt vmcnt(4)" ::: "memory");
    ATT_BAR;
    pg::bf16x8 qf[4];
#pragma unroll
    for (int s4 = 0; s4 < 4; ++s4) qf[s4] = *(const PG_LAS pg::bf16x8*)(lds + 81920 + h * 4096 + s4 * 1024 + lane * 16);
    f32x16 scur; ATT_QK(scur, 0);
    int j = 0, sj = 0;
    for (int kk = 0; ; ++kk) {
        const int nit = att_item(c, kk + 1, sch); const bool has_next = nit >= 0; const AttIt nxt = has_next ? att_decode(nit) : cur;
        float m = sink, lsum = 0.f;
        f32x16 o0 = {}, o1 = {};
        const int nt = cur.nt;
        for (int t = 0; t < nt; ++t, ++j) {
            const int s1 = sj == 4 ? 0 : sj + 1, s4g = sj == 0 ? 4 : sj - 1;
            if (t == 0) ATT_DMA_Q(nxt, 0);
            ATT_DMA_TILE(s4g, j + 4);
            const unsigned vbs = (unsigned)(size_t)lds + (unsigned)sj * 16384u;
            v2u va[2][2], vc[2][2];
#pragma unroll
            for (int dt = 0; dt < 2; ++dt) { const unsigned ad = vbs + trv[dt];
                asm volatile("ds_read_b64_tr_b16 %0, %1" : "=v"(va[0][dt]) : "v"(ad));
                asm volatile("ds_read_b64_tr_b16 %0, %1 offset:1024" : "=v"(vc[0][dt]) : "v"(ad));
                asm volatile("ds_read_b64_tr_b16 %0, %1 offset:2048" : "=v"(va[1][dt]) : "v"(ad));
                asm volatile("ds_read_b64_tr_b16 %0, %1 offset:3072" : "=v"(vc[1][dt]) : "v"(ad)); }
            v4u kf[4];
            { const unsigned kbs = (unsigned)(size_t)lds + (unsigned)s1 * 16384u;
#pragma unroll
              for (int s4 = 0; s4 < 4; ++s4) asm volatile("ds_read_b128 %0, %1" : "=v"(kf[s4]) : "v"(kbs + koff[s4])); }
            if (t == nt - 1) {
#pragma unroll
                for (int s4 = 0; s4 < 4; ++s4) qf[s4] = *(const PG_LAS pg::bf16x8*)(lds + 81920 + h * 4096 + s4 * 1024 + lane * 16); }
            f32x16 sacc = scur;
            const int ti = (t < 8) ? -1 : cur.ilo + t - 8;
            if (ti == 0 || ti == 8) {
#pragma unroll
                for (int i = 0; i < 16; ++i) { const int kq = (i & 3) + 8 * (i >> 2) + 4 * hh; const bool ok = (ti == 0) ? (kq >= qr) : (kq <= qr); sacc[i] = ok ? sacc[i] : -1.0e30f; }
            }
            float mt = sacc[0];
#pragma unroll
            for (int i = 1; i < 16; ++i) mt = fmaxf(mt, sacc[i]);
            mt = hmax32(mt);
            const bool grow = mt > m + 8.f;
            if (__any(grow)) {
                const float mn = grow ? mt : m, alpha = __builtin_amdgcn_exp2f(m - mn); m = mn; lsum *= alpha;
#pragma unroll
                for (int i = 0; i < 16; ++i) { o0[i] *= alpha; o1[i] *= alpha; } }
            asm volatile("s_waitcnt lgkmcnt(0)" : "+v"(kf[0]), "+v"(kf[1]), "+v"(kf[2]), "+v"(kf[3]), "+v"(va[0][0]), "+v"(vc[0][0]), "+v"(va[0][1]), "+v"(vc[0][1]), "+v"(va[1][0]), "+v"(vc[1][0]), "+v"(va[1][1]), "+v"(vc[1][1]));
            f32x16 snext = {}; f32x2 ps2 = {0.f, 0.f}; const f32x2 mm = {m, m};
#pragma unroll
            for (int g = 0; g < 4; ++g) {
                snext = __builtin_amdgcn_mfma_f32_32x32x16_bf16(__builtin_bit_cast(pg::bf16x8, kf[g]), qf[g], snext, 0, 0, 0);
#pragma unroll
                for (int i = 2 * g; i < 2 * g + 2; ++i) { const f32x2 d = (f32x2){sacc[2 * i], sacc[2 * i + 1]} - mm; const f32x2 ev = {__builtin_amdgcn_exp2f(d.x), __builtin_amdgcn_exp2f(d.y)};
                    sacc[2 * i] = ev.x; sacc[2 * i + 1] = ev.y; ps2 += ev; }
                __builtin_amdgcn_sched_barrier(0);
            }
            lsum += ps2.x + ps2.y;
#pragma unroll
            for (int s2 = 0; s2 < 2; ++s2) {
                v4u pw; pw.x = cvt_pk_bf16(sacc[8 * s2 + 0], sacc[8 * s2 + 1]); pw.y = cvt_pk_bf16(sacc[8 * s2 + 2], sacc[8 * s2 + 3]);
                pw.z = cvt_pk_bf16(sacc[8 * s2 + 4], sacc[8 * s2 + 5]); pw.w = cvt_pk_bf16(sacc[8 * s2 + 6], sacc[8 * s2 + 7]);
                const pg::bf16x8 pf = __builtin_bit_cast(pg::bf16x8, pw);
#pragma unroll
                for (int dt = 0; dt < 2; ++dt) {
                    const pg::bf16x8 vf = __builtin_bit_cast(pg::bf16x8, (v4u){va[s2][dt].x, va[s2][dt].y, vc[s2][dt].x, vc[s2][dt].y});
                    if (dt == 0) o0 = __builtin_amdgcn_mfma_f32_32x32x16_bf16(vf, pf, o0, 0, 0, 0);
                    else o1 = __builtin_amdgcn_mfma_f32_32x32x16_bf16(vf, pf, o1, 0, 0, 0);
                }
            }
            scur = snext;
            if (t == 0) asm volatile("s_waitcnt vmcnt(8)" ::: "memory"); else asm volatile("s_waitcnt vmcnt(4)" ::: "memory");
            ATT_BAR;
            sj = s1;
        }
        const float ltot = hsum32(lsum);
        const float inv = __builtin_amdgcn_rcpf(ltot + __builtin_amdgcn_exp2f(sink - m));
        float sq = 0.f;
#pragma unroll
        for (int i = 0; i < 16; ++i) { o0[i] *= inv; o1[i] *= inv; sq += o0[i] * o0[i] + o1[i] * o1[i]; }
        sq = hsum32(sq);
        if (hh == 0) ssq[h * 32 + qr] = sq;
        ATT_BAR;
        float tot = 0.f;
#pragma unroll
        for (int w = 0; w < 8; ++w) tot += ssq[w * 32 + qr];
        const float rstd = rsqrtf(tot * (1.f / 512.f) + EPS);
        bf16* orow = MIX + (size_t)(cur.tq0 + qr) * D + h * 64;
#pragma unroll
        for (int dt = 0; dt < 2; ++dt)
#pragma unroll
            for (int i4 = 0; i4 < 4; ++i4) { const int d = 32 * dt + 8 * i4 + 4 * hh; const f32x4 gg = *(const PG_LAS f32x4*)(gl + h * 64 + d);
                const f32x16& oo = dt == 0 ? o0 : o1;
                v2u w; w.x = cvt_pk_bf16(oo[4 * i4 + 0] * rstd * gg.x, oo[4 * i4 + 1] * rstd * gg.y); w.y = cvt_pk_bf16(oo[4 * i4 + 2] * rstd * gg.z, oo[4 * i4 + 3] * rstd * gg.w);
                *(v2u*)(orow + d) = w; }
        if (!has_next) break;
        cur = nxt;
    }
    asm volatile("s_waitcnt vmcnt(0)" ::: "memory");
    __syncthreads();
#undef ATT_DMA_TILE
#undef ATT_QK
#undef ATT_BAR
#undef ATT_DMA_Q
}
__global__ void __launch_bounds__(NTHR, 2) k_attn(P a, int l) {
    extern __shared__ __attribute__((aligned(16))) unsigned char smem[];
    a.wv = __builtin_amdgcn_readfirstlane(threadIdx.x >> 6);
    attn_phase<0>(a, l, (PG_LAS unsigned char*)smem, (int)gridDim.x, (int)blockIdx.x, 0); attn_phase<0>(a, l, (PG_LAS unsigned char*)smem, (int)gridDim.x, (int)blockIdx.x, 1);
}

__device__ __forceinline__ float scan_sum(float v, int) { return dpp_scan<false>(v); }
__device__ __forceinline__ float scan_max(float v, int) { return dpp_scan<true>(v); }
constexpr int ML_ITEMS = NB * NCHUNK;
constexpr int ML_LDS = 65536 + 65536 + 16384;
__device__ __forceinline__ void ml_load_v(const bf16* U, int tk0, PG_LAS unsigned char* lds, int tid) {
#pragma unroll
    for (int i = 0; i < 8; ++i) { const int cid = tid + 512 * i, sg = cid >> 6, r = cid & 63, hv = r >> 4, ch = r & 15;
        const v4u v = *(const v4u*)(U + (size_t)(tk0 + sg) * UW + U_VM + hv * 128 + ch * 8);
        *(PG_LAS v4u*)(lds + hv * 16384 + sg * 256 + ((ch * 16) ^ ((sg & 3) << 6))) = v; }
}
__device__ __forceinline__ float ml_tok(const bf16* U, int tk, int lo, int hi, int col) { return (tk >= lo && tk < hi) ? bf2f(U[(size_t)tk * UW + col]) : 0.f; }

template <int NT> __device__ __forceinline__ void conv8(const P& a, int l, const bf16* U, int tk0, int s0, int lo, int hi, int ch0, float (&out)[NT][8]) {
    float cw[5][8], cb[8];
#pragma unroll
    for (int j = 0; j < 5; ++j) { const f32x4 w0 = *(const f32x4*)(a.conv_w + (l * 5 + j) * 512 + ch0), w1 = *(const f32x4*)(a.conv_w + (l * 5 + j) * 512 + ch0 + 4);
        cw[j][0] = w0.x; cw[j][1] = w0.y; cw[j][2] = w0.z; cw[j][3] = w0.w; cw[j][4] = w1.x; cw[j][5] = w1.y; cw[j][6] = w1.z; cw[j][7] = w1.w; }
    { const f32x4 b0 = *(const f32x4*)(a.conv_b + l * 512 + ch0), b1 = *(const f32x4*)(a.conv_b + l * 512 + ch0 + 4);
      cb[0] = b0.x; cb[1] = b0.y; cb[2] = b0.z; cb[3] = b0.w; cb[4] = b1.x; cb[5] = b1.y; cb[6] = b1.z; cb[7] = b1.w; }
    v4u rows[NT + 4];
#pragma unroll
    for (int r = 0; r < NT + 4; ++r) { const int tk = tk0 + s0 + r - 2; const bool ok = tk >= lo && tk < hi; const int tkc = tk < lo ? lo : (tk >= hi ? hi - 1 : tk);
        const v4u v = *(const v4u*)(U + (size_t)tkc * UW + U_QM + ch0); rows[r] = ok ? v : (v4u){0u, 0u, 0u, 0u}; }
#pragma unroll
    for (int i = 0; i < NT; ++i) {
        float y[8];
#pragma unroll
        for (int c = 0; c < 8; ++c) y[c] = cb[c];
#pragma unroll
        for (int j = 0; j < 5; ++j) { const v4u x = rows[i + j];
            y[0] += cw[j][0] * bf_lo(x.x); y[1] += cw[j][1] * bf_hi(x.x); y[2] += cw[j][2] * bf_lo(x.y); y[3] += cw[j][3] * bf_hi(x.y);
            y[4] += cw[j][4] * bf_lo(x.z); y[5] += cw[j][5] * bf_hi(x.z); y[6] += cw[j][6] * bf_lo(x.w); y[7] += cw[j][7] * bf_hi(x.w); }
#pragma unroll
        for (int c = 0; c < 8; ++c) out[i][c] = silu_f(y[c]);
    }
}

__device__ __forceinline__ void ml_d1_phase(const P& a_in, int l, PG_LAS unsigned char* lds, int G, int c0) {
    PHASE_ENTRY(a_in)
    const int tid = otid(), lane = tid & 63, wave = __builtin_amdgcn_readfirstlane(tid >> 6), hd = wave >> 1, dir = wave & 1;
    const int hh = lane >> 5, lr = lane & 31, tr_q = (lane & 15) >> 2, tr_p = lane & 3, tr_g = (lane >> 4) & 1;
    const bf16* U = (const bf16*)(a.ws + WS_U); const float* GT = (const float*)(a.ws + WS_GATES);
    bf16* ST = (bf16*)(a.ws + WS_ST); float* NL = (float*)(a.ws + WS_NL); float* SC = (float*)(a.ws + WS_SC);
    PG_LAS unsigned char* kwt = lds + 65536;
    PG_LAS float* wts = (PG_LAS float*)(lds + 131072);
    for (int item = c0; item < ML_ITEMS; item += G) {
        const int b = item / NCHUNK, c = item - b * NCHUNK, tk0 = b * TPB + 64 * c;
        const int lo = c < 4 ? b * TPB : b * TPB + CTX, hi = c < 4 ? b * TPB + CTX : (b + 1) * TPB;
        const int cc = ((b * 4 + hd) * 2 + dir) * NCHUNK + c;
        ml_load_v(U, tk0, lds, tid);
        {
            const int t = dir ? 63 - lane : lane;
            const float li = GT[(size_t)(tk0 + t) * 16 + dir * 8 + hd], lf = logsigmoid_f(GT[(size_t)(tk0 + t) * 16 + dir * 8 + 4 + hd]);
            const float bc = scan_sum(lf, lane), bend = lane_bcast(bc, 63);
            const float g = bend - bc + li, mloc = wave_max(g);
            wts[wave * 64 + t] = __expf(g - mloc);
            if (lane == 0) { SC[(size_t)cc * 4 + 0] = bend; SC[(size_t)cc * 4 + 1] = mloc; }
        }
        __syncthreads();
        {
            const int chg = tid & 31, sb = tid >> 5, s0 = 4 * sb, khd = chg >> 3, d0 = (chg & 7) * 8;
            float kv[4][8];
            conv8<4>(a, l, U, tk0, s0, lo, hi, 256 + 8 * chg, kv);
#pragma unroll
            for (int i = 0; i < 4; ++i) { const int sg = s0 + i;
#pragma unroll
                for (int dd = 0; dd < 2; ++dd) { const float w = wts[(khd * 2 + dd) * 64 + sg];
                    v4u o; o.x = cvt_pk_bf16(kv[i][0] * w, kv[i][1] * w); o.y = cvt_pk_bf16(kv[i][2] * w, kv[i][3] * w); o.z = cvt_pk_bf16(kv[i][4] * w, kv[i][5] * w); o.w = cvt_pk_bf16(kv[i][6] * w, kv[i][7] * w);
                    *(PG_LAS v4u*)(kwt + (khd * 2 + dd) * 8192 + sg * 128 + ((2 * d0) ^ (((sg >> 1) & 1) << 6))) = o; } }
        }
        __syncthreads();
        PG_LAS unsigned char* kw = kwt + wave * 8192;
        {
            float ns = 0.f;
#pragma unroll 8
            for (int sg = 0; sg < 64; ++sg) ns += bf2f(*(const PG_LAS bf16*)(kw + sg * 128 + ((2 * lane) ^ (((sg >> 1) & 1) << 6))));
            NL[(size_t)cc * 64 + lane] = ns;
        }
        pg::bf16x8 af[2][4];
#pragma unroll
        for (int dt = 0; dt < 2; ++dt)
#pragma unroll
            for (int s4 = 0; s4 < 4; ++s4) { const int r1 = 16 * s4 + 8 * hh + tr_q, r2 = r1 + 4; const int dbyte = 2 * (32 * dt + 16 * tr_g + 4 * tr_p);
                const v4s v1 = __builtin_amdgcn_ds_read_tr16_b64_v4i16((PG_LAS v4s*)(kw + r1 * 128 + (dbyte ^ (((r1 >> 1) & 1) << 6))));
                const v4s v2 = __builtin_amdgcn_ds_read_tr16_b64_v4i16((PG_LAS v4s*)(kw + r2 * 128 + (dbyte ^ (((r2 >> 1) & 1) << 6))));
                af[dt][s4] = (pg::bf16x8){v1[0], v1[1], v1[2], v1[3], v2[0], v2[1], v2[2], v2[3]}; }
        PG_LAS unsigned char* vb = lds + hd * 16384;
#pragma unroll
        for (int et = 0; et < 4; ++et) {
            pg::bf16x8 bfr[4];
            const int ebyte = 2 * (32 * et + 16 * tr_g + 4 * tr_p);
#pragma unroll
            for (int s4 = 0; s4 < 4; ++s4) { const int r1 = 16 * s4 + 8 * hh + tr_q, r2 = r1 + 4;
                const v4s v1 = __builtin_amdgcn_ds_read_tr16_b64_v4i16((PG_LAS v4s*)(vb + r1 * 256 + (ebyte ^ ((r1 & 3) << 6))));
                const v4s v2 = __builtin_amdgcn_ds_read_tr16_b64_v4i16((PG_LAS v4s*)(vb + r2 * 256 + (ebyte ^ ((r2 & 3) << 6))));
                bfr[s4] = (pg::bf16x8){v1[0], v1[1], v1[2], v1[3], v2[0], v2[1], v2[2], v2[3]}; }
#pragma unroll
            for (int dt = 0; dt < 2; ++dt) {
                f32x16 acc = {};
#pragma unroll
                for (int s4 = 0; s4 < 4; ++s4) acc = __builtin_amdgcn_mfma_f32_32x32x16_bf16(af[dt][s4], bfr[s4], acc, 0, 0, 0);
                v4u o0, o1;
                o0.x = cvt_pk_bf16(acc[0], acc[1]); o0.y = cvt_pk_bf16(acc[2], acc[3]); o0.z = cvt_pk_bf16(acc[4], acc[5]); o0.w = cvt_pk_bf16(acc[6], acc[7]);
                o1.x = cvt_pk_bf16(acc[8], acc[9]); o1.y = cvt_pk_bf16(acc[10], acc[11]); o1.z = cvt_pk_bf16(acc[12], acc[13]); o1.w = cvt_pk_bf16(acc[14], acc[15]);
                bf16* dst = ST + ((size_t)cc * 8 + dt * 4 + et) * 1024 + lane * 16;
                *(v4u*)dst = o0; *(v4u*)(dst + 8) = o1;
            }
        }
        __syncthreads();
    }
}
__device__ __forceinline__ void ml_d2_phase(const P& a_in, int wg) {
    PHASE_ENTRY(a_in)
    const int tid = otid(), chain = wg >> 2, quarter = wg & 3, dir = chain & 1;
    bf16* ST = (bf16*)(a.ws + WS_ST); float* NL = (float*)(a.ws + WS_NL); float* SC = (float*)(a.ws + WS_SC);
    const bool cw = tid < 256, nw = (quarter == 0 && tid >= 256 && tid < 320);
    if (cw || nw) {
    float st[8];
#pragma unroll
    for (int j = 0; j < 8; ++j) st[j] = 0.f;
    float nst = 0.f, m = 0.f;
    const size_t unit = (size_t)(quarter * 256 + tid) * 8;
#pragma unroll 1
    for (int i0 = 0; i0 < NCHUNK; i0 += 4) {
        v4u x[4]; float nx[4], be[4], ml[4]; int cidx[4];
#pragma unroll
        for (int k = 0; k < 4; ++k) { const int i = i0 + k; const int c = dir == 0 ? i : (i < 4 ? 3 - i : 71 - i); cidx[k] = chain * NCHUNK + c;
            be[k] = SC[(size_t)cidx[k] * 4]; ml[k] = SC[(size_t)cidx[k] * 4 + 1];
            if (cw) x[k] = *(const v4u*)(ST + (size_t)cidx[k] * 8192 + unit); else nx[k] = NL[(size_t)cidx[k] * 64 + (tid - 256)]; }
#pragma unroll
        for (int k = 0; k < 4; ++k) {
            const float mn = fmaxf(be[k] + m, ml[k]), fa = __expf(be[k] + m - mn), fb = __expf(ml[k] - mn);
            if (cw) {
                v4u o; o.x = pk2(st[0], st[1]); o.y = pk2(st[2], st[3]); o.z = pk2(st[4], st[5]); o.w = pk2(st[6], st[7]);
                *(v4u*)(ST + (size_t)cidx[k] * 8192 + unit) = o;
                st[0] = fa * st[0] + fb * bf_lo(x[k].x); st[1] = fa * st[1] + fb * bf_hi(x[k].x); st[2] = fa * st[2] + fb * bf_lo(x[k].y); st[3] = fa * st[3] + fb * bf_hi(x[k].y);
                st[4] = fa * st[4] + fb * bf_lo(x[k].z); st[5] = fa * st[5] + fb * bf_hi(x[k].z); st[6] = fa * st[6] + fb * bf_lo(x[k].w); st[7] = fa * st[7] + fb * bf_hi(x[k].w);
            } else {
                NL[(size_t)cidx[k] * 64 + (tid - 256)] = nst; nst = fa * nst + fb * nx[k];
                if (tid == 256) SC[(size_t)cidx[k] * 4 + 2] = m;
            }
            m = mn;
        }
    }
    }
}
__device__ __forceinline__ void ml_d3_phase(const P& a_in, int l, PG_LAS unsigned char* lds, int G, int c0) {
    PHASE_ENTRY(a_in)
    const int tid = otid(), wave = __builtin_amdgcn_readfirstlane(tid >> 6), hd = wave >> 1, qt = wave & 1;
    const bf16* U = (const bf16*)(a.ws + WS_U); const float* GT = (const float*)(a.ws + WS_GATES);
    const bf16* ST = (const bf16*)(a.ws + WS_ST); const float* NL = (const float*)(a.ws + WS_NL); const float* SC = (const float*)(a.ws + WS_SC);
    bf16* MIX = (bf16*)(a.ws + WS_MIX);
    PG_LAS unsigned char* qtile = lds + 65536 + hd * 16384;
    PG_LAS unsigned char* ktile = qtile + 8192;
    PG_LAS float* aarr = (PG_LAS float*)(lds + 131072 + wave * 2048);
    { const int ln_ = otid() & 63; const float* gm_ = a.g_ml + l * 512 + hd * 128; aarr[320 + ln_] = gm_[ln_]; aarr[384 + ln_] = gm_[64 + ln_]; }
    for (int item = c0; item < ML_ITEMS; item += G) {
        int lane = tid & 63; asm volatile("" : "+v"(lane));
        const int hh = lane >> 5, lr = lane & 31, tr_q = (lane & 15) >> 2, tr_p = lane & 3, tr_g = (lane >> 4) & 1;
        const int tq = 32 * qt + lr;
        const int b = item / NCHUNK, c = item - b * NCHUNK, tk0 = b * TPB + 64 * c;
        const int lo = c < 4 ? b * TPB : b * TPB + CTX, hi = c < 4 ? b * TPB + CTX : (b + 1) * TPB;
        float gli[2], glf[2], gmp[2];
#pragma unroll
        for (int dd = 0; dd < 2; ++dd) { const int t = dd ? 63 - lane : lane;
            gli[dd] = GT[(size_t)(tk0 + t) * 16 + dd * 8 + hd]; glf[dd] = GT[(size_t)(tk0 + t) * 16 + dd * 8 + 4 + hd]; gmp[dd] = SC[(size_t)(((b * 4 + hd) * 2 + dd) * NCHUNK + c) * 4 + 2]; }
        ml_load_v(U, tk0, lds, tid);
#pragma unroll
        for (int dd = 0; dd < 2; ++dd) aarr[192 + dd * 64 + lane] = NL[(size_t)(((b * 4 + hd) * 2 + dd) * NCHUNK + c) * 64 + lane];
        {
            const int chg = tid & 63, s0 = 8 * (tid >> 6), ch0 = 8 * chg;
            float kv[8][8];
            conv8<8>(a, l, U, tk0, s0, lo, hi, ch0, kv);
            PG_LAS unsigned char* dstt = lds + 65536 + ((ch0 & 255) >> 6) * 16384 + (ch0 >> 8) * 8192;
            const float qsc = ch0 < 256 ? 0.125f : 1.f; const int chunk = (ch0 & 63) >> 3;
#pragma unroll
            for (int i = 0; i < 8; ++i) { const int sg = s0 + i;
                v4u o; o.x = cvt_pk_bf16(kv[i][0] * qsc, kv[i][1] * qsc); o.y = cvt_pk_bf16(kv[i][2] * qsc, kv[i][3] * qsc); o.z = cvt_pk_bf16(kv[i][4] * qsc, kv[i][5] * qsc); o.w = cvt_pk_bf16(kv[i][6] * qsc, kv[i][7] * qsc);
                *(PG_LAS v4u*)(dstt + sg * 128 + 16 * (chunk ^ ((sg >> 1) & 7))) = o; }
        }
        __syncthreads();
#define D3_QF(s4) ({ const int sw_ = (tq >> 1) & 7; \
            const v2u lo2_ = *(const PG_LAS v2u*)(qtile + tq * 128 + 16 * ((2 * (s4)) ^ sw_) + 8 * hh), hi2_ = *(const PG_LAS v2u*)(qtile + tq * 128 + 16 * ((2 * (s4) + 1) ^ sw_) + 8 * hh); \
            __builtin_bit_cast(pg::bf16x8, (v4u){lo2_.x, lo2_.y, hi2_.x, hi2_.y}); })
        f32x16 hs[4];
#pragma unroll
        for (int et = 0; et < 4; ++et) hs[et] = (f32x16){};
#pragma unroll 1
        for (int dir = 0; dir < 2; ++dir) {
            const int cc = ((b * 4 + hd) * 2 + dir) * NCHUNK + c;
            const float mprev = dir ? gmp[1] : gmp[0];
            {
                const int t = dir ? 63 - lane : lane;
                const float li = dir ? gli[1] : gli[0], lf = logsigmoid_f(dir ? glf[1] : glf[0]);
                const float bc = scan_sum(lf, lane), av = li - bc, pm = scan_max(av, lane), Mv = fmaxf(mprev, pm);
                aarr[t] = av; aarr[64 + t] = Mv; aarr[128 + t] = bc;
            }
            const float Mq = aarr[64 + tq], bq = aarr[128 + tq];
            const float wq = __expf(mprev - Mq);
            pg::bf16x8 cs[2][2][2];
#pragma unroll
            for (int dt = 0; dt < 2; ++dt) { const bf16* src = ST + ((size_t)cc * 8 + dt * 4) * 1024 + lane * 16; cs[0][dt][0] = *(const pg::bf16x8*)src; cs[0][dt][1] = *(const pg::bf16x8*)(src + 8); }
            float qn = 0.f;
#pragma unroll
            for (int s4 = 0; s4 < 4; ++s4) { const f32x4 n0 = *(const PG_LAS f32x4*)(aarr + 192 + dir * 64 + 16 * s4 + 4 * hh), n1 = *(const PG_LAS f32x4*)(aarr + 192 + dir * 64 + 16 * s4 + 8 + 4 * hh);
                const v4u qw = __builtin_bit_cast(v4u, D3_QF(s4));
                qn += bf_lo(qw.x) * n0.x + bf_hi(qw.x) * n0.y + bf_lo(qw.y) * n0.z + bf_hi(qw.y) * n0.w + bf_lo(qw.z) * n1.x + bf_hi(qw.z) * n1.y + bf_lo(qw.w) * n1.z + bf_hi(qw.w) * n1.w; }
            qn = hsum32(qn);
            pg::bf16x8 pf[2][2]; float psum = 0.f;
#pragma unroll
            for (int st = 0; st < 2; ++st) {
                f32x16 acc = {}; const int sg = 32 * st + lr, sw = (sg >> 1) & 7;
#pragma unroll
                for (int s4 = 0; s4 < 4; ++s4) {
                    const v2u lo2 = *(const PG_LAS v2u*)(ktile + sg * 128 + 16 * ((2 * s4) ^ sw) + 8 * hh), hi2 = *(const PG_LAS v2u*)(ktile + sg * 128 + 16 * ((2 * s4 + 1) ^ sw) + 8 * hh);
                    const pg::bf16x8 kf = __builtin_bit_cast(pg::bf16x8, (v4u){lo2.x, lo2.y, hi2.x, hi2.y});
                    acc = __builtin_amdgcn_mfma_f32_32x32x16_bf16(kf, D3_QF(s4), acc, 0, 0, 0); }
#pragma unroll
                for (int i4 = 0; i4 < 4; ++i4) { const f32x4 av = *(const PG_LAS f32x4*)(aarr + 32 * st + 8 * i4 + 4 * hh);
#pragma unroll
                    for (int j = 0; j < 4; ++j) { const int sgk = 32 * st + 8 * i4 + 4 * hh + j; const bool ok = dir ? (sgk >= tq) : (sgk <= tq);
                        const float p = ok ? acc[4 * i4 + j] * __expf(av[j] - Mq) : 0.f; acc[4 * i4 + j] = p; psum += p; } }
#pragma unroll
                for (int s2 = 0; s2 < 2; ++s2) { v4u pw; pw.x = cvt_pk_bf16(acc[8 * s2 + 0], acc[8 * s2 + 1]); pw.y = cvt_pk_bf16(acc[8 * s2 + 2], acc[8 * s2 + 3]);
                    pw.z = cvt_pk_bf16(acc[8 * s2 + 4], acc[8 * s2 + 5]); pw.w = cvt_pk_bf16(acc[8 * s2 + 6], acc[8 * s2 + 7]); pf[st][s2] = __builtin_bit_cast(pg::bf16x8, pw); }
            }
            psum = hsum32(psum);
            const float den = psum + wq * qn;
            const float rden = __builtin_amdgcn_rcpf(fmaxf(fabsf(den), __expf(-(bq + Mq))));
            PG_LAS unsigned char* vb = lds + hd * 16384;
#pragma unroll
            for (int dt = 0; dt < 2; ++dt) { const bf16* src = ST + ((size_t)cc * 8 + dt * 4 + 1) * 1024 + lane * 16; cs[1][dt][0] = *(const pg::bf16x8*)src; cs[1][dt][1] = *(const pg::bf16x8*)(src + 8); }
#pragma unroll
            for (int et = 0; et < 4; ++et) {
                f32x16 acc = {};
#pragma unroll
                for (int dt = 0; dt < 2; ++dt) {
                    acc = __builtin_amdgcn_mfma_f32_32x32x16_bf16(cs[et & 1][dt][0], D3_QF(2 * dt), acc, 0, 0, 0);
                    acc = __builtin_amdgcn_mfma_f32_32x32x16_bf16(cs[et & 1][dt][1], D3_QF(2 * dt + 1), acc, 0, 0, 0); }
                if (et < 2) {
#pragma unroll
                    for (int dt = 0; dt < 2; ++dt) { const bf16* src = ST + ((size_t)cc * 8 + dt * 4 + et + 2) * 1024 + lane * 16; cs[et & 1][dt][0] = *(const pg::bf16x8*)src; cs[et & 1][dt][1] = *(const pg::bf16x8*)(src + 8); } }
#pragma unroll
                for (int i = 0; i < 16; ++i) acc[i] *= wq;
                const int ebyte = 2 * (32 * et + 16 * tr_g + 4 * tr_p);
#pragma unroll
                for (int st = 0; st < 2; ++st)
#pragma unroll
                    for (int s2 = 0; s2 < 2; ++s2) { const int r1 = 32 * st + 16 * s2 + 4 * hh + tr_q, r2 = r1 + 8;
                        const v4s v1 = __builtin_amdgcn_ds_read_tr16_b64_v4i16((PG_LAS v4s*)(vb + r1 * 256 + (ebyte ^ ((r1 & 3) << 6))));
                        const v4s v2 = __builtin_amdgcn_ds_read_tr16_b64_v4i16((PG_LAS v4s*)(vb + r2 * 256 + (ebyte ^ ((r2 & 3) << 6))));
                        const pg::bf16x8 vf = {v1[0], v1[1], v1[2], v1[3], v2[0], v2[1], v2[2], v2[3]};
                        acc = __builtin_amdgcn_mfma_f32_32x32x16_bf16(vf, pf[st][s2], acc, 0, 0, 0); }
                hs[et] += acc * rden;
            }
        }
        const bf16* om = U + (size_t)(tk0 + tq) * UW + U_OM + hd * 128;
        v2u ov[4][4];
#pragma unroll
        for (int et = 0; et < 4; ++et)
#pragma unroll
            for (int i4 = 0; i4 < 4; ++i4) ov[et][i4] = *(const v2u*)(om + 32 * et + 8 * i4 + 4 * hh);
        float sq = 0.f;
#pragma unroll
        for (int et = 0; et < 4; ++et)
#pragma unroll
            for (int i = 0; i < 16; ++i) sq += hs[et][i] * hs[et][i];
        sq = hsum32(sq);
        const float rstd = rsqrtf(sq * (1.f / 128.f) + EPS);
        bf16* orow = MIX + (size_t)(tk0 + tq) * D + 512 + hd * 128;
#pragma unroll
        for (int et = 0; et < 4; ++et)
#pragma unroll
            for (int i4 = 0; i4 < 4; ++i4) { const int e = 32 * et + 8 * i4 + 4 * hh; const f32x4 gg = *(const PG_LAS f32x4*)(aarr + 320 + e); const v2u o2 = ov[et][i4];
                const float y0 = hs[et][4 * i4 + 0] * rstd * gg.x * sigmoid_f(bf_lo(o2.x)), y1 = hs[et][4 * i4 + 1] * rstd * gg.y * sigmoid_f(bf_hi(o2.x));
                const float y2 = hs[et][4 * i4 + 2] * rstd * gg.z * sigmoid_f(bf_lo(o2.y)), y3 = hs[et][4 * i4 + 3] * rstd * gg.w * sigmoid_f(bf_hi(o2.y));
                v2u w; w.x = cvt_pk_bf16(y0, y1); w.y = cvt_pk_bf16(y2, y3); *(v2u*)(orow + e) = w; }
        __syncthreads();
    }
}
__global__ void __launch_bounds__(NTHR, 2) k_ml_d1(P a, int l) { a.wv = __builtin_amdgcn_readfirstlane(threadIdx.x >> 6); extern __shared__ __attribute__((aligned(16))) unsigned char smem[]; ml_d1_phase(a, l, (PG_LAS unsigned char*)smem, (int)gridDim.x, (int)blockIdx.x); }
__global__ void __launch_bounds__(NTHR, 2) k_ml_d2(P a) { a.wv = __builtin_amdgcn_readfirstlane(threadIdx.x >> 6); ml_d2_phase(a, (int)blockIdx.x); }
__global__ void __launch_bounds__(NTHR, 2) k_ml_d3(P a, int l) { a.wv = __builtin_amdgcn_readfirstlane(threadIdx.x >> 6); extern __shared__ __attribute__((aligned(16))) unsigned char smem[]; ml_d3_phase(a, l, (PG_LAS unsigned char*)smem, (int)gridDim.x, (int)blockIdx.x); }

#define XB_TMO      128
#define XB_XCNT(j)  (256  + 64 * (j))
#define XB_XSUB(j)  (1280 + 64 * (j))
#define XB_XGEN(j)  (2304 + 64 * (j))
#define XB_TOP      3328
#define XB_TOPGEN   3392
#define XCD_BAR_WORDS 3456
#define XB_SPIN_CAP (1u << 20)
__device__ __forceinline__ unsigned xb_ld(unsigned* p)              { return __hip_atomic_load(p, __ATOMIC_RELAXED, __HIP_MEMORY_SCOPE_AGENT); }
__device__ __forceinline__ unsigned xb_add(unsigned* p, unsigned v) { return __hip_atomic_fetch_add(p, v, __ATOMIC_RELAXED, __HIP_MEMORY_SCOPE_AGENT); }
__device__ __forceinline__ unsigned xb_xcc_id() { return (unsigned)__builtin_amdgcn_s_getreg((3 << 11) | 20) & 0xFu; }
#define XB_SPIN(cond, bar) do { unsigned _sp = 0; while (cond) { __builtin_amdgcn_s_sleep(1); \
    if ((++_sp & 255u) == 0u) { if (xb_ld(&(bar)[XB_TMO])) break; if (_sp > XB_SPIN_CAP) { atomicAdd(&(bar)[XB_TMO], 1u); break; } } } } while (0)
struct XcdBarrier { unsigned* bar; unsigned x; volatile PG_LAS unsigned* st; };
__device__ __forceinline__ XcdBarrier xcd_barrier_post(unsigned* bar, volatile PG_LAS unsigned* st, int tid) {
    XcdBarrier b; b.bar = bar; b.x = xb_xcc_id(); b.st = st;
    if (tid == 0) (void)xb_add(&bar[XB_XCNT(b.x)], 1u);
    return b;
}
__device__ __forceinline__ void xcd_barrier_complete(unsigned* bar, unsigned x, unsigned& nloc, unsigned& nx) {
    const unsigned G = gridDim.x * gridDim.y * gridDim.z;
    unsigned sum, cnt, mine, sp = 0u;
    for (;;) {
        sum = 0u; cnt = 0u; mine = 0u;
#pragma unroll
        for (unsigned j = 0; j < 16; ++j) { const unsigned c = xb_ld(&bar[XB_XCNT(j)]); sum += c; cnt += (c > 0u) ? 1u : 0u; mine = (j == x) ? c : mine; }
        if (sum == G) break;
        __builtin_amdgcn_s_sleep(1);
        if ((++sp & 255u) == 0u) { if (xb_ld(&bar[XB_TMO])) break; if (sp > XB_SPIN_CAP) { atomicAdd(&bar[XB_TMO], 1u); break; } }
    }
    nloc = mine > 0u ? mine : 1u; nx = cnt > 0u ? cnt : 1u;
}
__device__ __forceinline__ void xcd_barrier(const XcdBarrier& b, int tid) {
    asm volatile("s_waitcnt vmcnt(0)" ::: "memory");
    __syncthreads();
    if (tid == 0) {
        unsigned* bar = b.bar; asm volatile("" : "+s"(bar)); unsigned bx = b.x; asm volatile("" : "+s"(bx));
        __builtin_amdgcn_s_waitcnt(0);
        unsigned nloc = b.st[0], nx = b.st[1];
        if (nloc == 0u) { xcd_barrier_complete(bar, bx, nloc, nx); b.st[0] = nloc; b.st[1] = nx; }
        const unsigned old = xb_add(&bar[XB_XSUB(bx)], 1u);
        const unsigned gen = old / nloc;
        if (old + 1u == (gen + 1u) * nloc) {
            __builtin_amdgcn_fence(__ATOMIC_RELEASE, "agent");
            asm volatile("s_waitcnt vmcnt(0)" ::: "memory");
            const unsigned og = xb_add(&bar[XB_TOP], 1u);
            const unsigned tg = og / nx;
            if (og + 1u == (tg + 1u) * nx) xb_add(&bar[XB_TOPGEN], 1u);
            else XB_SPIN(xb_ld(&bar[XB_TOPGEN]) == tg, bar);
            __builtin_amdgcn_fence(__ATOMIC_ACQUIRE, "agent");
            xb_add(&bar[XB_XGEN(bx)], 1u);
            asm volatile("s_waitcnt vmcnt(0)" ::: "memory");
        } else {
            XB_SPIN(xb_ld(&bar[XB_XGEN(bx)]) == gen, bar);
            __builtin_amdgcn_fence(__ATOMIC_ACQUIRE, "agent");
            asm volatile("s_waitcnt vmcnt(0)" ::: "memory");
        }
    }
    __syncthreads();
}
__device__ __forceinline__ void modvec_phase(const P& a_in, PG_LAS float* lds, int G, int c) {
    PHASE_ENTRY(a_in)
    PG_LAS float* cond = lds;
    PG_LAS float* red = lds + MODR * D;
    const int t = otid(), kg = t >> 5, cl = t & 31;
    for (int i = t; i < MODR * D; i += NTHR) { const int r = i / D, k = i % D; const float v = r < NB ? a.c[r * D + k] : a.c_ctx[k]; cond[i] = silu_f(v); }
    __syncthreads();
    float* mod = (float*)(a.ws + WS_MOD);
    for (int item = c; item < DEPTH * 192; item += G) {
        const int l = item / 192, nc = item % 192, n = nc * 32 + cl;
        float acc[MODR];
#pragma unroll
        for (int r = 0; r < MODR; ++r) acc[r] = 0.f;
        const float* w = a.w_mod + (size_t)l * D * MODW + n;
#pragma unroll 8
        for (int k = kg * 64; k < kg * 64 + 64; ++k) { const float wv = w[(size_t)k * MODW];
#pragma unroll
            for (int r = 0; r < MODR; ++r) acc[r] += cond[r * D + k] * wv; }
#pragma unroll
        for (int r = 0; r < MODR; ++r) red[(kg * MODR + r) * 32 + cl] = acc[r];
        __syncthreads();
        for (int i = t; i < MODR * 32; i += NTHR) { const int r = i / 32, j = i % 32, nn = nc * 32 + j; float sacc = a.b_mod[l * MODW + nn];
#pragma unroll
            for (int q = 0; q < 16; ++q) sacc += red[(q * MODR + r) * 32 + j];
            mod[((size_t)l * MODR + r) * MODW + nn] = sacc; }
        __syncthreads();
    }
}
__device__ __forceinline__ void conv_dense_weights(const P& a_in, PG_LAS float* scr, int gw, int ngw, int lane) {
    PHASE_ENTRY(a_in)
    conv_dense_range(a, 0, DN_ITEMS, gw, ngw, scr, lane);
}
__device__ __forceinline__ void conv_expert_weights(const P& a_in, int li, PG_LAS float* scr, int gw, int ngw, int lane) {
    PHASE_ENTRY(a_in)
    unsigned char* ws = a.ws;
#pragma unroll 1
    for (int e = 0; e < NE; ++e) {
        tr_matrix(a.exp_w1 + ((size_t)li * NE + e) * D * FFN, D, FFN, FFN, (bf16*)(ws + WS_WE13) + (size_t)e * 2 * FFN * D, 1, scr, gw, ngw, lane);
        tr_matrix(a.exp_w3 + ((size_t)li * NE + e) * D * FFN, D, FFN, FFN, (bf16*)(ws + WS_WE13) + (size_t)e * 2 * FFN * D, 2, scr, gw, ngw, lane);
        tr_matrix(a.exp_w2 + ((size_t)li * NE + e) * FFN * D, FFN, D, D, (bf16*)(ws + WS_WE2) + (size_t)e * D * FFN, 0, scr, gw, ngw, lane);
    }
}
#if MEGA
constexpr int MEGA_LDS = 147456;
__global__ void __launch_bounds__(NTHR, 2) k_mega(P a_k) {
    extern __shared__ __attribute__((aligned(16))) unsigned char smem[];
    PG_LAS unsigned char* lds = (PG_LAS unsigned char*)smem;
    P a = a_k; a.wv = __builtin_amdgcn_readfirstlane(threadIdx.x >> 6);
    const int G = (int)gridDim.x, wg = (int)blockIdx.x;
    volatile PG_LAS unsigned* bst = (volatile PG_LAS unsigned*)(lds + MEGA_LDS - 16);
    if (otid() == 0) { bst[0] = 0u; bst[1] = 0u; bst[2] = 0u; bst[3] = 0u; }
    __syncthreads();
    const XcdBarrier bar = xcd_barrier_post((unsigned*)(a.ws + WS_CTL) + 1024, bst, otid());
    { const int t_ = otid(); conv_dense_weights(a, (PG_LAS float*)smem + (t_ >> 6) * (64 * 33), wg * 8 + (t_ >> 6), G * 8, t_ & 63); }
    __syncthreads();
    modvec_phase(a, (PG_LAS float*)smem, G, wg);
      { for (int i = otid(); i < 64 * 16; i += NTHR) { const int pos = i / 16, f = i % 16; const float ang = (float)pos * powf(10000.0f, -(float)f / 16.0f);
        float* t = (float*)(a.ws + WS_ROPE); t[2 * i] = cosf(ang); t[2 * i + 1] = sinf(ang); } }
    xcd_barrier(bar, otid());
    if (PROBE == 31) { { const int t_ = otid(); conv_dense_weights(a, (PG_LAS float*)smem + (t_ >> 6) * (64 * 33), wg * 8 + (t_ >> 6), G * 8, t_ & 63); } __syncthreads(); modvec_phase(a, (PG_LAS float*)smem, G, wg); xcd_barrier(bar, otid()); }
#pragma unroll 1
    for (int l = 0; l < DEPTH; ++l) {
        if (l == 0) norm_phase<0, true, 0>(a, l, wg, (PG_LAS float*)smem);
        else if (l == 2) norm_phase<0, false, 2>(a, l, wg, (PG_LAS float*)smem, l - 1, 5);
        else norm_phase<0, false, 1>(a, l, wg, (PG_LAS float*)smem, l - 1, 5);
        xcd_barrier(bar, otid());
        gemm_run<EM_IN>(a, l, lds, G, wg);
        xcd_barrier(bar, otid());
        if (PROBE == 6) { gemm_run<EM_IN>(a, l, lds, G, wg); xcd_barrier(bar, otid()); }
        ml_d1_phase(a, l, lds, G, wg);
        attn_phase<0>(a, l, lds, G, wg, 0);
        xcd_barrier(bar, otid());
        if (PROBE == 5) { ml_d1_phase(a, l, lds, G, wg); xcd_barrier(bar, otid()); }
        ml_d2_phase(a, wg);
        { int li_, j0_, j1_; if (conv_sched(l, CP_D2, li_, j0_, j1_)) { __syncthreads(); const int t_ = otid(), wv_ = __builtin_amdgcn_readfirstlane(t_ >> 6);
            conv_expert_range(a, li_, j0_, j1_, wg * 8 + wv_, G * 8, (PG_LAS float*)smem + wv_ * (64 * 33), t_ & 63); } }
        xcd_barrier(bar, otid());
        ml_d3_phase(a, l, lds, G, wg);
        attn_phase<0>(a, l, lds, G, wg, 1);
        xcd_barrier(bar, otid());
        if (PROBE == 2) { ml_d3_phase(a, l, lds, G, wg); xcd_barrier(bar, otid()); }
        if (PROBE == 30) { attn_phase<1>(a, l, lds, G, wg, 1); xcd_barrier(bar, otid()); }
        if (PROBE == 4) { xcd_barrier(bar, otid()); xcd_barrier(bar, otid()); xcd_barrier(bar, otid()); xcd_barrier(bar, otid()); }
        gemm_run<EM_OUT>(a, l, lds, G, wg);
        xcd_barrier(bar, otid());
        if (PROBE == 10) { gemm_run<EM_OUT>(a, l, lds, G, wg); xcd_barrier(bar, otid()); }
        if ((l & 1) == 0) {
            if (l == 0) norm_phase<1, true, 1>(a, l, wg, (PG_LAS float*)smem, l, 2);
            else norm_phase<1, false, 1>(a, l, wg, (PG_LAS float*)smem, l, 2);
            xcd_barrier(bar, otid());
            gemm_run<EM_F1>(a, l, lds, G, wg);
            xcd_barrier(bar, otid());
            if (PROBE == 7) { gemm_run<EM_F1>(a, l, lds, G, wg); xcd_barrier(bar, otid()); }
            if (PROBE == 20 || PROBE == 21) { gemm_run<EM_F1>(a, l, lds, G, wg, true); xcd_barrier(bar, otid()); }
            gemm_run<EM_F2D>(a, l, lds, G, wg);
            xcd_barrier(bar, otid());
            if (PROBE == 11) { gemm_run<EM_F2D>(a, l, lds, G, wg); xcd_barrier(bar, otid()); }
        } else {
            norm_phase<2, false, 1>(a, l, wg, (PG_LAS float*)smem, l, 2);
            xcd_barrier(bar, otid());
            if (PROBE == 12) { norm_phase<2, false, 0>(a, l, wg, (PG_LAS float*)smem, l, 2); xcd_barrier(bar, otid()); }
            moe_pos_phase(a, wg, (int*)smem);
            xcd_barrier(bar, otid());
            gemm_run<EM_F1M>(a, l, lds, G, wg);
            xcd_barrier(bar, otid());
            if (PROBE == 8) { gemm_run<EM_F1M>(a, l, lds, G, wg); xcd_barrier(bar, otid()); }
            gemm_run<EM_F2M>(a, l, lds, G, wg);
            xcd_barrier(bar, otid());
            if (PROBE == 9) { gemm_run<EM_F2M>(a, l, lds, G, wg); xcd_barrier(bar, otid()); }
        }
    }
    norm_phase<3, false, 2>(a, DEPTH, wg, (PG_LAS float*)smem, DEPTH - 1, 5);
}
#endif

#ifndef FAST_IN
#define FAST_IN 1
#endif
#ifndef FAST_OUT
#define FAST_OUT 1
#endif
#ifndef FAST_F1
#define FAST_F1 1
#endif
#ifndef FAST_F2
#define FAST_F2 1
#endif
#ifndef FAST_F1M
#define FAST_F1M 1
#endif
#ifndef FAST_F2M
#define FAST_F2M 1
#endif
constexpr int GEMM_LDS = 131072 + 1024 + 8192;
template <int WHICH> static void launch_gemm(hipStream_t s, const P& a, int l) {
    static bool once = false;
    if (!once) { (void)hipFuncSetAttribute((const void*)k_gemm<WHICH>, hipFuncAttributeMaxDynamicSharedMemorySize, GEMM_LDS); once = true; }
    hipLaunchKernelGGL((k_gemm<WHICH>), dim3(NWG), dim3(NTHR), GEMM_LDS, s, a, l);
}
static void launch_tr(hipStream_t s, const float* W, int K, int ld, int N, bf16* WT, int mode) {
    hipLaunchKernelGGL(k_transpose, dim3(512), dim3(256), 0, s, W, K, ld, N, WT, mode);
}
extern "C" void kernel_launch(void* const* d_in, const int* in_sizes, int n_in, void* d_out, int out_size, void* d_ws, size_t ws_size, hipStream_t stream) {
    if (n_in != 25 || ws_size < WS_END) { fprintf(stderr, "kernel_launch: bad args n_in %d ws %zu need %zu\n", n_in, ws_size, (size_t)WS_END); return; }
    static bool init = false;
    constexpr int NORM_LDS = 8192 * 4 + 8 * 32 * 4 + 64;
    if (!init) {
        init = true;
    }
    P a{};
    const float** f = (const float**)&a;
    for (int i = 0; i < 25; ++i) f[i] = (const float*)d_in[i];
    a.out = (float*)d_out; a.ws = (unsigned char*)d_ws;
    unsigned char* ws = a.ws;
    hipMemsetAsync(ws + WS_CTL, 0, 32768, stream);
#if MEGA
    {
        static bool once = false;
        if (!once) { (void)hipFuncSetAttribute((const void*)k_mega, hipFuncAttributeMaxDynamicSharedMemorySize, MEGA_LDS); once = true; }
        hipLaunchKernelGGL(k_mega, dim3(NWG), dim3(NTHR), MEGA_LDS, stream, a);
        return;
    }
#endif
#if !MEGA
    for (int l = 0; l < DEPTH; ++l) {
        launch_tr(stream, a.w_in + (size_t)l * D * INW, D, INW, UW, (bf16*)(ws + WS_WIN) + (size_t)l * UW * D, 0);
        launch_tr(stream, a.w_out + (size_t)l * D * D, D, D, D, (bf16*)(ws + WS_WOUT) + (size_t)l * D * D, 0);
    }
    for (int i = 0; i < 2; ++i) {
        launch_tr(stream, a.ffn_w1 + (size_t)i * D * FFN, D, FFN, FFN, (bf16*)(ws + WS_WF13) + (size_t)i * 2 * FFN * D, 1);
        launch_tr(stream, a.ffn_w3 + (size_t)i * D * FFN, D, FFN, FFN, (bf16*)(ws + WS_WF13) + (size_t)i * 2 * FFN * D, 2);
        launch_tr(stream, a.ffn_w2 + (size_t)i * FFN * D, FFN, D, D, (bf16*)(ws + WS_WF2) + (size_t)i * D * FFN, 0);
    }
    hipLaunchKernelGGL(k_modvec, dim3(DEPTH * 96), dim3(256), 0, stream, a);
    hipLaunchKernelGGL(k_rope_table, dim3(4), dim3(256), 0, stream, a);
    for (int l = 0; l < DEPTH; ++l) {
        const bool moe = l & 1;
        if (l == 0) hipLaunchKernelGGL((k_norm<0, true, false>), dim3(NWG), dim3(NTHR), NORM_LDS, stream, a, l);
        else if (l == 2) hipLaunchKernelGGL((k_norm<0, false, true>), dim3(NWG), dim3(NTHR), NORM_LDS, stream, a, l);
        else hipLaunchKernelGGL((k_norm<0, false, false>), dim3(NWG), dim3(NTHR), NORM_LDS, stream, a, l);
        if (FAST_IN) launch_gemm<EM_IN>(stream, a, l);
        else {
        hipLaunchKernelGGL((k_ngemm<EM_IN>), dim3(UW / 64, T_ALL / 64), dim3(256), 0, stream, a, l, (const bf16*)(ws + WS_HX), (const bf16*)(ws + WS_WIN) + (size_t)l * UW * D, T_ALL, UW, D);
        hipLaunchKernelGGL(k_rope_apply, dim3((T_ALL * 320 + 255) / 256), dim3(256), 0, stream, a); }
#ifndef FAST_ATT
#define FAST_ATT 1
#endif
        if (FAST_ATT) hipLaunchKernelGGL(k_attn, dim3(NWG), dim3(NTHR), ATT_LDS, stream, a, l);
        else hipLaunchKernelGGL(k_attn_naive, dim3(T_ALL), dim3(512), 0, stream, a, l);
#ifndef FAST_ML
#define FAST_ML 1
#endif
        if (FAST_ML) {
            static bool once = false;
            if (!once) { (void)hipFuncSetAttribute((const void*)k_ml_d1, hipFuncAttributeMaxDynamicSharedMemorySize, ML_LDS); (void)hipFuncSetAttribute((const void*)k_ml_d3, hipFuncAttributeMaxDynamicSharedMemorySize, ML_LDS); once = true; }
            hipLaunchKernelGGL(k_ml_d1, dim3(NWG), dim3(NTHR), ML_LDS, stream, a, l);
            hipLaunchKernelGGL(k_ml_d2, dim3(NWG), dim3(NTHR), 0, stream, a);
            hipLaunchKernelGGL(k_ml_d3, dim3(NWG), dim3(NTHR), ML_LDS, stream, a, l);
        } else {
        hipLaunchKernelGGL(k_mlstm_naive, dim3(64), dim3(256), 0, stream, a, l);
        hipLaunchKernelGGL(k_merge_naive, dim3(T_ALL), dim3(256), 0, stream, a, l); }
        if (FAST_OUT) launch_gemm<EM_OUT>(stream, a, l);
        else hipLaunchKernelGGL((k_ngemm<EM_OUT>), dim3(D / 64, T_ALL / 64), dim3(256), 0, stream, a, l, (const bf16*)(ws + WS_MIX), (const bf16*)(ws + WS_WOUT) + (size_t)l * D * D, T_ALL, D, D);
        if (!moe) {
            hipLaunchKernelGGL((k_norm<1, false, false>), dim3(NWG), dim3(NTHR), NORM_LDS, stream, a, l);
            if (FAST_F1) launch_gemm<EM_F1>(stream, a, l);
            else hipLaunchKernelGGL((k_ngemm<EM_F1>), dim3(FFN / 64, T_ALL / 64), dim3(256), 0, stream, a, l, (const bf16*)(ws + WS_HX), (const bf16*)(ws + WS_WF13) + (size_t)(l >> 1) * 2 * FFN * D, T_ALL, FFN, D);
            if (FAST_F2) launch_gemm<EM_F2D>(stream, a, l);
            else hipLaunchKernelGGL((k_ngemm<EM_F2D>), dim3(D / 64, T_ALL / 64), dim3(256), 0, stream, a, l, (const bf16*)(ws + WS_HID), (const bf16*)(ws + WS_WF2) + (size_t)(l >> 1) * D * FFN, T_ALL, D, FFN);
        } else {
            const int li = l >> 1;
            for (int e = 0; e < NE; ++e) {
                launch_tr(stream, a.exp_w1 + ((size_t)li * NE + e) * D * FFN, D, FFN, FFN, (bf16*)(ws + WS_WE13) + (size_t)e * 2 * FFN * D, 1);
                launch_tr(stream, a.exp_w3 + ((size_t)li * NE + e) * D * FFN, D, FFN, FFN, (bf16*)(ws + WS_WE13) + (size_t)e * 2 * FFN * D, 2);
                launch_tr(stream, a.exp_w2 + ((size_t)li * NE + e) * FFN * D, FFN, D, D, (bf16*)(ws + WS_WE2) + (size_t)e * D * FFN, 0);
            }
            hipLaunchKernelGGL((k_norm<2, false, false>), dim3(NWG), dim3(NTHR), NORM_LDS, stream, a, l);
            hipLaunchKernelGGL(k_moe_pos, dim3(NWG), dim3(NTHR), 16384, stream, a);
            if (FAST_F1M) launch_gemm<EM_F1M>(stream, a, l);
            else hipLaunchKernelGGL((k_ngemm<EM_F1M>), dim3(FFN / 64, MOE_ROWS / 64), dim3(256), 0, stream, a, l, (const bf16*)(ws + WS_HX), (const bf16*)(ws + WS_WE13), MOE_ROWS, FFN, D);
            if (FAST_F2M) launch_gemm<EM_F2M>(stream, a, l);
            else hipLaunchKernelGGL((k_ngemm<EM_F2M>), dim3(D / 64, MOE_ROWS / 64), dim3(256), 0, stream, a, l, (const bf16*)(ws + WS_HID), (const bf16*)(ws + WS_WE2), MOE_ROWS, D, FFN);
        }
    }
    hipLaunchKernelGGL((k_norm<3, false, true>), dim3(NWG), dim3(NTHR), NORM_LDS, stream, a, DEPTH);
#endif
}
```

```cpp
#include <hip/hip_runtime.h>
#include <cstdio>
#include <cstdint>

#ifndef MEGA
#define MEGA 1
#endif
#ifndef PROBE
#define PROBE 0
#endif
typedef unsigned short bf16;
#define PG_LAS __attribute__((address_space(3)))
typedef unsigned v4u __attribute__((ext_vector_type(4)));
typedef unsigned v2u __attribute__((ext_vector_type(2)));
typedef float f32x4 __attribute__((ext_vector_type(4)));

constexpr int D = 1024, NB = 8, SEQ = 4096, CTX = 256, TPB = SEQ + CTX, T_ALL = NB * TPB, DEPTH = 4;
constexpr int INW = 2320, UW = 2304, FFN = 2816, NE = 8;
constexpr int U_QA = 0, U_KA = 512, U_VA = 640, U_QM = 768, U_KM = 1024, U_VM = 1280, U_OM = 1792;
constexpr int MODW = 6 * D, MODR = NB + 1;
constexpr int MOE_ROWS = 2 * T_ALL + NE * 256;
constexpr int MOE_TILES = MOE_ROWS / 256;
constexpr float EPS = 1e-6f;
constexpr int NWG = 256, NTHR = 512;
constexpr int ROWS_PER_WG = T_ALL / NWG;

constexpr size_t MiB = 1u << 20;
constexpr size_t al(size_t x) { return (x + 255) & ~(size_t)255; }
constexpr size_t WS_CTL = 0;
constexpr size_t WS_ROPE = 1 * MiB;
constexpr size_t WS_MOD = WS_ROPE + 65536;
constexpr size_t WS_TOKE = al(WS_MOD + (size_t)DEPTH * MODR * MODW * 4);
constexpr size_t WS_TOKW = al(WS_TOKE + (size_t)T_ALL * 8);
constexpr size_t WS_TOKP = al(WS_TOKW + (size_t)T_ALL * 8);
constexpr size_t WS_ROWT = al(WS_TOKP + (size_t)T_ALL * 8);
constexpr size_t WS_ROWW = al(WS_ROWT + (size_t)MOE_ROWS * 4);
constexpr size_t WS_TILEE = al(WS_ROWW + (size_t)MOE_ROWS * 4);
constexpr size_t WS_CNT = al(WS_TILEE + 4096);
constexpr size_t WS_GATES = al(WS_CNT + (size_t)NWG * 8 * 4);
constexpr size_t WS_WIN = al(WS_GATES + (size_t)T_ALL * 16 * 4);
constexpr size_t WS_WOUT = al(WS_WIN + (size_t)DEPTH * UW * D * 2);
constexpr size_t WS_WF13 = al(WS_WOUT + (size_t)DEPTH * D * D * 2);
constexpr size_t WS_WF2 = al(WS_WF13 + (size_t)2 * 2 * FFN * D * 2);
constexpr size_t WS_WE2 = al(WS_WF2 + (size_t)2 * D * FFN * 2);
constexpr size_t WS_WE13 = al(WS_WE2 + (size_t)NE * D * FFN * 2);
constexpr size_t WS_YS = WS_WE13;
constexpr size_t WS_HX = al(WS_YS + (size_t)MOE_ROWS * D * 2);
constexpr size_t WS_X = al(WS_HX + (size_t)T_ALL * D * 2);
constexpr size_t WS_BIG = al(WS_X + (size_t)T_ALL * D * 2);
static_assert(WS_YS + (size_t)MOE_ROWS * D * 2 <= WS_HX && WS_WE13 + (size_t)NE * 2 * FFN * D * 2 <= WS_HX, "YS overlay");
constexpr size_t WS_U = WS_BIG;
constexpr size_t WS_MIX = al(WS_U + (size_t)T_ALL * UW * 2);
constexpr size_t WS_HDIR = al(WS_MIX + (size_t)T_ALL * D * 2);
constexpr int NCHUNK = TPB / 64, NCHAIN = NB * 4 * 2;
constexpr size_t WS_ST = WS_HDIR;
constexpr size_t WS_NL = al(WS_ST + (size_t)NCHAIN * NCHUNK * 16384);
constexpr size_t WS_SC = al(WS_NL + (size_t)NCHAIN * NCHUNK * 64 * 4);
constexpr size_t WS_DELTA = WS_BIG + 250 * MiB;
constexpr size_t WS_HID = WS_BIG;
constexpr size_t WS_END = al(WS_BIG + (size_t)MOE_ROWS * FFN * 2);
static_assert(WS_HDIR + (size_t)2 * T_ALL * 512 * 4 <= WS_END && WS_SC + (size_t)NCHAIN * NCHUNK * 16 <= WS_END, "HDIR / state buffers fit");

struct P {
    const float *x, *c, *ctx, *c_ctx, *norm1_g, *norm2_g, *w_mod, *b_mod, *w_in, *conv_w, *conv_b, *b_gates, *attn_sink, *g_att, *g_ml, *w_out,
        *ffn_w1, *ffn_w3, *ffn_w2, *w_router, *b_router, *exp_w1, *exp_w3, *exp_w2, *final_g;
    float* out;
    unsigned char* ws;
    int wv, pad;
};

__device__ __forceinline__ unsigned f2bf(float f) { unsigned u = __builtin_bit_cast(unsigned, f); return (u + 0x7fffu + ((u >> 16) & 1u)) >> 16; }
__device__ __forceinline__ unsigned pk2(float lo, float hi) { return f2bf(lo) | (f2bf(hi) << 16); }
typedef float f32x2v __attribute__((ext_vector_type(2)));
typedef __bf16 bf16x2v __attribute__((ext_vector_type(2)));
__device__ __forceinline__ unsigned cvt_pk_bf16(float lo, float hi) { const f32x2v v = {lo, hi}; return __builtin_bit_cast(unsigned, __builtin_convertvector(v, bf16x2v)); }
__device__ __forceinline__ float bf_lo(unsigned w) { return __builtin_bit_cast(float, w << 16); }
__device__ __forceinline__ float bf_hi(unsigned w) { return __builtin_bit_cast(float, w & 0xffff0000u); }
__device__ __forceinline__ float bf2f(bf16 h) { return __builtin_bit_cast(float, (unsigned)h << 16); }
#ifndef XLANE_OLD
#define XLANE_OLD 0
#endif
#if XLANE_OLD
template <int M> __device__ __forceinline__ float swz_xor(float v) { return __shfl_xor(v, M); }
__device__ __forceinline__ float hsum32(float v) { return v + __shfl_xor(v, 32); }
__device__ __forceinline__ float hmax32(float v) { return fmaxf(v, __shfl_xor(v, 32)); }
__device__ __forceinline__ float wave_sum(float v) {
#pragma unroll
    for (int o = 1; o < 64; o <<= 1) v += __shfl_xor(v, o);
    return v;
}
__device__ __forceinline__ float wave_max(float v) {
#pragma unroll
    for (int o = 1; o < 64; o <<= 1) v = fmaxf(v, __shfl_xor(v, o));
    return v;
}
__device__ __forceinline__ float lane_bcast(float v, int src) { return __shfl(v, src); }
template <int OFF> __device__ __forceinline__ float xchg_xor(float v, bool) { return __shfl_xor(v, OFF); }
template <bool MAXOP> __device__ __forceinline__ float dpp_scan(float v) {
    const int lane = (int)__builtin_amdgcn_mbcnt_hi(~0u, __builtin_amdgcn_mbcnt_lo(~0u, 0u));
#pragma unroll
    for (int o = 1; o < 64; o <<= 1) { const float y = __shfl_up(v, o); if (lane >= o) v = MAXOP ? fmaxf(v, y) : v + y; }
    return v;
}
#else
template <int M> __device__ __forceinline__ float swz_xor(float v) { return __builtin_bit_cast(float, __builtin_amdgcn_ds_swizzle(__builtin_bit_cast(int, v), 0x1f | (M << 10))); }
struct HalfSwap { float a, b; };
__device__ __forceinline__ HalfSwap half_swap(float v) {
    float x = v, y = v;
    asm volatile("s_nop 1\n\tv_permlane32_swap_b32 %0, %1\n\ts_nop 0" : "+v"(x), "+v"(y));
    return HalfSwap{x, y};
}
__device__ __forceinline__ float hsum32(float v) { const HalfSwap r = half_swap(v); return r.a + r.b; }
__device__ __forceinline__ float hmax32(float v) { const HalfSwap r = half_swap(v); return fmaxf(r.a, r.b); }
__device__ __forceinline__ float wave_sum(float v) { v += swz_xor<1>(v); v += swz_xor<2>(v); v += swz_xor<4>(v); v += swz_xor<8>(v); v += swz_xor<16>(v); return hsum32(v); }
__device__ __forceinline__ float wave_max(float v) { v = fmaxf(v, swz_xor<1>(v)); v = fmaxf(v, swz_xor<2>(v)); v = fmaxf(v, swz_xor<4>(v)); v = fmaxf(v, swz_xor<8>(v)); v = fmaxf(v, swz_xor<16>(v)); return hmax32(v); }
__device__ __forceinline__ float lane_bcast(float v, int src) { return __builtin_bit_cast(float, __builtin_amdgcn_readlane(__builtin_bit_cast(int, v), src)); }
template <int OFF> __device__ __forceinline__ float xchg_xor(float v, bool up) {
    if constexpr (OFF == 32) { const HalfSwap r = half_swap(v); return up ? r.a : r.b; }
    else return swz_xor<OFF>(v);
}
#define DPP_STEP(ctrl, rm) { const float t_ = __builtin_bit_cast(float, __builtin_amdgcn_update_dpp(__builtin_bit_cast(int, idv), __builtin_bit_cast(int, v), ctrl, rm, 0xf, false)); v = MAXOP ? fmaxf(v, t_) : v + t_; }
template <bool MAXOP> __device__ __forceinline__ float dpp_scan(float v) {
    const float idv = MAXOP ? -3.0e38f : 0.f;
    DPP_STEP(0x111, 0xf) DPP_STEP(0x112, 0xf) DPP_STEP(0x114, 0xf) DPP_STEP(0x118, 0xf) DPP_STEP(0x142, 0xa) DPP_STEP(0x143, 0xc)
    return v;
}
#endif
template <int N, int OFF> struct RS { static __device__ __forceinline__ float run(float (&v)[N], int lane) {
    constexpr int H = N / 2; float w[H]; const bool up = (lane & OFF) != 0;
#pragma unroll
    for (int i = 0; i < H; ++i) { const float keep = up ? v[i + H] : v[i], send = up ? v[i] : v[i + H]; w[i] = keep + xchg_xor<OFF>(send, up); }
    return RS<H, OFF / 2>::run(w, lane); } };
template <int OFF> struct RS<1, OFF> { static __device__ __forceinline__ float run(float (&v)[1], int lane) { float x = v[0];
    if constexpr (OFF >= 16) x += swz_xor<16>(x);
    if constexpr (OFF >= 8) x += swz_xor<8>(x);
    if constexpr (OFF >= 4) x += swz_xor<4>(x);
    if constexpr (OFF >= 2) x += swz_xor<2>(x);
    if constexpr (OFF >= 1) x += swz_xor<1>(x);
    return x; } };
__device__ __forceinline__ float silu_f(float x) { return x * __builtin_amdgcn_rcpf(1.f + __expf(-x)); }
__device__ __forceinline__ float sigmoid_f(float x) { return __builtin_amdgcn_rcpf(1.f + __expf(-x)); }
__device__ __forceinline__ float logsigmoid_f(float x) { return fminf(x, 0.f) - log1pf(__expf(-fabsf(x))); }
__device__ __forceinline__ int tk_modrow(int tk) { const int b = tk / TPB, p = tk - b * TPB; return p < CTX ? NB : b; }
__device__ __forceinline__ const float* in_row(const P& a, int tk) {
    const int b = tk / TPB, p = tk - b * TPB;
    return p < CTX ? a.ctx + ((size_t)b * CTX + p) * D : a.x + ((size_t)b * SEQ + (p - CTX)) * D;
}

__device__ __forceinline__ int otid_w(int wv) { int t; asm volatile("v_mbcnt_lo_u32_b32 %0, -1, 0\n\tv_mbcnt_hi_u32_b32 %0, -1, %0\n\ts_nop 0\n\tv_lshl_add_u32 %0, %1, 6, %0" : "=&v"(t) : "s"(wv)); return t; }
#define otid() otid_w(a.wv)
#define PHASE_ENTRY(a_in) P a = a_in; { unsigned long long z_ = 0; asm volatile("" : "+s"(z_)); a.ws = a_in.ws + z_; }
__device__ __forceinline__ void tr_load(const float* W, int ld, int N, int item, int lane, f32x4 (&v)[8]) {
    const int nblk = N / 32, kb = item / nblk, nb = item % nblk, k0 = 64 * kb, n0 = 32 * nb;
#pragma unroll
    for (int i = 0; i < 8; ++i) { const int kk = 8 * i + (lane >> 3), nn = 4 * (lane & 7);
        v[i] = __builtin_nontemporal_load((const f32x4*)(W + (size_t)(k0 + kk) * ld + n0 + nn)); }
}
__device__ __forceinline__ void tr_store(const f32x4 (&v)[8], int K, int N, bf16* WT, int mode, PG_LAS float* scr, int item, int lane) {
    const int nblk = N / 32, kb = item / nblk, nb = item % nblk, k0 = 64 * kb, n0 = 32 * nb;
#pragma unroll
    for (int i = 0; i < 8; ++i) { const int kk = 8 * i + (lane >> 3), nn = 4 * (lane & 7);
        PG_LAS float* d = scr + kk * 33 + nn; d[0] = v[i].x; d[1] = v[i].y; d[2] = v[i].z; d[3] = v[i].w; }
    __builtin_amdgcn_s_waitcnt(0xC07F); asm volatile("" ::: "memory");
    const int c = lane & 7;
    const int d0 = mode == 0 ? n0 : ((n0 >> 7) * 256 + (mode == 2 ? 128 : 0) + (n0 & 127));
#pragma unroll
    for (int j = 0; j < 4; ++j) { const int n = (lane >> 3) + 8 * j; const PG_LAS float* s = scr + (8 * c) * 33 + n;
        v4u o; o.x = cvt_pk_bf16(s[0 * 33], s[1 * 33]); o.y = cvt_pk_bf16(s[2 * 33], s[3 * 33]); o.z = cvt_pk_bf16(s[4 * 33], s[5 * 33]); o.w = cvt_pk_bf16(s[6 * 33], s[7 * 33]);
        __builtin_nontemporal_store(o, (v4u*)(WT + (size_t)(d0 + n) * K + k0 + 8 * c)); }
    __builtin_amdgcn_s_waitcnt(0xC07F); asm volatile("" ::: "memory");
}
__device__ __forceinline__ void tr_matrix(const float* W, int K, int ld, int N, bf16* WT, int mode, PG_LAS float* scr, int gw, int ngw, int lane) {
    const int items = (K / 64) * (N / 32);
    f32x4 cur[8], nxt[8];
    int it = gw;
    if (it < items) tr_load(W, ld, N, it, lane, cur);
    for (; it < items; it += ngw) {
        const int nit = it + ngw;
        if (nit < items) tr_load(W, ld, N, nit, lane, nxt);
        tr_store(cur, K, N, WT, mode, scr, it, lane);
#pragma unroll
        for (int i = 0; i < 8; ++i) cur[i] = nxt[i];
    }
}
constexpr int EXP_ITEMS_M = (D / 64) * (FFN / 32), EXP_ITEMS_E = 3 * EXP_ITEMS_M, EXP_ITEMS = NE * EXP_ITEMS_E;
struct TrJob { const float* W; bf16* WT; int K, ld, N, mode, it; };
__device__ __forceinline__ TrJob expert_job(const P& a, int li, int j) {
    const int e = j / EXP_ITEMS_E, r = j - e * EXP_ITEMS_E, m = r / EXP_ITEMS_M, it = r - m * EXP_ITEMS_M;
    TrJob t; t.it = it;
    if (m < 2) { t.W = (m == 0 ? a.exp_w1 : a.exp_w3) + ((size_t)li * NE + e) * D * FFN; t.K = D; t.ld = FFN; t.N = FFN; t.WT = (bf16*)(a.ws + WS_WE13) + (size_t)e * 2 * FFN * D; t.mode = 1 + m; }
    else { t.W = a.exp_w2 + ((size_t)li * NE + e) * FFN * D; t.K = FFN; t.ld = D; t.N = D; t.WT = (bf16*)(a.ws + WS_WE2) + (size_t)e * D * FFN; t.mode = 0; }
    return t;
}
__device__ __forceinline__ void conv_expert_range(const P& a, int li, int j0, int j1, int slot, int nslots, PG_LAS float* scr, int lane) {
    int j = j0 + slot; if (j >= j1) return;
    TrJob cur = expert_job(a, li, j), nxt = cur; f32x4 cv[8], nv[8];
    tr_load(cur.W, cur.ld, cur.N, cur.it, lane, cv);
    for (; j < j1; j += nslots) {
        const int jn = j + nslots;
        if (jn < j1) { nxt = expert_job(a, li, jn); tr_load(nxt.W, nxt.ld, nxt.N, nxt.it, lane, nv); }
        tr_store(cv, cur.K, cur.N, cur.WT, cur.mode, scr, cur.it, lane);
        cur = nxt;
#pragma unroll
        for (int i = 0; i < 8; ++i) cv[i] = nv[i];
    }
}
constexpr int DN_IN = (D / 64) * (UW / 32), DN_OUT = (D / 64) * (D / 32), DN_L = DN_IN + DN_OUT, DN_ITEMS = DEPTH * DN_L + 2 * EXP_ITEMS_E;
__device__ __forceinline__ TrJob dense_job(const P& a, int j) {
    TrJob t;
    if (j < DEPTH * DN_L) { const int l = j / DN_L, r = j - l * DN_L; t.K = D; t.mode = 0;
        if (r < DN_IN) { t.W = a.w_in + (size_t)l * D * INW; t.ld = INW; t.N = UW; t.WT = (bf16*)(a.ws + WS_WIN) + (size_t)l * UW * D; t.it = r; }
        else { t.W = a.w_out + (size_t)l * D * D; t.ld = D; t.N = D; t.WT = (bf16*)(a.ws + WS_WOUT) + (size_t)l * D * D; t.it = r - DN_IN; } }
    else { const int q = j - DEPTH * DN_L, i = q / EXP_ITEMS_E, r = q - i * EXP_ITEMS_E, m = r / EXP_ITEMS_M; t.it = r - m * EXP_ITEMS_M;
        if (m < 2) { t.W = (m == 0 ? a.ffn_w1 : a.ffn_w3) + (size_t)i * D * FFN; t.K = D; t.ld = FFN; t.N = FFN; t.WT = (bf16*)(a.ws + WS_WF13) + (size_t)i * 2 * FFN * D; t.mode = 1 + m; }
        else { t.W = a.ffn_w2 + (size_t)i * FFN * D; t.K = FFN; t.ld = D; t.N = D; t.WT = (bf16*)(a.ws + WS_WF2) + (size_t)i * D * FFN; t.mode = 0; } }
    return t;
}
__device__ __forceinline__ void conv_dense_range(const P& a, int j0, int j1, int slot, int nslots, PG_LAS float* scr, int lane) {
    int j = j0 + slot; if (j >= j1) return;
    TrJob cur = dense_job(a, j), nxt = cur; f32x4 cv[8], nv[8];
    tr_load(cur.W, cur.ld, cur.N, cur.it, lane, cv);
    for (; j < j1; j += nslots) {
        const int jn = j + nslots;
        if (jn < j1) { nxt = dense_job(a, jn); tr_load(nxt.W, nxt.ld, nxt.N, nxt.it, lane, nv); }
        tr_store(cv, cur.K, cur.N, cur.WT, cur.mode, scr, cur.it, lane);
        cur = nxt;
#pragma unroll
        for (int i = 0; i < 8; ++i) cv[i] = nv[i];
    }
}
__global__ void __launch_bounds__(256) k_transpose(const float* W, int K, int ld, int N, bf16* WT, int mode) {
    __shared__ float scr[4][64 * 33];
    const int wave = threadIdx.x >> 6, lane = threadIdx.x & 63;
    tr_matrix(W, K, ld, N, WT, mode, (PG_LAS float*)scr[wave], blockIdx.x * 4 + wave, gridDim.x * 4, lane);
}
__global__ void __launch_bounds__(256) k_modvec(P a) {
    __shared__ float cond[MODR][D];
    __shared__ float red[4][MODR][64];
    const int l = blockIdx.x / 96, nc = blockIdx.x % 96, t = threadIdx.x, kg = t >> 6, n = nc * 64 + (t & 63);
    for (int i = t; i < MODR * D; i += 256) { const int r = i / D, k = i % D; const float v = r < NB ? a.c[r * D + k] : a.c_ctx[k]; cond[r][k] = silu_f(v); }
    __syncthreads();
    float acc[MODR];
#pragma unroll
    for (int r = 0; r < MODR; ++r) acc[r] = 0.f;
    const float* w = a.w_mod + (size_t)l * D * MODW + n;
    for (int k = kg * 256; k < kg * 256 + 256; ++k) { const float wv = w[(size_t)k * MODW];
#pragma unroll
        for (int r = 0; r < MODR; ++r) acc[r] += cond[r][k] * wv; }
#pragma unroll
    for (int r = 0; r < MODR; ++r) red[kg][r][t & 63] = acc[r];
    __syncthreads();
    float* mod = (float*)(a.ws + WS_MOD);
    for (int i = t; i < MODR * 64; i += 256) { const int r = i / 64, j = i % 64; const int nn = nc * 64 + j;
        mod[((size_t)l * MODR + r) * MODW + nn] = red[0][r][j] + red[1][r][j] + red[2][r][j] + red[3][r][j] + a.b_mod[l * MODW + nn]; }
}
__global__ void k_rope_table(P a) {
    const int i = blockIdx.x * blockDim.x + threadIdx.x; if (i >= 64 * 16) return;
    const int pos = i / 16, f = i % 16; const float inv = powf(10000.0f, -(float)f / 16.0f); const float ang = (float)pos * inv;
    float* t = (float*)(a.ws + WS_ROPE); t[2 * i] = cosf(ang); t[2 * i + 1] = sinf(ang);
}

template <int MODE, bool SRC_IN, int PEND>
__device__ __forceinline__ void norm_phase(const P& a_in, int l, int wg, PG_LAS float* lds, int pl = 0, int pchunk = 0) {
    PHASE_ENTRY(a_in)
    const int tid = otid(), lane = tid & 63, wave = tid >> 6;
#define NCOFF(j) (512 * ((j) >> 1) + 8 * lane + 4 * ((j) & 1))
    bf16* X = (bf16*)(a.ws + WS_X); bf16* HX = (bf16*)(a.ws + WS_HX); const float* MOD = (const float*)(a.ws + WS_MOD);
    PG_LAS float* wl = lds; PG_LAS unsigned* wlu = (PG_LAS unsigned*)lds;
    PG_LAS int* cnt_l = (PG_LAS int*)(lds + 8192 + 8 * 32);
    if (MODE == 0) {
        for (int i = tid; i < D * 2; i += NTHR) { const int c = i >> 1, hf = i & 1; const float* wp = a.w_in + ((size_t)l * D + c) * INW + UW + 8 * hf;
            const f32x4 w0 = *(const f32x4*)wp, w1 = *(const f32x4*)(wp + 4);
            const int j = 2 * (c >> 9) + ((c >> 2) & 1), ln = (c >> 3) & 63, ii = c & 3; v4u o; o.x = pk2(w0.x, w0.y); o.y = pk2(w0.z, w0.w); o.z = pk2(w1.x, w1.y); o.w = pk2(w1.z, w1.w);
            *(PG_LAS v4u*)(wlu + ((((j * 4 + ii) * 2 + hf) * 64 + ln) * 4)) = o; }
    }
    if (MODE == 2) {
        for (int i = tid; i < D * 2; i += NTHR) { const int c = i >> 1, g4 = i & 1; const f32x4 w = *(const f32x4*)(a.w_router + ((size_t)(l >> 1) * D + c) * NE + 4 * g4);
            const int j = 2 * (c >> 9) + ((c >> 2) & 1), ln = (c >> 3) & 63, ii = c & 3; *(PG_LAS f32x4*)(wl + ((((j * 4 + ii) * 2 + g4) * 64 + ln) * 4)) = w; }
        if (tid < NE) cnt_l[tid] = 0;
    }
    if (MODE == 0 || MODE == 2) __syncthreads();
    const float* gvec = MODE == 0 ? a.norm1_g + l * D : (MODE == 3 ? a.final_g : a.norm2_g + l * D);
    f32x4 gv[4];
#pragma unroll
    for (int j = 0; j < 4; ++j) gv[j] = *(const f32x4*)(gvec + NCOFF(j));
    const int row0 = wg * ROWS_PER_WG + wave * 17;
    int mr_c = -1, mr_p = -1; f32x4 cA[4], cB[4], cM[4];
#pragma unroll
    for (int j = 0; j < 4; ++j) { cA[j] = (f32x4){0.f, 0.f, 0.f, 0.f}; cB[j] = cA[j]; cM[j] = cA[j]; }
    int posA = 0, posB = 0;
    if (PEND == 2) { const int* tp = (const int*)(a.ws + WS_TOKP) + 2 * (row0 + (lane < 17 ? lane : 0)); posA = min(max(tp[0], 0), MOE_ROWS - 1); posB = min(max(tp[1], 0), MOE_ROWS - 1); }
    f32x4 nx[2][4]; v4u nxb[2][2], nd0[2][2], nd1[2][2];
#define NORM_LOAD_GROUP(g) do { _Pragma("unroll") for (int r_ = 0; r_ < 2; ++r_) { const int ri_ = (g) * 2 + r_, rc_ = ri_ < 17 ? ri_ : 0, tk_ = row0 + rc_; \
        if (SRC_IN) { const float* xr_ = in_row(a, tk_); _Pragma("unroll") for (int j = 0; j < 4; ++j) nx[r_][j] = *(const f32x4*)(xr_ + NCOFF(j)); } \
        else { const bf16* xr_ = X + (size_t)tk_ * D; _Pragma("unroll") for (int J = 0; J < 2; ++J) nxb[r_][J] = *(const v4u*)(xr_ + 512 * J + 8 * lane); } \
        if (PEND == 1) { const bf16* dl_ = (const bf16*)(a.ws + WS_DELTA) + (size_t)tk_ * D; _Pragma("unroll") for (int J = 0; J < 2; ++J) nd0[r_][J] = *(const v4u*)(dl_ + 512 * J + 8 * lane); } \
        if (PEND == 2) { const int p0_ = __builtin_amdgcn_readlane(posA, rc_), p1_ = __builtin_amdgcn_readlane(posB, rc_); const bf16* ys_ = (const bf16*)(a.ws + WS_YS); \
            _Pragma("unroll") for (int J = 0; J < 2; ++J) { nd0[r_][J] = *(const v4u*)(ys_ + (size_t)p0_ * D + 512 * J + 8 * lane); nd1[r_][J] = *(const v4u*)(ys_ + (size_t)p1_ * D + 512 * J + 8 * lane); } } } } while (0)
    NORM_LOAD_GROUP(0);
#pragma unroll 1
    for (int grp = 0; grp < 9; ++grp) {
        f32x4 h[2][4], cx[2][4]; v4u cd0[2][2], cd1[2][2];
#pragma unroll
        for (int r = 0; r < 2; ++r)
#pragma unroll
            for (int J = 0; J < 2; ++J) {
                if (SRC_IN) { cx[r][2 * J] = nx[r][2 * J]; cx[r][2 * J + 1] = nx[r][2 * J + 1]; }
                else { const v4u w = nxb[r][J]; cx[r][2 * J] = (f32x4){bf_lo(w.x), bf_hi(w.x), bf_lo(w.y), bf_hi(w.y)}; cx[r][2 * J + 1] = (f32x4){bf_lo(w.z), bf_hi(w.z), bf_lo(w.w), bf_hi(w.w)}; }
                if (PEND != 0) cd0[r][J] = nd0[r][J]; if (PEND == 2) cd1[r][J] = nd1[r][J]; }
        if (grp + 1 < 9) NORM_LOAD_GROUP(grp + 1);
        int tks[2]; bool valid[2], dead[2];
#pragma unroll
        for (int r = 0; r < 2; ++r) {
            const int ri = grp * 2 + r; valid[r] = ri < 17; const int tk = row0 + (valid[r] ? ri : 0); tks[r] = tk;
            const int b = tk / TPB, p = tk - b * TPB, mr = p < CTX ? NB : b; dead[r] = (MODE == 2 && l == DEPTH - 1 && p < CTX);
            f32x4 xv[4];
#pragma unroll
            for (int j = 0; j < 4; ++j) xv[j] = cx[r][j];
            if (PEND != 0) {
                if (mr != mr_p) { mr_p = mr; const float* mp = MOD + ((size_t)pl * MODR + mr) * MODW + (PEND == 2 ? 5 : pchunk) * D;
#pragma unroll
                    for (int j = 0; j < 4; ++j) cM[j] = *(const f32x4*)(mp + NCOFF(j)); }
                if (PEND == 2) {
#pragma unroll
                    for (int j = 0; j < 4; ++j) { const v4u a0 = cd0[r][j >> 1], a1 = cd1[r][j >> 1]; const v2u y0 = (j & 1) ? (v2u){a0.z, a0.w} : (v2u){a0.x, a0.y}, y1 = (j & 1) ? (v2u){a1.z, a1.w} : (v2u){a1.x, a1.y};
                        xv[j].x += cM[j].x * (bf_lo(y0.x) + bf_lo(y1.x)); xv[j].y += cM[j].y * (bf_hi(y0.x) + bf_hi(y1.x));
                        xv[j].z += cM[j].z * (bf_lo(y0.y) + bf_lo(y1.y)); xv[j].w += cM[j].w * (bf_hi(y0.y) + bf_hi(y1.y)); }
                } else {
#pragma unroll
                    for (int j = 0; j < 4; ++j) { const v4u a0 = cd0[r][j >> 1]; const v2u y0 = (j & 1) ? (v2u){a0.z, a0.w} : (v2u){a0.x, a0.y};
                        xv[j].x += cM[j].x * bf_lo(y0.x); xv[j].y += cM[j].y * bf_hi(y0.x); xv[j].z += cM[j].z * bf_lo(y0.y); xv[j].w += cM[j].w * bf_hi(y0.y); }
                }
                if (valid[r] && MODE != 3) {
#pragma unroll
                    for (int J = 0; J < 2; ++J) { v4u o; o.x = cvt_pk_bf16(xv[2 * J].x, xv[2 * J].y); o.y = cvt_pk_bf16(xv[2 * J].z, xv[2 * J].w); o.z = cvt_pk_bf16(xv[2 * J + 1].x, xv[2 * J + 1].y); o.w = cvt_pk_bf16(xv[2 * J + 1].z, xv[2 * J + 1].w);
                        *(v4u*)(X + (size_t)tk * D + 512 * J + 8 * lane) = o; } }
            }
            float ss = 0.f;
#pragma unroll
            for (int j = 0; j < 4; ++j) ss += (xv[j].x * xv[j].x + xv[j].y * xv[j].y) + (xv[j].z * xv[j].z + xv[j].w * xv[j].w);
            const float rstd = rsqrtf(wave_sum(ss) * (1.f / D) + EPS);
            if (MODE == 3) {
                if (valid[r] && p >= CTX) { float* o = a.out + ((size_t)b * SEQ + (p - CTX)) * D;
#pragma unroll
                    for (int j = 0; j < 4; ++j) *(f32x4*)(o + NCOFF(j)) = xv[j] * rstd * gv[j]; }
            } else {
                if (mr != mr_c) {
                    mr_c = mr; const float* mrow = MOD + ((size_t)l * MODR + mr) * MODW;
                    const float* shp = mrow + (MODE == 0 ? 0 : 3) * D; const float* scp = mrow + (MODE == 0 ? 1 : 4) * D;
#pragma unroll
                    for (int j = 0; j < 4; ++j) { const f32x4 sh = *(const f32x4*)(shp + NCOFF(j)), sc = *(const f32x4*)(scp + NCOFF(j)); cA[j] = gv[j] * (sc + 1.f); cB[j] = sh; }
                }
#pragma unroll
                for (int j = 0; j < 4; ++j) h[r][j] = xv[j] * rstd * cA[j] + cB[j];
                if (valid[r]) {
#pragma unroll
                    for (int J = 0; J < 2; ++J) { v4u o; o.x = cvt_pk_bf16(h[r][2 * J].x, h[r][2 * J].y); o.y = cvt_pk_bf16(h[r][2 * J].z, h[r][2 * J].w); o.z = cvt_pk_bf16(h[r][2 * J + 1].x, h[r][2 * J + 1].y); o.w = cvt_pk_bf16(h[r][2 * J + 1].z, h[r][2 * J + 1].w);
                        *(v4u*)(HX + (size_t)tk * D + 512 * J + 8 * lane) = o; } }
            }
        }
        if (MODE == 0) {
            float acc[2][16];
#pragma unroll
            for (int r = 0; r < 2; ++r)
#pragma unroll
                for (int g = 0; g < 16; ++g) acc[r][g] = 0.f;
#pragma unroll
            for (int j = 0; j < 4; ++j)
#pragma unroll
                for (int ii = 0; ii < 4; ++ii) {
#pragma unroll
                    for (int hf = 0; hf < 2; ++hf) { const v4u w = *(const PG_LAS v4u*)(wlu + ((((j * 4 + ii) * 2 + hf) * 64 + lane) * 4));
#pragma unroll
                        for (int r = 0; r < 2; ++r) { const float hv = h[r][j][ii];
                            acc[r][8 * hf + 0] += hv * bf_lo(w.x); acc[r][8 * hf + 1] += hv * bf_hi(w.x); acc[r][8 * hf + 2] += hv * bf_lo(w.y); acc[r][8 * hf + 3] += hv * bf_hi(w.y);
                            acc[r][8 * hf + 4] += hv * bf_lo(w.z); acc[r][8 * hf + 5] += hv * bf_hi(w.z); acc[r][8 * hf + 6] += hv * bf_lo(w.w); acc[r][8 * hf + 7] += hv * bf_hi(w.w); } }
                    asm volatile("" ::: "memory"); }
            float flat[32];
#pragma unroll
            for (int r = 0; r < 2; ++r)
#pragma unroll
                for (int g = 0; g < 16; ++g) flat[r * 16 + g] = acc[r][g];
            const float sum = RS<32, 32>::run(flat, lane);
            { const int idx = (lane >> 1) & 31, r = idx >> 4, g = idx & 15;
              float v = sum + a.b_gates[l * 16 + g]; v = 15.f * tanhf(v * (1.f / 15.f));
              const int ri = grp * 2 + r;
              if ((lane & 1) == 0 && ri < 17) ((float*)(a.ws + WS_GATES))[(size_t)(row0 + ri) * 16 + g] = v; }
        }
        if (MODE == 2) {
            float acc[2][8];
#pragma unroll
            for (int r = 0; r < 2; ++r)
#pragma unroll
                for (int g = 0; g < 8; ++g) acc[r][g] = 0.f;
#pragma unroll
            for (int j = 0; j < 4; ++j)
#pragma unroll
                for (int ii = 0; ii < 4; ++ii) {
#pragma unroll
                    for (int g4 = 0; g4 < 2; ++g4) { const f32x4 w = *(const PG_LAS f32x4*)(wl + ((((j * 4 + ii) * 2 + g4) * 64 + lane) * 4));
#pragma unroll
                        for (int r = 0; r < 2; ++r) { const float hv = h[r][j][ii]; acc[r][4 * g4 + 0] += hv * w.x; acc[r][4 * g4 + 1] += hv * w.y; acc[r][4 * g4 + 2] += hv * w.z; acc[r][4 * g4 + 3] += hv * w.w; } }
                    asm volatile("" ::: "memory"); }
            float flat[16];
#pragma unroll
            for (int r = 0; r < 2; ++r)
#pragma unroll
                for (int g = 0; g < 8; ++g) flat[r * 8 + g] = acc[r][g];
            const float sum = RS<16, 32>::run(flat, lane);
#pragma unroll
            for (int r = 0; r < 2; ++r) {
                float lg[8];
#pragma unroll
                for (int g = 0; g < 8; ++g) { const float v = lane_bcast(sum, (r * 8 + g) << 2) + a.b_router[(l >> 1) * NE + g]; lg[g] = (v == v) ? fminf(fmaxf(v, -1.0e30f), 1.0e30f) : -1.0e30f; }
                int e0 = 0; float v0 = lg[0];
#pragma unroll
                for (int g = 1; g < 8; ++g) if (lg[g] > v0) { v0 = lg[g]; e0 = g; }
                int e1 = (e0 + 1) & 7; float v1 = -3.0e38f;
#pragma unroll
                for (int g = 0; g < 8; ++g) if (g != e0 && lg[g] > v1) { v1 = lg[g]; e1 = g; }
                const float w0 = 1.f / (1.f + __expf(v1 - v0)), w1 = 1.f - w0;
                if (lane == 0 && valid[r]) { const int tk = tks[r];
                    int* te = (int*)(a.ws + WS_TOKE) + 2 * tk; te[0] = dead[r] ? -1 : e0; te[1] = dead[r] ? -1 : e1; }
                if (lane == 0 && valid[r] && !dead[r]) { const int tk = tks[r];
                    float* tw = (float*)(a.ws + WS_TOKW) + 2 * tk; tw[0] = w0; tw[1] = w1;
                    __hip_atomic_fetch_add(&cnt_l[e0], 1, __ATOMIC_RELAXED, __HIP_MEMORY_SCOPE_WORKGROUP); __hip_atomic_fetch_add(&cnt_l[e1], 1, __ATOMIC_RELAXED, __HIP_MEMORY_SCOPE_WORKGROUP); }
            }
        }
    }
    if (MODE == 2) { __syncthreads(); if (tid < NE) ((int*)(a.ws + WS_CNT))[wg * NE + tid] = cnt_l[tid]; }
}
#undef NCOFF
template <int MODE, bool SRC_IN, int PEND>
__global__ void __launch_bounds__(NTHR, 2) k_norm(P a, int l) {
    extern __shared__ __attribute__((aligned(16))) unsigned char smem[];
    a.wv = __builtin_amdgcn_readfirstlane(threadIdx.x >> 6);
    norm_phase<MODE, SRC_IN, PEND>(a, l, blockIdx.x, (PG_LAS float*)smem);
}

__device__ __forceinline__ void moe_pos_phase(const P& a_in, int wg, int* lds) {
    PHASE_ENTRY(a_in)
    const int tid = otid(), lane = tid & 63, wave = __builtin_amdgcn_readfirstlane(tid >> 6);
    int* cnt = lds;
    int* tot = lds + 2048;
    int* wc = lds + 2048 + 32;
    const int* gc = (const int*)(a.ws + WS_CNT);
    for (int i = tid; i < NWG * NE; i += NTHR) cnt[i] = gc[i];
    const int* te = (const int*)(a.ws + WS_TOKE); const float* tw = (const float*)(a.ws + WS_TOKW);
    int* tp = (int*)(a.ws + WS_TOKP); int* rowt = (int*)(a.ws + WS_ROWT); float* roww = (float*)(a.ws + WS_ROWW);
    constexpr int NENT = 2 * ROWS_PER_WG;
    const int ent = tid < NENT ? te[2 * wg * ROWS_PER_WG + tid] : -1;
    const float entw = tid < NENT ? tw[2 * wg * ROWS_PER_WG + tid] : 0.f;
    int rank = 0;
#pragma unroll
    for (int e = 0; e < NE; ++e) { const unsigned long long mk = __ballot(ent == e);
        const int below = __builtin_amdgcn_mbcnt_hi((unsigned)(mk >> 32), __builtin_amdgcn_mbcnt_lo((unsigned)mk, 0u));
        if (ent == e) rank = below;
        if (lane == 0) wc[wave * NE + e] = __popcll(mk); }
    __syncthreads();
    {
        const int e = wave; int v[4], sum = 0;
#pragma unroll
        for (int q = 0; q < 4; ++q) { v[q] = cnt[(4 * lane + q) * NE + e]; sum += v[q]; }
        const int incl = (int)dpp_scan<false>((float)sum);
        const int total = __builtin_amdgcn_readlane(incl, 63);
        const int lw = wg >> 2, lq = wg & 3;
        int mine = incl - sum; if (lq > 0) mine += v[0]; if (lq > 1) mine += v[1]; if (lq > 2) mine += v[2];
        const int pre = __builtin_amdgcn_readlane(mine, lw);
        if (lane == 0) { tot[e] = total; tot[16 + e] = pre; }
    }
    __syncthreads();
    if (tid == 0) { int s = 0; for (int e = 0; e < NE; ++e) { tot[8 + e] = s; s += (tot[e] + 255) & ~255; } tot[24] = s; }
    __syncthreads();
    if (ent >= 0) {
        int off = 0;
        for (int w = 0; w < wave; ++w) off += wc[w * NE + ent];
        const int pos = tot[8 + ent] + tot[16 + ent] + off + rank;
        const int tk = wg * ROWS_PER_WG + (tid >> 1);
        tp[2 * wg * ROWS_PER_WG + tid] = pos; rowt[pos] = tk; roww[pos] = entw;
    }
    if (wg < NE) { const int s0 = tot[8 + wg] + tot[wg], s1 = tot[8 + wg] + ((tot[wg] + 255) & ~255); for (int r = s0 + tid; r < s1; r += NTHR) { rowt[r] = 0; roww[r] = 0.f; } }
    if (wg == 0) { int* tile_e = (int*)(a.ws + WS_TILEE); const int nt = tot[24] >> 8;
        for (int t = tid; t < MOE_TILES; t += NTHR) { int e = 0; for (int q = 1; q < NE; ++q) if (t * 256 >= tot[8 + q]) e = q; tile_e[t] = t < nt ? e : 0; }
        if (tid == 0) tile_e[MOE_TILES] = nt; }
}
__global__ void __launch_bounds__(NTHR, 2) k_moe_pos(P a) {
    extern __shared__ __attribute__((aligned(16))) unsigned char smem[];
    a.wv = __builtin_amdgcn_readfirstlane(threadIdx.x >> 6);
    moe_pos_phase(a, blockIdx.x, (int*)smem);
}

enum { EM_IN = 0, EM_OUT = 1, EM_F1 = 2, EM_F2D = 3, EM_F1M = 4, EM_F2M = 5 };
template <int EM>
__global__ void __launch_bounds__(256) k_ngemm(P a, int l, const bf16* A, const bf16* Bt, int M, int N, int K) {
    constexpr bool DUAL = (EM == EM_F1 || EM == EM_F1M), MOE = (EM == EM_F1M || EM == EM_F2M);
    __shared__ __attribute__((aligned(16))) float As[32][64], Bs[32][64], Bs2[DUAL ? 32 : 1][64];
    const int t = threadIdx.x, tx = t & 15, ty = t >> 4;
    const int row0 = blockIdx.y * 64, col0 = blockIdx.x * 64;
    const int* tile_e = (const int*)(a.ws + WS_TILEE); const int* rowt = (const int*)(a.ws + WS_ROWT);
    if (MOE) { if (row0 >= tile_e[MOE_TILES] * 256) return; }
    const int e = MOE ? tile_e[row0 >> 8] : 0;
    const bf16* B = Bt + (MOE ? (size_t)e * (DUAL ? 2 * FFN : D) * K : 0);
    const int lr = t >> 2, kc = (t & 3) * 8;
    const int arow = (EM == EM_F1M) ? rowt[row0 + lr] : row0 + lr;
    const int brow = DUAL ? ((col0 >> 7) * 256 + (col0 & 127) + lr) : col0 + lr;
    float acc[4][4], acc2[4][4];
#pragma unroll
    for (int i = 0; i < 4; ++i)
#pragma unroll
        for (int j = 0; j < 4; ++j) { acc[i][j] = 0.f; acc2[i][j] = 0.f; }
    for (int k0 = 0; k0 < K; k0 += 32) {
        const v4u av = *(const v4u*)(A + (size_t)arow * K + k0 + kc);
        const v4u bv = *(const v4u*)(B + (size_t)brow * K + k0 + kc);
        v4u bv2 = bv; if (DUAL) bv2 = *(const v4u*)(B + (size_t)(brow + 128) * K + k0 + kc);
        __syncthreads();
        As[kc + 0][lr] = bf_lo(av.x); As[kc + 1][lr] = bf_hi(av.x); As[kc + 2][lr] = bf_lo(av.y); As[kc + 3][lr] = bf_hi(av.y);
        As[kc + 4][lr] = bf_lo(av.z); As[kc + 5][lr] = bf_hi(av.z); As[kc + 6][lr] = bf_lo(av.w); As[kc + 7][lr] = bf_hi(av.w);
        Bs[kc + 0][lr] = bf_lo(bv.x); Bs[kc + 1][lr] = bf_hi(bv.x); Bs[kc + 2][lr] = bf_lo(bv.y); Bs[kc + 3][lr] = bf_hi(bv.y);
        Bs[kc + 4][lr] = bf_lo(bv.z); Bs[kc + 5][lr] = bf_hi(bv.z); Bs[kc + 6][lr] = bf_lo(bv.w); Bs[kc + 7][lr] = bf_hi(bv.w);
        if (DUAL) { Bs2[kc + 0][lr] = bf_lo(bv2.x); Bs2[kc + 1][lr] = bf_hi(bv2.x); Bs2[kc + 2][lr] = bf_lo(bv2.y); Bs2[kc + 3][lr] = bf_hi(bv2.y);
            Bs2[kc + 4][lr] = bf_lo(bv2.z); Bs2[kc + 5][lr] = bf_hi(bv2.z); Bs2[kc + 6][lr] = bf_lo(bv2.w); Bs2[kc + 7][lr] = bf_hi(bv2.w); }
        __syncthreads();
#pragma unroll 8
        for (int k = 0; k < 32; ++k) {
            const f32x4 av4 = *(const f32x4*)&As[k][ty * 4], bv4 = *(const f32x4*)&Bs[k][tx * 4];
#pragma unroll
            for (int i = 0; i < 4; ++i)
#pragma unroll
                for (int j = 0; j < 4; ++j) acc[i][j] += av4[i] * bv4[j];
            if (DUAL) { const f32x4 b2 = *(const f32x4*)&Bs2[k][tx * 4];
#pragma unroll
                for (int i = 0; i < 4; ++i)
#pragma unroll
                    for (int j = 0; j < 4; ++j) acc2[i][j] += av4[i] * b2[j]; }
        }
    }
    const float* MOD = (const float*)(a.ws + WS_MOD); float* X = (float*)(a.ws + WS_X);
#pragma unroll
    for (int i = 0; i < 4; ++i) {
        const int r = row0 + ty * 4 + i;
#pragma unroll
        for (int j = 0; j < 4; ++j) {
            const int c = col0 + tx * 4 + j; const float v = acc[i][j];
            if (EM == EM_IN) ((bf16*)(a.ws + WS_U))[(size_t)r * UW + c] = (bf16)f2bf(v);
            if (EM == EM_OUT) { const float* base = (l == 0) ? in_row(a, r) : X + (size_t)r * D; X[(size_t)r * D + c] = base[c] + MOD[((size_t)l * MODR + tk_modrow(r)) * MODW + 2 * D + c] * v; }
            if (EM == EM_F1) ((bf16*)(a.ws + WS_HID))[(size_t)r * FFN + c] = (bf16)f2bf(silu_f(v) * acc2[i][j]);
            if (EM == EM_F1M) ((bf16*)(a.ws + WS_HID))[(size_t)r * FFN + c] = (bf16)f2bf(silu_f(v) * acc2[i][j] * ((const float*)(a.ws + WS_ROWW))[r]);
            if (EM == EM_F2D) X[(size_t)r * D + c] += MOD[((size_t)l * MODR + tk_modrow(r)) * MODW + 5 * D + c] * v;
            if (EM == EM_F2M) ((bf16*)(a.ws + WS_YS))[(size_t)r * D + c] = (bf16)f2bf(v);
        }
    }
}
__global__ void __launch_bounds__(256) k_rope_apply(P a) {
    const size_t i = (size_t)blockIdx.x * 256 + threadIdx.x; if (i >= (size_t)T_ALL * 20 * 16) return;
    const int tk = (int)(i / 320), rem = (int)(i % 320), grp = rem / 16, f = rem % 16;
    const int b = tk / TPB, p = tk - b * TPB; bf16* u = (bf16*)(a.ws + WS_U) + (size_t)tk * UW + grp * 32;
    float x1 = bf2f(u[f]), x2 = bf2f(u[f + 16]);
    const float sc = grp < 16 ? 0.125f : 1.f;
    if (p >= CTX) { const int s = p - CTX, pos = (grp & 1) ? (s & 63) : (s >> 6); const float* t = (const float*)(a.ws + WS_ROPE) + 2 * (pos * 16 + f);
        const float cs = t[0], sn = t[1]; const float y1 = x1 * cs - x2 * sn, y2 = x2 * cs + x1 * sn; x1 = y1; x2 = y2; }
    u[f] = (bf16)f2bf(x1 * sc); u[f + 16] = (bf16)f2bf(x2 * sc);
}

__global__ void __launch_bounds__(512, 2) k_attn_naive(P a, int l) {
    __shared__ float ssq[8];
    const int tk = blockIdx.x, h = threadIdx.x >> 6, lane = threadIdx.x & 63, kvh = h >> 2;
    const int b = tk / TPB, p = tk - b * TPB; const bool isctx = p < CTX;
    const bf16* U = (const bf16*)(a.ws + WS_U);
    float q[64];
    { const v4u* qp = (const v4u*)(U + (size_t)tk * UW + U_QA + h * 64);
#pragma unroll
      for (int i = 0; i < 8; ++i) { const v4u w = qp[i]; q[8 * i + 0] = bf_lo(w.x); q[8 * i + 1] = bf_hi(w.x); q[8 * i + 2] = bf_lo(w.y); q[8 * i + 3] = bf_hi(w.y); q[8 * i + 4] = bf_lo(w.z); q[8 * i + 5] = bf_hi(w.z); q[8 * i + 6] = bf_lo(w.w); q[8 * i + 7] = bf_hi(w.w); } }
    const int s = p - CTX; const int j0 = isctx ? 0 : (s - 128 < 0 ? 0 : s - 128), j1 = isctx ? -1 : (s + 128 > SEQ - 1 ? SEQ - 1 : s + 128);
    const int nlat = j1 - j0 + 1, nk = CTX + (isctx ? 0 : nlat);
    const int tb = b * TPB;
    float sc[9];
#pragma unroll
    for (int it = 0; it < 9; ++it) { const int idx = lane + 64 * it; sc[it] = -3.0e38f;
        if (idx < nk) { const int kt = idx < CTX ? tb + idx : tb + CTX + j0 + (idx - CTX); const v4u* kp = (const v4u*)(U + (size_t)kt * UW + U_KA + kvh * 64); float d = 0.f;
#pragma unroll
            for (int i = 0; i < 8; ++i) { const v4u w = kp[i]; d += q[8 * i + 0] * bf_lo(w.x) + q[8 * i + 1] * bf_hi(w.x) + q[8 * i + 2] * bf_lo(w.y) + q[8 * i + 3] * bf_hi(w.y) + q[8 * i + 4] * bf_lo(w.z) + q[8 * i + 5] * bf_hi(w.z) + q[8 * i + 6] * bf_lo(w.w) + q[8 * i + 7] * bf_hi(w.w); }
            sc[it] = d; } }
    const float sink = a.attn_sink[l * 8 + h];
    float m = sink;
#pragma unroll
    for (int it = 0; it < 9; ++it) m = fmaxf(m, sc[it]);
    m = wave_max(m);
    float o[64];
#pragma unroll
    for (int d = 0; d < 64; ++d) o[d] = 0.f;
    float den = 0.f;
#pragma unroll
    for (int it = 0; it < 9; ++it) { const int idx = lane + 64 * it;
        if (idx < nk) { const float pr = __expf(sc[it] - m); den += pr; const int kt = idx < CTX ? tb + idx : tb + CTX + j0 + (idx - CTX); const v4u* vp = (const v4u*)(U + (size_t)kt * UW + U_VA + kvh * 64);
#pragma unroll
            for (int i = 0; i < 8; ++i) { const v4u w = vp[i]; o[8 * i + 0] += pr * bf_lo(w.x); o[8 * i + 1] += pr * bf_hi(w.x); o[8 * i + 2] += pr * bf_lo(w.y); o[8 * i + 3] += pr * bf_hi(w.y); o[8 * i + 4] += pr * bf_lo(w.z); o[8 * i + 5] += pr * bf_hi(w.z); o[8 * i + 6] += pr * bf_lo(w.w); o[8 * i + 7] += pr * bf_hi(w.w); } } }
    den = wave_sum(den) + __expf(sink - m);
    float mine = 0.f;
#pragma unroll
    for (int d = 0; d < 64; ++d) { const float sd = wave_sum(o[d]); mine = (lane == d) ? sd : mine; }
    mine /= den;
    const float sq = wave_sum(mine * mine);
    if (lane == 0) ssq[h] = sq;
    __syncthreads();
    float tot = 0.f;
#pragma unroll
    for (int i = 0; i < 8; ++i) tot += ssq[i];
    const float rstd = rsqrtf(tot * (1.f / 512.f) + EPS);
    ((bf16*)(a.ws + WS_MIX))[(size_t)tk * D + h * 64 + lane] = (bf16)f2bf(mine * rstd * a.g_att[l * 512 + h * 64 + lane]);
}

__device__ __forceinline__ float conv_qk(const P& a, int l, const bf16* U, int tk, int ch) {
    const int b = tk / TPB, p = tk - b * TPB; const int lo = p < CTX ? 0 : CTX, hi = p < CTX ? CTX : TPB;
    float y = a.conv_b[l * 512 + ch];
#pragma unroll
    for (int j = 0; j < 5; ++j) { const int pp = p + j - 2; if (pp >= lo && pp < hi) y += a.conv_w[(l * 5 + j) * 512 + ch] * bf2f(U[(size_t)(b * TPB + pp) * UW + U_QM + ch]); }
    return silu_f(y);
}
__global__ void __launch_bounds__(256) k_mlstm_naive(P a, int l) {
    __shared__ float qs[2][64], ks[2][64], part[2][2][128], sc[2][4];
    const int t = threadIdx.x, dir = blockIdx.x & 1, hd = (blockIdx.x >> 1) & 3, b = blockIdx.x >> 3;
    const bf16* U = (const bf16*)(a.ws + WS_U); const float* G = (const float*)(a.ws + WS_GATES);
    float* HD = (float*)(a.ws + WS_HDIR) + (size_t)dir * T_ALL * 512;
    const int e = t & 127, half = t >> 7;
    float C[32];
#pragma unroll
    for (int i = 0; i < 32; ++i) C[i] = 0.f;
    float nst = 0.f, m = 0.f;
    for (int tau = 0; tau < TPB; ++tau) {
        const int pb = tau & 1;
        const int p = dir == 0 ? tau : (tau < CTX ? CTX - 1 - tau : CTX + (SEQ - 1) - (tau - CTX));
        const int tk = b * TPB + p;
        if (t < 64) qs[pb][t] = 0.125f * conv_qk(a, l, U, tk, hd * 64 + t);
        else if (t < 128) ks[pb][t - 64] = conv_qk(a, l, U, tk, 256 + hd * 64 + (t - 64));
        const float li = G[(size_t)tk * 16 + dir * 8 + hd], lf = logsigmoid_f(G[(size_t)tk * 16 + dir * 8 + 4 + hd]);
        const float mn = fmaxf(lf + m, li), fd = __expf(lf + m - mn), iw = __expf(li - mn);
        m = mn;
        const float v = bf2f(U[(size_t)tk * UW + U_VM + hd * 128 + e]);
        __syncthreads();
        float ph = 0.f;
#pragma unroll
        for (int i = 0; i < 32; ++i) { const int dk = half * 32 + i; C[i] = fd * C[i] + iw * ks[pb][dk] * v; ph += qs[pb][dk] * C[i]; }
        part[pb][half][e] = ph;
        if (t < 64) { nst = fd * nst + iw * ks[pb][t]; const float qn = wave_sum(qs[pb][t] * nst); if (t == 0) sc[pb][0] = qn; }
        __syncthreads();
        if (t < 128) { const float num = part[pb][0][t] + part[pb][1][t]; const float den = fmaxf(fabsf(sc[pb][0]), __expf(-mn)); HD[(size_t)tk * 512 + hd * 128 + t] = num / den; }
    }
}
__global__ void __launch_bounds__(256) k_merge_naive(P a, int l) {
    const int tk = blockIdx.x, hd = threadIdx.x >> 6, lane = threadIdx.x & 63;
    const float* H0 = (const float*)(a.ws + WS_HDIR); const float* H1 = H0 + (size_t)T_ALL * 512; const bf16* U = (const bf16*)(a.ws + WS_U);
    const int c0 = hd * 128 + lane, c1 = c0 + 64;
    const float h0 = H0[(size_t)tk * 512 + c0] + H1[(size_t)tk * 512 + c0], h1 = H0[(size_t)tk * 512 + c1] + H1[(size_t)tk * 512 + c1];
    const float rstd = rsqrtf(wave_sum(h0 * h0 + h1 * h1) * (1.f / 128.f) + EPS);
    bf16* mx = (bf16*)(a.ws + WS_MIX) + (size_t)tk * D + 512;
    mx[c0] = (bf16)f2bf(h0 * rstd * a.g_ml[l * 512 + c0] * sigmoid_f(bf2f(U[(size_t)tk * UW + U_OM + c0])));
    mx[c1] = (bf16)f2bf(h1 * rstd * a.g_ml[l * 512 + c1] * sigmoid_f(bf2f(U[(size_t)tk * UW + U_OM + c1])));
}

namespace pg {
#define PG_LAS __attribute__((address_space(3)))
typedef short bf16x8 __attribute__((ext_vector_type(8)));
constexpr int BM = 256, BK = 64, HALF = 128, HTB = HALF * BK * 2, STAGE_BYTES = 8 * HTB, NXCD = 8, WGM = 8;
__host__ __device__ __forceinline__ int lds_byte(int r, int c) { const int st = (r >> 4) * 2 + (c >> 5), rr = r & 15, cc = c & 31, ob = rr * 64 + cc * 2; return st * 1024 + (ob ^ (((ob >> 9) & 1) << 5)); }
__host__ __device__ __forceinline__ void stage_rc(int b, int& R, int& C) { const int st = b / 1024, sb = b % 1024, swz = sb ^ (((sb >> 9) & 1) << 5); R = (st >> 1) * 16 + swz / 64; C = (st & 1) * 32 + (swz % 64) / 2; }
__host__ __device__ __forceinline__ int perm32(int rho) { const int n = rho >> 4, i = rho & 15; return 8 * (i >> 2) + 4 * n + (i & 3); }
struct Unit { int pm, pn, e; };
struct Order {
    int nM, nN, nwg, G, c, lat;
    __device__ void init(int nM_, int nN_, int G_, int c_) { nM = nM_; nN = nN_; nwg = nM * nN; G = G_; c = c_; lat = 0; }
    __device__ bool next(int i, Unit& u) const {
        const long L = (long)i * G + c; if (L >= nwg) return false;
        int wgid = (int)L; { const int q = nwg / NXCD, r = nwg % NXCD, xcd = wgid % NXCD, off = wgid / NXCD; wgid = (xcd < r ? xcd * (q + 1) : r * (q + 1) + (xcd - r) * q) + off; }
        const int nig = WGM * nN, gid = wgid / nig, fm = gid * WGM, gsz = (nM - fm) < WGM ? (nM - fm) : WGM;
        u.pm = fm + ((wgid % nig) % gsz); u.pn = (wgid % nig) / gsz; u.e = 0; if (lat) u.pm = (u.pm >> 4) * 17 + 1 + (u.pm & 15); return true;
    }
};
struct Gemm { const bf16* A; const bf16* Bt; int K; int brows; const int* rowt; const int* tile_e; int wv; };

template <class Epi, bool GATHER, bool MOE>
__device__ __forceinline__ void gemm_phase(PG_LAS unsigned char* lds, const Gemm g, const Order& S, const Epi& E) {
    const int tid = otid_w(g.wv), wid = __builtin_amdgcn_readfirstlane(tid >> 6), lane = tid & 63, wr = wid >> 2, wc = wid & 3, fr = lane & 15, fq = lane >> 4;
    const int K = g.K, nt = K / BK;
    int Rr[2], Cc[2]; unsigned voffB[2];
#pragma unroll
    for (int i = 0; i < 2; ++i) { int R, C; stage_rc(tid * 16 + i * 8192, R, C); Rr[i] = R; Cc[i] = C; const int Rb = Epi::PERM ? ((R & ~31) + perm32(R & 31)) : R; voffB[i] = (unsigned)(Rb * K + C) * 2u; }
    const size_t hstep = (size_t)HALF * K * 2;
    const unsigned ldsw = (unsigned)wid * 1024u;
    const int aoff = lds_byte(wr * 64 + fr, fq * 8), boff = lds_byte(wc * 32 + fr, fq * 8);
    const char* Ab = (const char*)g.A;
#define PG_SA(b, h) (((b) * 2 + (h)) * HTB)
#define PG_SB(b, h) ((4 + (b) * 2 + (h)) * HTB)
#define PG_STAGE_B(bufoff, gbase) do { _Pragma("unroll") for (int _i = 0; _i < 2; ++_i) \
        __builtin_amdgcn_global_load_lds((const unsigned*)((const char*)(gbase) + voffB[_i]), (PG_LAS unsigned*)(lds + (bufoff) + ldsw + _i * 8192), 16, 0, 0); } while (0)
#define PG_STAGE_A(bufoff, offs, h, kb) do { _Pragma("unroll") for (int _i = 0; _i < 2; ++_i) \
        __builtin_amdgcn_global_load_lds((const unsigned*)(Ab + (size_t)(offs)[h][_i] + (size_t)(kb)), (PG_LAS unsigned*)(lds + (bufoff) + ldsw + _i * 8192), 16, 0, 0); } while (0)
#define PG_LDA(dst, b, h) do { _Pragma("unroll") for (int m = 0; m < 4; ++m) _Pragma("unroll") for (int k = 0; k < 2; ++k) dst[m][k] = *(const PG_LAS bf16x8*)(lds + PG_SA(b, h) + aoff + m * 2048 + k * 1024); } while (0)
#define PG_LDB(dst, b, h) do { _Pragma("unroll") for (int n = 0; n < 2; ++n) _Pragma("unroll") for (int k = 0; k < 2; ++k) dst[n][k] = *(const PG_LAS bf16x8*)(lds + PG_SB(b, h) + boff + n * 2048 + k * 1024); } while (0)
#define PG_MMA(ai, bj, At, Bt) do { __builtin_amdgcn_s_setprio(1); _Pragma("unroll") for (int m = 0; m < 4; ++m) _Pragma("unroll") for (int n = 0; n < 2; ++n) _Pragma("unroll") for (int k = 0; k < 2; ++k) \
        acc[ai][bj][m][n] = __builtin_amdgcn_mfma_f32_16x16x32_bf16(Bt[n][k], At[m][k], acc[ai][bj][m][n], 0, 0, 0); __builtin_amdgcn_s_setprio(0); } while (0)
#define PG_WAIT_V(n) asm volatile("s_waitcnt vmcnt(" #n ")" ::: "memory")
#define PG_WAIT_L(n) asm volatile("s_waitcnt lgkmcnt(" #n ")" ::: "memory")
#define PG_BAR __builtin_amdgcn_s_barrier()
#define PG_SCHED __builtin_amdgcn_sched_barrier(0)
#define PG_AOFFS(dst, u) do { _Pragma("unroll") for (int _h = 0; _h < 2; ++_h) _Pragma("unroll") for (int _i = 0; _i < 2; ++_i) { \
        const int _r = (u).pm * BM + _h * HALF + Rr[_i]; const int _row = GATHER ? g.rowt[_r] : _r; dst[_h][_i] = (unsigned)_row * (unsigned)(K * 2) + (unsigned)(Cc[_i] * 2); } } while (0)
#define PG_BBASE(u) ((const char*)g.Bt + ((size_t)(u).e * g.brows + (size_t)(u).pn * BM) * (size_t)K * 2)
    Unit cur, nxt; int ui = 0;
    if (!S.next(0, cur)) return;
    if (MOE) cur.e = g.tile_e[cur.pm];
    f32x4 acc[2][2][4][2];
#pragma unroll
    for (int a = 0; a < 2; ++a)
#pragma unroll
        for (int b = 0; b < 2; ++b)
#pragma unroll
            for (int m = 0; m < 4; ++m)
#pragma unroll
                for (int n = 0; n < 2; ++n) acc[a][b][m][n] = (f32x4){0.f, 0.f, 0.f, 0.f};
    bf16x8 At[4][2], B0[2][2], B1[2][2];
    unsigned offC[2][2], offN[2][2];
    PG_AOFFS(offC, cur);
    const char* cB = PG_BBASE(cur);
    const size_t kstep = (size_t)(BK * 2);
    PG_STAGE_B(PG_SB(0, 0), cB); PG_STAGE_B(PG_SB(0, 1), cB + hstep); PG_STAGE_A(PG_SA(0, 0), offC, 0, 0); PG_STAGE_A(PG_SA(0, 1), offC, 1, 0);
    if (wr == 1) PG_BAR;
    PG_WAIT_V(2); PG_BAR;
    PG_STAGE_B(PG_SB(1, 0), cB + kstep); PG_STAGE_A(PG_SA(1, 0), offC, 0, kstep); PG_STAGE_B(PG_SB(1, 1), cB + hstep + kstep);
    PG_WAIT_V(6); PG_BAR;
    for (;;) {
        bool has_next = S.next(ui + 1, nxt);
        if (has_next) { if (MOE) nxt.e = g.tile_e[nxt.pm]; if (GATHER) PG_AOFFS(offN, nxt); }
        else if (GATHER) {
#pragma unroll
            for (int h = 0; h < 2; ++h)
#pragma unroll
                for (int i = 0; i < 2; ++i) offN[h][i] = offC[h][i]; }
        const char* nB = has_next ? PG_BBASE(nxt) : cB;
        for (int t = 0; t < nt; t += 2) {
            const bool last = (t == nt - 2);
            const size_t k1 = (size_t)(t + 1) * kstep;
            const size_t k2 = last ? 0 : (size_t)(t + 2) * kstep;
            const char* b2 = last ? nB : cB + (size_t)(t + 2) * kstep; const char* b3 = b2 + kstep;
            PG_LDB(B0, 0, 0); PG_LDB(B1, 0, 1); PG_SCHED; PG_LDA(At, 0, 0); PG_STAGE_A(PG_SA(1, 1), offC, 1, k1);
            PG_WAIT_V(8); PG_WAIT_L(0); PG_BAR; PG_MMA(0, 0, At, B0); PG_MMA(0, 1, At, B1); PG_BAR; PG_SCHED;
            if (last) {
                if (GATHER) {
#pragma unroll
                    for (int h = 0; h < 2; ++h)
#pragma unroll
                        for (int i = 0; i < 2; ++i) offC[h][i] = offN[h][i];
                } else if (has_next) { PG_AOFFS(offC, nxt); }
            }
            PG_LDA(At, 0, 1); PG_STAGE_B(PG_SB(0, 0), b2); PG_STAGE_B(PG_SB(0, 1), b2 + hstep); PG_STAGE_A(PG_SA(0, 0), offC, 0, k2);
            PG_WAIT_V(8); PG_WAIT_L(0); PG_BAR; PG_MMA(1, 0, At, B0); PG_MMA(1, 1, At, B1); PG_BAR; PG_SCHED;
            PG_LDB(B0, 1, 0); PG_LDB(B1, 1, 1); PG_SCHED; PG_LDA(At, 1, 0); PG_STAGE_A(PG_SA(0, 1), offC, 1, k2);
            PG_WAIT_V(8); PG_WAIT_L(0); PG_BAR; PG_MMA(0, 0, At, B0); PG_MMA(0, 1, At, B1); PG_BAR; PG_SCHED;
            PG_LDA(At, 1, 1); PG_STAGE_B(PG_SB(1, 0), b3); PG_STAGE_B(PG_SB(1, 1), b3 + hstep); PG_STAGE_A(PG_SA(1, 0), offC, 0, k2 + kstep);
            PG_WAIT_V(8); PG_WAIT_L(0); PG_BAR; PG_MMA(1, 0, At, B0); PG_MMA(1, 1, At, B1); PG_BAR; PG_SCHED;
        }
        if (wr == 0) PG_BAR;
        E(acc, cur, wr, wc, fr, fq);
        if (!has_next) break;
#pragma unroll
        for (int a = 0; a < 2; ++a)
#pragma unroll
            for (int b = 0; b < 2; ++b)
#pragma unroll
                for (int m = 0; m < 4; ++m)
#pragma unroll
                    for (int n = 0; n < 2; ++n) acc[a][b][m][n] = (f32x4){0.f, 0.f, 0.f, 0.f};
        cur = nxt; cB = nB; ++ui;
        if (wr == 1) PG_BAR;
    }
    PG_WAIT_V(0);
    PG_BAR;
#undef PG_SA
#undef PG_SB
#undef PG_STAGE_A
#undef PG_STAGE_B
#undef PG_LDA
#undef PG_LDB
#undef PG_MMA
#undef PG_WAIT_V
#undef PG_WAIT_L
#undef PG_BAR
#undef PG_SCHED
#undef PG_AOFFS
#undef PG_BBASE
}
}


struct EpiIn {
    static constexpr bool PERM = false;
    bf16* U; const PG_LAS float* rope;
    __device__ __forceinline__ void operator()(const f32x4 (&acc)[2][2][4][2], const pg::Unit& u, int wr, int wc, int fr, int fq) const {
        const int tb = (u.pm * 256) / TPB, p0 = u.pm * 256 - tb * TPB; const bool latent = p0 >= CTX;
#pragma unroll
        for (int ai = 0; ai < 2; ++ai)
#pragma unroll
            for (int m = 0; m < 4; ++m) {
                const int rl = ai * 128 + wr * 64 + m * 16 + fr; const int r = u.pm * 256 + rl; const int s = p0 + rl - CTX;
                bf16* rowp = U + (size_t)r * UW + u.pn * 256 + wc * 32 + ((fq & 1) ? 16 + 4 * (fq - 1) : 4 * fq);
#pragma unroll
                for (int bj = 0; bj < 2; ++bj) {
                    const int G = (u.pn * 256 + bj * 128 + wc * 32) >> 5;
                    f32x4 x1 = acc[ai][bj][m][0], x2 = acc[ai][bj][m][1];
                    if (G < 20) {
                        if (latent) { const int pos = (G & 1) ? (s & 63) : (s >> 6); const PG_LAS float* t = rope + (pos * 16 + 4 * fq) * 2;
                            const f32x4 t0 = *(const PG_LAS f32x4*)t, t1 = *(const PG_LAS f32x4*)(t + 4);
                            const f32x4 cs = (f32x4){t0.x, t0.z, t1.x, t1.z}, sn = (f32x4){t0.y, t0.w, t1.y, t1.w};
                            const f32x4 y1 = x1 * cs - x2 * sn, y2 = x2 * cs + x1 * sn; x1 = y1; x2 = y2; }
                        if (G < 16) { x1 = x1 * 0.18033688011112042f; x2 = x2 * 0.18033688011112042f; }
                    }
                    v2u o1, o2; o1.x = cvt_pk_bf16(x1.x, x1.y); o1.y = cvt_pk_bf16(x1.z, x1.w); o2.x = cvt_pk_bf16(x2.x, x2.y); o2.y = cvt_pk_bf16(x2.z, x2.w);
                    asm volatile("s_nop 1\n\tv_permlane16_swap_b32 %0, %2\n\tv_permlane16_swap_b32 %1, %3\n\ts_nop 0" : "+v"(o1.x), "+v"(o1.y), "+v"(o2.x), "+v"(o2.y));
                    *(v4u*)(rowp + bj * 128) = (v4u){o1.x, o1.y, o2.x, o2.y};
                }
            }
    }
};
template <int CHUNK, bool INPLACE> struct EpiRes {
    static constexpr bool PERM = false;
    float* X; const float* modl; const float* xin; const float* cin; int l; float* Xo;
    __device__ __forceinline__ void operator()(const f32x4 (&acc)[2][2][4][2], const pg::Unit& u, int wr, int wc, int fr, int fq) const {
        const int tb = (u.pm * 256) / TPB, p0 = u.pm * 256 - tb * TPB; const int mr = p0 < CTX ? NB : tb;
        const float* mv = modl + (size_t)mr * MODW + CHUNK * D + u.pn * 256 + wc * 32 + 4 * fq;
        f32x4 mod[2][2];
#pragma unroll
        for (int bj = 0; bj < 2; ++bj)
#pragma unroll
            for (int n = 0; n < 2; ++n) mod[bj][n] = *(const f32x4*)(mv + bj * 128 + n * 16);
        const bool from_in = (!INPLACE) && l == 0;
        const int co = u.pn * 256 + wc * 32 + 4 * fq;
#pragma unroll
        for (int ai = 0; ai < 2; ++ai) {
            f32x4 bs[4][2][2];
#pragma unroll
            for (int m = 0; m < 4; ++m) {
                const int rl = ai * 128 + wr * 64 + m * 16 + fr; const int r = u.pm * 256 + rl; const int p = p0 + rl;
                const float* bp = from_in ? (p < CTX ? cin + ((size_t)tb * CTX + p) * D : xin + ((size_t)tb * SEQ + (p - CTX)) * D) : X + (size_t)r * D;
#pragma unroll
                for (int bj = 0; bj < 2; ++bj)
#pragma unroll
                    for (int n = 0; n < 2; ++n) bs[m][bj][n] = *(const f32x4*)(bp + co + bj * 128 + n * 16);
            }
#pragma unroll
            for (int m = 0; m < 4; ++m) {
                const int r = u.pm * 256 + ai * 128 + wr * 64 + m * 16 + fr;
#pragma unroll
                for (int bj = 0; bj < 2; ++bj)
#pragma unroll
                    for (int n = 0; n < 2; ++n) *(f32x4*)(Xo + (size_t)r * D + co + bj * 128 + n * 16) = bs[m][bj][n] + mod[bj][n] * acc[ai][bj][m][n];
            }
        }
    }
};
template <bool MOE> struct EpiSwiglu {
    static constexpr bool PERM = true;
    bf16* H; const float* roww;
    __device__ __forceinline__ void operator()(const f32x4 (&acc)[2][2][4][2], const pg::Unit& u, int wr, int wc, int fr, int fq) const {
        float rws[2][4];
#pragma unroll
        for (int ai = 0; ai < 2; ++ai)
#pragma unroll
            for (int m = 0; m < 4; ++m) rws[ai][m] = MOE ? roww[u.pm * 256 + ai * 128 + wr * 64 + m * 16 + fr] : 1.f;
#pragma unroll
        for (int ai = 0; ai < 2; ++ai)
#pragma unroll
            for (int m = 0; m < 4; ++m) {
                const int r = u.pm * 256 + ai * 128 + wr * 64 + m * 16 + fr;
                const float rw = rws[ai][m];
                f32x4 h0, h1;
#pragma unroll
                for (int j = 0; j < 4; ++j) { const float g0 = acc[ai][0][m][0][j], g1 = acc[ai][0][m][1][j];
                    h0[j] = g0 * __builtin_amdgcn_rcpf(1.f + __expf(-g0)) * acc[ai][1][m][0][j] * rw; h1[j] = g1 * __builtin_amdgcn_rcpf(1.f + __expf(-g1)) * acc[ai][1][m][1][j] * rw; }
                v4u w; w.x = cvt_pk_bf16(h0.x, h0.y); w.y = cvt_pk_bf16(h0.z, h0.w); w.z = cvt_pk_bf16(h1.x, h1.y); w.w = cvt_pk_bf16(h1.z, h1.w);
                *(v4u*)(H + (size_t)r * FFN + u.pn * 128 + wc * 32 + 8 * fq) = w;
            }
    }
};
struct EpiYs {
    static constexpr bool PERM = true;
    bf16* Y;
    __device__ __forceinline__ void operator()(const f32x4 (&acc)[2][2][4][2], const pg::Unit& u, int wr, int wc, int fr, int fq) const {
#pragma unroll
        for (int ai = 0; ai < 2; ++ai)
#pragma unroll
            for (int m = 0; m < 4; ++m) {
                bf16* rowp = Y + (size_t)(u.pm * 256 + ai * 128 + wr * 64 + m * 16 + fr) * D + u.pn * 256 + wc * 32 + 8 * fq;
#pragma unroll
                for (int bj = 0; bj < 2; ++bj) { const f32x4 v0 = acc[ai][bj][m][0], v1 = acc[ai][bj][m][1];
                    v4u w; w.x = cvt_pk_bf16(v0.x, v0.y); w.y = cvt_pk_bf16(v0.z, v0.w); w.z = cvt_pk_bf16(v1.x, v1.y); w.w = cvt_pk_bf16(v1.z, v1.w);
                    *(v4u*)(rowp + bj * 128) = w; }
            }
    }
};
template <bool COMPUTE> struct EpiProbe {
    static constexpr bool PERM = true;
    __device__ __forceinline__ void operator()(const f32x4 (&acc)[2][2][4][2], const pg::Unit& u, int wr, int wc, int fr, int fq) const {
#pragma unroll
        for (int ai = 0; ai < 2; ++ai)
#pragma unroll
            for (int m = 0; m < 4; ++m) {
                if (COMPUTE) { f32x4 h0, h1;
#pragma unroll
                    for (int j = 0; j < 4; ++j) { const float g0 = acc[ai][0][m][0][j], g1 = acc[ai][0][m][1][j];
                        h0[j] = g0 * __builtin_amdgcn_rcpf(1.f + __expf(-g0)) * acc[ai][1][m][0][j]; h1[j] = g1 * __builtin_amdgcn_rcpf(1.f + __expf(-g1)) * acc[ai][1][m][1][j]; }
                    v4u w; w.x = cvt_pk_bf16(h0.x, h0.y); w.y = cvt_pk_bf16(h0.z, h0.w); w.z = cvt_pk_bf16(h1.x, h1.y); w.w = cvt_pk_bf16(h1.z, h1.w);
                    asm volatile("" :: "v"(w));
                } else {
#pragma unroll
                    for (int bj = 0; bj < 2; ++bj) { asm volatile("" :: "v"(acc[ai][bj][m][0]), "v"(acc[ai][bj][m][1])); }
                }
            }
    }
};
enum { CP_D2 = 0, CP_OUT = 1, CP_F1 = 2, CP_F2D = 3, CP_IN = 4 };
__device__ __forceinline__ bool conv_sched(int l, int phase, int& li, int& j0, int& j1) {
    li = l >> 1;
    if ((l & 1) == 0) {
        if (phase == CP_D2)  { j0 = l == 0 ? 0 : 1000; j1 = l == 0 ? 7500 : 8500; return true; }
        if (phase == CP_OUT) { j0 = l == 0 ? 7500 : 8500; j1 = l == 0 ? 12000 : 13000; return true; }
        if (phase == CP_F1)  { j0 = l == 0 ? 12000 : 13000; j1 = l == 0 ? 13500 : 14500; return true; }
        if (phase == CP_F2D) { j0 = l == 0 ? 13500 : 14500; j1 = l == 0 ? 25500 : 26500; return true; }
        if (phase == CP_IN && l == 2) { j0 = 0; j1 = 1000; return true; }
        return false;
    }
    if (phase == CP_IN) { j0 = l == 1 ? 25500 : 26500; j1 = l == 1 ? 26500 : 27500; return true; }
    if (phase == CP_D2) { j0 = l == 1 ? 26500 : 27500; j1 = EXP_ITEMS; return true; }
    return false;
}
#ifndef STAGGER_TICKS
#define STAGGER_TICKS 0
#endif
__device__ __forceinline__ void conv_tail(const P& a, int l, int phase, const pg::Order& S, PG_LAS unsigned char* lds) {
    int li, j0, j1; if (!conv_sched(l, phase, li, j0, j1)) return;
    const int rem = S.nwg % S.G; if (rem == 0 || S.c < rem) return;
    const int t_ = otid(), wv = __builtin_amdgcn_readfirstlane(t_ >> 6);
    conv_expert_range(a, li, j0, j1, (S.c - rem) * 8 + wv, (S.G - rem) * 8, (PG_LAS float*)lds + wv * (64 * 33), t_ & 63);
}
template <int WHICH> __device__ __forceinline__ void gemm_run(const P& a_in, int l, PG_LAS unsigned char* lds, int G, int c, bool probe = false) {
    PHASE_ENTRY(a_in)
    if (STAGGER_TICKS > 0 && (WHICH == EM_F1 || WHICH == EM_F1M)) {
        const unsigned long long t0 = __builtin_amdgcn_s_memrealtime(); const unsigned long long dl = (unsigned long long)((c & 3) * STAGGER_TICKS);
        while (__builtin_amdgcn_s_memrealtime() - t0 < dl) __builtin_amdgcn_s_sleep(8);
    }
    unsigned char* ws = a.ws; pg::Order S;
    if (WHICH == EM_IN) { S.init(T_ALL / 256, UW / 256, G, c); pg::Gemm g{(const bf16*)(ws + WS_HX), (const bf16*)(ws + WS_WIN) + (size_t)l * UW * D, D, 0, nullptr, nullptr, a.wv};
        PG_LAS float* rl = (PG_LAS float*)(lds + 131072 + 1024); const float* rg = (const float*)(ws + WS_ROPE);
        for (int i = otid(); i < 2048; i += NTHR) rl[i] = rg[i];
        __syncthreads();
        EpiIn E{(bf16*)(ws + WS_U), rl}; pg::gemm_phase<EpiIn, false, false>(lds, g, S, E);
        conv_tail(a, l, CP_IN, S, lds); }
    if (WHICH == EM_OUT) { if (l == DEPTH - 1) { S.init(NB * SEQ / 256, D / 256, G, c); S.lat = 1; } else S.init(T_ALL / 256, D / 256, G, c); pg::Gemm g{(const bf16*)(ws + WS_MIX), (const bf16*)(ws + WS_WOUT) + (size_t)l * D * D, D, 0, nullptr, nullptr, a.wv};
        EpiYs E{(bf16*)(ws + WS_DELTA)}; pg::gemm_phase<EpiYs, false, false>(lds, g, S, E);
        conv_tail(a, l, CP_OUT, S, lds); }
    if (WHICH == EM_F1) { S.init(T_ALL / 256, 2 * FFN / 256, G, c); pg::Gemm g{(const bf16*)(ws + WS_HX), (const bf16*)(ws + WS_WF13) + (size_t)(l >> 1) * 2 * FFN * D, D, 0, nullptr, nullptr, a.wv};
        if (PROBE == 20 && probe) { EpiProbe<false> E; pg::gemm_phase<EpiProbe<false>, false, false>(lds, g, S, E); }
        else if (PROBE == 21 && probe) { EpiProbe<true> E; pg::gemm_phase<EpiProbe<true>, false, false>(lds, g, S, E); }
        else { EpiSwiglu<false> E{(bf16*)(ws + WS_HID), nullptr}; pg::gemm_phase<EpiSwiglu<false>, false, false>(lds, g, S, E); conv_tail(a, l, CP_F1, S, lds); } }
    if (WHICH == EM_F2D) { S.init(T_ALL / 256, D / 256, G, c); pg::Gemm g{(const bf16*)(ws + WS_HID), (const bf16*)(ws + WS_WF2) + (size_t)(l >> 1) * D * FFN, FFN, 0, nullptr, nullptr, a.wv};
        EpiYs E{(bf16*)(ws + WS_DELTA)}; pg::gemm_phase<EpiYs, false, false>(lds, g, S, E);
        conv_tail(a, l, CP_F2D, S, lds); }
    if (WHICH == EM_F1M) { const int* te = (const int*)(ws + WS_TILEE); const int nt = __builtin_amdgcn_readfirstlane(te[MOE_TILES]); S.init(nt, 2 * FFN / 256, G, c);
        pg::Gemm g{(const bf16*)(ws + WS_HX), (const bf16*)(ws + WS_WE13), D, 2 * FFN, (const int*)(ws + WS_ROWT), te, a.wv};
        EpiSwiglu<true> E{(bf16*)(ws + WS_HID), (const float*)(ws + WS_ROWW)}; pg::gemm_phase<EpiSwiglu<true>, true, true>(lds, g, S, E); }
    if (WHICH == EM_F2M) { const int* te = (const int*)(ws + WS_TILEE); const int nt = __builtin_amdgcn_readfirstlane(te[MOE_TILES]); S.init(nt, D / 256, G, c);
        pg::Gemm g{(const bf16*)(ws + WS_HID), (const bf16*)(ws + WS_WE2), FFN, D, nullptr, te, a.wv};
        EpiYs E{(bf16*)(ws + WS_YS)}; pg::gemm_phase<EpiYs, false, true>(lds, g, S, E); }
}
template <int WHICH> __global__ void __launch_bounds__(NTHR, 2) k_gemm(P a, int l) {
    extern __shared__ __attribute__((aligned(16))) unsigned char smem[];
    a.wv = __builtin_amdgcn_readfirstlane(threadIdx.x >> 6);
    gemm_run<WHICH>(a, l, (PG_LAS unsigned char*)smem, (int)gridDim.x, (int)blockIdx.x);
}

typedef float f32x2 __attribute__((ext_vector_type(2)));
typedef float f32x16 __attribute__((ext_vector_type(16)));
typedef short v4s __attribute__((ext_vector_type(4)));
constexpr int ATT_ITEMS = NB * (SEQ / 32) + NB * (CTX / 32);
constexpr int ATT_LDS = 5 * 16384 + 32768 + 1024 + 2048;
__device__ __forceinline__ int att_item(int c, int kk, int sch) {
    const int x = c & 7, idx = c >> 3;
    if (sch == 0) return (idx >= 4 && kk == 0) ? x * 128 + (idx - 4) : -1;
    if (idx < 4) return -1;
    const int j = idx - 4;
    if (kk < 3) return x * 128 + 28 + 3 * j + kk;
    if (kk == 3) return j < 16 ? x * 128 + 112 + j : (j < 24 ? NB * (SEQ / 32) + x * 8 + (j - 16) : -1);
    return -1;
}
struct AttIt { int tb, tq0, ilo, nt; };
__device__ __forceinline__ AttIt att_decode(int it) {
    AttIt I;
    if (it < NB * (SEQ / 32)) { const int b = it >> 7, s0 = (it & 127) * 32; I.tb = b * TPB; I.tq0 = I.tb + CTX + s0;
        I.ilo = s0 >= 128 ? 0 : (128 - s0) / 32; int ihi = (SEQ + 96 - s0) / 32; ihi = ihi > 8 ? 8 : ihi; I.nt = 8 + (ihi - I.ilo + 1); }
    else { const int j = it - NB * (SEQ / 32), b = j >> 3; I.tb = b * TPB; I.tq0 = I.tb + (j & 7) * 32; I.ilo = 0; I.nt = 8; }
    return I;
}
__device__ __forceinline__ int att_tok(const AttIt& I, int t) { return t < 8 ? I.tb + 32 * t : I.tq0 - 128 + 32 * (I.ilo + t - 8); }
template <int PM> __device__ __forceinline__ void attn_phase(const P& a_in, int l, PG_LAS unsigned char* lds, int G, int c_in, int sch) {
    PHASE_ENTRY(a_in)
    int c = c_in; asm volatile("" : "+s"(c));
    const int tid = otid(), lane = tid & 63, h = __builtin_amdgcn_readfirstlane(tid >> 6), kvh = h >> 2;
    const int qr = lane & 31, hh = lane >> 5;
    const bf16* U = (const bf16*)(a.ws + WS_U); bf16* MIX = (bf16*)(a.ws + (PM ? WS_DELTA : WS_MIX));
    PG_LAS float* ssq = (PG_LAS float*)(lds + 114688); PG_LAS float* gl = (PG_LAS float*)(lds + 115712);
    float sink = a.attn_sink[l * 8 + h] * 1.4426950408889634f;
    asm volatile("" : "+v"(sink));
    const int st_isv = (tid >> 8) & 1, st_key = (tid >> 3) & 31, st_pos = tid & 7;
    const int st_ch = st_isv ? (st_pos ^ (((st_key >> 1) & 1) << 2)) : (st_pos ^ ((st_key >> 1) & 7));
    const int st_col = (st_isv ? U_VA : U_KA) + st_ch * 8;
    const unsigned st_lds = (unsigned)h * 1024u;
    const int q_goff = qr * UW + U_QA + h * 64 + 8 * hh;
    const int k_row = qr * 128, k_sw = (qr >> 1) & 7;
    const int tr_q = (lane & 15) >> 2, tr_p = lane & 3, tr_g = (lane >> 4) & 1;
    unsigned trv[2];
#pragma unroll
    for (int dt = 0; dt < 2; ++dt) trv[dt] = (unsigned)(kvh * 8192 + 4096 + (4 * hh + tr_q) * 128 + ((2 * (32 * dt + 16 * tr_g + 4 * tr_p)) ^ (((tr_q >> 1) & 1) << 6)));
    unsigned koff[4];
#pragma unroll
    for (int s4 = 0; s4 < 4; ++s4) koff[s4] = (unsigned)(kvh * 8192 + k_row + 16 * ((2 * s4 + hh) ^ k_sw));
    int it0 = att_item(c, 0, sch); if (it0 < 0) return;
    __syncthreads();
    for (int i = tid; i < 512; i += NTHR) gl[i] = a.g_att[l * 512 + i];
    AttIt cur = att_decode(it0);
    int tk0, tk1;
    {
        int e0 = lane, e1 = 64 + lane, r0 = -1, r1 = -1, lastt = 0;
        for (int kk = 0; kk < 5; ++kk) { const int it_ = att_item(c, kk, sch); if (it_ < 0) break; const AttIt I = att_decode(it_);
            if (r0 < 0) { if (e0 < I.nt) r0 = att_tok(I, e0); else e0 -= I.nt; }
            if (r1 < 0) { if (e1 < I.nt) r1 = att_tok(I, e1); else e1 -= I.nt; }
            lastt = att_tok(I, I.nt - 1); }
        tk0 = r0 < 0 ? lastt : r0; tk1 = r1 < 0 ? lastt : r1;
    }
#define ATT_DMA_TILE(stage, idx) do { const int i_ = (idx); const int kt_ = __builtin_amdgcn_readlane(i_ < 64 ? tk0 : tk1, i_ & 63) + st_key; const bf16* g_ = U + (size_t)kt_ * UW + st_col; \
        __builtin_amdgcn_global_load_lds((const unsigned*)g_, (PG_LAS unsigned*)(lds + (stage) * 16384 + st_lds), 16, 0, 0); \
        __builtin_amdgcn_global_load_lds((const unsigned*)(g_ + 64), (PG_LAS unsigned*)(lds + (stage) * 16384 + 8192 + st_lds), 16, 0, 0); } while (0)
#define ATT_DMA_Q(I, par) do { const bf16* g_ = U + (size_t)(I).tq0 * UW + q_goff; _Pragma("unroll") for (int i_ = 0; i_ < 4; ++i_) \
        __builtin_amdgcn_global_load_lds((const unsigned*)(g_ + 16 * i_), (PG_LAS unsigned*)(lds + 81920 + h * 4096 + i_ * 1024), 16, 0, 0); } while (0)
#define ATT_BAR do { asm volatile("s_waitcnt lgkmcnt(0)" ::: "memory"); __builtin_amdgcn_s_barrier(); asm volatile("" ::: "memory"); } while (0)
#define ATT_QK(dst, stage) do { PG_LAS unsigned char* kb_ = lds + (stage) * 16384 + kvh * 8192; dst = (f32x16){}; _Pragma("unroll") for (int s4 = 0; s4 < 4; ++s4) { \
        const pg::bf16x8 kf_ = *(const PG_LAS pg::bf16x8*)(kb_ + k_row + 16 * ((2 * s4 + hh) ^ k_sw)); dst = __builtin_amdgcn_mfma_f32_32x32x16_bf16(kf_, qf[s4], dst, 0, 0, 0); } } while (0)
    ATT_DMA_Q(cur, 0);
    ATT_DMA_TILE(0, 0); ATT_DMA_TILE(1, 1); ATT_DMA_TILE(2, 2); ATT_DMA_TILE(3, 3);
    asm volatile("s_waitcnt vmcnt(4)" ::: "memory");
    ATT_BAR;
    pg::bf16x8 qf[4];
#pragma unroll
    for (int s4 = 0; s4 < 4; ++s4) qf[s4] = *(const PG_LAS pg::bf16x8*)(lds + 81920 + h * 4096 + s4 * 1024 + lane * 16);
    f32x16 scur; ATT_QK(scur, 0);
    int j = 0, sj = 0;
    for (int kk = 0; ; ++kk) {
        const int nit = att_item(c, kk + 1, sch); const bool has_next = nit >= 0; const AttIt nxt = has_next ? att_decode(nit) : cur;
        float m = sink, lsum = 0.f;
        f32x16 o0 = {}, o1 = {};
        const int nt = cur.nt;
        for (int t = 0; t < nt; ++t, ++j) {
            const int s1 = sj == 4 ? 0 : sj + 1, s4g = sj == 0 ? 4 : sj - 1;
            if (t == 0) ATT_DMA_Q(nxt, 0);
            ATT_DMA_TILE(s4g, j + 4);
            const unsigned vbs = (unsigned)(size_t)lds + (unsigned)sj * 16384u;
            v2u va[2][2], vc[2][2];
#pragma unroll
            for (int dt = 0; dt < 2; ++dt) { const unsigned ad = vbs + trv[dt];
                asm volatile("ds_read_b64_tr_b16 %0, %1" : "=v"(va[0][dt]) : "v"(ad));
                asm volatile("ds_read_b64_tr_b16 %0, %1 offset:1024" : "=v"(vc[0][dt]) : "v"(ad));
                asm volatile("ds_read_b64_tr_b16 %0, %1 offset:2048" : "=v"(va[1][dt]) : "v"(ad));
                asm volatile("ds_read_b64_tr_b16 %0, %1 offset:3072" : "=v"(vc[1][dt]) : "v"(ad)); }
            v4u kf[4];
            { const unsigned kbs = (unsigned)(size_t)lds + (unsigned)s1 * 16384u;
#pragma unroll
              for (int s4 = 0; s4 < 4; ++s4) asm volatile("ds_read_b128 %0, %1" : "=v"(kf[s4]) : "v"(kbs + koff[s4])); }
            if (t == nt - 1) {
#pragma unroll
                for (int s4 = 0; s4 < 4; ++s4) qf[s4] = *(const PG_LAS pg::bf16x8*)(lds + 81920 + h * 4096 + s4 * 1024 + lane * 16); }
            f32x16 sacc = scur;
            const int ti = (t < 8) ? -1 : cur.ilo + t - 8;
            if (ti == 0 || ti == 8) {
#pragma unroll
                for (int i = 0; i < 16; ++i) { const int kq = (i & 3) + 8 * (i >> 2) + 4 * hh; const bool ok = (ti == 0) ? (kq >= qr) : (kq <= qr); sacc[i] = ok ? sacc[i] : -1.0e30f; }
            }
            float mt = sacc[0];
#pragma unroll
            for (int i = 1; i < 16; ++i) mt = fmaxf(mt, sacc[i]);
            mt = hmax32(mt);
            const bool grow = mt > m + 8.f;
            if (__any(grow)) {
                const float mn = grow ? mt : m, alpha = __builtin_amdgcn_exp2f(m - mn); m = mn; lsum *= alpha;
#pragma unroll
                for (int i = 0; i < 16; ++i) { o0[i] *= alpha; o1[i] *= alpha; } }
            asm volatile("s_waitcnt lgkmcnt(0)" : "+v"(kf[0]), "+v"(kf[1]), "+v"(kf[2]), "+v"(kf[3]), "+v"(va[0][0]), "+v"(vc[0][0]), "+v"(va[0][1]), "+v"(vc[0][1]), "+v"(va[1][0]), "+v"(vc[1][0]), "+v"(va[1][1]), "+v"(vc[1][1]));
            f32x16 snext = {}; f32x2 ps2 = {0.f, 0.f}; const f32x2 mm = {m, m};
#pragma unroll
            for (int g = 0; g < 4; ++g) {
                snext = __builtin_amdgcn_mfma_f32_32x32x16_bf16(__builtin_bit_cast(pg::bf16x8, kf[g]), qf[g], snext, 0, 0, 0);
#pragma unroll
                for (int i = 2 * g; i < 2 * g + 2; ++i) { const f32x2 d = (f32x2){sacc[2 * i], sacc[2 * i + 1]} - mm; const f32x2 ev = {__builtin_amdgcn_exp2f(d.x), __builtin_amdgcn_exp2f(d.y)};
                    sacc[2 * i] = ev.x; sacc[2 * i + 1] = ev.y; ps2 += ev; }
                __builtin_amdgcn_sched_barrier(0);
            }
            lsum += ps2.x + ps2.y;
#pragma unroll
            for (int s2 = 0; s2 < 2; ++s2) {
                v4u pw; pw.x = cvt_pk_bf16(sacc[8 * s2 + 0], sacc[8 * s2 + 1]); pw.y = cvt_pk_bf16(sacc[8 * s2 + 2], sacc[8 * s2 + 3]);
                pw.z = cvt_pk_bf16(sacc[8 * s2 + 4], sacc[8 * s2 + 5]); pw.w = cvt_pk_bf16(sacc[8 * s2 + 6], sacc[8 * s2 + 7]);
                const pg::bf16x8 pf = __builtin_bit_cast(pg::bf16x8, pw);
#pragma unroll
                for (int dt = 0; dt < 2; ++dt) {
                    const pg::bf16x8 vf = __builtin_bit_cast(pg::bf16x8, (v4u){va[s2][dt].x, va[s2][dt].y, vc[s2][dt].x, vc[s2][dt].y});
                    if (dt == 0) o0 = __builtin_amdgcn_mfma_f32_32x32x16_bf16(vf, pf, o0, 0, 0, 0);
                    else o1 = __builtin_amdgcn_mfma_f32_32x32x16_bf16(vf, pf, o1, 0, 0, 0);
                }
            }
            scur = snext;
            if (t == 0) asm volatile("s_waitcnt vmcnt(8)" ::: "memory"); else asm volatile("s_waitcnt vmcnt(4)" ::: "memory");
            ATT_BAR;
            sj = s1;
        }
        const float ltot = hsum32(lsum);
        const float inv = __builtin_amdgcn_rcpf(ltot + __builtin_amdgcn_exp2f(sink - m));
        float sq = 0.f;
#pragma unroll
        for (int i = 0; i < 16; ++i) { o0[i] *= inv; o1[i] *= inv; sq += o0[i] * o0[i] + o1[i] * o1[i]; }
        sq = hsum32(sq);
        if (hh == 0) ssq[h * 32 + qr] = sq;
        ATT_BAR;
        float tot = 0.f;
#pragma unroll
        for (int w = 0; w < 8; ++w) tot += ssq[w * 32 + qr];
        const float rstd = rsqrtf(tot * (1.f / 512.f) + EPS);
        bf16* orow = MIX + (size_t)(cur.tq0 + qr) * D + h * 64;
#pragma unroll
        for (int dt = 0; dt < 2; ++dt)
#pragma unroll
            for (int i4 = 0; i4 < 4; ++i4) { const int d = 32 * dt + 8 * i4 + 4 * hh; const f32x4 gg = *(const PG_LAS f32x4*)(gl + h * 64 + d);
                const f32x16& oo = dt == 0 ? o0 : o1;
                v2u w; w.x = cvt_pk_bf16(oo[4 * i4 + 0] * rstd * gg.x, oo[4 * i4 + 1] * rstd * gg.y); w.y = cvt_pk_bf16(oo[4 * i4 + 2] * rstd * gg.z, oo[4 * i4 + 3] * rstd * gg.w);
                *(v2u*)(orow + d) = w; }
        if (!has_next) break;
        cur = nxt;
    }
    asm volatile("s_waitcnt vmcnt(0)" ::: "memory");
    __syncthreads();
#undef ATT_DMA_TILE
#undef ATT_QK
#undef ATT_BAR
#undef ATT_DMA_Q
}
__global__ void __launch_bounds__(NTHR, 2) k_attn(P a, int l) {
    extern __shared__ __attribute__((aligned(16))) unsigned char smem[];
    a.wv = __builtin_amdgcn_readfirstlane(threadIdx.x >> 6);
    attn_phase<0>(a, l, (PG_LAS unsigned char*)smem, (int)gridDim.x, (int)blockIdx.x, 0); attn_phase<0>(a, l, (PG_LAS unsigned char*)smem, (int)gridDim.x, (int)blockIdx.x, 1);
}

__device__ __forceinline__ float scan_sum(float v, int) { return dpp_scan<false>(v); }
__device__ __forceinline__ float scan_max(float v, int) { return dpp_scan<true>(v); }
constexpr int ML_ITEMS = NB * NCHUNK;
constexpr int ML_LDS = 65536 + 65536 + 16384;
__device__ __forceinline__ void ml_load_v(const bf16* U, int tk0, PG_LAS unsigned char* lds, int tid) {
#pragma unroll
    for (int i = 0; i < 8; ++i) { const int cid = tid + 512 * i, sg = cid >> 6, r = cid & 63, hv = r >> 4, ch = r & 15;
        const v4u v = *(const v4u*)(U + (size_t)(tk0 + sg) * UW + U_VM + hv * 128 + ch * 8);
        *(PG_LAS v4u*)(lds + hv * 16384 + sg * 256 + ((ch * 16) ^ ((sg & 3) << 6))) = v; }
}
__device__ __forceinline__ float ml_tok(const bf16* U, int tk, int lo, int hi, int col) { return (tk >= lo && tk < hi) ? bf2f(U[(size_t)tk * UW + col]) : 0.f; }

template <int NT> __device__ __forceinline__ void conv8(const P& a, int l, const bf16* U, int tk0, int s0, int lo, int hi, int ch0, float (&out)[NT][8]) {
    float cw[5][8], cb[8];
#pragma unroll
    for (int j = 0; j < 5; ++j) { const f32x4 w0 = *(const f32x4*)(a.conv_w + (l * 5 + j) * 512 + ch0), w1 = *(const f32x4*)(a.conv_w + (l * 5 + j) * 512 + ch0 + 4);
        cw[j][0] = w0.x; cw[j][1] = w0.y; cw[j][2] = w0.z; cw[j][3] = w0.w; cw[j][4] = w1.x; cw[j][5] = w1.y; cw[j][6] = w1.z; cw[j][7] = w1.w; }
    { const f32x4 b0 = *(const f32x4*)(a.conv_b + l * 512 + ch0), b1 = *(const f32x4*)(a.conv_b + l * 512 + ch0 + 4);
      cb[0] = b0.x; cb[1] = b0.y; cb[2] = b0.z; cb[3] = b0.w; cb[4] = b1.x; cb[5] = b1.y; cb[6] = b1.z; cb[7] = b1.w; }
    v4u rows[NT + 4];
#pragma unroll
    for (int r = 0; r < NT + 4; ++r) { const int tk = tk0 + s0 + r - 2; const bool ok = tk >= lo && tk < hi; const int tkc = tk < lo ? lo : (tk >= hi ? hi - 1 : tk);
        const v4u v = *(const v4u*)(U + (size_t)tkc * UW + U_QM + ch0); rows[r] = ok ? v : (v4u){0u, 0u, 0u, 0u}; }
#pragma unroll
    for (int i = 0; i < NT; ++i) {
        float y[8];
#pragma unroll
        for (int c = 0; c < 8; ++c) y[c] = cb[c];
#pragma unroll
        for (int j = 0; j < 5; ++j) { const v4u x = rows[i + j];
            y[0] += cw[j][0] * bf_lo(x.x); y[1] += cw[j][1] * bf_hi(x.x); y[2] += cw[j][2] * bf_lo(x.y); y[3] += cw[j][3] * bf_hi(x.y);
            y[4] += cw[j][4] * bf_lo(x.z); y[5] += cw[j][5] * bf_hi(x.z); y[6] += cw[j][6] * bf_lo(x.w); y[7] += cw[j][7] * bf_hi(x.w); }
#pragma unroll
        for (int c = 0; c < 8; ++c) out[i][c] = silu_f(y[c]);
    }
}

__device__ __forceinline__ void ml_d1_phase(const P& a_in, int l, PG_LAS unsigned char* lds, int G, int c0) {
    PHASE_ENTRY(a_in)
    const int tid = otid(), lane = tid & 63, wave = __builtin_amdgcn_readfirstlane(tid >> 6), hd = wave >> 1, dir = wave & 1;
    const int hh = lane >> 5, lr = lane & 31, tr_q = (lane & 15) >> 2, tr_p = lane & 3, tr_g = (lane >> 4) & 1;
    const bf16* U = (const bf16*)(a.ws + WS_U); const float* GT = (const float*)(a.ws + WS_GATES);
    bf16* ST = (bf16*)(a.ws + WS_ST); float* NL = (float*)(a.ws + WS_NL); float* SC = (float*)(a.ws + WS_SC);
    PG_LAS unsigned char* kwt = lds + 65536;
    PG_LAS float* wts = (PG_LAS float*)(lds + 131072);
    for (int item = c0; item < ML_ITEMS; item += G) {
        const int b = item / NCHUNK, c = item - b * NCHUNK, tk0 = b * TPB + 64 * c;
        const int lo = c < 4 ? b * TPB : b * TPB + CTX, hi = c < 4 ? b * TPB + CTX : (b + 1) * TPB;
        const int cc = ((b * 4 + hd) * 2 + dir) * NCHUNK + c;
        ml_load_v(U, tk0, lds, tid);
        {
            const int t = dir ? 63 - lane : lane;
            const float li = GT[(size_t)(tk0 + t) * 16 + dir * 8 + hd], lf = logsigmoid_f(GT[(size_t)(tk0 + t) * 16 + dir * 8 + 4 + hd]);
            const float bc = scan_sum(lf, lane), bend = lane_bcast(bc, 63);
            const float g = bend - bc + li, mloc = wave_max(g);
            wts[wave * 64 + t] = __expf(g - mloc);
            if (lane == 0) { SC[(size_t)cc * 4 + 0] = bend; SC[(size_t)cc * 4 + 1] = mloc; }
        }
        __syncthreads();
        {
            const int chg = tid & 31, sb = tid >> 5, s0 = 4 * sb, khd = chg >> 3, d0 = (chg & 7) * 8;
            float kv[4][8];
            conv8<4>(a, l, U, tk0, s0, lo, hi, 256 + 8 * chg, kv);
#pragma unroll
            for (int i = 0; i < 4; ++i) { const int sg = s0 + i;
#pragma unroll
                for (int dd = 0; dd < 2; ++dd) { const float w = wts[(khd * 2 + dd) * 64 + sg];
                    v4u o; o.x = cvt_pk_bf16(kv[i][0] * w, kv[i][1] * w); o.y = cvt_pk_bf16(kv[i][2] * w, kv[i][3] * w); o.z = cvt_pk_bf16(kv[i][4] * w, kv[i][5] * w); o.w = cvt_pk_bf16(kv[i][6] * w, kv[i][7] * w);
                    *(PG_LAS v4u*)(kwt + (khd * 2 + dd) * 8192 + sg * 128 + ((2 * d0) ^ (((sg >> 1) & 1) << 6))) = o; } }
        }
        __syncthreads();
        PG_LAS unsigned char* kw = kwt + wave * 8192;
        {
            float ns = 0.f;
#pragma unroll 8
            for (int sg = 0; sg < 64; ++sg) ns += bf2f(*(const PG_LAS bf16*)(kw + sg * 128 + ((2 * lane) ^ (((sg >> 1) & 1) << 6))));
            NL[(size_t)cc * 64 + lane] = ns;
        }
        pg::bf16x8 af[2][4];
#pragma unroll
        for (int dt = 0; dt < 2; ++dt)
#pragma unroll
            for (int s4 = 0; s4 < 4; ++s4) { const int r1 = 16 * s4 + 8 * hh + tr_q, r2 = r1 + 4; const int dbyte = 2 * (32 * dt + 16 * tr_g + 4 * tr_p);
                const v4s v1 = __builtin_amdgcn_ds_read_tr16_b64_v4i16((PG_LAS v4s*)(kw + r1 * 128 + (dbyte ^ (((r1 >> 1) & 1) << 6))));
                const v4s v2 = __builtin_amdgcn_ds_read_tr16_b64_v4i16((PG_LAS v4s*)(kw + r2 * 128 + (dbyte ^ (((r2 >> 1) & 1) << 6))));
                af[dt][s4] = (pg::bf16x8){v1[0], v1[1], v1[2], v1[3], v2[0], v2[1], v2[2], v2[3]}; }
        PG_LAS unsigned char* vb = lds + hd * 16384;
#pragma unroll
        for (int et = 0; et < 4; ++et) {
            pg::bf16x8 bfr[4];
            const int ebyte = 2 * (32 * et + 16 * tr_g + 4 * tr_p);
#pragma unroll
            for (int s4 = 0; s4 < 4; ++s4) { const int r1 = 16 * s4 + 8 * hh + tr_q, r2 = r1 + 4;
                const v4s v1 = __builtin_amdgcn_ds_read_tr16_b64_v4i16((PG_LAS v4s*)(vb + r1 * 256 + (ebyte ^ ((r1 & 3) << 6))));
                const v4s v2 = __builtin_amdgcn_ds_read_tr16_b64_v4i16((PG_LAS v4s*)(vb + r2 * 256 + (ebyte ^ ((r2 & 3) << 6))));
                bfr[s4] = (pg::bf16x8){v1[0], v1[1], v1[2], v1[3], v2[0], v2[1], v2[2], v2[3]}; }
#pragma unroll
            for (int dt = 0; dt < 2; ++dt) {
                f32x16 acc = {};
#pragma unroll
                for (int s4 = 0; s4 < 4; ++s4) acc = __builtin_amdgcn_mfma_f32_32x32x16_bf16(af[dt][s4], bfr[s4], acc, 0, 0, 0);
                v4u o0, o1;
                o0.x = cvt_pk_bf16(acc[0], acc[1]); o0.y = cvt_pk_bf16(acc[2], acc[3]); o0.z = cvt_pk_bf16(acc[4], acc[5]); o0.w = cvt_pk_bf16(acc[6], acc[7]);
                o1.x = cvt_pk_bf16(acc[8], acc[9]); o1.y = cvt_pk_bf16(acc[10], acc[11]); o1.z = cvt_pk_bf16(acc[12], acc[13]); o1.w = cvt_pk_bf16(acc[14], acc[15]);
                bf16* dst = ST + ((size_t)cc * 8 + dt * 4 + et) * 1024 + lane * 16;
                *(v4u*)dst = o0; *(v4u*)(dst + 8) = o1;
            }
        }
        __syncthreads();
    }
}
__device__ __forceinline__ void ml_d2_phase(const P& a_in, int wg) {
    PHASE_ENTRY(a_in)
    const int tid = otid(), chain = wg >> 2, quarter = wg & 3, dir = chain & 1;
    bf16* ST = (bf16*)(a.ws + WS_ST); float* NL = (float*)(a.ws + WS_NL); float* SC = (float*)(a.ws + WS_SC);
    const bool cw = tid < 256, nw = (quarter == 0 && tid >= 256 && tid < 320);
    if (cw || nw) {
    float st[8];
#pragma unroll
    for (int j = 0; j < 8; ++j) st[j] = 0.f;
    float nst = 0.f, m = 0.f;
    const size_t unit = (size_t)(quarter * 256 + tid) * 8;
#pragma unroll 1
    for (int i0 = 0; i0 < NCHUNK; i0 += 4) {
        v4u x[4]; float nx[4], be[4], ml[4]; int cidx[4];
#pragma unroll
        for (int k = 0; k < 4; ++k) { const int i = i0 + k; const int c = dir == 0 ? i : (i < 4 ? 3 - i : 71 - i); cidx[k] = chain * NCHUNK + c;
            be[k] = SC[(size_t)cidx[k] * 4]; ml[k] = SC[(size_t)cidx[k] * 4 + 1];
            if (cw) x[k] = *(const v4u*)(ST + (size_t)cidx[k] * 8192 + unit); else nx[k] = NL[(size_t)cidx[k] * 64 + (tid - 256)]; }
#pragma unroll
        for (int k = 0; k < 4; ++k) {
            const float mn = fmaxf(be[k] + m, ml[k]), fa = __expf(be[k] + m - mn), fb = __expf(ml[k] - mn);
            if (cw) {
                v4u o; o.x = pk2(st[0], st[1]); o.y = pk2(st[2], st[3]); o.z = pk2(st[4], st[5]); o.w = pk2(st[6], st[7]);
                *(v4u*)(ST + (size_t)cidx[k] * 8192 + unit) = o;
                st[0] = fa * st[0] + fb * bf_lo(x[k].x); st[1] = fa * st[1] + fb * bf_hi(x[k].x); st[2] = fa * st[2] + fb * bf_lo(x[k].y); st[3] = fa * st[3] + fb * bf_hi(x[k].y);
                st[4] = fa * st[4] + fb * bf_lo(x[k].z); st[5] = fa * st[5] + fb * bf_hi(x[k].z); st[6] = fa * st[6] + fb * bf_lo(x[k].w); st[7] = fa * st[7] + fb * bf_hi(x[k].w);
            } else {
                NL[(size_t)cidx[k] * 64 + (tid - 256)] = nst; nst = fa * nst + fb * nx[k];
                if (tid == 256) SC[(size_t)cidx[k] * 4 + 2] = m;
            }
            m = mn;
        }
    }
    }
}
__device__ __forceinline__ void ml_d3_phase(const P& a_in, int l, PG_LAS unsigned char* lds, int G, int c0) {
    PHASE_ENTRY(a_in)
    const int tid = otid(), wave = __builtin_amdgcn_readfirstlane(tid >> 6), hd = wave >> 1, qt = wave & 1;
    const bf16* U = (const bf16*)(a.ws + WS_U); const float* GT = (const float*)(a.ws + WS_GATES);
    const bf16* ST = (const bf16*)(a.ws + WS_ST); const float* NL = (const float*)(a.ws + WS_NL); const float* SC = (const float*)(a.ws + WS_SC);
    bf16* MIX = (bf16*)(a.ws + WS_MIX);
    PG_LAS unsigned char* qtile = lds + 65536 + hd * 16384;
    PG_LAS unsigned char* ktile = qtile + 8192;
    PG_LAS float* aarr = (PG_LAS float*)(lds + 131072 + wave * 2048);
    { const int ln_ = otid() & 63; const float* gm_ = a.g_ml + l * 512 + hd * 128; aarr[320 + ln_] = gm_[ln_]; aarr[384 + ln_] = gm_[64 + ln_]; }
    for (int item = c0; item < ML_ITEMS; item += G) {
        int lane = tid & 63; asm volatile("" : "+v"(lane));
        const int hh = lane >> 5, lr = lane & 31, tr_q = (lane & 15) >> 2, tr_p = lane & 3, tr_g = (lane >> 4) & 1;
        const int tq = 32 * qt + lr;
        const int b = item / NCHUNK, c = item - b * NCHUNK, tk0 = b * TPB + 64 * c;
        const int lo = c < 4 ? b * TPB : b * TPB + CTX, hi = c < 4 ? b * TPB + CTX : (b + 1) * TPB;
        float gli[2], glf[2], gmp[2];
#pragma unroll
        for (int dd = 0; dd < 2; ++dd) { const int t = dd ? 63 - lane : lane;
            gli[dd] = GT[(size_t)(tk0 + t) * 16 + dd * 8 + hd]; glf[dd] = GT[(size_t)(tk0 + t) * 16 + dd * 8 + 4 + hd]; gmp[dd] = SC[(size_t)(((b * 4 + hd) * 2 + dd) * NCHUNK + c) * 4 + 2]; }
        ml_load_v(U, tk0, lds, tid);
#pragma unroll
        for (int dd = 0; dd < 2; ++dd) aarr[192 + dd * 64 + lane] = NL[(size_t)(((b * 4 + hd) * 2 + dd) * NCHUNK + c) * 64 + lane];
        {
            const int chg = tid & 63, s0 = 8 * (tid >> 6), ch0 = 8 * chg;
            float kv[8][8];
            conv8<8>(a, l, U, tk0, s0, lo, hi, ch0, kv);
            PG_LAS unsigned char* dstt = lds + 65536 + ((ch0 & 255) >> 6) * 16384 + (ch0 >> 8) * 8192;
            const float qsc = ch0 < 256 ? 0.125f : 1.f; const int chunk = (ch0 & 63) >> 3;
#pragma unroll
            for (int i = 0; i < 8; ++i) { const int sg = s0 + i;
                v4u o; o.x = cvt_pk_bf16(kv[i][0] * qsc, kv[i][1] * qsc); o.y = cvt_pk_bf16(kv[i][2] * qsc, kv[i][3] * qsc); o.z = cvt_pk_bf16(kv[i][4] * qsc, kv[i][5] * qsc); o.w = cvt_pk_bf16(kv[i][6] * qsc, kv[i][7] * qsc);
                *(PG_LAS v4u*)(dstt + sg * 128 + 16 * (chunk ^ ((sg >> 1) & 7))) = o; }
        }
        __syncthreads();
#define D3_QF(s4) ({ const int sw_ = (tq >> 1) & 7; \
            const v2u lo2_ = *(const PG_LAS v2u*)(qtile + tq * 128 + 16 * ((2 * (s4)) ^ sw_) + 8 * hh), hi2_ = *(const PG_LAS v2u*)(qtile + tq * 128 + 16 * ((2 * (s4) + 1) ^ sw_) + 8 * hh); \
            __builtin_bit_cast(pg::bf16x8, (v4u){lo2_.x, lo2_.y, hi2_.x, hi2_.y}); })
        f32x16 hs[4];
#pragma unroll
        for (int et = 0; et < 4; ++et) hs[et] = (f32x16){};
#pragma unroll 1
        for (int dir = 0; dir < 2; ++dir) {
            const int cc = ((b * 4 + hd) * 2 + dir) * NCHUNK + c;
            const float mprev = dir ? gmp[1] : gmp[0];
            {
                const int t = dir ? 63 - lane : lane;
                const float li = dir ? gli[1] : gli[0], lf = logsigmoid_f(dir ? glf[1] : glf[0]);
                const float bc = scan_sum(lf, lane), av = li - bc, pm = scan_max(av, lane), Mv = fmaxf(mprev, pm);
                aarr[t] = av; aarr[64 + t] = Mv; aarr[128 + t] = bc;
            }
            const float Mq = aarr[64 + tq], bq = aarr[128 + tq];
            const float wq = __expf(mprev - Mq);
            pg::bf16x8 cs[2][2][2];
#pragma unroll
            for (int dt = 0; dt < 2; ++dt) { const bf16* src = ST + ((size_t)cc * 8 + dt * 4) * 1024 + lane * 16; cs[0][dt][0] = *(const pg::bf16x8*)src; cs[0][dt][1] = *(const pg::bf16x8*)(src + 8); }
            float qn = 0.f;
#pragma unroll
            for (int s4 = 0; s4 < 4; ++s4) { const f32x4 n0 = *(const PG_LAS f32x4*)(aarr + 192 + dir * 64 + 16 * s4 + 4 * hh), n1 = *(const PG_LAS f32x4*)(aarr + 192 + dir * 64 + 16 * s4 + 8 + 4 * hh);
                const v4u qw = __builtin_bit_cast(v4u, D3_QF(s4));
                qn += bf_lo(qw.x) * n0.x + bf_hi(qw.x) * n0.y + bf_lo(qw.y) * n0.z + bf_hi(qw.y) * n0.w + bf_lo(qw.z) * n1.x + bf_hi(qw.z) * n1.y + bf_lo(qw.w) * n1.z + bf_hi(qw.w) * n1.w; }
            qn = hsum32(qn);
            pg::bf16x8 pf[2][2]; float psum = 0.f;
#pragma unroll
            for (int st = 0; st < 2; ++st) {
                f32x16 acc = {}; const int sg = 32 * st + lr, sw = (sg >> 1) & 7;
#pragma unroll
                for (int s4 = 0; s4 < 4; ++s4) {
                    const v2u lo2 = *(const PG_LAS v2u*)(ktile + sg * 128 + 16 * ((2 * s4) ^ sw) + 8 * hh), hi2 = *(const PG_LAS v2u*)(ktile + sg * 128 + 16 * ((2 * s4 + 1) ^ sw) + 8 * hh);
                    const pg::bf16x8 kf = __builtin_bit_cast(pg::bf16x8, (v4u){lo2.x, lo2.y, hi2.x, hi2.y});
                    acc = __builtin_amdgcn_mfma_f32_32x32x16_bf16(kf, D3_QF(s4), acc, 0, 0, 0); }
#pragma unroll
                for (int i4 = 0; i4 < 4; ++i4) { const f32x4 av = *(const PG_LAS f32x4*)(aarr + 32 * st + 8 * i4 + 4 * hh);
#pragma unroll
                    for (int j = 0; j < 4; ++j) { const int sgk = 32 * st + 8 * i4 + 4 * hh + j; const bool ok = dir ? (sgk >= tq) : (sgk <= tq);
                        const float p = ok ? acc[4 * i4 + j] * __expf(av[j] - Mq) : 0.f; acc[4 * i4 + j] = p; psum += p; } }
#pragma unroll
                for (int s2 = 0; s2 < 2; ++s2) { v4u pw; pw.x = cvt_pk_bf16(acc[8 * s2 + 0], acc[8 * s2 + 1]); pw.y = cvt_pk_bf16(acc[8 * s2 + 2], acc[8 * s2 + 3]);
                    pw.z = cvt_pk_bf16(acc[8 * s2 + 4], acc[8 * s2 + 5]); pw.w = cvt_pk_bf16(acc[8 * s2 + 6], acc[8 * s2 + 7]); pf[st][s2] = __builtin_bit_cast(pg::bf16x8, pw); }
            }
            psum = hsum32(psum);
            const float den = psum + wq * qn;
            const float rden = __builtin_amdgcn_rcpf(fmaxf(fabsf(den), __expf(-(bq + Mq))));
            PG_LAS unsigned char* vb = lds + hd * 16384;
#pragma unroll
            for (int dt = 0; dt < 2; ++dt) { const bf16* src = ST + ((size_t)cc * 8 + dt * 4 + 1) * 1024 + lane * 16; cs[1][dt][0] = *(const pg::bf16x8*)src; cs[1][dt][1] = *(const pg::bf16x8*)(src + 8); }
#pragma unroll
            for (int et = 0; et < 4; ++et) {
                f32x16 acc = {};
#pragma unroll
                for (int dt = 0; dt < 2; ++dt) {
                    acc = __builtin_amdgcn_mfma_f32_32x32x16_bf16(cs[et & 1][dt][0], D3_QF(2 * dt), acc, 0, 0, 0);
                    acc = __builtin_amdgcn_mfma_f32_32x32x16_bf16(cs[et & 1][dt][1], D3_QF(2 * dt + 1), acc, 0, 0, 0); }
                if (et < 2) {
#pragma unroll
                    for (int dt = 0; dt < 2; ++dt) { const bf16* src = ST + ((size_t)cc * 8 + dt * 4 + et + 2) * 1024 + lane * 16; cs[et & 1][dt][0] = *(const pg::bf16x8*)src; cs[et & 1][dt][1] = *(const pg::bf16x8*)(src + 8); } }
#pragma unroll
                for (int i = 0; i < 16; ++i) acc[i] *= wq;
                const int ebyte = 2 * (32 * et + 16 * tr_g + 4 * tr_p);
#pragma unroll
                for (int st = 0; st < 2; ++st)
#pragma unroll
                    for (int s2 = 0; s2 < 2; ++s2) { const int r1 = 32 * st + 16 * s2 + 4 * hh + tr_q, r2 = r1 + 8;
                        const v4s v1 = __builtin_amdgcn_ds_read_tr16_b64_v4i16((PG_LAS v4s*)(vb + r1 * 256 + (ebyte ^ ((r1 & 3) << 6))));
                        const v4s v2 = __builtin_amdgcn_ds_read_tr16_b64_v4i16((PG_LAS v4s*)(vb + r2 * 256 + (ebyte ^ ((r2 & 3) << 6))));
                        const pg::bf16x8 vf = {v1[0], v1[1], v1[2], v1[3], v2[0], v2[1], v2[2], v2[3]};
                        acc = __builtin_amdgcn_mfma_f32_32x32x16_bf16(vf, pf[st][s2], acc, 0, 0, 0); }
                hs[et] += acc * rden;
            }
        }
        const bf16* om = U + (size_t)(tk0 + tq) * UW + U_OM + hd * 128;
        v2u ov[4][4];
#pragma unroll
        for (int et = 0; et < 4; ++et)
#pragma unroll
            for (int i4 = 0; i4 < 4; ++i4) ov[et][i4] = *(const v2u*)(om + 32 * et + 8 * i4 + 4 * hh);
        float sq = 0.f;
#pragma unroll
        for (int et = 0; et < 4; ++et)
#pragma unroll
            for (int i = 0; i < 16; ++i) sq += hs[et][i] * hs[et][i];
        sq = hsum32(sq);
        const float rstd = rsqrtf(sq * (1.f / 128.f) + EPS);
        bf16* orow = MIX + (size_t)(tk0 + tq) * D + 512 + hd * 128;
#pragma unroll
        for (int et = 0; et < 4; ++et)
#pragma unroll
            for (int i4 = 0; i4 < 4; ++i4) { const int e = 32 * et + 8 * i4 + 4 * hh; const f32x4 gg = *(const PG_LAS f32x4*)(aarr + 320 + e); const v2u o2 = ov[et][i4];
                const float y0 = hs[et][4 * i4 + 0] * rstd * gg.x * sigmoid_f(bf_lo(o2.x)), y1 = hs[et][4 * i4 + 1] * rstd * gg.y * sigmoid_f(bf_hi(o2.x));
                const float y2 = hs[et][4 * i4 + 2] * rstd * gg.z * sigmoid_f(bf_lo(o2.y)), y3 = hs[et][4 * i4 + 3] * rstd * gg.w * sigmoid_f(bf_hi(o2.y));
                v2u w; w.x = cvt_pk_bf16(y0, y1); w.y = cvt_pk_bf16(y2, y3); *(v2u*)(orow + e) = w; }
        __syncthreads();
    }
}
__global__ void __launch_bounds__(NTHR, 2) k_ml_d1(P a, int l) { a.wv = __builtin_amdgcn_readfirstlane(threadIdx.x >> 6); extern __shared__ __attribute__((aligned(16))) unsigned char smem[]; ml_d1_phase(a, l, (PG_LAS unsigned char*)smem, (int)gridDim.x, (int)blockIdx.x); }
__global__ void __launch_bounds__(NTHR, 2) k_ml_d2(P a) { a.wv = __builtin_amdgcn_readfirstlane(threadIdx.x >> 6); ml_d2_phase(a, (int)blockIdx.x); }
__global__ void __launch_bounds__(NTHR, 2) k_ml_d3(P a, int l) { a.wv = __builtin_amdgcn_readfirstlane(threadIdx.x >> 6); extern __shared__ __attribute__((aligned(16))) unsigned char smem[]; ml_d3_phase(a, l, (PG_LAS unsigned char*)smem, (int)gridDim.x, (int)blockIdx.x); }

#define XB_TMO      128
#define XB_XCNT(j)  (256  + 64 * (j))
#define XB_XSUB(j)  (1280 + 64 * (j))
#define XB_XGEN(j)  (2304 + 64 * (j))
#define XB_TOP      3328
#define XB_TOPGEN   3392
#define XCD_BAR_WORDS 3456
#define XB_SPIN_CAP (1u << 20)
__device__ __forceinline__ unsigned xb_ld(unsigned* p)              { return __hip_atomic_load(p, __ATOMIC_RELAXED, __HIP_MEMORY_SCOPE_AGENT); }
__device__ __forceinline__ unsigned xb_add(unsigned* p, unsigned v) { return __hip_atomic_fetch_add(p, v, __ATOMIC_RELAXED, __HIP_MEMORY_SCOPE_AGENT); }
__device__ __forceinline__ unsigned xb_xcc_id() { return (unsigned)__builtin_amdgcn_s_getreg((3 << 11) | 20) & 0xFu; }
#define XB_SPIN(cond, bar) do { unsigned _sp = 0; while (cond) { __builtin_amdgcn_s_sleep(8); \
    if ((++_sp & 255u) == 0u) { if (xb_ld(&(bar)[XB_TMO])) break; if (_sp > XB_SPIN_CAP) { atomicAdd(&(bar)[XB_TMO], 1u); break; } } } } while (0)
struct XcdBarrier { unsigned* bar; unsigned x; volatile PG_LAS unsigned* st; };
__device__ __forceinline__ XcdBarrier xcd_barrier_post(unsigned* bar, volatile PG_LAS unsigned* st, int tid) {
    XcdBarrier b; b.bar = bar; b.x = xb_xcc_id(); b.st = st;
    if (tid == 0) (void)xb_add(&bar[XB_XCNT(b.x)], 1u);
    return b;
}
__device__ __forceinline__ void xcd_barrier_complete(unsigned* bar, unsigned x, unsigned& nloc, unsigned& nx) {
    const unsigned G = gridDim.x * gridDim.y * gridDim.z;
    unsigned sum, cnt, mine, sp = 0u;
    for (;;) {
        sum = 0u; cnt = 0u; mine = 0u;
#pragma unroll
        for (unsigned j = 0; j < 16; ++j) { const unsigned c = xb_ld(&bar[XB_XCNT(j)]); sum += c; cnt += (c > 0u) ? 1u : 0u; mine = (j == x) ? c : mine; }
        if (sum == G) break;
        __builtin_amdgcn_s_sleep(1);
        if ((++sp & 255u) == 0u) { if (xb_ld(&bar[XB_TMO])) break; if (sp > XB_SPIN_CAP) { atomicAdd(&bar[XB_TMO], 1u); break; } }
    }
    nloc = mine > 0u ? mine : 1u; nx = cnt > 0u ? cnt : 1u;
}
__device__ __forceinline__ void xcd_barrier(const XcdBarrier& b, int tid) {
    asm volatile("s_waitcnt vmcnt(0)" ::: "memory");
    __syncthreads();
    if (tid == 0) {
        unsigned* bar = b.bar; asm volatile("" : "+s"(bar)); unsigned bx = b.x; asm volatile("" : "+s"(bx));
        __builtin_amdgcn_s_waitcnt(0);
        unsigned nloc = b.st[0], nx = b.st[1];
        if (nloc == 0u) { xcd_barrier_complete(bar, bx, nloc, nx); b.st[0] = nloc; b.st[1] = nx; }
        const unsigned old = xb_add(&bar[XB_XSUB(bx)], 1u);
        const unsigned gen = old / nloc;
        if (old + 1u == (gen + 1u) * nloc) {
            __builtin_amdgcn_fence(__ATOMIC_RELEASE, "agent");
            asm volatile("s_waitcnt vmcnt(0)" ::: "memory");
            const unsigned og = xb_add(&bar[XB_TOP], 1u);
            const unsigned tg = og / nx;
            if (og + 1u == (tg + 1u) * nx) xb_add(&bar[XB_TOPGEN], 1u);
            else XB_SPIN(xb_ld(&bar[XB_TOPGEN]) == tg, bar);
            __builtin_amdgcn_fence(__ATOMIC_ACQUIRE, "agent");
            xb_add(&bar[XB_XGEN(bx)], 1u);
            asm volatile("s_waitcnt vmcnt(0)" ::: "memory");
        } else {
            XB_SPIN(xb_ld(&bar[XB_XGEN(bx)]) == gen, bar);
            __builtin_amdgcn_fence(__ATOMIC_ACQUIRE, "agent");
            asm volatile("s_waitcnt vmcnt(0)" ::: "memory");
        }
    }
    __syncthreads();
}
__device__ __forceinline__ void modvec_phase(const P& a_in, PG_LAS float* lds, int G, int c) {
    PHASE_ENTRY(a_in)
    PG_LAS float* cond = lds;
    PG_LAS float* red = lds + MODR * D;
    const int t = otid(), kg = t >> 5, cl = t & 31;
    for (int i = t; i < MODR * D; i += NTHR) { const int r = i / D, k = i % D; const float v = r < NB ? a.c[r * D + k] : a.c_ctx[k]; cond[i] = silu_f(v); }
    __syncthreads();
    float* mod = (float*)(a.ws + WS_MOD);
    for (int item = c; item < DEPTH * 192; item += G) {
        const int l = item / 192, nc = item % 192, n = nc * 32 + cl;
        float acc[MODR];
#pragma unroll
        for (int r = 0; r < MODR; ++r) acc[r] = 0.f;
        const float* w = a.w_mod + (size_t)l * D * MODW + n;
#pragma unroll 8
        for (int k = kg * 64; k < kg * 64 + 64; ++k) { const float wv = w[(size_t)k * MODW];
#pragma unroll
            for (int r = 0; r < MODR; ++r) acc[r] += cond[r * D + k] * wv; }
#pragma unroll
        for (int r = 0; r < MODR; ++r) red[(kg * MODR + r) * 32 + cl] = acc[r];
        __syncthreads();
        for (int i = t; i < MODR * 32; i += NTHR) { const int r = i / 32, j = i % 32, nn = nc * 32 + j; float sacc = a.b_mod[l * MODW + nn];
#pragma unroll
            for (int q = 0; q < 16; ++q) sacc += red[(q * MODR + r) * 32 + j];
            mod[((size_t)l * MODR + r) * MODW + nn] = sacc; }
        __syncthreads();
    }
}
__device__ __forceinline__ void conv_dense_weights(const P& a_in, PG_LAS float* scr, int gw, int ngw, int lane) {
    PHASE_ENTRY(a_in)
    conv_dense_range(a, 0, DN_ITEMS, gw, ngw, scr, lane);
}
__device__ __forceinline__ void conv_expert_weights(const P& a_in, int li, PG_LAS float* scr, int gw, int ngw, int lane) {
    PHASE_ENTRY(a_in)
    unsigned char* ws = a.ws;
#pragma unroll 1
    for (int e = 0; e < NE; ++e) {
        tr_matrix(a.exp_w1 + ((size_t)li * NE + e) * D * FFN, D, FFN, FFN, (bf16*)(ws + WS_WE13) + (size_t)e * 2 * FFN * D, 1, scr, gw, ngw, lane);
        tr_matrix(a.exp_w3 + ((size_t)li * NE + e) * D * FFN, D, FFN, FFN, (bf16*)(ws + WS_WE13) + (size_t)e * 2 * FFN * D, 2, scr, gw, ngw, lane);
        tr_matrix(a.exp_w2 + ((size_t)li * NE + e) * FFN * D, FFN, D, D, (bf16*)(ws + WS_WE2) + (size_t)e * D * FFN, 0, scr, gw, ngw, lane);
    }
}
#if MEGA
constexpr int MEGA_LDS = 147456;
__global__ void __launch_bounds__(NTHR, 2) k_mega(P a_k) {
    extern __shared__ __attribute__((aligned(16))) unsigned char smem[];
    PG_LAS unsigned char* lds = (PG_LAS unsigned char*)smem;
    P a = a_k; a.wv = __builtin_amdgcn_readfirstlane(threadIdx.x >> 6);
    const int G = (int)gridDim.x, wg = (int)blockIdx.x;
    volatile PG_LAS unsigned* bst = (volatile PG_LAS unsigned*)(lds + MEGA_LDS - 16);
    if (otid() == 0) { bst[0] = 0u; bst[1] = 0u; bst[2] = 0u; bst[3] = 0u; }
    __syncthreads();
    const XcdBarrier bar = xcd_barrier_post((unsigned*)(a.ws + WS_CTL) + 1024, bst, otid());
    { const int t_ = otid(); conv_dense_weights(a, (PG_LAS float*)smem + (t_ >> 6) * (64 * 33), wg * 8 + (t_ >> 6), G * 8, t_ & 63); }
    __syncthreads();
    modvec_phase(a, (PG_LAS float*)smem, G, wg);
      { for (int i = otid(); i < 64 * 16; i += NTHR) { const int pos = i / 16, f = i % 16; const float ang = (float)pos * powf(10000.0f, -(float)f / 16.0f);
        float* t = (float*)(a.ws + WS_ROPE); t[2 * i] = cosf(ang); t[2 * i + 1] = sinf(ang); } }
    xcd_barrier(bar, otid());
    if (PROBE == 31) { { const int t_ = otid(); conv_dense_weights(a, (PG_LAS float*)smem + (t_ >> 6) * (64 * 33), wg * 8 + (t_ >> 6), G * 8, t_ & 63); } __syncthreads(); modvec_phase(a, (PG_LAS float*)smem, G, wg); xcd_barrier(bar, otid()); }
#pragma unroll 1
    for (int l = 0; l < DEPTH; ++l) {
        if (l == 0) norm_phase<0, true, 0>(a, l, wg, (PG_LAS float*)smem);
        else if (l == 2) norm_phase<0, false, 2>(a, l, wg, (PG_LAS float*)smem, l - 1, 5);
        else norm_phase<0, false, 1>(a, l, wg, (PG_LAS float*)smem, l - 1, 5);
        xcd_barrier(bar, otid());
        gemm_run<EM_IN>(a, l, lds, G, wg);
        xcd_barrier(bar, otid());
        if (PROBE == 6) { gemm_run<EM_IN>(a, l, lds, G, wg); xcd_barrier(bar, otid()); }
        ml_d1_phase(a, l, lds, G, wg);
        attn_phase<0>(a, l, lds, G, wg, 0);
        xcd_barrier(bar, otid());
        if (PROBE == 5) { ml_d1_phase(a, l, lds, G, wg); xcd_barrier(bar, otid()); }
        ml_d2_phase(a, wg);
        { int li_, j0_, j1_; if (conv_sched(l, CP_D2, li_, j0_, j1_)) { __syncthreads(); const int t_ = otid(), wv_ = __builtin_amdgcn_readfirstlane(t_ >> 6);
            conv_expert_range(a, li_, j0_, j1_, wg * 8 + wv_, G * 8, (PG_LAS float*)smem + wv_ * (64 * 33), t_ & 63); } }
        xcd_barrier(bar, otid());
        ml_d3_phase(a, l, lds, G, wg);
        attn_phase<0>(a, l, lds, G, wg, 1);
        xcd_barrier(bar, otid());
        if (PROBE == 2) { ml_d3_phase(a, l, lds, G, wg); xcd_barrier(bar, otid()); }
        if (PROBE == 30) { attn_phase<1>(a, l, lds, G, wg, 1); xcd_barrier(bar, otid()); }
        if (PROBE == 4) { xcd_barrier(bar, otid()); xcd_barrier(bar, otid()); xcd_barrier(bar, otid()); xcd_barrier(bar, otid()); }
        gemm_run<EM_OUT>(a, l, lds, G, wg);
        xcd_barrier(bar, otid());
        if (PROBE == 10) { gemm_run<EM_OUT>(a, l, lds, G, wg); xcd_barrier(bar, otid()); }
        if ((l & 1) == 0) {
            if (l == 0) norm_phase<1, true, 1>(a, l, wg, (PG_LAS float*)smem, l, 2);
            else norm_phase<1, false, 1>(a, l, wg, (PG_LAS float*)smem, l, 2);
            xcd_barrier(bar, otid());
            gemm_run<EM_F1>(a, l, lds, G, wg);
            xcd_barrier(bar, otid());
            if (PROBE == 7) { gemm_run<EM_F1>(a, l, lds, G, wg); xcd_barrier(bar, otid()); }
            if (PROBE == 20 || PROBE == 21) { gemm_run<EM_F1>(a, l, lds, G, wg, true); xcd_barrier(bar, otid()); }
            gemm_run<EM_F2D>(a, l, lds, G, wg);
            xcd_barrier(bar, otid());
            if (PROBE == 11) { gemm_run<EM_F2D>(a, l, lds, G, wg); xcd_barrier(bar, otid()); }
        } else {
            norm_phase<2, false, 1>(a, l, wg, (PG_LAS float*)smem, l, 2);
            xcd_barrier(bar, otid());
            if (PROBE == 12) { norm_phase<2, false, 0>(a, l, wg, (PG_LAS float*)smem, l, 2); xcd_barrier(bar, otid()); }
            moe_pos_phase(a, wg, (int*)smem);
            xcd_barrier(bar, otid());
            gemm_run<EM_F1M>(a, l, lds, G, wg);
            xcd_barrier(bar, otid());
            if (PROBE == 8) { gemm_run<EM_F1M>(a, l, lds, G, wg); xcd_barrier(bar, otid()); }
            gemm_run<EM_F2M>(a, l, lds, G, wg);
            xcd_barrier(bar, otid());
            if (PROBE == 9) { gemm_run<EM_F2M>(a, l, lds, G, wg); xcd_barrier(bar, otid()); }
        }
    }
    norm_phase<3, false, 2>(a, DEPTH, wg, (PG_LAS float*)smem, DEPTH - 1, 5);
}
#endif

#ifndef FAST_IN
#define FAST_IN 1
#endif
#ifndef FAST_OUT
#define FAST_OUT 1
#endif
#ifndef FAST_F1
#define FAST_F1 1
#endif
#ifndef FAST_F2
#define FAST_F2 1
#endif
#ifndef FAST_F1M
#define FAST_F1M 1
#endif
#ifndef FAST_F2M
#define FAST_F2M 1
#endif
constexpr int GEMM_LDS = 131072 + 1024 + 8192;
template <int WHICH> static void launch_gemm(hipStream_t s, const P& a, int l) {
    static bool once = false;
    if (!once) { (void)hipFuncSetAttribute((const void*)k_gemm<WHICH>, hipFuncAttributeMaxDynamicSharedMemorySize, GEMM_LDS); once = true; }
    hipLaunchKernelGGL((k_gemm<WHICH>), dim3(NWG), dim3(NTHR), GEMM_LDS, s, a, l);
}
static void launch_tr(hipStream_t s, const float* W, int K, int ld, int N, bf16* WT, int mode) {
    hipLaunchKernelGGL(k_transpose, dim3(512), dim3(256), 0, s, W, K, ld, N, WT, mode);
}
extern "C" void kernel_launch(void* const* d_in, const int* in_sizes, int n_in, void* d_out, int out_size, void* d_ws, size_t ws_size, hipStream_t stream) {
    if (n_in != 25 || ws_size < WS_END) { fprintf(stderr, "kernel_launch: bad args n_in %d ws %zu need %zu\n", n_in, ws_size, (size_t)WS_END); return; }
    static bool init = false;
    constexpr int NORM_LDS = 8192 * 4 + 8 * 32 * 4 + 64;
    if (!init) {
        init = true;
    }
    P a{};
    const float** f = (const float**)&a;
    for (int i = 0; i < 25; ++i) f[i] = (const float*)d_in[i];
    a.out = (float*)d_out; a.ws = (unsigned char*)d_ws;
    unsigned char* ws = a.ws;
    hipMemsetAsync(ws + WS_CTL, 0, 32768, stream);
#if MEGA
    {
        static bool once = false;
        if (!once) { (void)hipFuncSetAttribute((const void*)k_mega, hipFuncAttributeMaxDynamicSharedMemorySize, MEGA_LDS); once = true; }
        hipLaunchKernelGGL(k_mega, dim3(NWG), dim3(NTHR), MEGA_LDS, stream, a);
        return;
    }
#endif
#if !MEGA
    for (int l = 0; l < DEPTH; ++l) {
        launch_tr(stream, a.w_in + (size_t)l * D * INW, D, INW, UW, (bf16*)(ws + WS_WIN) + (size_t)l * UW * D, 0);
        launch_tr(stream, a.w_out + (size_t)l * D * D, D, D, D, (bf16*)(ws + WS_WOUT) + (size_t)l * D * D, 0);
    }
    for (int i = 0; i < 2; ++i) {
        launch_tr(stream, a.ffn_w1 + (size_t)i * D * FFN, D, FFN, FFN, (bf16*)(ws + WS_WF13) + (size_t)i * 2 * FFN * D, 1);
        launch_tr(stream, a.ffn_w3 + (size_t)i * D * FFN, D, FFN, FFN, (bf16*)(ws + WS_WF13) + (size_t)i * 2 * FFN * D, 2);
        launch_tr(stream, a.ffn_w2 + (size_t)i * FFN * D, FFN, D, D, (bf16*)(ws + WS_WF2) + (size_t)i * D * FFN, 0);
    }
    hipLaunchKernelGGL(k_modvec, dim3(DEPTH * 96), dim3(256), 0, stream, a);
    hipLaunchKernelGGL(k_rope_table, dim3(4), dim3(256), 0, stream, a);
    for (int l = 0; l < DEPTH; ++l) {
        const bool moe = l & 1;
        if (l == 0) hipLaunchKernelGGL((k_norm<0, true, false>), dim3(NWG), dim3(NTHR), NORM_LDS, stream, a, l);
        else if (l == 2) hipLaunchKernelGGL((k_norm<0, false, true>), dim3(NWG), dim3(NTHR), NORM_LDS, stream, a, l);
        else hipLaunchKernelGGL((k_norm<0, false, false>), dim3(NWG), dim3(NTHR), NORM_LDS, stream, a, l);
        if (FAST_IN) launch_gemm<EM_IN>(stream, a, l);
        else {
        hipLaunchKernelGGL((k_ngemm<EM_IN>), dim3(UW / 64, T_ALL / 64), dim3(256), 0, stream, a, l, (const bf16*)(ws + WS_HX), (const bf16*)(ws + WS_WIN) + (size_t)l * UW * D, T_ALL, UW, D);
        hipLaunchKernelGGL(k_rope_apply, dim3((T_ALL * 320 + 255) / 256), dim3(256), 0, stream, a); }
#ifndef FAST_ATT
#define FAST_ATT 1
#endif
        if (FAST_ATT) hipLaunchKernelGGL(k_attn, dim3(NWG), dim3(NTHR), ATT_LDS, stream, a, l);
        else hipLaunchKernelGGL(k_attn_naive, dim3(T_ALL), dim3(512), 0, stream, a, l);
#ifndef FAST_ML
#define FAST_ML 1
#endif
        if (FAST_ML) {
            static bool once = false;
            if (!once) { (void)hipFuncSetAttribute((const void*)k_ml_d1, hipFuncAttributeMaxDynamicSharedMemorySize, ML_LDS); (void)hipFuncSetAttribute((const void*)k_ml_d3, hipFuncAttributeMaxDynamicSharedMemorySize, ML_LDS); once = true; }
            hipLaunchKernelGGL(k_ml_d1, dim3(NWG), dim3(NTHR), ML_LDS, stream, a, l);
            hipLaunchKernelGGL(k_ml_d2, dim3(NWG), dim3(NTHR), 0, stream, a);
            hipLaunchKernelGGL(k_ml_d3, dim3(NWG), dim3(NTHR), ML_LDS, stream, a, l);
        } else {
        hipLaunchKernelGGL(k_mlstm_naive, dim3(64), dim3(256), 0, stream, a, l);
        hipLaunchKernelGGL(k_merge_naive, dim3(T_ALL), dim3(256), 0, stream, a, l); }
        if (FAST_OUT) launch_gemm<EM_OUT>(stream, a, l);
        else hipLaunchKernelGGL((k_ngemm<EM_OUT>), dim3(D / 64, T_ALL / 64), dim3(256), 0, stream, a, l, (const bf16*)(ws + WS_MIX), (const bf16*)(ws + WS_WOUT) + (size_t)l * D * D, T_ALL, D, D);
        if (!moe) {
            hipLaunchKernelGGL((k_norm<1, false, false>), dim3(NWG), dim3(NTHR), NORM_LDS, stream, a, l);
            if (FAST_F1) launch_gemm<EM_F1>(stream, a, l);
            else hipLaunchKernelGGL((k_ngemm<EM_F1>), dim3(FFN / 64, T_ALL / 64), dim3(256), 0, stream, a, l, (const bf16*)(ws + WS_HX), (const bf16*)(ws + WS_WF13) + (size_t)(l >> 1) * 2 * FFN * D, T_ALL, FFN, D);
            if (FAST_F2) launch_gemm<EM_F2D>(stream, a, l);
            else hipLaunchKernelGGL((k_ngemm<EM_F2D>), dim3(D / 64, T_ALL / 64), dim3(256), 0, stream, a, l, (const bf16*)(ws + WS_HID), (const bf16*)(ws + WS_WF2) + (size_t)(l >> 1) * D * FFN, T_ALL, D, FFN);
        } else {
            const int li = l >> 1;
            for (int e = 0; e < NE; ++e) {
                launch_tr(stream, a.exp_w1 + ((size_t)li * NE + e) * D * FFN, D, FFN, FFN, (bf16*)(ws + WS_WE13) + (size_t)e * 2 * FFN * D, 1);
                launch_tr(stream, a.exp_w3 + ((size_t)li * NE + e) * D * FFN, D, FFN, FFN, (bf16*)(ws + WS_WE13) + (size_t)e * 2 * FFN * D, 2);
                launch_tr(stream, a.exp_w2 + ((size_t)li * NE + e) * FFN * D, FFN, D, D, (bf16*)(ws + WS_WE2) + (size_t)e * D * FFN, 0);
            }
            hipLaunchKernelGGL((k_norm<2, false, false>), dim3(NWG), dim3(NTHR), NORM_LDS, stream, a, l);
            hipLaunchKernelGGL(k_moe_pos, dim3(NWG), dim3(NTHR), 16384, stream, a);
            if (FAST_F1M) launch_gemm<EM_F1M>(stream, a, l);
            else hipLaunchKernelGGL((k_ngemm<EM_F1M>), dim3(FFN / 64, MOE_ROWS / 64), dim3(256), 0, stream, a, l, (const bf16*)(ws + WS_HX), (const bf16*)(ws + WS_WE13), MOE_ROWS, FFN, D);
            if (FAST_F2M) launch_gemm<EM_F2M>(stream, a, l);
            else hipLaunchKernelGGL((k_ngemm<EM_F2M>), dim3(D / 64, MOE_ROWS / 64), dim3(256), 0, stream, a, l, (const bf16*)(ws + WS_HID), (const bf16*)(ws + WS_WE2), MOE_ROWS, D, FFN);
        }
    }
    hipLaunchKernelGGL((k_norm<3, false, true>), dim3(NWG), dim3(NTHR), NORM_LDS, stream, a, DEPTH);
#endif
}
```

```cpp
#include <hip/hip_runtime.h>
#include <cstdio>
#include <cstdint>

#ifndef MEGA
#define MEGA 1
#endif
#ifndef PROBE
#define PROBE 0
#ifndef SPLIT_MAXS
#define SPLIT_MAXS 3
#endif
#endif
typedef unsigned short bf16;
#define PG_LAS __attribute__((address_space(3)))
typedef unsigned v4u __attribute__((ext_vector_type(4)));
typedef unsigned v2u __attribute__((ext_vector_type(2)));
typedef float f32x4 __attribute__((ext_vector_type(4)));

constexpr int D = 1024, NB = 8, SEQ = 4096, CTX = 256, TPB = SEQ + CTX, T_ALL = NB * TPB, DEPTH = 4;
constexpr int INW = 2320, UW = 2304, FFN = 2816, NE = 8;
constexpr int U_QA = 0, U_KA = 512, U_VA = 640, U_QM = 768, U_KM = 1024, U_VM = 1280, U_OM = 1792;
constexpr int MODW = 6 * D, MODR = NB + 1;
constexpr int MOE_ROWS = 2 * T_ALL + NE * 256;
constexpr int MOE_TILES = MOE_ROWS / 256;
constexpr float EPS = 1e-6f;
constexpr int NWG = 256, NTHR = 512;
constexpr int ROWS_PER_WG = T_ALL / NWG;

constexpr size_t MiB = 1u << 20;
constexpr size_t al(size_t x) { return (x + 255) & ~(size_t)255; }
constexpr size_t WS_CTL = 0;
constexpr size_t WS_ROPE = 1 * MiB;
constexpr size_t WS_MOD = WS_ROPE + 65536;
constexpr size_t WS_TOKE = al(WS_MOD + (size_t)DEPTH * MODR * MODW * 4);
constexpr size_t WS_TOKW = al(WS_TOKE + (size_t)T_ALL * 8);
constexpr size_t WS_TOKP = al(WS_TOKW + (size_t)T_ALL * 8);
constexpr size_t WS_ROWT = al(WS_TOKP + (size_t)T_ALL * 8);
constexpr size_t WS_ROWW = al(WS_ROWT + (size_t)MOE_ROWS * 4);
constexpr size_t WS_TILEE = al(WS_ROWW + (size_t)MOE_ROWS * 4);
constexpr size_t WS_CNT = al(WS_TILEE + 4096);
constexpr size_t WS_GATES = al(WS_CNT + (size_t)NWG * 8 * 4);
constexpr size_t WS_WIN = al(WS_GATES + (size_t)T_ALL * 16 * 4);
constexpr size_t WS_WOUT = al(WS_WIN + (size_t)DEPTH * UW * D * 2);
constexpr size_t WS_WF13 = al(WS_WOUT + (size_t)DEPTH * D * D * 2);
constexpr size_t WS_WF2 = al(WS_WF13 + (size_t)2 * 2 * FFN * D * 2);
constexpr size_t WS_WE2 = al(WS_WF2 + (size_t)2 * D * FFN * 2);
constexpr size_t WS_WE13 = al(WS_WE2 + (size_t)NE * D * FFN * 2);
constexpr size_t WS_YS = WS_WE13;
constexpr size_t WS_HX = al(WS_YS + (size_t)MOE_ROWS * D * 2);
constexpr size_t WS_X = al(WS_HX + (size_t)T_ALL * D * 2);
constexpr size_t WS_BIG = al(WS_X + (size_t)T_ALL * D * 2);
static_assert(WS_YS + (size_t)MOE_ROWS * D * 2 <= WS_HX && WS_WE13 + (size_t)NE * 2 * FFN * D * 2 <= WS_HX, "YS overlay");
constexpr size_t WS_U = WS_BIG;
constexpr size_t WS_MIX = al(WS_U + (size_t)T_ALL * UW * 2);
constexpr size_t WS_HDIR = al(WS_MIX + (size_t)T_ALL * D * 2);
constexpr int NCHUNK = TPB / 64, NCHAIN = NB * 4 * 2;
constexpr size_t WS_ST = WS_HDIR;
constexpr size_t WS_NL = al(WS_ST + (size_t)NCHAIN * NCHUNK * 16384);
constexpr size_t WS_SC = al(WS_NL + (size_t)NCHAIN * NCHUNK * 64 * 4);
constexpr size_t WS_DELTA = WS_BIG + 250 * MiB;
constexpr size_t WS_HID = WS_BIG;
constexpr size_t WS_YSP = al(WS_BIG + (size_t)MOE_ROWS * FFN * 2);
constexpr size_t YSP_STRIDE = (size_t)64 * 256 * D;
constexpr size_t WS_END = al(WS_YSP + 2 * YSP_STRIDE * 2);
static_assert(WS_HDIR + (size_t)2 * T_ALL * 512 * 4 <= WS_END && WS_SC + (size_t)NCHAIN * NCHUNK * 16 <= WS_END, "HDIR / state buffers fit");

struct P {
    const float *x, *c, *ctx, *c_ctx, *norm1_g, *norm2_g, *w_mod, *b_mod, *w_in, *conv_w, *conv_b, *b_gates, *attn_sink, *g_att, *g_ml, *w_out,
        *ffn_w1, *ffn_w3, *ffn_w2, *w_router, *b_router, *exp_w1, *exp_w3, *exp_w2, *final_g;
    float* out;
    unsigned char* ws;
    int wv, pad;
};

__device__ __forceinline__ unsigned f2bf(float f) { unsigned u = __builtin_bit_cast(unsigned, f); return (u + 0x7fffu + ((u >> 16) & 1u)) >> 16; }
__device__ __forceinline__ unsigned pk2(float lo, float hi) { return f2bf(lo) | (f2bf(hi) << 16); }
typedef float f32x2v __attribute__((ext_vector_type(2)));
typedef __bf16 bf16x2v __attribute__((ext_vector_type(2)));
__device__ __forceinline__ unsigned cvt_pk_bf16(float lo, float hi) { const f32x2v v = {lo, hi}; return __builtin_bit_cast(unsigned, __builtin_convertvector(v, bf16x2v)); }
__device__ __forceinline__ float bf_lo(unsigned w) { return __builtin_bit_cast(float, w << 16); }
__device__ __forceinline__ float bf_hi(unsigned w) { return __builtin_bit_cast(float, w & 0xffff0000u); }
__device__ __forceinline__ float bf2f(bf16 h) { return __builtin_bit_cast(float, (unsigned)h << 16); }
#ifndef XLANE_OLD
#define XLANE_OLD 0
#endif
#if XLANE_OLD
template <int M> __device__ __forceinline__ float swz_xor(float v) { return __shfl_xor(v, M); }
__device__ __forceinline__ float hsum32(float v) { return v + __shfl_xor(v, 32); }
__device__ __forceinline__ float hmax32(float v) { return fmaxf(v, __shfl_xor(v, 32)); }
__device__ __forceinline__ float wave_sum(float v) {
#pragma unroll
    for (int o = 1; o < 64; o <<= 1) v += __shfl_xor(v, o);
    return v;
}
__device__ __forceinline__ float wave_max(float v) {
#pragma unroll
    for (int o = 1; o < 64; o <<= 1) v = fmaxf(v, __shfl_xor(v, o));
    return v;
}
__device__ __forceinline__ float lane_bcast(float v, int src) { return __shfl(v, src); }
template <int OFF> __device__ __forceinline__ float xchg_xor(float v, bool) { return __shfl_xor(v, OFF); }
template <bool MAXOP> __device__ __forceinline__ float dpp_scan(float v) {
    const int lane = (int)__builtin_amdgcn_mbcnt_hi(~0u, __builtin_amdgcn_mbcnt_lo(~0u, 0u));
#pragma unroll
    for (int o = 1; o < 64; o <<= 1) { const float y = __shfl_up(v, o); if (lane >= o) v = MAXOP ? fmaxf(v, y) : v + y; }
    return v;
}
#else
template <int M> __device__ __forceinline__ float swz_xor(float v) { return __builtin_bit_cast(float, __builtin_amdgcn_ds_swizzle(__builtin_bit_cast(int, v), 0x1f | (M << 10))); }
struct HalfSwap { float a, b; };
__device__ __forceinline__ HalfSwap half_swap(float v) {
    float x = v, y = v;
    asm volatile("s_nop 1\n\tv_permlane32_swap_b32 %0, %1\n\ts_nop 0" : "+v"(x), "+v"(y));
    return HalfSwap{x, y};
}
__device__ __forceinline__ float hsum32(float v) { const HalfSwap r = half_swap(v); return r.a + r.b; }
__device__ __forceinline__ float hmax32(float v) { const HalfSwap r = half_swap(v); return fmaxf(r.a, r.b); }
__device__ __forceinline__ float wave_sum(float v) { v += swz_xor<1>(v); v += swz_xor<2>(v); v += swz_xor<4>(v); v += swz_xor<8>(v); v += swz_xor<16>(v); return hsum32(v); }
__device__ __forceinline__ float wave_max(float v) { v = fmaxf(v, swz_xor<1>(v)); v = fmaxf(v, swz_xor<2>(v)); v = fmaxf(v, swz_xor<4>(v)); v = fmaxf(v, swz_xor<8>(v)); v = fmaxf(v, swz_xor<16>(v)); return hmax32(v); }
__device__ __forceinline__ float lane_bcast(float v, int src) { return __builtin_bit_cast(float, __builtin_amdgcn_readlane(__builtin_bit_cast(int, v), src)); }
template <int OFF> __device__ __forceinline__ float xchg_xor(float v, bool up) {
    if constexpr (OFF == 32) { const HalfSwap r = half_swap(v); return up ? r.a : r.b; }
    else return swz_xor<OFF>(v);
}
#define DPP_STEP(ctrl, rm) { const float t_ = __builtin_bit_cast(float, __builtin_amdgcn_update_dpp(__builtin_bit_cast(int, idv), __builtin_bit_cast(int, v), ctrl, rm, 0xf, false)); v = MAXOP ? fmaxf(v, t_) : v + t_; }
template <bool MAXOP> __device__ __forceinline__ float dpp_scan(float v) {
    const float idv = MAXOP ? -3.0e38f : 0.f;
    DPP_STEP(0x111, 0xf) DPP_STEP(0x112, 0xf) DPP_STEP(0x114, 0xf) DPP_STEP(0x118, 0xf) DPP_STEP(0x142, 0xa) DPP_STEP(0x143, 0xc)
    return v;
}
#endif
template <int N, int OFF> struct RS { static __device__ __forceinline__ float run(float (&v)[N], int lane) {
    constexpr int H = N / 2; float w[H]; const bool up = (lane & OFF) != 0;
#pragma unroll
    for (int i = 0; i < H; ++i) { const float keep = up ? v[i + H] : v[i], send = up ? v[i] : v[i + H]; w[i] = keep + xchg_xor<OFF>(send, up); }
    return RS<H, OFF / 2>::run(w, lane); } };
template <int OFF> struct RS<1, OFF> { static __device__ __forceinline__ float run(float (&v)[1], int lane) { float x = v[0];
    if constexpr (OFF >= 16) x += swz_xor<16>(x);
    if constexpr (OFF >= 8) x += swz_xor<8>(x);
    if constexpr (OFF >= 4) x += swz_xor<4>(x);
    if constexpr (OFF >= 2) x += swz_xor<2>(x);
    if constexpr (OFF >= 1) x += swz_xor<1>(x);
    return x; } };
__device__ __forceinline__ float silu_f(float x) { return x * __builtin_amdgcn_rcpf(1.f + __expf(-x)); }
__device__ __forceinline__ float sigmoid_f(float x) { return __builtin_amdgcn_rcpf(1.f + __expf(-x)); }
__device__ __forceinline__ float logsigmoid_f(float x) { return fminf(x, 0.f) - log1pf(__expf(-fabsf(x))); }
__device__ __forceinline__ int tk_modrow(int tk) { const int b = tk / TPB, p = tk - b * TPB; return p < CTX ? NB : b; }
__device__ __forceinline__ const float* in_row(const P& a, int tk) {
    const int b = tk / TPB, p = tk - b * TPB;
    return p < CTX ? a.ctx + ((size_t)b * CTX + p) * D : a.x + ((size_t)b * SEQ + (p - CTX)) * D;
}

__device__ __forceinline__ int otid_w(int wv) { int t; asm volatile("v_mbcnt_lo_u32_b32 %0, -1, 0\n\tv_mbcnt_hi_u32_b32 %0, -1, %0\n\ts_nop 0\n\tv_lshl_add_u32 %0, %1, 6, %0" : "=&v"(t) : "s"(wv)); return t; }
#define otid() otid_w(a.wv)
#define PHASE_ENTRY(a_in) P a = a_in; { unsigned long long z_ = 0; asm volatile("" : "+s"(z_)); a.ws = a_in.ws + z_; }
__device__ __forceinline__ void tr_load(const float* W, int ld, int N, int item, int lane, f32x4 (&v)[8]) {
    const int nblk = N / 32, kb = item / nblk, nb = item % nblk, k0 = 64 * kb, n0 = 32 * nb;
#pragma unroll
    for (int i = 0; i < 8; ++i) { const int kk = 8 * i + (lane >> 3), nn = 4 * (lane & 7);
        v[i] = __builtin_nontemporal_load((const f32x4*)(W + (size_t)(k0 + kk) * ld + n0 + nn)); }
}
__device__ __forceinline__ void tr_store(const f32x4 (&v)[8], int K, int N, bf16* WT, int mode, PG_LAS float* scr, int item, int lane) {
    const int nblk = N / 32, kb = item / nblk, nb = item % nblk, k0 = 64 * kb, n0 = 32 * nb;
#pragma unroll
    for (int i = 0; i < 8; ++i) { const int kk = 8 * i + (lane >> 3), nn = 4 * (lane & 7);
        PG_LAS float* d = scr + kk * 33 + nn; d[0] = v[i].x; d[1] = v[i].y; d[2] = v[i].z; d[3] = v[i].w; }
    __builtin_amdgcn_s_waitcnt(0xC07F); asm volatile("" ::: "memory");
    const int c = lane & 7;
    const int d0 = mode == 0 ? n0 : ((n0 >> 7) * 256 + (mode == 2 ? 128 : 0) + (n0 & 127));
#pragma unroll
    for (int j = 0; j < 4; ++j) { const int n = (lane >> 3) + 8 * j; const PG_LAS float* s = scr + (8 * c) * 33 + n;
        v4u o; o.x = cvt_pk_bf16(s[0 * 33], s[1 * 33]); o.y = cvt_pk_bf16(s[2 * 33], s[3 * 33]); o.z = cvt_pk_bf16(s[4 * 33], s[5 * 33]); o.w = cvt_pk_bf16(s[6 * 33], s[7 * 33]);
        __builtin_nontemporal_store(o, (v4u*)(WT + (size_t)(d0 + n) * K + k0 + 8 * c)); }
    __builtin_amdgcn_s_waitcnt(0xC07F); asm volatile("" ::: "memory");
}
__device__ __forceinline__ void tr_matrix(const float* W, int K, int ld, int N, bf16* WT, int mode, PG_LAS float* scr, int gw, int ngw, int lane) {
    const int items = (K / 64) * (N / 32);
    f32x4 cur[8], nxt[8];
    int it = gw;
    if (it < items) tr_load(W, ld, N, it, lane, cur);
    for (; it < items; it += ngw) {
        const int nit = it + ngw;
        if (nit < items) tr_load(W, ld, N, nit, lane, nxt);
        tr_store(cur, K, N, WT, mode, scr, it, lane);
#pragma unroll
        for (int i = 0; i < 8; ++i) cur[i] = nxt[i];
    }
}
constexpr int EXP_ITEMS_M = (D / 64) * (FFN / 32), EXP_ITEMS_E = 3 * EXP_ITEMS_M, EXP_ITEMS = NE * EXP_ITEMS_E;
struct TrJob { const float* W; bf16* WT; int K, ld, N, mode, it; };
__device__ __forceinline__ TrJob expert_job(const P& a, int li, int j) {
    const int e = j / EXP_ITEMS_E, r = j - e * EXP_ITEMS_E, m = r / EXP_ITEMS_M, it = r - m * EXP_ITEMS_M;
    TrJob t; t.it = it;
    if (m < 2) { t.W = (m == 0 ? a.exp_w1 : a.exp_w3) + ((size_t)li * NE + e) * D * FFN; t.K = D; t.ld = FFN; t.N = FFN; t.WT = (bf16*)(a.ws + WS_WE13) + (size_t)e * 2 * FFN * D; t.mode = 1 + m; }
    else { t.W = a.exp_w2 + ((size_t)li * NE + e) * FFN * D; t.K = FFN; t.ld = D; t.N = D; t.WT = (bf16*)(a.ws + WS_WE2) + (size_t)e * D * FFN; t.mode = 0; }
    return t;
}
__device__ __forceinline__ void conv_expert_range(const P& a, int li, int j0, int j1, int slot, int nslots, PG_LAS float* scr, int lane) {
    int j = j0 + slot; if (j >= j1) return;
    TrJob cur = expert_job(a, li, j), n1 = cur, n2 = cur; f32x4 cv[8], v1[8], v2[8];
    tr_load(cur.W, cur.ld, cur.N, cur.it, lane, cv);
    if (j + nslots < j1) { n1 = expert_job(a, li, j + nslots); tr_load(n1.W, n1.ld, n1.N, n1.it, lane, v1); }
    for (; j < j1; j += nslots) {
        const int jn = j + 2 * nslots;
        if (jn < j1) { n2 = expert_job(a, li, jn); tr_load(n2.W, n2.ld, n2.N, n2.it, lane, v2); }
        tr_store(cv, cur.K, cur.N, cur.WT, cur.mode, scr, cur.it, lane);
        cur = n1; n1 = n2;
#pragma unroll
        for (int i = 0; i < 8; ++i) { cv[i] = v1[i]; v1[i] = v2[i]; }
    }
}
constexpr int DN_IN = (D / 64) * (UW / 32), DN_OUT = (D / 64) * (D / 32), DN_L = DN_IN + DN_OUT, DN_ITEMS = DEPTH * DN_L + 2 * EXP_ITEMS_E;
__device__ __forceinline__ TrJob dense_job(const P& a, int j) {
    TrJob t;
    if (j < DEPTH * DN_L) { const int l = j / DN_L, r = j - l * DN_L; t.K = D; t.mode = 0;
        if (r < DN_IN) { t.W = a.w_in + (size_t)l * D * INW; t.ld = INW; t.N = UW; t.WT = (bf16*)(a.ws + WS_WIN) + (size_t)l * UW * D; t.it = r; }
        else { t.W = a.w_out + (size_t)l * D * D; t.ld = D; t.N = D; t.WT = (bf16*)(a.ws + WS_WOUT) + (size_t)l * D * D; t.it = r - DN_IN; } }
    else { const int q = j - DEPTH * DN_L, i = q / EXP_ITEMS_E, r = q - i * EXP_ITEMS_E, m = r / EXP_ITEMS_M; t.it = r - m * EXP_ITEMS_M;
        if (m < 2) { t.W = (m == 0 ? a.ffn_w1 : a.ffn_w3) + (size_t)i * D * FFN; t.K = D; t.ld = FFN; t.N = FFN; t.WT = (bf16*)(a.ws + WS_WF13) + (size_t)i * 2 * FFN * D; t.mode = 1 + m; }
        else { t.W = a.ffn_w2 + (size_t)i * FFN * D; t.K = FFN; t.ld = D; t.N = D; t.WT = (bf16*)(a.ws + WS_WF2) + (size_t)i * D * FFN; t.mode = 0; } }
    return t;
}
__device__ __forceinline__ void conv_dense_range(const P& a, int j0, int j1, int slot, int nslots, PG_LAS float* scr, int lane) {
    int j = j0 + slot; if (j >= j1) return;
    TrJob cur = dense_job(a, j), n1 = cur, n2 = cur; f32x4 cv[8], v1[8], v2[8];
    tr_load(cur.W, cur.ld, cur.N, cur.it, lane, cv);
    if (j + nslots < j1) { n1 = dense_job(a, j + nslots); tr_load(n1.W, n1.ld, n1.N, n1.it, lane, v1); }
    for (; j < j1; j += nslots) {
        const int jn = j + 2 * nslots;
        if (jn < j1) { n2 = dense_job(a, jn); tr_load(n2.W, n2.ld, n2.N, n2.it, lane, v2); }
        tr_store(cv, cur.K, cur.N, cur.WT, cur.mode, scr, cur.it, lane);
        cur = n1; n1 = n2;
#pragma unroll
        for (int i = 0; i < 8; ++i) { cv[i] = v1[i]; v1[i] = v2[i]; }
    }
}
__global__ void __launch_bounds__(256) k_transpose(const float* W, int K, int ld, int N, bf16* WT, int mode) {
    __shared__ float scr[4][64 * 33];
    const int wave = threadIdx.x >> 6, lane = threadIdx.x & 63;
    tr_matrix(W, K, ld, N, WT, mode, (PG_LAS float*)scr[wave], blockIdx.x * 4 + wave, gridDim.x * 4, lane);
}
__global__ void __launch_bounds__(256) k_modvec(P a) {
    __shared__ float cond[MODR][D];
    __shared__ float red[4][MODR][64];
    const int l = blockIdx.x / 96, nc = blockIdx.x % 96, t = threadIdx.x, kg = t >> 6, n = nc * 64 + (t & 63);
    for (int i = t; i < MODR * D; i += 256) { const int r = i / D, k = i % D; const float v = r < NB ? a.c[r * D + k] : a.c_ctx[k]; cond[r][k] = silu_f(v); }
    __syncthreads();
    float acc[MODR];
#pragma unroll
    for (int r = 0; r < MODR; ++r) acc[r] = 0.f;
    const float* w = a.w_mod + (size_t)l * D * MODW + n;
    for (int k = kg * 256; k < kg * 256 + 256; ++k) { const float wv = w[(size_t)k * MODW];
#pragma unroll
        for (int r = 0; r < MODR; ++r) acc[r] += cond[r][k] * wv; }
#pragma unroll
    for (int r = 0; r < MODR; ++r) red[kg][r][t & 63] = acc[r];
    __syncthreads();
    float* mod = (float*)(a.ws + WS_MOD);
    for (int i = t; i < MODR * 64; i += 256) { const int r = i / 64, j = i % 64; const int nn = nc * 64 + j;
        mod[((size_t)l * MODR + r) * MODW + nn] = red[0][r][j] + red[1][r][j] + red[2][r][j] + red[3][r][j] + a.b_mod[l * MODW + nn]; }
}
__global__ void k_rope_table(P a) {
    const int i = blockIdx.x * blockDim.x + threadIdx.x; if (i >= 64 * 16) return;
    const int pos = i / 16, f = i % 16; const float inv = powf(10000.0f, -(float)f / 16.0f); const float ang = (float)pos * inv;
    float* t = (float*)(a.ws + WS_ROPE); t[2 * i] = cosf(ang); t[2 * i + 1] = sinf(ang);
}

template <int MODE, bool SRC_IN, int PEND>
__device__ __forceinline__ void norm_phase(const P& a_in, int l, int wg, PG_LAS float* lds, int pl = 0, int pchunk = 0) {
    PHASE_ENTRY(a_in)
    const int tid = otid(), lane = tid & 63, wave = tid >> 6;
#define NCOFF(j) (512 * ((j) >> 1) + 8 * lane + 4 * ((j) & 1))
    bf16* X = (bf16*)(a.ws + WS_X); bf16* HX = (bf16*)(a.ws + WS_HX); const float* MOD = (const float*)(a.ws + WS_MOD);
    PG_LAS float* wl = lds; PG_LAS unsigned* wlu = (PG_LAS unsigned*)lds;
    PG_LAS int* cnt_l = (PG_LAS int*)(lds + 8192 + 8 * 32);
    if (MODE == 0) {
        for (int i = tid; i < D * 2; i += NTHR) { const int c = i >> 1, hf = i & 1; const float* wp = a.w_in + ((size_t)l * D + c) * INW + UW + 8 * hf;
            const f32x4 w0 = *(const f32x4*)wp, w1 = *(const f32x4*)(wp + 4);
            const int j = 2 * (c >> 9) + ((c >> 2) & 1), ln = (c >> 3) & 63, ii = c & 3; v4u o; o.x = pk2(w0.x, w0.y); o.y = pk2(w0.z, w0.w); o.z = pk2(w1.x, w1.y); o.w = pk2(w1.z, w1.w);
            *(PG_LAS v4u*)(wlu + ((((j * 4 + ii) * 2 + hf) * 64 + ln) * 4)) = o; }
    }
    if (MODE == 2) {
        for (int i = tid; i < D * 2; i += NTHR) { const int c = i >> 1, g4 = i & 1; const f32x4 w = *(const f32x4*)(a.w_router + ((size_t)(l >> 1) * D + c) * NE + 4 * g4);
            const int j = 2 * (c >> 9) + ((c >> 2) & 1), ln = (c >> 3) & 63, ii = c & 3; *(PG_LAS f32x4*)(wl + ((((j * 4 + ii) * 2 + g4) * 64 + ln) * 4)) = w; }
        if (tid < NE) cnt_l[tid] = 0;
    }
    if (MODE == 0 || MODE == 2) __syncthreads();
    const float* gvec = MODE == 0 ? a.norm1_g + l * D : (MODE == 3 ? a.final_g : a.norm2_g + l * D);
    f32x4 gv[4];
#pragma unroll
    for (int j = 0; j < 4; ++j) gv[j] = *(const f32x4*)(gvec + NCOFF(j));
    const int row0 = wg * ROWS_PER_WG + wave * 17;
    int mr_c = -1, mr_p = -1; f32x4 cA[4], cB[4], cM[4];
#pragma unroll
    for (int j = 0; j < 4; ++j) { cA[j] = (f32x4){0.f, 0.f, 0.f, 0.f}; cB[j] = cA[j]; cM[j] = cA[j]; }
    int posA = 0, posB = 0;
    if (PEND == 2) { const int* tp = (const int*)(a.ws + WS_TOKP) + 2 * (row0 + (lane < 17 ? lane : 0)); posA = min(max(tp[0], 0), MOE_ROWS - 1); posB = min(max(tp[1], 0), MOE_ROWS - 1); }
    f32x4 nx[2][4]; v4u nxb[2][2], nd0[2][2], nd1[2][2];
#define NORM_LOAD_GROUP(g) do { _Pragma("unroll") for (int r_ = 0; r_ < 2; ++r_) { const int ri_ = (g) * 2 + r_, rc_ = ri_ < 17 ? ri_ : 0, tk_ = row0 + rc_; \
        if (SRC_IN) { const float* xr_ = in_row(a, tk_); _Pragma("unroll") for (int j = 0; j < 4; ++j) nx[r_][j] = *(const f32x4*)(xr_ + NCOFF(j)); } \
        else { const bf16* xr_ = X + (size_t)tk_ * D; _Pragma("unroll") for (int J = 0; J < 2; ++J) nxb[r_][J] = *(const v4u*)(xr_ + 512 * J + 8 * lane); } \
        if (PEND == 1) { const bf16* dl_ = (const bf16*)(a.ws + WS_DELTA) + (size_t)tk_ * D; _Pragma("unroll") for (int J = 0; J < 2; ++J) nd0[r_][J] = __builtin_nontemporal_load((const v4u*)(dl_ + 512 * J + 8 * lane)); } \
        if (PEND == 2) { const int p0_ = __builtin_amdgcn_readlane(posA, rc_), p1_ = __builtin_amdgcn_readlane(posB, rc_); const bf16* ys_ = (const bf16*)(a.ws + WS_YS); \
            _Pragma("unroll") for (int J = 0; J < 2; ++J) { nd0[r_][J] = __builtin_nontemporal_load((const v4u*)(ys_ + (size_t)p0_ * D + 512 * J + 8 * lane)); nd1[r_][J] = __builtin_nontemporal_load((const v4u*)(ys_ + (size_t)p1_ * D + 512 * J + 8 * lane)); } } } } while (0)
    NORM_LOAD_GROUP(0);
#pragma unroll 1
    for (int grp = 0; grp < 9; ++grp) {
        f32x4 h[2][4], cx[2][4]; v4u cd0[2][2], cd1[2][2];
#pragma unroll
        for (int r = 0; r < 2; ++r)
#pragma unroll
            for (int J = 0; J < 2; ++J) {
                if (SRC_IN) { cx[r][2 * J] = nx[r][2 * J]; cx[r][2 * J + 1] = nx[r][2 * J + 1]; }
                else { const v4u w = nxb[r][J]; cx[r][2 * J] = (f32x4){bf_lo(w.x), bf_hi(w.x), bf_lo(w.y), bf_hi(w.y)}; cx[r][2 * J + 1] = (f32x4){bf_lo(w.z), bf_hi(w.z), bf_lo(w.w), bf_hi(w.w)}; }
                if (PEND != 0) cd0[r][J] = nd0[r][J]; if (PEND == 2) cd1[r][J] = nd1[r][J]; }
        if (grp + 1 < 9) NORM_LOAD_GROUP(grp + 1);
        int tks[2]; bool valid[2], dead[2];
#pragma unroll
        for (int r = 0; r < 2; ++r) {
            const int ri = grp * 2 + r; valid[r] = ri < 17; const int tk = row0 + (valid[r] ? ri : 0); tks[r] = tk;
            const int b = tk / TPB, p = tk - b * TPB, mr = p < CTX ? NB : b; dead[r] = (MODE == 2 && l == DEPTH - 1 && p < CTX);
            f32x4 xv[4];
#pragma unroll
            for (int j = 0; j < 4; ++j) xv[j] = cx[r][j];
            if (PEND != 0) {
                if (mr != mr_p) { mr_p = mr; const float* mp = MOD + ((size_t)pl * MODR + mr) * MODW + (PEND == 2 ? 5 : pchunk) * D;
#pragma unroll
                    for (int j = 0; j < 4; ++j) cM[j] = *(const f32x4*)(mp + NCOFF(j)); }
                if (PEND == 2) {
#pragma unroll
                    for (int j = 0; j < 4; ++j) { const v4u a0 = cd0[r][j >> 1], a1 = cd1[r][j >> 1]; const v2u y0 = (j & 1) ? (v2u){a0.z, a0.w} : (v2u){a0.x, a0.y}, y1 = (j & 1) ? (v2u){a1.z, a1.w} : (v2u){a1.x, a1.y};
                        xv[j].x += cM[j].x * (bf_lo(y0.x) + bf_lo(y1.x)); xv[j].y += cM[j].y * (bf_hi(y0.x) + bf_hi(y1.x));
                        xv[j].z += cM[j].z * (bf_lo(y0.y) + bf_lo(y1.y)); xv[j].w += cM[j].w * (bf_hi(y0.y) + bf_hi(y1.y)); }
                } else {
#pragma unroll
                    for (int j = 0; j < 4; ++j) { const v4u a0 = cd0[r][j >> 1]; const v2u y0 = (j & 1) ? (v2u){a0.z, a0.w} : (v2u){a0.x, a0.y};
                        xv[j].x += cM[j].x * bf_lo(y0.x); xv[j].y += cM[j].y * bf_hi(y0.x); xv[j].z += cM[j].z * bf_lo(y0.y); xv[j].w += cM[j].w * bf_hi(y0.y); }
                }
                if (valid[r] && MODE != 3) {
#pragma unroll
                    for (int J = 0; J < 2; ++J) { v4u o; o.x = cvt_pk_bf16(xv[2 * J].x, xv[2 * J].y); o.y = cvt_pk_bf16(xv[2 * J].z, xv[2 * J].w); o.z = cvt_pk_bf16(xv[2 * J + 1].x, xv[2 * J + 1].y); o.w = cvt_pk_bf16(xv[2 * J + 1].z, xv[2 * J + 1].w);
                        *(v4u*)(X + (size_t)tk * D + 512 * J + 8 * lane) = o; } }
            }
            float ss = 0.f;
#pragma unroll
            for (int j = 0; j < 4; ++j) ss += (xv[j].x * xv[j].x + xv[j].y * xv[j].y) + (xv[j].z * xv[j].z + xv[j].w * xv[j].w);
            const float rstd = rsqrtf(wave_sum(ss) * (1.f / D) + EPS);
            if (MODE == 3) {
                if (valid[r] && p >= CTX) { float* o = a.out + ((size_t)b * SEQ + (p - CTX)) * D;
#pragma unroll
                    for (int j = 0; j < 4; ++j) *(f32x4*)(o + NCOFF(j)) = xv[j] * rstd * gv[j]; }
            } else {
                if (mr != mr_c) {
                    mr_c = mr; const float* mrow = MOD + ((size_t)l * MODR + mr) * MODW;
                    const float* shp = mrow + (MODE == 0 ? 0 : 3) * D; const float* scp = mrow + (MODE == 0 ? 1 : 4) * D;
#pragma unroll
                    for (int j = 0; j < 4; ++j) { const f32x4 sh = *(const f32x4*)(shp + NCOFF(j)), sc = *(const f32x4*)(scp + NCOFF(j)); cA[j] = gv[j] * (sc + 1.f); cB[j] = sh; }
                }
#pragma unroll
                for (int j = 0; j < 4; ++j) h[r][j] = xv[j] * rstd * cA[j] + cB[j];
                if (valid[r]) {
#pragma unroll
                    for (int J = 0; J < 2; ++J) { v4u o; o.x = cvt_pk_bf16(h[r][2 * J].x, h[r][2 * J].y); o.y = cvt_pk_bf16(h[r][2 * J].z, h[r][2 * J].w); o.z = cvt_pk_bf16(h[r][2 * J + 1].x, h[r][2 * J + 1].y); o.w = cvt_pk_bf16(h[r][2 * J + 1].z, h[r][2 * J + 1].w);
                        *(v4u*)(HX + (size_t)tk * D + 512 * J + 8 * lane) = o; } }
            }
        }
        if (MODE == 0) {
            float acc[2][16];
#pragma unroll
            for (int r = 0; r < 2; ++r)
#pragma unroll
                for (int g = 0; g < 16; ++g) acc[r][g] = 0.f;
#pragma unroll
            for (int j = 0; j < 4; ++j)
#pragma unroll
                for (int ii = 0; ii < 4; ++ii) {
#pragma unroll
                    for (int hf = 0; hf < 2; ++hf) { const v4u w = *(const PG_LAS v4u*)(wlu + ((((j * 4 + ii) * 2 + hf) * 64 + lane) * 4));
#pragma unroll
                        for (int r = 0; r < 2; ++r) { const float hv = h[r][j][ii];
                            acc[r][8 * hf + 0] += hv * bf_lo(w.x); acc[r][8 * hf + 1] += hv * bf_hi(w.x); acc[r][8 * hf + 2] += hv * bf_lo(w.y); acc[r][8 * hf + 3] += hv * bf_hi(w.y);
                            acc[r][8 * hf + 4] += hv * bf_lo(w.z); acc[r][8 * hf + 5] += hv * bf_hi(w.z); acc[r][8 * hf + 6] += hv * bf_lo(w.w); acc[r][8 * hf + 7] += hv * bf_hi(w.w); } }
                    asm volatile("" ::: "memory"); }
            float flat[32];
#pragma unroll
            for (int r = 0; r < 2; ++r)
#pragma unroll
                for (int g = 0; g < 16; ++g) flat[r * 16 + g] = acc[r][g];
            const float sum = RS<32, 32>::run(flat, lane);
            { const int idx = (lane >> 1) & 31, r = idx >> 4, g = idx & 15;
              float v = sum + a.b_gates[l * 16 + g]; v = 15.f * tanhf(v * (1.f / 15.f));
              const int ri = grp * 2 + r;
              if ((lane & 1) == 0 && ri < 17) ((float*)(a.ws + WS_GATES))[(size_t)(row0 + ri) * 16 + g] = v; }
        }
        if (MODE == 2) {
            float acc[2][8];
#pragma unroll
            for (int r = 0; r < 2; ++r)
#pragma unroll
                for (int g = 0; g < 8; ++g) acc[r][g] = 0.f;
#pragma unroll
            for (int j = 0; j < 4; ++j)
#pragma unroll
                for (int ii = 0; ii < 4; ++ii) {
#pragma unroll
                    for (int g4 = 0; g4 < 2; ++g4) { const f32x4 w = *(const PG_LAS f32x4*)(wl + ((((j * 4 + ii) * 2 + g4) * 64 + lane) * 4));
#pragma unroll
                        for (int r = 0; r < 2; ++r) { const float hv = h[r][j][ii]; acc[r][4 * g4 + 0] += hv * w.x; acc[r][4 * g4 + 1] += hv * w.y; acc[r][4 * g4 + 2] += hv * w.z; acc[r][4 * g4 + 3] += hv * w.w; } }
                    asm volatile("" ::: "memory"); }
            float flat[16];
#pragma unroll
            for (int r = 0; r < 2; ++r)
#pragma unroll
                for (int g = 0; g < 8; ++g) flat[r * 8 + g] = acc[r][g];
            const float sum = RS<16, 32>::run(flat, lane);
#pragma unroll
            for (int r = 0; r < 2; ++r) {
                float lg[8];
#pragma unroll
                for (int g = 0; g < 8; ++g) { const float v = lane_bcast(sum, (r * 8 + g) << 2) + a.b_router[(l >> 1) * NE + g]; lg[g] = (v == v) ? fminf(fmaxf(v, -1.0e30f), 1.0e30f) : -1.0e30f; }
                int e0 = 0; float v0 = lg[0];
#pragma unroll
                for (int g = 1; g < 8; ++g) if (lg[g] > v0) { v0 = lg[g]; e0 = g; }
                int e1 = (e0 + 1) & 7; float v1 = -3.0e38f;
#pragma unroll
                for (int g = 0; g < 8; ++g) if (g != e0 && lg[g] > v1) { v1 = lg[g]; e1 = g; }
                const float w0 = 1.f / (1.f + __expf(v1 - v0)), w1 = 1.f - w0;
                if (lane == 0 && valid[r]) { const int tk = tks[r];
                    int* te = (int*)(a.ws + WS_TOKE) + 2 * tk; te[0] = dead[r] ? -1 : e0; te[1] = dead[r] ? -1 : e1; }
                if (lane == 0 && valid[r] && !dead[r]) { const int tk = tks[r];
                    float* tw = (float*)(a.ws + WS_TOKW) + 2 * tk; tw[0] = w0; tw[1] = w1;
                    __hip_atomic_fetch_add(&cnt_l[e0], 1, __ATOMIC_RELAXED, __HIP_MEMORY_SCOPE_WORKGROUP); __hip_atomic_fetch_add(&cnt_l[e1], 1, __ATOMIC_RELAXED, __HIP_MEMORY_SCOPE_WORKGROUP); }
            }
        }
    }
    if (MODE == 2) { __syncthreads(); if (tid < NE) ((int*)(a.ws + WS_CNT))[wg * NE + tid] = cnt_l[tid]; }
}
#undef NCOFF
template <int MODE, bool SRC_IN, int PEND>
__global__ void __launch_bounds__(NTHR, 2) k_norm(P a, int l) {
    extern __shared__ __attribute__((aligned(16))) unsigned char smem[];
    a.wv = __builtin_amdgcn_readfirstlane(threadIdx.x >> 6);
    norm_phase<MODE, SRC_IN, PEND>(a, l, blockIdx.x, (PG_LAS float*)smem);
}

__device__ __forceinline__ void moe_pos_phase(const P& a_in, int wg, int* lds) {
    PHASE_ENTRY(a_in)
    const int tid = otid(), lane = tid & 63, wave = __builtin_amdgcn_readfirstlane(tid >> 6);
    int* cnt = lds;
    int* tot = lds + 2048;
    int* wc = lds + 2048 + 32;
    const int* gc = (const int*)(a.ws + WS_CNT);
    for (int i = tid; i < NWG * NE; i += NTHR) cnt[i] = gc[i];
    const int* te = (const int*)(a.ws + WS_TOKE); const float* tw = (const float*)(a.ws + WS_TOKW);
    int* tp = (int*)(a.ws + WS_TOKP); int* rowt = (int*)(a.ws + WS_ROWT); float* roww = (float*)(a.ws + WS_ROWW);
    constexpr int NENT = 2 * ROWS_PER_WG;
    const int ent = tid < NENT ? te[2 * wg * ROWS_PER_WG + tid] : -1;
    const float entw = tid < NENT ? tw[2 * wg * ROWS_PER_WG + tid] : 0.f;
    int rank = 0;
#pragma unroll
    for (int e = 0; e < NE; ++e) { const unsigned long long mk = __ballot(ent == e);
        const int below = __builtin_amdgcn_mbcnt_hi((unsigned)(mk >> 32), __builtin_amdgcn_mbcnt_lo((unsigned)mk, 0u));
        if (ent == e) rank = below;
        if (lane == 0) wc[wave * NE + e] = __popcll(mk); }
    __syncthreads();
    {
        const int e = wave; int v[4], sum = 0;
#pragma unroll
        for (int q = 0; q < 4; ++q) { v[q] = cnt[(4 * lane + q) * NE + e]; sum += v[q]; }
        const int incl = (int)dpp_scan<false>((float)sum);
        const int total = __builtin_amdgcn_readlane(incl, 63);
        const int lw = wg >> 2, lq = wg & 3;
        int mine = incl - sum; if (lq > 0) mine += v[0]; if (lq > 1) mine += v[1]; if (lq > 2) mine += v[2];
        const int pre = __builtin_amdgcn_readlane(mine, lw);
        if (lane == 0) { tot[e] = total; tot[16 + e] = pre; }
    }
    __syncthreads();
    if (tid == 0) { int s = 0; for (int e = 0; e < NE; ++e) { tot[8 + e] = s; s += (tot[e] + 255) & ~255; } tot[24] = s; }
    __syncthreads();
    if (ent >= 0) {
        int off = 0;
        for (int w = 0; w < wave; ++w) off += wc[w * NE + ent];
        const int pos = tot[8 + ent] + tot[16 + ent] + off + rank;
        const int tk = wg * ROWS_PER_WG + (tid >> 1);
        tp[2 * wg * ROWS_PER_WG + tid] = pos; rowt[pos] = tk; roww[pos] = entw;
    }
    if (wg < NE) { const int s0 = tot[8 + wg] + tot[wg], s1 = tot[8 + wg] + ((tot[wg] + 255) & ~255); for (int r = s0 + tid; r < s1; r += NTHR) { rowt[r] = 0; roww[r] = 0.f; } }
    if (wg == 0) { int* tile_e = (int*)(a.ws + WS_TILEE); const int nt = tot[24] >> 8;
        for (int t = tid; t < MOE_TILES; t += NTHR) { int e = 0; for (int q = 1; q < NE; ++q) if (t * 256 >= tot[8 + q]) e = q; tile_e[t] = t < nt ? e : 0; }
        if (tid == 0) tile_e[MOE_TILES] = nt; }
}
__global__ void __launch_bounds__(NTHR, 2) k_moe_pos(P a) {
    extern __shared__ __attribute__((aligned(16))) unsigned char smem[];
    a.wv = __builtin_amdgcn_readfirstlane(threadIdx.x >> 6);
    moe_pos_phase(a, blockIdx.x, (int*)smem);
}

enum { EM_IN = 0, EM_OUT = 1, EM_F1 = 2, EM_F2D = 3, EM_F1M = 4, EM_F2M = 5 };
template <int EM>
__global__ void __launch_bounds__(256) k_ngemm(P a, int l, const bf16* A, const bf16* Bt, int M, int N, int K) {
    constexpr bool DUAL = (EM == EM_F1 || EM == EM_F1M), MOE = (EM == EM_F1M || EM == EM_F2M);
    __shared__ __attribute__((aligned(16))) float As[32][64], Bs[32][64], Bs2[DUAL ? 32 : 1][64];
    const int t = threadIdx.x, tx = t & 15, ty = t >> 4;
    const int row0 = blockIdx.y * 64, col0 = blockIdx.x * 64;
    const int* tile_e = (const int*)(a.ws + WS_TILEE); const int* rowt = (const int*)(a.ws + WS_ROWT);
    if (MOE) { if (row0 >= tile_e[MOE_TILES] * 256) return; }
    const int e = MOE ? tile_e[row0 >> 8] : 0;
    const bf16* B = Bt + (MOE ? (size_t)e * (DUAL ? 2 * FFN : D) * K : 0);
    const int lr = t >> 2, kc = (t & 3) * 8;
    const int arow = (EM == EM_F1M) ? rowt[row0 + lr] : row0 + lr;
    const int brow = DUAL ? ((col0 >> 7) * 256 + (col0 & 127) + lr) : col0 + lr;
    float acc[4][4], acc2[4][4];
#pragma unroll
    for (int i = 0; i < 4; ++i)
#pragma unroll
        for (int j = 0; j < 4; ++j) { acc[i][j] = 0.f; acc2[i][j] = 0.f; }
    for (int k0 = 0; k0 < K; k0 += 32) {
        const v4u av = *(const v4u*)(A + (size_t)arow * K + k0 + kc);
        const v4u bv = *(const v4u*)(B + (size_t)brow * K + k0 + kc);
        v4u bv2 = bv; if (DUAL) bv2 = *(const v4u*)(B + (size_t)(brow + 128) * K + k0 + kc);
        __syncthreads();
        As[kc + 0][lr] = bf_lo(av.x); As[kc + 1][lr] = bf_hi(av.x); As[kc + 2][lr] = bf_lo(av.y); As[kc + 3][lr] = bf_hi(av.y);
        As[kc + 4][lr] = bf_lo(av.z); As[kc + 5][lr] = bf_hi(av.z); As[kc + 6][lr] = bf_lo(av.w); As[kc + 7][lr] = bf_hi(av.w);
        Bs[kc + 0][lr] = bf_lo(bv.x); Bs[kc + 1][lr] = bf_hi(bv.x); Bs[kc + 2][lr] = bf_lo(bv.y); Bs[kc + 3][lr] = bf_hi(bv.y);
        Bs[kc + 4][lr] = bf_lo(bv.z); Bs[kc + 5][lr] = bf_hi(bv.z); Bs[kc + 6][lr] = bf_lo(bv.w); Bs[kc + 7][lr] = bf_hi(bv.w);
        if (DUAL) { Bs2[kc + 0][lr] = bf_lo(bv2.x); Bs2[kc + 1][lr] = bf_hi(bv2.x); Bs2[kc + 2][lr] = bf_lo(bv2.y); Bs2[kc + 3][lr] = bf_hi(bv2.y);
            Bs2[kc + 4][lr] = bf_lo(bv2.z); Bs2[kc + 5][lr] = bf_hi(bv2.z); Bs2[kc + 6][lr] = bf_lo(bv2.w); Bs2[kc + 7][lr] = bf_hi(bv2.w); }
        __syncthreads();
#pragma unroll 8
        for (int k = 0; k < 32; ++k) {
            const f32x4 av4 = *(const f32x4*)&As[k][ty * 4], bv4 = *(const f32x4*)&Bs[k][tx * 4];
#pragma unroll
            for (int i = 0; i < 4; ++i)
#pragma unroll
                for (int j = 0; j < 4; ++j) acc[i][j] += av4[i] * bv4[j];
            if (DUAL) { const f32x4 b2 = *(const f32x4*)&Bs2[k][tx * 4];
#pragma unroll
                for (int i = 0; i < 4; ++i)
#pragma unroll
                    for (int j = 0; j < 4; ++j) acc2[i][j] += av4[i] * b2[j]; }
        }
    }
    const float* MOD = (const float*)(a.ws + WS_MOD); float* X = (float*)(a.ws + WS_X);
#pragma unroll
    for (int i = 0; i < 4; ++i) {
        const int r = row0 + ty * 4 + i;
#pragma unroll
        for (int j = 0; j < 4; ++j) {
            const int c = col0 + tx * 4 + j; const float v = acc[i][j];
            if (EM == EM_IN) ((bf16*)(a.ws + WS_U))[(size_t)r * UW + c] = (bf16)f2bf(v);
            if (EM == EM_OUT) { const float* base = (l == 0) ? in_row(a, r) : X + (size_t)r * D; X[(size_t)r * D + c] = base[c] + MOD[((size_t)l * MODR + tk_modrow(r)) * MODW + 2 * D + c] * v; }
            if (EM == EM_F1) ((bf16*)(a.ws + WS_HID))[(size_t)r * FFN + c] = (bf16)f2bf(silu_f(v) * acc2[i][j]);
            if (EM == EM_F1M) ((bf16*)(a.ws + WS_HID))[(size_t)r * FFN + c] = (bf16)f2bf(silu_f(v) * acc2[i][j] * ((const float*)(a.ws + WS_ROWW))[r]);
            if (EM == EM_F2D) X[(size_t)r * D + c] += MOD[((size_t)l * MODR + tk_modrow(r)) * MODW + 5 * D + c] * v;
            if (EM == EM_F2M) ((bf16*)(a.ws + WS_YS))[(size_t)r * D + c] = (bf16)f2bf(v);
        }
    }
}
__global__ void __launch_bounds__(256) k_rope_apply(P a) {
    const size_t i = (size_t)blockIdx.x * 256 + threadIdx.x; if (i >= (size_t)T_ALL * 20 * 16) return;
    const int tk = (int)(i / 320), rem = (int)(i % 320), grp = rem / 16, f = rem % 16;
    const int b = tk / TPB, p = tk - b * TPB; bf16* u = (bf16*)(a.ws + WS_U) + (size_t)tk * UW + grp * 32;
    float x1 = bf2f(u[f]), x2 = bf2f(u[f + 16]);
    const float sc = grp < 16 ? 0.125f : 1.f;
    if (p >= CTX) { const int s = p - CTX, pos = (grp & 1) ? (s & 63) : (s >> 6); const float* t = (const float*)(a.ws + WS_ROPE) + 2 * (pos * 16 + f);
        const float cs = t[0], sn = t[1]; const float y1 = x1 * cs - x2 * sn, y2 = x2 * cs + x1 * sn; x1 = y1; x2 = y2; }
    u[f] = (bf16)f2bf(x1 * sc); u[f + 16] = (bf16)f2bf(x2 * sc);
}

__global__ void __launch_bounds__(512, 2) k_attn_naive(P a, int l) {
    __shared__ float ssq[8];
    const int tk = blockIdx.x, h = threadIdx.x >> 6, lane = threadIdx.x & 63, kvh = h >> 2;
    const int b = tk / TPB, p = tk - b * TPB; const bool isctx = p < CTX;
    const bf16* U = (const bf16*)(a.ws + WS_U);
    float q[64];
    { const v4u* qp = (const v4u*)(U + (size_t)tk * UW + U_QA + h * 64);
#pragma unroll
      for (int i = 0; i < 8; ++i) { const v4u w = qp[i]; q[8 * i + 0] = bf_lo(w.x); q[8 * i + 1] = bf_hi(w.x); q[8 * i + 2] = bf_lo(w.y); q[8 * i + 3] = bf_hi(w.y); q[8 * i + 4] = bf_lo(w.z); q[8 * i + 5] = bf_hi(w.z); q[8 * i + 6] = bf_lo(w.w); q[8 * i + 7] = bf_hi(w.w); } }
    const int s = p - CTX; const int j0 = isctx ? 0 : (s - 128 < 0 ? 0 : s - 128), j1 = isctx ? -1 : (s + 128 > SEQ - 1 ? SEQ - 1 : s + 128);
    const int nlat = j1 - j0 + 1, nk = CTX + (isctx ? 0 : nlat);
    const int tb = b * TPB;
    float sc[9];
#pragma unroll
    for (int it = 0; it < 9; ++it) { const int idx = lane + 64 * it; sc[it] = -3.0e38f;
        if (idx < nk) { const int kt = idx < CTX ? tb + idx : tb + CTX + j0 + (idx - CTX); const v4u* kp = (const v4u*)(U + (size_t)kt * UW + U_KA + kvh * 64); float d = 0.f;
#pragma unroll
            for (int i = 0; i < 8; ++i) { const v4u w = kp[i]; d += q[8 * i + 0] * bf_lo(w.x) + q[8 * i + 1] * bf_hi(w.x) + q[8 * i + 2] * bf_lo(w.y) + q[8 * i + 3] * bf_hi(w.y) + q[8 * i + 4] * bf_lo(w.z) + q[8 * i + 5] * bf_hi(w.z) + q[8 * i + 6] * bf_lo(w.w) + q[8 * i + 7] * bf_hi(w.w); }
            sc[it] = d; } }
    const float sink = a.attn_sink[l * 8 + h];
    float m = sink;
#pragma unroll
    for (int it = 0; it < 9; ++it) m = fmaxf(m, sc[it]);
    m = wave_max(m);
    float o[64];
#pragma unroll
    for (int d = 0; d < 64; ++d) o[d] = 0.f;
    float den = 0.f;
#pragma unroll
    for (int it = 0; it < 9; ++it) { const int idx = lane + 64 * it;
        if (idx < nk) { const float pr = __expf(sc[it] - m); den += pr; const int kt = idx < CTX ? tb + idx : tb + CTX + j0 + (idx - CTX); const v4u* vp = (const v4u*)(U + (size_t)kt * UW + U_VA + kvh * 64);
#pragma unroll
            for (int i = 0; i < 8; ++i) { const v4u w = vp[i]; o[8 * i + 0] += pr * bf_lo(w.x); o[8 * i + 1] += pr * bf_hi(w.x); o[8 * i + 2] += pr * bf_lo(w.y); o[8 * i + 3] += pr * bf_hi(w.y); o[8 * i + 4] += pr * bf_lo(w.z); o[8 * i + 5] += pr * bf_hi(w.z); o[8 * i + 6] += pr * bf_lo(w.w); o[8 * i + 7] += pr * bf_hi(w.w); } } }
    den = wave_sum(den) + __expf(sink - m);
    float mine = 0.f;
#pragma unroll
    for (int d = 0; d < 64; ++d) { const float sd = wave_sum(o[d]); mine = (lane == d) ? sd : mine; }
    mine /= den;
    const float sq = wave_sum(mine * mine);
    if (lane == 0) ssq[h] = sq;
    __syncthreads();
    float tot = 0.f;
#pragma unroll
    for (int i = 0; i < 8; ++i) tot += ssq[i];
    const float rstd = rsqrtf(tot * (1.f / 512.f) + EPS);
    ((bf16*)(a.ws + WS_MIX))[(size_t)tk * D + h * 64 + lane] = (bf16)f2bf(mine * rstd * a.g_att[l * 512 + h * 64 + lane]);
}

__device__ __forceinline__ float conv_qk(const P& a, int l, const bf16* U, int tk, int ch) {
    const int b = tk / TPB, p = tk - b * TPB; const int lo = p < CTX ? 0 : CTX, hi = p < CTX ? CTX : TPB;
    float y = a.conv_b[l * 512 + ch];
#pragma unroll
    for (int j = 0; j < 5; ++j) { const int pp = p + j - 2; if (pp >= lo && pp < hi) y += a.conv_w[(l * 5 + j) * 512 + ch] * bf2f(U[(size_t)(b * TPB + pp) * UW + U_QM + ch]); }
    return silu_f(y);
}
__global__ void __launch_bounds__(256) k_mlstm_naive(P a, int l) {
    __shared__ float qs[2][64], ks[2][64], part[2][2][128], sc[2][4];
    const int t = threadIdx.x, dir = blockIdx.x & 1, hd = (blockIdx.x >> 1) & 3, b = blockIdx.x >> 3;
    const bf16* U = (const bf16*)(a.ws + WS_U); const float* G = (const float*)(a.ws + WS_GATES);
    float* HD = (float*)(a.ws + WS_HDIR) + (size_t)dir * T_ALL * 512;
    const int e = t & 127, half = t >> 7;
    float C[32];
#pragma unroll
    for (int i = 0; i < 32; ++i) C[i] = 0.f;
    float nst = 0.f, m = 0.f;
    for (int tau = 0; tau < TPB; ++tau) {
        const int pb = tau & 1;
        const int p = dir == 0 ? tau : (tau < CTX ? CTX - 1 - tau : CTX + (SEQ - 1) - (tau - CTX));
        const int tk = b * TPB + p;
        if (t < 64) qs[pb][t] = 0.125f * conv_qk(a, l, U, tk, hd * 64 + t);
        else if (t < 128) ks[pb][t - 64] = conv_qk(a, l, U, tk, 256 + hd * 64 + (t - 64));
        const float li = G[(size_t)tk * 16 + dir * 8 + hd], lf = logsigmoid_f(G[(size_t)tk * 16 + dir * 8 + 4 + hd]);
        const float mn = fmaxf(lf + m, li), fd = __expf(lf + m - mn), iw = __expf(li - mn);
        m = mn;
        const float v = bf2f(U[(size_t)tk * UW + U_VM + hd * 128 + e]);
        __syncthreads();
        float ph = 0.f;
#pragma unroll
        for (int i = 0; i < 32; ++i) { const int dk = half * 32 + i; C[i] = fd * C[i] + iw * ks[pb][dk] * v; ph += qs[pb][dk] * C[i]; }
        part[pb][half][e] = ph;
        if (t < 64) { nst = fd * nst + iw * ks[pb][t]; const float qn = wave_sum(qs[pb][t] * nst); if (t == 0) sc[pb][0] = qn; }
        __syncthreads();
        if (t < 128) { const float num = part[pb][0][t] + part[pb][1][t]; const float den = fmaxf(fabsf(sc[pb][0]), __expf(-mn)); HD[(size_t)tk * 512 + hd * 128 + t] = num / den; }
    }
}
__global__ void __launch_bounds__(256) k_merge_naive(P a, int l) {
    const int tk = blockIdx.x, hd = threadIdx.x >> 6, lane = threadIdx.x & 63;
    const float* H0 = (const float*)(a.ws + WS_HDIR); const float* H1 = H0 + (size_t)T_ALL * 512; const bf16* U = (const bf16*)(a.ws + WS_U);
    const int c0 = hd * 128 + lane, c1 = c0 + 64;
    const float h0 = H0[(size_t)tk * 512 + c0] + H1[(size_t)tk * 512 + c0], h1 = H0[(size_t)tk * 512 + c1] + H1[(size_t)tk * 512 + c1];
    const float rstd = rsqrtf(wave_sum(h0 * h0 + h1 * h1) * (1.f / 128.f) + EPS);
    bf16* mx = (bf16*)(a.ws + WS_MIX) + (size_t)tk * D + 512;
    mx[c0] = (bf16)f2bf(h0 * rstd * a.g_ml[l * 512 + c0] * sigmoid_f(bf2f(U[(size_t)tk * UW + U_OM + c0])));
    mx[c1] = (bf16)f2bf(h1 * rstd * a.g_ml[l * 512 + c1] * sigmoid_f(bf2f(U[(size_t)tk * UW + U_OM + c1])));
}

namespace pg {
#define PG_LAS __attribute__((address_space(3)))
typedef short bf16x8 __attribute__((ext_vector_type(8)));
constexpr int BM = 256, BK = 64, HALF = 128, HTB = HALF * BK * 2, STAGE_BYTES = 8 * HTB, NXCD = 8, WGM = 8;
__host__ __device__ __forceinline__ int lds_byte(int r, int c) { const int st = (r >> 4) * 2 + (c >> 5), rr = r & 15, cc = c & 31, ob = rr * 64 + cc * 2; return st * 1024 + (ob ^ (((ob >> 9) & 1) << 5)); }
__host__ __device__ __forceinline__ void stage_rc(int b, int& R, int& C) { const int st = b / 1024, sb = b % 1024, swz = sb ^ (((sb >> 9) & 1) << 5); R = (st >> 1) * 16 + swz / 64; C = (st & 1) * 32 + (swz % 64) / 2; }
__host__ __device__ __forceinline__ int perm32(int rho) { const int n = rho >> 4, i = rho & 15; return 8 * (i >> 2) + 4 * n + (i & 3); }
struct Unit { int pm, pn, e, ks, kn; };
struct Order {
    int nM, nN, nwg, G, c, lat;
    int full, rem, S, rt;
    __device__ void init(int nM_, int nN_, int G_, int c_) { nM = nM_; nN = nN_; nwg = nM * nN; G = G_; c = c_; lat = 0; S = 0; full = nwg; rem = 0; rt = 0; }
    __device__ void init_split(int nM_, int nN_, int G_, int c_) { init(nM_, nN_, G_, c_); full = (nwg / G) * G; rem = nwg - full; rt = rem / nN; S = rem == 0 ? 1 : ((SPLIT_MAXS >= 3 && rem * 3 <= G) ? 3 : ((SPLIT_MAXS >= 2 && rem * 2 <= G) ? 2 : 1)); }
    __device__ bool next(int i, Unit& u) const {
        const long L = (long)i * G + c; u.ks = 0; u.kn = 1; u.e = 0;
        if (S != 0) {
            if (L >= full) {
                if (i != full / G) return false;
                const int p = c; if (p >= rem * S) return false;
                const int idx = p % rem; u.ks = p / rem; u.kn = S; u.pm = full / nN + idx % rt; u.pn = idx / rt; return true;
            }
        } else if (L >= nwg) return false;
        const int nw = S != 0 ? full : nwg, nMe = S != 0 ? full / nN : nM;
        int wgid = (int)L; { const int q = nw / NXCD, r = nw % NXCD, xcd = wgid % NXCD, off = wgid / NXCD; wgid = (xcd < r ? xcd * (q + 1) : r * (q + 1) + (xcd - r) * q) + off; }
        const int nig = WGM * nN, gid = wgid / nig, fm = gid * WGM, gsz = (nMe - fm) < WGM ? (nMe - fm) : WGM;
        u.pm = fm + ((wgid % nig) % gsz); u.pn = (wgid % nig) / gsz; if (lat) u.pm = (u.pm >> 4) * 17 + 1 + (u.pm & 15); return true;
    }
};
struct Gemm { const bf16* A; const bf16* Bt; int K; int brows; const int* rowt; const int* tile_e; int wv; };

template <class Epi, bool GATHER, bool MOE, bool SPLIT = false>
__device__ __forceinline__ void gemm_phase(PG_LAS unsigned char* lds, const Gemm g, const Order& S, const Epi& E) {
    const int tid = otid_w(g.wv), wid = __builtin_amdgcn_readfirstlane(tid >> 6), lane = tid & 63, wr = wid >> 2, wc = wid & 3, fr = lane & 15, fq = lane >> 4;
    const int K = g.K, ntK = K / BK;
#define PG_KOFF(u) (SPLIT ? (size_t)(2 * ((ntK / 2) * (u).ks / (u).kn)) * (size_t)(BK * 2) : (size_t)0)
#define PG_KNT(u) (SPLIT ? 2 * ((ntK / 2) * ((u).ks + 1) / (u).kn - (ntK / 2) * (u).ks / (u).kn) : ntK)
    int Rr[2], Cc[2]; unsigned voffB[2];
#pragma unroll
    for (int i = 0; i < 2; ++i) { int R, C; stage_rc(tid * 16 + i * 8192, R, C); Rr[i] = R; Cc[i] = C; const int Rb = Epi::PERM ? ((R & ~31) + perm32(R & 31)) : R; voffB[i] = (unsigned)(Rb * K + C) * 2u; }
    const size_t hstep = (size_t)HALF * K * 2;
    const unsigned ldsw = (unsigned)wid * 1024u;
    const int aoff = lds_byte(wr * 64 + fr, fq * 8), boff = lds_byte(wc * 32 + fr, fq * 8);
    const char* Ab = (const char*)g.A;
#define PG_SA(b, h) (((b) * 2 + (h)) * HTB)
#define PG_SB(b, h) ((4 + (b) * 2 + (h)) * HTB)
#define PG_STAGE_B(bufoff, gbase) do { _Pragma("unroll") for (int _i = 0; _i < 2; ++_i) \
        __builtin_amdgcn_global_load_lds((const unsigned*)((const char*)(gbase) + voffB[_i]), (PG_LAS unsigned*)(lds + (bufoff) + ldsw + _i * 8192), 16, 0, 0); } while (0)
#define PG_STAGE_A(bufoff, offs, h, kb) do { _Pragma("unroll") for (int _i = 0; _i < 2; ++_i) \
        __builtin_amdgcn_global_load_lds((const unsigned*)(Ab + (size_t)(offs)[h][_i] + (size_t)(kb)), (PG_LAS unsigned*)(lds + (bufoff) + ldsw + _i * 8192), 16, 0, 0); } while (0)
#define PG_LDA(dst, b, h) do { _Pragma("unroll") for (int m = 0; m < 4; ++m) _Pragma("unroll") for (int k = 0; k < 2; ++k) dst[m][k] = *(const PG_LAS bf16x8*)(lds + PG_SA(b, h) + aoff + m * 2048 + k * 1024); } while (0)
#define PG_LDB(dst, b, h) do { _Pragma("unroll") for (int n = 0; n < 2; ++n) _Pragma("unroll") for (int k = 0; k < 2; ++k) dst[n][k] = *(const PG_LAS bf16x8*)(lds + PG_SB(b, h) + boff + n * 2048 + k * 1024); } while (0)
#define PG_MMA(ai, bj, At, Bt) do { __builtin_amdgcn_s_setprio(1); _Pragma("unroll") for (int m = 0; m < 4; ++m) _Pragma("unroll") for (int n = 0; n < 2; ++n) _Pragma("unroll") for (int k = 0; k < 2; ++k) \
        acc[ai][bj][m][n] = __builtin_amdgcn_mfma_f32_16x16x32_bf16(Bt[n][k], At[m][k], acc[ai][bj][m][n], 0, 0, 0); __builtin_amdgcn_s_setprio(0); } while (0)
#define PG_WAIT_V(n) asm volatile("s_waitcnt vmcnt(" #n ")" ::: "memory")
#define PG_WAIT_L(n) asm volatile("s_waitcnt lgkmcnt(" #n ")" ::: "memory")
#define PG_BAR __builtin_amdgcn_s_barrier()
#define PG_SCHED __builtin_amdgcn_sched_barrier(0)
#define PG_AOFFS(dst, u) do { _Pragma("unroll") for (int _h = 0; _h < 2; ++_h) _Pragma("unroll") for (int _i = 0; _i < 2; ++_i) { \
        const int _r = (u).pm * BM + _h * HALF + Rr[_i]; const int _row = GATHER ? g.rowt[_r] : _r; dst[_h][_i] = (unsigned)_row * (unsigned)(K * 2) + (unsigned)(Cc[_i] * 2) + (unsigned)PG_KOFF(u); } } while (0)
#define PG_BBASE(u) ((const char*)g.Bt + ((size_t)(u).e * g.brows + (size_t)(u).pn * BM) * (size_t)K * 2 + PG_KOFF(u))
    Unit cur, nxt; int ui = 0;
    if (!S.next(0, cur)) return;
    if (MOE) cur.e = g.tile_e[cur.pm];
    f32x4 acc[2][2][4][2];
#pragma unroll
    for (int a = 0; a < 2; ++a)
#pragma unroll
        for (int b = 0; b < 2; ++b)
#pragma unroll
            for (int m = 0; m < 4; ++m)
#pragma unroll
                for (int n = 0; n < 2; ++n) acc[a][b][m][n] = (f32x4){0.f, 0.f, 0.f, 0.f};
    bf16x8 At[4][2], B0[2][2], B1[2][2];
    unsigned offC[2][2], offN[2][2];
    PG_AOFFS(offC, cur);
    const char* cB = PG_BBASE(cur);
    int nt = PG_KNT(cur);
    const size_t kstep = (size_t)(BK * 2);
    PG_STAGE_B(PG_SB(0, 0), cB); PG_STAGE_B(PG_SB(0, 1), cB + hstep); PG_STAGE_A(PG_SA(0, 0), offC, 0, 0); PG_STAGE_A(PG_SA(0, 1), offC, 1, 0);
    if (wr == 1) PG_BAR;
    PG_WAIT_V(2); PG_BAR;
    PG_STAGE_B(PG_SB(1, 0), cB + kstep); PG_STAGE_A(PG_SA(1, 0), offC, 0, kstep); PG_STAGE_B(PG_SB(1, 1), cB + hstep + kstep);
    PG_WAIT_V(6); PG_BAR;
    for (;;) {
        bool has_next = S.next(ui + 1, nxt);
        if (has_next) { if (MOE) nxt.e = g.tile_e[nxt.pm]; if (GATHER) PG_AOFFS(offN, nxt); }
        else if (GATHER) {
#pragma unroll
            for (int h = 0; h < 2; ++h)
#pragma unroll
                for (int i = 0; i < 2; ++i) offN[h][i] = offC[h][i]; }
        const char* nB = has_next ? PG_BBASE(nxt) : cB;
        for (int t = 0; t < nt; t += 2) {
            const bool last = (t == nt - 2);
            const size_t k1 = (size_t)(t + 1) * kstep;
            const size_t k2 = last ? 0 : (size_t)(t + 2) * kstep;
            const char* b2 = last ? nB : cB + (size_t)(t + 2) * kstep; const char* b3 = b2 + kstep;
            PG_LDB(B0, 0, 0); PG_LDB(B1, 0, 1); PG_SCHED; PG_LDA(At, 0, 0); PG_STAGE_A(PG_SA(1, 1), offC, 1, k1);
            PG_WAIT_V(8); PG_WAIT_L(0); PG_BAR; PG_MMA(0, 0, At, B0); PG_MMA(0, 1, At, B1); PG_BAR; PG_SCHED;
            if (last) {
                if (GATHER) {
#pragma unroll
                    for (int h = 0; h < 2; ++h)
#pragma unroll
                        for (int i = 0; i < 2; ++i) offC[h][i] = offN[h][i];
                } else if (has_next) { PG_AOFFS(offC, nxt); }
            }
            PG_LDA(At, 0, 1); PG_STAGE_B(PG_SB(0, 0), b2); PG_STAGE_B(PG_SB(0, 1), b2 + hstep); PG_STAGE_A(PG_SA(0, 0), offC, 0, k2);
            PG_WAIT_V(8); PG_WAIT_L(0); PG_BAR; PG_MMA(1, 0, At, B0); PG_MMA(1, 1, At, B1); PG_BAR; PG_SCHED;
            PG_LDB(B0, 1, 0); PG_LDB(B1, 1, 1); PG_SCHED; PG_LDA(At, 1, 0); PG_STAGE_A(PG_SA(0, 1), offC, 1, k2);
            PG_WAIT_V(8); PG_WAIT_L(0); PG_BAR; PG_MMA(0, 0, At, B0); PG_MMA(0, 1, At, B1); PG_BAR; PG_SCHED;
            PG_LDA(At, 1, 1); PG_STAGE_B(PG_SB(1, 0), b3); PG_STAGE_B(PG_SB(1, 1), b3 + hstep); PG_STAGE_A(PG_SA(1, 0), offC, 0, k2 + kstep);
            PG_WAIT_V(8); PG_WAIT_L(0); PG_BAR; PG_MMA(1, 0, At, B0); PG_MMA(1, 1, At, B1); PG_BAR; PG_SCHED;
        }
        if (wr == 0) PG_BAR;
        E(acc, cur, wr, wc, fr, fq);
        if (!has_next) break;
#pragma unroll
        for (int a = 0; a < 2; ++a)
#pragma unroll
            for (int b = 0; b < 2; ++b)
#pragma unroll
                for (int m = 0; m < 4; ++m)
#pragma unroll
                    for (int n = 0; n < 2; ++n) acc[a][b][m][n] = (f32x4){0.f, 0.f, 0.f, 0.f};
        cur = nxt; cB = nB; ++ui; if (SPLIT) nt = PG_KNT(cur);
        if (wr == 1) PG_BAR;
    }
    PG_WAIT_V(0);
    PG_BAR;
#undef PG_SA
#undef PG_SB
#undef PG_STAGE_A
#undef PG_STAGE_B
#undef PG_LDA
#undef PG_LDB
#undef PG_MMA
#undef PG_WAIT_V
#undef PG_WAIT_L
#undef PG_BAR
#undef PG_SCHED
#undef PG_AOFFS
#undef PG_BBASE
#undef PG_KOFF
#undef PG_KNT
}
}


struct EpiIn {
    static constexpr bool PERM = false;
    bf16* U; const PG_LAS float* rope;
    __device__ __forceinline__ void operator()(const f32x4 (&acc)[2][2][4][2], const pg::Unit& u, int wr, int wc, int fr, int fq) const {
        const int tb = (u.pm * 256) / TPB, p0 = u.pm * 256 - tb * TPB; const bool latent = p0 >= CTX;
#pragma unroll
        for (int ai = 0; ai < 2; ++ai)
#pragma unroll
            for (int m = 0; m < 4; ++m) {
                const int rl = ai * 128 + wr * 64 + m * 16 + fr; const int r = u.pm * 256 + rl; const int s = p0 + rl - CTX;
                bf16* rowp = U + (size_t)r * UW + u.pn * 256 + wc * 32 + ((fq & 1) ? 16 + 4 * (fq - 1) : 4 * fq);
#pragma unroll
                for (int bj = 0; bj < 2; ++bj) {
                    const int G = (u.pn * 256 + bj * 128 + wc * 32) >> 5;
                    f32x4 x1 = acc[ai][bj][m][0], x2 = acc[ai][bj][m][1];
                    if (G < 20) {
                        if (latent) { const int pos = (G & 1) ? (s & 63) : (s >> 6); const PG_LAS float* t = rope + pos * 36 + 8 * fq;
                            const f32x4 t0 = *(const PG_LAS f32x4*)t, t1 = *(const PG_LAS f32x4*)(t + 4);
                            const f32x4 cs = (f32x4){t0.x, t0.z, t1.x, t1.z}, sn = (f32x4){t0.y, t0.w, t1.y, t1.w};
                            const f32x4 y1 = x1 * cs - x2 * sn, y2 = x2 * cs + x1 * sn; x1 = y1; x2 = y2; }
                        if (G < 16) { x1 = x1 * 0.18033688011112042f; x2 = x2 * 0.18033688011112042f; }
                    }
                    v2u o1, o2; o1.x = cvt_pk_bf16(x1.x, x1.y); o1.y = cvt_pk_bf16(x1.z, x1.w); o2.x = cvt_pk_bf16(x2.x, x2.y); o2.y = cvt_pk_bf16(x2.z, x2.w);
                    asm volatile("s_nop 1\n\tv_permlane16_swap_b32 %0, %2\n\tv_permlane16_swap_b32 %1, %3\n\ts_nop 0" : "+v"(o1.x), "+v"(o1.y), "+v"(o2.x), "+v"(o2.y));
                    *(v4u*)(rowp + bj * 128) = (v4u){o1.x, o1.y, o2.x, o2.y};
                }
            }
    }
};
template <int CHUNK, bool INPLACE> struct EpiRes {
    static constexpr bool PERM = false;
    float* X; const float* modl; const float* xin; const float* cin; int l; float* Xo;
    __device__ __forceinline__ void operator()(const f32x4 (&acc)[2][2][4][2], const pg::Unit& u, int wr, int wc, int fr, int fq) const {
        const int tb = (u.pm * 256) / TPB, p0 = u.pm * 256 - tb * TPB; const int mr = p0 < CTX ? NB : tb;
        const float* mv = modl + (size_t)mr * MODW + CHUNK * D + u.pn * 256 + wc * 32 + 4 * fq;
        f32x4 mod[2][2];
#pragma unroll
        for (int bj = 0; bj < 2; ++bj)
#pragma unroll
            for (int n = 0; n < 2; ++n) mod[bj][n] = *(const f32x4*)(mv + bj * 128 + n * 16);
        const bool from_in = (!INPLACE) && l == 0;
        const int co = u.pn * 256 + wc * 32 + 4 * fq;
#pragma unroll
        for (int ai = 0; ai < 2; ++ai) {
            f32x4 bs[4][2][2];
#pragma unroll
            for (int m = 0; m < 4; ++m) {
                const int rl = ai * 128 + wr * 64 + m * 16 + fr; const int r = u.pm * 256 + rl; const int p = p0 + rl;
                const float* bp = from_in ? (p < CTX ? cin + ((size_t)tb * CTX + p) * D : xin + ((size_t)tb * SEQ + (p - CTX)) * D) : X + (size_t)r * D;
#pragma unroll
                for (int bj = 0; bj < 2; ++bj)
#pragma unroll
                    for (int n = 0; n < 2; ++n) bs[m][bj][n] = *(const f32x4*)(bp + co + bj * 128 + n * 16);
            }
#pragma unroll
            for (int m = 0; m < 4; ++m) {
                const int r = u.pm * 256 + ai * 128 + wr * 64 + m * 16 + fr;
#pragma unroll
                for (int bj = 0; bj < 2; ++bj)
#pragma unroll
                    for (int n = 0; n < 2; ++n) *(f32x4*)(Xo + (size_t)r * D + co + bj * 128 + n * 16) = bs[m][bj][n] + mod[bj][n] * acc[ai][bj][m][n];
            }
        }
    }
};
template <bool MOE> struct EpiSwiglu {
    static constexpr bool PERM = true;
    bf16* H; const float* roww;
    __device__ __forceinline__ void operator()(const f32x4 (&acc)[2][2][4][2], const pg::Unit& u, int wr, int wc, int fr, int fq) const {
        float rws[2][4];
#pragma unroll
        for (int ai = 0; ai < 2; ++ai)
#pragma unroll
            for (int m = 0; m < 4; ++m) rws[ai][m] = MOE ? roww[u.pm * 256 + ai * 128 + wr * 64 + m * 16 + fr] : 1.f;
#pragma unroll
        for (int ai = 0; ai < 2; ++ai)
#pragma unroll
            for (int m = 0; m < 4; ++m) {
                const int r = u.pm * 256 + ai * 128 + wr * 64 + m * 16 + fr;
                const float rw = rws[ai][m];
                f32x4 h0, h1;
#pragma unroll
                for (int j = 0; j < 4; ++j) { const float g0 = acc[ai][0][m][0][j], g1 = acc[ai][0][m][1][j];
                    h0[j] = g0 * __builtin_amdgcn_rcpf(1.f + __expf(-g0)) * acc[ai][1][m][0][j] * rw; h1[j] = g1 * __builtin_amdgcn_rcpf(1.f + __expf(-g1)) * acc[ai][1][m][1][j] * rw; }
                v4u w; w.x = cvt_pk_bf16(h0.x, h0.y); w.y = cvt_pk_bf16(h0.z, h0.w); w.z = cvt_pk_bf16(h1.x, h1.y); w.w = cvt_pk_bf16(h1.z, h1.w);
                *(v4u*)(H + (size_t)r * FFN + u.pn * 128 + wc * 32 + 8 * fq) = w;
            }
    }
};
struct EpiYs {
    static constexpr bool PERM = true;
    bf16* Y;
    __device__ __forceinline__ void operator()(const f32x4 (&acc)[2][2][4][2], const pg::Unit& u, int wr, int wc, int fr, int fq) const {
#pragma unroll
        for (int ai = 0; ai < 2; ++ai)
#pragma unroll
            for (int m = 0; m < 4; ++m) {
                bf16* rowp = Y + (size_t)(u.pm * 256 + ai * 128 + wr * 64 + m * 16 + fr) * D + u.pn * 256 + wc * 32 + 8 * fq;
#pragma unroll
                for (int bj = 0; bj < 2; ++bj) { const f32x4 v0 = acc[ai][bj][m][0], v1 = acc[ai][bj][m][1];
                    v4u w; w.x = cvt_pk_bf16(v0.x, v0.y); w.y = cvt_pk_bf16(v0.z, v0.w); w.z = cvt_pk_bf16(v1.x, v1.y); w.w = cvt_pk_bf16(v1.z, v1.w);
                    *(v4u*)(rowp + bj * 128) = w; }
            }
    }
};
struct EpiYsSplit {
    static constexpr bool PERM = true;
    bf16* Y; bf16* Yp; int row0;
    __device__ __forceinline__ void operator()(const f32x4 (&acc)[2][2][4][2], const pg::Unit& u, int wr, int wc, int fr, int fq) const {
        bf16* base = u.ks == 0 ? Y : Yp + (size_t)(u.ks - 1) * YSP_STRIDE - (size_t)row0 * D;
#pragma unroll
        for (int ai = 0; ai < 2; ++ai)
#pragma unroll
            for (int m = 0; m < 4; ++m) {
                bf16* rowp = base + (size_t)(u.pm * 256 + ai * 128 + wr * 64 + m * 16 + fr) * D + u.pn * 256 + wc * 32 + 8 * fq;
#pragma unroll
                for (int bj = 0; bj < 2; ++bj) { const f32x4 v0 = acc[ai][bj][m][0], v1 = acc[ai][bj][m][1];
                    v4u w; w.x = cvt_pk_bf16(v0.x, v0.y); w.y = cvt_pk_bf16(v0.z, v0.w); w.z = cvt_pk_bf16(v1.x, v1.y); w.w = cvt_pk_bf16(v1.z, v1.w);
                    *(v4u*)(rowp + bj * 128) = w; }
            }
    }
};
__device__ __forceinline__ void ys_fixup_phase(const P& a_in, int wg, int G, int row0, int rows, int S) {
    PHASE_ENTRY(a_in)
    const int tid = otid(), lane = tid & 63, wave = __builtin_amdgcn_readfirstlane(tid >> 6);
    bf16* Y = (bf16*)(a.ws + WS_YS) + (size_t)row0 * D; const bf16* Yp = (const bf16*)(a.ws + WS_YSP);
    for (int r = wg * 8 + wave; r < rows; r += G * 8) {
        bf16* yr = Y + (size_t)r * D + 16 * lane; const bf16* p1 = Yp + (size_t)r * D + 16 * lane; const bf16* p2 = p1 + YSP_STRIDE;
        v4u y[2], q1[2], q2[2];
#pragma unroll
        for (int h = 0; h < 2; ++h) { y[h] = *(const v4u*)(yr + 8 * h); q1[h] = *(const v4u*)(p1 + 8 * h); q2[h] = S > 2 ? *(const v4u*)(p2 + 8 * h) : (v4u){0u, 0u, 0u, 0u}; }
#pragma unroll
        for (int h = 0; h < 2; ++h) { v4u o;
            o.x = cvt_pk_bf16(bf_lo(y[h].x) + bf_lo(q1[h].x) + bf_lo(q2[h].x), bf_hi(y[h].x) + bf_hi(q1[h].x) + bf_hi(q2[h].x));
            o.y = cvt_pk_bf16(bf_lo(y[h].y) + bf_lo(q1[h].y) + bf_lo(q2[h].y), bf_hi(y[h].y) + bf_hi(q1[h].y) + bf_hi(q2[h].y));
            o.z = cvt_pk_bf16(bf_lo(y[h].z) + bf_lo(q1[h].z) + bf_lo(q2[h].z), bf_hi(y[h].z) + bf_hi(q1[h].z) + bf_hi(q2[h].z));
            o.w = cvt_pk_bf16(bf_lo(y[h].w) + bf_lo(q1[h].w) + bf_lo(q2[h].w), bf_hi(y[h].w) + bf_hi(q1[h].w) + bf_hi(q2[h].w));
            *(v4u*)(yr + 8 * h) = o; }
    }
}
template <bool COMPUTE> struct EpiProbe {
    static constexpr bool PERM = true;
    __device__ __forceinline__ void operator()(const f32x4 (&acc)[2][2][4][2], const pg::Unit& u, int wr, int wc, int fr, int fq) const {
#pragma unroll
        for (int ai = 0; ai < 2; ++ai)
#pragma unroll
            for (int m = 0; m < 4; ++m) {
                if (COMPUTE) { f32x4 h0, h1;
#pragma unroll
                    for (int j = 0; j < 4; ++j) { const float g0 = acc[ai][0][m][0][j], g1 = acc[ai][0][m][1][j];
                        h0[j] = g0 * __builtin_amdgcn_rcpf(1.f + __expf(-g0)) * acc[ai][1][m][0][j]; h1[j] = g1 * __builtin_amdgcn_rcpf(1.f + __expf(-g1)) * acc[ai][1][m][1][j]; }
                    v4u w; w.x = cvt_pk_bf16(h0.x, h0.y); w.y = cvt_pk_bf16(h0.z, h0.w); w.z = cvt_pk_bf16(h1.x, h1.y); w.w = cvt_pk_bf16(h1.z, h1.w);
                    asm volatile("" :: "v"(w));
                } else {
#pragma unroll
                    for (int bj = 0; bj < 2; ++bj) { asm volatile("" :: "v"(acc[ai][bj][m][0]), "v"(acc[ai][bj][m][1])); }
                }
            }
    }
};
enum { CP_D2 = 0, CP_OUT = 1, CP_F1 = 2, CP_F2D = 3, CP_IN = 4 };
__device__ __forceinline__ bool conv_sched(int l, int phase, int& li, int& j0, int& j1) {
    li = l >> 1;
    if ((l & 1) == 0) {
        if (phase == CP_IN)  { j0 = 0;     j1 = 2000;  return true; }
        if (phase == CP_D2)  { j0 = 2000;  j1 = 4500;  return true; }
        if (phase == CP_OUT) { j0 = 4500;  j1 = 10500; return true; }
        if (phase == CP_F1)  { j0 = 10500; j1 = 12500; return true; }
        if (phase == CP_F2D) { j0 = 12500; j1 = 28500; return true; }
        return false;
    }
    if (phase == CP_IN) { j0 = 28500; j1 = 30500; return true; }
    if (phase == CP_D2) { j0 = 30500; j1 = EXP_ITEMS; return true; }
    return false;
}
#ifndef STAGGER_TICKS
#define STAGGER_TICKS 0
#endif
__device__ __forceinline__ void conv_tail(const P& a, int l, int phase, const pg::Order& S, PG_LAS unsigned char* lds) {
    int li, j0, j1; if (!conv_sched(l, phase, li, j0, j1)) return;
    const int rem = S.nwg % S.G; if (rem == 0 || S.c < rem) return;
    const int t_ = otid(), wv = __builtin_amdgcn_readfirstlane(t_ >> 6);
    conv_expert_range(a, li, j0, j1, (S.c - rem) * 8 + wv, (S.G - rem) * 8, (PG_LAS float*)lds + wv * (64 * 33), t_ & 63);
}
template <int WHICH> __device__ __forceinline__ void gemm_run(const P& a_in, int l, PG_LAS unsigned char* lds, int G, int c, bool probe = false) {
    PHASE_ENTRY(a_in)
    if (STAGGER_TICKS > 0 && (WHICH == EM_F1 || WHICH == EM_F1M)) {
        const unsigned long long t0 = __builtin_amdgcn_s_memrealtime(); const unsigned long long dl = (unsigned long long)((c & 3) * STAGGER_TICKS);
        while (__builtin_amdgcn_s_memrealtime() - t0 < dl) __builtin_amdgcn_s_sleep(8);
    }
    unsigned char* ws = a.ws; pg::Order S;
    if (WHICH == EM_IN) { S.init(T_ALL / 256, UW / 256, G, c); pg::Gemm g{(const bf16*)(ws + WS_HX), (const bf16*)(ws + WS_WIN) + (size_t)l * UW * D, D, 0, nullptr, nullptr, a.wv};
        PG_LAS float* rl = (PG_LAS float*)(lds + 131072 + 1024); const float* rg = (const float*)(ws + WS_ROPE);
        for (int i = otid(); i < 2048; i += NTHR) rl[(i >> 5) * 36 + (i & 31)] = rg[i];
        __syncthreads();
        EpiIn E{(bf16*)(ws + WS_U), rl}; pg::gemm_phase<EpiIn, false, false>(lds, g, S, E);
        conv_tail(a, l, CP_IN, S, lds); }
    if (WHICH == EM_OUT) { if (l == DEPTH - 1) { S.init(NB * SEQ / 256, D / 256, G, c); S.lat = 1; } else S.init(T_ALL / 256, D / 256, G, c); pg::Gemm g{(const bf16*)(ws + WS_MIX), (const bf16*)(ws + WS_WOUT) + (size_t)l * D * D, D, 0, nullptr, nullptr, a.wv};
        EpiYs E{(bf16*)(ws + WS_DELTA)}; pg::gemm_phase<EpiYs, false, false>(lds, g, S, E);
        conv_tail(a, l, CP_OUT, S, lds); }
    if (WHICH == EM_F1) { S.init(T_ALL / 256, 2 * FFN / 256, G, c); pg::Gemm g{(const bf16*)(ws + WS_HX), (const bf16*)(ws + WS_WF13) + (size_t)(l >> 1) * 2 * FFN * D, D, 0, nullptr, nullptr, a.wv};
        if (PROBE == 20 && probe) { EpiProbe<false> E; pg::gemm_phase<EpiProbe<false>, false, false>(lds, g, S, E); }
        else if (PROBE == 21 && probe) { EpiProbe<true> E; pg::gemm_phase<EpiProbe<true>, false, false>(lds, g, S, E); }
        else { EpiSwiglu<false> E{(bf16*)(ws + WS_HID), nullptr}; pg::gemm_phase<EpiSwiglu<false>, false, false>(lds, g, S, E); conv_tail(a, l, CP_F1, S, lds); } }
    if (WHICH == EM_F2D) { S.init(T_ALL / 256, D / 256, G, c); pg::Gemm g{(const bf16*)(ws + WS_HID), (const bf16*)(ws + WS_WF2) + (size_t)(l >> 1) * D * FFN, FFN, 0, nullptr, nullptr, a.wv};
        EpiYs E{(bf16*)(ws + WS_DELTA)}; pg::gemm_phase<EpiYs, false, false>(lds, g, S, E);
        conv_tail(a, l, CP_F2D, S, lds); }
    if (WHICH == EM_F1M) { const int* te = (const int*)(ws + WS_TILEE); const int nt = __builtin_amdgcn_readfirstlane(te[MOE_TILES]); S.init(nt, 2 * FFN / 256, G, c);
        pg::Gemm g{(const bf16*)(ws + WS_HX), (const bf16*)(ws + WS_WE13), D, 2 * FFN, (const int*)(ws + WS_ROWT), te, a.wv};
        EpiSwiglu<true> E{(bf16*)(ws + WS_HID), (const float*)(ws + WS_ROWW)}; pg::gemm_phase<EpiSwiglu<true>, true, true>(lds, g, S, E); }
    if (WHICH == EM_F2M) { const int* te = (const int*)(ws + WS_TILEE); const int nt = __builtin_amdgcn_readfirstlane(te[MOE_TILES]); S.init_split(nt, D / 256, G, c);
        pg::Gemm g{(const bf16*)(ws + WS_HID), (const bf16*)(ws + WS_WE2), FFN, D, nullptr, te, a.wv};
        EpiYsSplit E{(bf16*)(ws + WS_YS), (bf16*)(ws + WS_YSP), (S.full / S.nN) * 256}; pg::gemm_phase<EpiYsSplit, false, true, true>(lds, g, S, E); }
}
template <int WHICH> __global__ void __launch_bounds__(NTHR, 2) k_gemm(P a, int l) {
    extern __shared__ __attribute__((aligned(16))) unsigned char smem[];
    a.wv = __builtin_amdgcn_readfirstlane(threadIdx.x >> 6);
    gemm_run<WHICH>(a, l, (PG_LAS unsigned char*)smem, (int)gridDim.x, (int)blockIdx.x);
}

typedef float f32x2 __attribute__((ext_vector_type(2)));
typedef float f32x16 __attribute__((ext_vector_type(16)));
typedef short v4s __attribute__((ext_vector_type(4)));
constexpr int ATT_ITEMS = NB * (SEQ / 32) + NB * (CTX / 32);
constexpr int ATT_LDS = 5 * 16384 + 32768 + 1024 + 2048;
__device__ __forceinline__ int att_item(int c, int kk, int sch) {
    const int x = c & 7, idx = c >> 3;
    if (sch == 0) return (idx >= 4 && kk == 0) ? x * 128 + (idx - 4) : -1;
    if (idx < 4) return -1;
    const int j = idx - 4;
    if (kk < 3) return x * 128 + 28 + 3 * j + kk;
    if (kk == 3) return j < 16 ? x * 128 + 112 + j : (j < 24 ? NB * (SEQ / 32) + x * 8 + (j - 16) : -1);
    return -1;
}
struct AttIt { int tb, tq0, ilo, nt; };
__device__ __forceinline__ AttIt att_decode(int it) {
    AttIt I;
    if (it < NB * (SEQ / 32)) { const int b = it >> 7, s0 = (it & 127) * 32; I.tb = b * TPB; I.tq0 = I.tb + CTX + s0;
        I.ilo = s0 >= 128 ? 0 : (128 - s0) / 32; int ihi = (SEQ + 96 - s0) / 32; ihi = ihi > 8 ? 8 : ihi; I.nt = 8 + (ihi - I.ilo + 1); }
    else { const int j = it - NB * (SEQ / 32), b = j >> 3; I.tb = b * TPB; I.tq0 = I.tb + (j & 7) * 32; I.ilo = 0; I.nt = 8; }
    return I;
}
__device__ __forceinline__ int att_tok(const AttIt& I, int t) { return t < 8 ? I.tb + 32 * t : I.tq0 - 128 + 32 * (I.ilo + t - 8); }
template <int PM> __device__ __forceinline__ void attn_phase(const P& a_in, int l, PG_LAS unsigned char* lds, int G, int c_in, int sch) {
    PHASE_ENTRY(a_in)
    int c = c_in; asm volatile("" : "+s"(c));
    const int tid = otid(), lane = tid & 63, h = __builtin_amdgcn_readfirstlane(tid >> 6), kvh = h >> 2;
    const int qr = lane & 31, hh = lane >> 5;
    const bf16* U = (const bf16*)(a.ws + WS_U); bf16* MIX = (bf16*)(a.ws + (PM ? WS_DELTA : WS_MIX));
    PG_LAS float* ssq = (PG_LAS float*)(lds + 114688); PG_LAS float* gl = (PG_LAS float*)(lds + 115712);
    float sink = a.attn_sink[l * 8 + h] * 1.4426950408889634f;
    asm volatile("" : "+v"(sink));
    const int st_isv = (tid >> 8) & 1, st_key = (tid >> 3) & 31, st_pos = tid & 7;
    const int st_ch = st_isv ? (st_pos ^ (((st_key >> 1) & 1) << 2)) : (st_pos ^ ((st_key >> 1) & 7));
    const int st_col = (st_isv ? U_VA : U_KA) + st_ch * 8;
    const unsigned st_lds = (unsigned)h * 1024u;
    const int q_goff = qr * UW + U_QA + h * 64 + 8 * hh;
    const int k_row = qr * 128, k_sw = (qr >> 1) & 7;
    const int tr_q = (lane & 15) >> 2, tr_p = lane & 3, tr_g = (lane >> 4) & 1;
    unsigned trv[2];
#pragma unroll
    for (int dt = 0; dt < 2; ++dt) trv[dt] = (unsigned)(kvh * 8192 + 4096 + (4 * hh + tr_q) * 128 + ((2 * (32 * dt + 16 * tr_g + 4 * tr_p)) ^ (((tr_q >> 1) & 1) << 6)));
    unsigned koff[4];
#pragma unroll
    for (int s4 = 0; s4 < 4; ++s4) koff[s4] = (unsigned)(kvh * 8192 + k_row + 16 * ((2 * s4 + hh) ^ k_sw));
    int it0 = att_item(c, 0, sch); if (it0 < 0) return;
    __syncthreads();
    for (int i = tid; i < 512; i += NTHR) gl[i] = a.g_att[l * 512 + i];
    AttIt cur = att_decode(it0);
    int tk0, tk1;
    {
        int e0 = lane, e1 = 64 + lane, r0 = -1, r1 = -1, lastt = 0;
        for (int kk = 0; kk < 5; ++kk) { const int it_ = att_item(c, kk, sch); if (it_ < 0) break; const AttIt I = att_decode(it_);
            if (r0 < 0) { if (e0 < I.nt) r0 = att_tok(I, e0); else e0 -= I.nt; }
            if (r1 < 0) { if (e1 < I.nt) r1 = att_tok(I, e1); else e1 -= I.nt; }
            lastt = att_tok(I, I.nt - 1); }
        tk0 = r0 < 0 ? lastt : r0; tk1 = r1 < 0 ? lastt : r1;
    }
#define ATT_DMA_TILE(stage, idx) do { const int i_ = (idx); const int kt_ = __builtin_amdgcn_readlane(i_ < 64 ? tk0 : tk1, i_ & 63) + st_key; const bf16* g_ = U + (size_t)kt_ * UW + st_col; \
        __builtin_amdgcn_global_load_lds((const unsigned*)g_, (PG_LAS unsigned*)(lds + (stage) * 16384 + st_lds), 16, 0, 0); \
        __builtin_amdgcn_global_load_lds((const unsigned*)(g_ + 64), (PG_LAS unsigned*)(lds + (stage) * 16384 + 8192 + st_lds), 16, 0, 0); } while (0)
#define ATT_DMA_Q(I, par) do { const bf16* g_ = U + (size_t)(I).tq0 * UW + q_goff; _Pragma("unroll") for (int i_ = 0; i_ < 4; ++i_) \
        __builtin_amdgcn_global_load_lds((const unsigned*)(g_ + 16 * i_), (PG_LAS unsigned*)(lds + 81920 + h * 4096 + i_ * 1024), 16, 0, 0); } while (0)
#define ATT_BAR do { asm volatile("s_waitcnt lgkmcnt(0)" ::: "memory"); __builtin_amdgcn_s_barrier(); asm volatile("" ::: "memory"); } while (0)
#define ATT_QK(dst, stage) do { PG_LAS unsigned char* kb_ = lds + (stage) * 16384 + kvh * 8192; dst = (f32x16){}; _Pragma("unroll") for (int s4 = 0; s4 < 4; ++s4) { \
        const pg::bf16x8 kf_ = *(const PG_LAS pg::bf16x8*)(kb_ + k_row + 16 * ((2 * s4 + hh) ^ k_sw)); dst = __builtin_amdgcn_mfma_f32_32x32x16_bf16(kf_, qf[s4], dst, 0, 0, 0); } } while (0)
    ATT_DMA_Q(cur, 0);
    ATT_DMA_TILE(0, 0); ATT_DMA_TILE(1, 1); ATT_DMA_TILE(2, 2); ATT_DMA_TILE(3, 3);
    asm volatile("s_waitcnt vmcnt(4)" ::: "memory");
    ATT_BAR;
    pg::bf16x8 qf[4];
#pragma unroll
    for (int s4 = 0; s4 < 4; ++s4) qf[s4] = *(const PG_LAS pg::bf16x8*)(lds + 81920 + h * 4096 + s4 * 1024 + lane * 16);
    f32x16 scur; ATT_QK(scur, 0);
    int j = 0, sj = 0;
    for (int kk = 0; ; ++kk) {
        const int nit = att_item(c, kk + 1, sch); const bool has_next = nit >= 0; const AttIt nxt = has_next ? att_decode(nit) : cur;
        float m = sink, lsum = 0.f;
        f32x16 o0 = {}, o1 = {};
        const int nt = cur.nt;
        for (int t = 0; t < nt; ++t, ++j) {
            const int s1 = sj == 4 ? 0 : sj + 1, s4g = sj == 0 ? 4 : sj - 1;
            if (t == 0) ATT_DMA_Q(nxt, 0);
            ATT_DMA_TILE(s4g, j + 4);
            const unsigned vbs = (unsigned)(size_t)lds + (unsigned)sj * 16384u;
            v2u va[2][2], vc[2][2];
#pragma unroll
            for (int dt = 0; dt < 2; ++dt) { const unsigned ad = vbs + trv[dt];
                asm volatile("ds_read_b64_tr_b16 %0, %1" : "=v"(va[0][dt]) : "v"(ad));
                asm volatile("ds_read_b64_tr_b16 %0, %1 offset:1024" : "=v"(vc[0][dt]) : "v"(ad));
                asm volatile("ds_read_b64_tr_b16 %0, %1 offset:2048" : "=v"(va[1][dt]) : "v"(ad));
                asm volatile("ds_read_b64_tr_b16 %0, %1 offset:3072" : "=v"(vc[1][dt]) : "v"(ad)); }
            v4u kf[4];
            { const unsigned kbs = (unsigned)(size_t)lds + (unsigned)s1 * 16384u;
#pragma unroll
              for (int s4 = 0; s4 < 4; ++s4) asm volatile("ds_read_b128 %0, %1" : "=v"(kf[s4]) : "v"(kbs + koff[s4])); }
            if (t == nt - 1) {
#pragma unroll
                for (int s4 = 0; s4 < 4; ++s4) qf[s4] = *(const PG_LAS pg::bf16x8*)(lds + 81920 + h * 4096 + s4 * 1024 + lane * 16); }
            f32x16 sacc = scur;
            const int ti = (t < 8) ? -1 : cur.ilo + t - 8;
            if (ti == 0 || ti == 8) {
#pragma unroll
                for (int i = 0; i < 16; ++i) { const int kq = (i & 3) + 8 * (i >> 2) + 4 * hh; const bool ok = (ti == 0) ? (kq >= qr) : (kq <= qr); sacc[i] = ok ? sacc[i] : -1.0e30f; }
            }
            float mt = sacc[0];
#pragma unroll
            for (int i = 1; i < 16; ++i) mt = fmaxf(mt, sacc[i]);
            mt = hmax32(mt);
            const bool grow = mt > m + 8.f;
            if (__any(grow)) {
                const float mn = grow ? mt : m, alpha = __builtin_amdgcn_exp2f(m - mn); m = mn; lsum *= alpha;
#pragma unroll
                for (int i = 0; i < 16; ++i) { o0[i] *= alpha; o1[i] *= alpha; } }
            asm volatile("s_waitcnt lgkmcnt(0)" : "+v"(kf[0]), "+v"(kf[1]), "+v"(kf[2]), "+v"(kf[3]), "+v"(va[0][0]), "+v"(vc[0][0]), "+v"(va[0][1]), "+v"(vc[0][1]), "+v"(va[1][0]), "+v"(vc[1][0]), "+v"(va[1][1]), "+v"(vc[1][1]));
            f32x16 snext = {}; f32x2 ps2 = {0.f, 0.f}; const f32x2 mm = {m, m};
#pragma unroll
            for (int g = 0; g < 4; ++g) {
                __builtin_amdgcn_s_setprio(1); snext = __builtin_amdgcn_mfma_f32_32x32x16_bf16(__builtin_bit_cast(pg::bf16x8, kf[g]), qf[g], snext, 0, 0, 0); __builtin_amdgcn_s_setprio(0);
#pragma unroll
                for (int i = 2 * g; i < 2 * g + 2; ++i) { const f32x2 d = (f32x2){sacc[2 * i], sacc[2 * i + 1]} - mm; const f32x2 ev = {__builtin_amdgcn_exp2f(d.x), __builtin_amdgcn_exp2f(d.y)};
                    sacc[2 * i] = ev.x; sacc[2 * i + 1] = ev.y; ps2 += ev; }
                __builtin_amdgcn_sched_barrier(0);
            }
            lsum += ps2.x + ps2.y;
#pragma unroll
            for (int s2 = 0; s2 < 2; ++s2) {
                v4u pw; pw.x = cvt_pk_bf16(sacc[8 * s2 + 0], sacc[8 * s2 + 1]); pw.y = cvt_pk_bf16(sacc[8 * s2 + 2], sacc[8 * s2 + 3]);
                pw.z = cvt_pk_bf16(sacc[8 * s2 + 4], sacc[8 * s2 + 5]); pw.w = cvt_pk_bf16(sacc[8 * s2 + 6], sacc[8 * s2 + 7]);
                const pg::bf16x8 pf = __builtin_bit_cast(pg::bf16x8, pw);
#pragma unroll
                for (int dt = 0; dt < 2; ++dt) {
                    const pg::bf16x8 vf = __builtin_bit_cast(pg::bf16x8, (v4u){va[s2][dt].x, va[s2][dt].y, vc[s2][dt].x, vc[s2][dt].y});
                    __builtin_amdgcn_s_setprio(1);
                    if (dt == 0) o0 = __builtin_amdgcn_mfma_f32_32x32x16_bf16(vf, pf, o0, 0, 0, 0);
                    else o1 = __builtin_amdgcn_mfma_f32_32x32x16_bf16(vf, pf, o1, 0, 0, 0);
                    __builtin_amdgcn_s_setprio(0);
                }
            }
            scur = snext;
            if (t == 0) asm volatile("s_waitcnt vmcnt(8)" ::: "memory"); else asm volatile("s_waitcnt vmcnt(4)" ::: "memory");
            ATT_BAR;
            sj = s1;
        }
        const float ltot = hsum32(lsum);
        const float inv = __builtin_amdgcn_rcpf(ltot + __builtin_amdgcn_exp2f(sink - m));
        float sq = 0.f;
#pragma unroll
        for (int i = 0; i < 16; ++i) { o0[i] *= inv; o1[i] *= inv; sq += o0[i] * o0[i] + o1[i] * o1[i]; }
        sq = hsum32(sq);
        if (hh == 0) ssq[h * 32 + qr] = sq;
        ATT_BAR;
        float tot = 0.f;
#pragma unroll
        for (int w = 0; w < 8; ++w) tot += ssq[w * 32 + qr];
        const float rstd = rsqrtf(tot * (1.f / 512.f) + EPS);
        bf16* orow = MIX + (size_t)(cur.tq0 + qr) * D + h * 64;
#pragma unroll
        for (int dt = 0; dt < 2; ++dt)
#pragma unroll
            for (int i4 = 0; i4 < 4; ++i4) { const int d = 32 * dt + 8 * i4 + 4 * hh; const f32x4 gg = *(const PG_LAS f32x4*)(gl + h * 64 + d);
                const f32x16& oo = dt == 0 ? o0 : o1;
                v2u w; w.x = cvt_pk_bf16(oo[4 * i4 + 0] * rstd * gg.x, oo[4 * i4 + 1] * rstd * gg.y); w.y = cvt_pk_bf16(oo[4 * i4 + 2] * rstd * gg.z, oo[4 * i4 + 3] * rstd * gg.w);
                *(v2u*)(orow + d) = w; }
        if (!has_next) break;
        cur = nxt;
    }
    asm volatile("s_waitcnt vmcnt(0)" ::: "memory");
    __syncthreads();
#undef ATT_DMA_TILE
#undef ATT_QK
#undef ATT_BAR
#undef ATT_DMA_Q
}
__global__ void __launch_bounds__(NTHR, 2) k_attn(P a, int l) {
    extern __shared__ __attribute__((aligned(16))) unsigned char smem[];
    a.wv = __builtin_amdgcn_readfirstlane(threadIdx.x >> 6);
    attn_phase<0>(a, l, (PG_LAS unsigned char*)smem, (int)gridDim.x, (int)blockIdx.x, 0); attn_phase<0>(a, l, (PG_LAS unsigned char*)smem, (int)gridDim.x, (int)blockIdx.x, 1);
}

__device__ __forceinline__ float scan_sum(float v, int) { return dpp_scan<false>(v); }
__device__ __forceinline__ float scan_max(float v, int) { return dpp_scan<true>(v); }
constexpr int ML_ITEMS = NB * NCHUNK;
constexpr int ML_LDS = 65536 + 65536 + 16384;
__device__ __forceinline__ void ml_load_v(const bf16* U, int tk0, PG_LAS unsigned char* lds, int tid) {
#pragma unroll
    for (int i = 0; i < 8; ++i) { const int cid = tid + 512 * i, sg = cid >> 6, r = cid & 63, hv = r >> 4, ch = r & 15;
        const v4u v = *(const v4u*)(U + (size_t)(tk0 + sg) * UW + U_VM + hv * 128 + ch * 8);
        *(PG_LAS v4u*)(lds + hv * 16384 + sg * 256 + ((ch * 16) ^ ((sg & 3) << 6))) = v; }
}
__device__ __forceinline__ float ml_tok(const bf16* U, int tk, int lo, int hi, int col) { return (tk >= lo && tk < hi) ? bf2f(U[(size_t)tk * UW + col]) : 0.f; }

template <int NT> __device__ __forceinline__ void conv8(const P& a, int l, const bf16* U, int tk0, int s0, int lo, int hi, int ch0, float (&out)[NT][8]) {
    float cw[5][8], cb[8];
#pragma unroll
    for (int j = 0; j < 5; ++j) { const f32x4 w0 = *(const f32x4*)(a.conv_w + (l * 5 + j) * 512 + ch0), w1 = *(const f32x4*)(a.conv_w + (l * 5 + j) * 512 + ch0 + 4);
        cw[j][0] = w0.x; cw[j][1] = w0.y; cw[j][2] = w0.z; cw[j][3] = w0.w; cw[j][4] = w1.x; cw[j][5] = w1.y; cw[j][6] = w1.z; cw[j][7] = w1.w; }
    { const f32x4 b0 = *(const f32x4*)(a.conv_b + l * 512 + ch0), b1 = *(const f32x4*)(a.conv_b + l * 512 + ch0 + 4);
      cb[0] = b0.x; cb[1] = b0.y; cb[2] = b0.z; cb[3] = b0.w; cb[4] = b1.x; cb[5] = b1.y; cb[6] = b1.z; cb[7] = b1.w; }
    v4u rows[NT + 4];
#pragma unroll
    for (int r = 0; r < NT + 4; ++r) { const int tk = tk0 + s0 + r - 2; const bool ok = tk >= lo && tk < hi; const int tkc = tk < lo ? lo : (tk >= hi ? hi - 1 : tk);
        const v4u v = *(const v4u*)(U + (size_t)tkc * UW + U_QM + ch0); rows[r] = ok ? v : (v4u){0u, 0u, 0u, 0u}; }
#pragma unroll
    for (int i = 0; i < NT; ++i) {
        float y[8];
#pragma unroll
        for (int c = 0; c < 8; ++c) y[c] = cb[c];
#pragma unroll
        for (int j = 0; j < 5; ++j) { const v4u x = rows[i + j];
            y[0] += cw[j][0] * bf_lo(x.x); y[1] += cw[j][1] * bf_hi(x.x); y[2] += cw[j][2] * bf_lo(x.y); y[3] += cw[j][3] * bf_hi(x.y);
            y[4] += cw[j][4] * bf_lo(x.z); y[5] += cw[j][5] * bf_hi(x.z); y[6] += cw[j][6] * bf_lo(x.w); y[7] += cw[j][7] * bf_hi(x.w); }
#pragma unroll
        for (int c = 0; c < 8; ++c) out[i][c] = silu_f(y[c]);
    }
}

__device__ __forceinline__ void ml_d1_phase(const P& a_in, int l, PG_LAS unsigned char* lds, int G, int c0) {
    PHASE_ENTRY(a_in)
    const int tid = otid(), lane = tid & 63, wave = __builtin_amdgcn_readfirstlane(tid >> 6), hd = wave >> 1, dir = wave & 1;
    const int hh = lane >> 5, lr = lane & 31, tr_q = (lane & 15) >> 2, tr_p = lane & 3, tr_g = (lane >> 4) & 1;
    const bf16* U = (const bf16*)(a.ws + WS_U); const float* GT = (const float*)(a.ws + WS_GATES);
    bf16* ST = (bf16*)(a.ws + WS_ST); float* NL = (float*)(a.ws + WS_NL); float* SC = (float*)(a.ws + WS_SC);
    PG_LAS unsigned char* kwt = lds + 65536;
    PG_LAS float* wts = (PG_LAS float*)(lds + 131072);
    for (int item = c0; item < ML_ITEMS; item += G) {
        const int b = item / NCHUNK, c = item - b * NCHUNK, tk0 = b * TPB + 64 * c;
        const int lo = c < 4 ? b * TPB : b * TPB + CTX, hi = c < 4 ? b * TPB + CTX : (b + 1) * TPB;
        const int cc = ((b * 4 + hd) * 2 + dir) * NCHUNK + c;
        ml_load_v(U, tk0, lds, tid);
        {
            const int t = dir ? 63 - lane : lane;
            const float li = GT[(size_t)(tk0 + t) * 16 + dir * 8 + hd], lf = logsigmoid_f(GT[(size_t)(tk0 + t) * 16 + dir * 8 + 4 + hd]);
            const float bc = scan_sum(lf, lane), bend = lane_bcast(bc, 63);
            const float g = bend - bc + li, mloc = wave_max(g);
            wts[wave * 64 + t] = __expf(g - mloc);
            if (lane == 0) { SC[(size_t)cc * 4 + 0] = bend; SC[(size_t)cc * 4 + 1] = mloc; }
        }
        __syncthreads();
        {
            const int chg = tid & 31, sb = tid >> 5, s0 = 4 * sb, khd = chg >> 3, d0 = (chg & 7) * 8;
            float kv[4][8];
            conv8<4>(a, l, U, tk0, s0, lo, hi, 256 + 8 * chg, kv);
#pragma unroll
            for (int i = 0; i < 4; ++i) { const int sg = s0 + i;
#pragma unroll
                for (int dd = 0; dd < 2; ++dd) { const float w = wts[(khd * 2 + dd) * 64 + sg];
                    v4u o; o.x = cvt_pk_bf16(kv[i][0] * w, kv[i][1] * w); o.y = cvt_pk_bf16(kv[i][2] * w, kv[i][3] * w); o.z = cvt_pk_bf16(kv[i][4] * w, kv[i][5] * w); o.w = cvt_pk_bf16(kv[i][6] * w, kv[i][7] * w);
                    *(PG_LAS v4u*)(kwt + (khd * 2 + dd) * 8192 + sg * 128 + ((2 * d0) ^ (((sg >> 1) & 1) << 6))) = o; } }
        }
        __syncthreads();
        PG_LAS unsigned char* kw = kwt + wave * 8192;
        {
            float ns = 0.f;
#pragma unroll 8
            for (int sg = 0; sg < 64; ++sg) ns += bf2f(*(const PG_LAS bf16*)(kw + sg * 128 + ((2 * lane) ^ (((sg >> 1) & 1) << 6))));
            NL[(size_t)cc * 64 + lane] = ns;
        }
        pg::bf16x8 af[2][4];
#pragma unroll
        for (int dt = 0; dt < 2; ++dt)
#pragma unroll
            for (int s4 = 0; s4 < 4; ++s4) { const int r1 = 16 * s4 + 8 * hh + tr_q, r2 = r1 + 4; const int dbyte = 2 * (32 * dt + 16 * tr_g + 4 * tr_p);
                const v4s v1 = __builtin_amdgcn_ds_read_tr16_b64_v4i16((PG_LAS v4s*)(kw + r1 * 128 + (dbyte ^ (((r1 >> 1) & 1) << 6))));
                const v4s v2 = __builtin_amdgcn_ds_read_tr16_b64_v4i16((PG_LAS v4s*)(kw + r2 * 128 + (dbyte ^ (((r2 >> 1) & 1) << 6))));
                af[dt][s4] = (pg::bf16x8){v1[0], v1[1], v1[2], v1[3], v2[0], v2[1], v2[2], v2[3]}; }
        PG_LAS unsigned char* vb = lds + hd * 16384;
#pragma unroll
        for (int et = 0; et < 4; ++et) {
            pg::bf16x8 bfr[4];
            const int ebyte = 2 * (32 * et + 16 * tr_g + 4 * tr_p);
#pragma unroll
            for (int s4 = 0; s4 < 4; ++s4) { const int r1 = 16 * s4 + 8 * hh + tr_q, r2 = r1 + 4;
                const v4s v1 = __builtin_amdgcn_ds_read_tr16_b64_v4i16((PG_LAS v4s*)(vb + r1 * 256 + (ebyte ^ ((r1 & 3) << 6))));
                const v4s v2 = __builtin_amdgcn_ds_read_tr16_b64_v4i16((PG_LAS v4s*)(vb + r2 * 256 + (ebyte ^ ((r2 & 3) << 6))));
                bfr[s4] = (pg::bf16x8){v1[0], v1[1], v1[2], v1[3], v2[0], v2[1], v2[2], v2[3]}; }
#pragma unroll
            for (int dt = 0; dt < 2; ++dt) {
                f32x16 acc = {};
#pragma unroll
                for (int s4 = 0; s4 < 4; ++s4) acc = __builtin_amdgcn_mfma_f32_32x32x16_bf16(af[dt][s4], bfr[s4], acc, 0, 0, 0);
                v4u o0, o1;
                o0.x = cvt_pk_bf16(acc[0], acc[1]); o0.y = cvt_pk_bf16(acc[2], acc[3]); o0.z = cvt_pk_bf16(acc[4], acc[5]); o0.w = cvt_pk_bf16(acc[6], acc[7]);
                o1.x = cvt_pk_bf16(acc[8], acc[9]); o1.y = cvt_pk_bf16(acc[10], acc[11]); o1.z = cvt_pk_bf16(acc[12], acc[13]); o1.w = cvt_pk_bf16(acc[14], acc[15]);
                bf16* dst = ST + ((size_t)cc * 8 + dt * 4 + et) * 1024 + lane * 16;
                *(v4u*)dst = o0; *(v4u*)(dst + 8) = o1;
            }
        }
        __syncthreads();
    }
}
__device__ __forceinline__ void ml_d2_phase(const P& a_in, int wg) {
    PHASE_ENTRY(a_in)
    const int tid = otid(), chain = wg >> 2, quarter = wg & 3, dir = chain & 1;
    bf16* ST = (bf16*)(a.ws + WS_ST); float* NL = (float*)(a.ws + WS_NL); float* SC = (float*)(a.ws + WS_SC);
    const bool cw = tid < 256, nw = (quarter == 0 && tid >= 256 && tid < 320);
    if (cw || nw) {
    float st[8];
#pragma unroll
    for (int j = 0; j < 8; ++j) st[j] = 0.f;
    float nst = 0.f, m = 0.f;
    const size_t unit = (size_t)(quarter * 256 + tid) * 8;
#pragma unroll 1
    for (int i0 = 0; i0 < NCHUNK; i0 += 4) {
        v4u x[4]; float nx[4], be[4], ml[4]; int cidx[4];
#pragma unroll
        for (int k = 0; k < 4; ++k) { const int i = i0 + k; const int c = dir == 0 ? i : (i < 4 ? 3 - i : 71 - i); cidx[k] = chain * NCHUNK + c;
            be[k] = SC[(size_t)cidx[k] * 4]; ml[k] = SC[(size_t)cidx[k] * 4 + 1];
            if (cw) x[k] = *(const v4u*)(ST + (size_t)cidx[k] * 8192 + unit); else nx[k] = NL[(size_t)cidx[k] * 64 + (tid - 256)]; }
#pragma unroll
        for (int k = 0; k < 4; ++k) {
            const float mn = fmaxf(be[k] + m, ml[k]), fa = __expf(be[k] + m - mn), fb = __expf(ml[k] - mn);
            if (cw) {
                v4u o; o.x = pk2(st[0], st[1]); o.y = pk2(st[2], st[3]); o.z = pk2(st[4], st[5]); o.w = pk2(st[6], st[7]);
                *(v4u*)(ST + (size_t)cidx[k] * 8192 + unit) = o;
                st[0] = fa * st[0] + fb * bf_lo(x[k].x); st[1] = fa * st[1] + fb * bf_hi(x[k].x); st[2] = fa * st[2] + fb * bf_lo(x[k].y); st[3] = fa * st[3] + fb * bf_hi(x[k].y);
                st[4] = fa * st[4] + fb * bf_lo(x[k].z); st[5] = fa * st[5] + fb * bf_hi(x[k].z); st[6] = fa * st[6] + fb * bf_lo(x[k].w); st[7] = fa * st[7] + fb * bf_hi(x[k].w);
            } else {
                NL[(size_t)cidx[k] * 64 + (tid - 256)] = nst; nst = fa * nst + fb * nx[k];
                if (tid == 256) SC[(size_t)cidx[k] * 4 + 2] = m;
            }
            m = mn;
        }
    }
    }
}
__device__ __forceinline__ void ml_d3_phase(const P& a_in, int l, PG_LAS unsigned char* lds, int G, int c0) {
    PHASE_ENTRY(a_in)
    const int tid = otid(), wave = __builtin_amdgcn_readfirstlane(tid >> 6), hd = wave >> 1, qt = wave & 1;
    const bf16* U = (const bf16*)(a.ws + WS_U); const float* GT = (const float*)(a.ws + WS_GATES);
    const bf16* ST = (const bf16*)(a.ws + WS_ST); const float* NL = (const float*)(a.ws + WS_NL); const float* SC = (const float*)(a.ws + WS_SC);
    bf16* MIX = (bf16*)(a.ws + WS_MIX);
    PG_LAS unsigned char* qtile = lds + 65536 + hd * 16384;
    PG_LAS unsigned char* ktile = qtile + 8192;
    PG_LAS float* aarr = (PG_LAS float*)(lds + 131072 + wave * 2048);
    { const int ln_ = otid() & 63; const float* gm_ = a.g_ml + l * 512 + hd * 128; aarr[320 + ln_] = gm_[ln_]; aarr[384 + ln_] = gm_[64 + ln_]; }
    for (int item = c0; item < ML_ITEMS; item += G) {
        int lane = tid & 63; asm volatile("" : "+v"(lane));
        const int hh = lane >> 5, lr = lane & 31, tr_q = (lane & 15) >> 2, tr_p = lane & 3, tr_g = (lane >> 4) & 1;
        const int tq = 32 * qt + lr;
        const int b = item / NCHUNK, c = item - b * NCHUNK, tk0 = b * TPB + 64 * c;
        const int lo = c < 4 ? b * TPB : b * TPB + CTX, hi = c < 4 ? b * TPB + CTX : (b + 1) * TPB;
        float gli[2], glf[2], gmp[2];
#pragma unroll
        for (int dd = 0; dd < 2; ++dd) { const int t = dd ? 63 - lane : lane;
            gli[dd] = GT[(size_t)(tk0 + t) * 16 + dd * 8 + hd]; glf[dd] = GT[(size_t)(tk0 + t) * 16 + dd * 8 + 4 + hd]; gmp[dd] = SC[(size_t)(((b * 4 + hd) * 2 + dd) * NCHUNK + c) * 4 + 2]; }
        ml_load_v(U, tk0, lds, tid);
#pragma unroll
        for (int dd = 0; dd < 2; ++dd) aarr[192 + dd * 64 + lane] = NL[(size_t)(((b * 4 + hd) * 2 + dd) * NCHUNK + c) * 64 + lane];
        {
            const int chg = tid & 63, s0 = 8 * (tid >> 6), ch0 = 8 * chg;
            float kv[8][8];
            conv8<8>(a, l, U, tk0, s0, lo, hi, ch0, kv);
            PG_LAS unsigned char* dstt = lds + 65536 + ((ch0 & 255) >> 6) * 16384 + (ch0 >> 8) * 8192;
            const float qsc = ch0 < 256 ? 0.125f : 1.f; const int chunk = (ch0 & 63) >> 3;
#pragma unroll
            for (int i = 0; i < 8; ++i) { const int sg = s0 + i;
                v4u o; o.x = cvt_pk_bf16(kv[i][0] * qsc, kv[i][1] * qsc); o.y = cvt_pk_bf16(kv[i][2] * qsc, kv[i][3] * qsc); o.z = cvt_pk_bf16(kv[i][4] * qsc, kv[i][5] * qsc); o.w = cvt_pk_bf16(kv[i][6] * qsc, kv[i][7] * qsc);
                *(PG_LAS v4u*)(dstt + sg * 128 + 16 * (chunk ^ ((sg >> 1) & 7))) = o; }
        }
        __syncthreads();
#define D3_QF(s4) ({ const int sw_ = (tq >> 1) & 7; \
            const v2u lo2_ = *(const PG_LAS v2u*)(qtile + tq * 128 + 16 * ((2 * (s4)) ^ sw_) + 8 * hh), hi2_ = *(const PG_LAS v2u*)(qtile + tq * 128 + 16 * ((2 * (s4) + 1) ^ sw_) + 8 * hh); \
            __builtin_bit_cast(pg::bf16x8, (v4u){lo2_.x, lo2_.y, hi2_.x, hi2_.y}); })
        f32x16 hs[4];
#pragma unroll
        for (int et = 0; et < 4; ++et) hs[et] = (f32x16){};
#pragma unroll 1
        for (int dir = 0; dir < 2; ++dir) {
            const int cc = ((b * 4 + hd) * 2 + dir) * NCHUNK + c;
            const float mprev = dir ? gmp[1] : gmp[0];
            {
                const int t = dir ? 63 - lane : lane;
                const float li = dir ? gli[1] : gli[0], lf = logsigmoid_f(dir ? glf[1] : glf[0]);
                const float bc = scan_sum(lf, lane), av = li - bc, pm = scan_max(av, lane), Mv = fmaxf(mprev, pm);
                aarr[t] = av; aarr[64 + t] = Mv; aarr[128 + t] = bc;
            }
            const float Mq = aarr[64 + tq], bq = aarr[128 + tq];
            const float wq = __expf(mprev - Mq);
            pg::bf16x8 cs[2][2][2];
#pragma unroll
            for (int dt = 0; dt < 2; ++dt) { const bf16* src = ST + ((size_t)cc * 8 + dt * 4) * 1024 + lane * 16; cs[0][dt][0] = *(const pg::bf16x8*)src; cs[0][dt][1] = *(const pg::bf16x8*)(src + 8); }
            float qn = 0.f;
#pragma unroll
            for (int s4 = 0; s4 < 4; ++s4) { const f32x4 n0 = *(const PG_LAS f32x4*)(aarr + 192 + dir * 64 + 16 * s4 + 4 * hh), n1 = *(const PG_LAS f32x4*)(aarr + 192 + dir * 64 + 16 * s4 + 8 + 4 * hh);
                const v4u qw = __builtin_bit_cast(v4u, D3_QF(s4));
                qn += bf_lo(qw.x) * n0.x + bf_hi(qw.x) * n0.y + bf_lo(qw.y) * n0.z + bf_hi(qw.y) * n0.w + bf_lo(qw.z) * n1.x + bf_hi(qw.z) * n1.y + bf_lo(qw.w) * n1.z + bf_hi(qw.w) * n1.w; }
            qn = hsum32(qn);
            pg::bf16x8 pf[2][2]; float psum = 0.f;
#pragma unroll
            for (int st = 0; st < 2; ++st) {
                f32x16 acc = {}; const int sg = 32 * st + lr, sw = (sg >> 1) & 7;
#pragma unroll
                for (int s4 = 0; s4 < 4; ++s4) {
                    const v2u lo2 = *(const PG_LAS v2u*)(ktile + sg * 128 + 16 * ((2 * s4) ^ sw) + 8 * hh), hi2 = *(const PG_LAS v2u*)(ktile + sg * 128 + 16 * ((2 * s4 + 1) ^ sw) + 8 * hh);
                    const pg::bf16x8 kf = __builtin_bit_cast(pg::bf16x8, (v4u){lo2.x, lo2.y, hi2.x, hi2.y});
                    acc = __builtin_amdgcn_mfma_f32_32x32x16_bf16(kf, D3_QF(s4), acc, 0, 0, 0); }
#pragma unroll
                for (int i4 = 0; i4 < 4; ++i4) { const f32x4 av = *(const PG_LAS f32x4*)(aarr + 32 * st + 8 * i4 + 4 * hh);
#pragma unroll
                    for (int j = 0; j < 4; ++j) { const int sgk = 32 * st + 8 * i4 + 4 * hh + j; const bool ok = dir ? (sgk >= tq) : (sgk <= tq);
                        const float p = ok ? acc[4 * i4 + j] * __expf(av[j] - Mq) : 0.f; acc[4 * i4 + j] = p; psum += p; } }
#pragma unroll
                for (int s2 = 0; s2 < 2; ++s2) { v4u pw; pw.x = cvt_pk_bf16(acc[8 * s2 + 0], acc[8 * s2 + 1]); pw.y = cvt_pk_bf16(acc[8 * s2 + 2], acc[8 * s2 + 3]);
                    pw.z = cvt_pk_bf16(acc[8 * s2 + 4], acc[8 * s2 + 5]); pw.w = cvt_pk_bf16(acc[8 * s2 + 6], acc[8 * s2 + 7]); pf[st][s2] = __builtin_bit_cast(pg::bf16x8, pw); }
            }
            psum = hsum32(psum);
            const float den = psum + wq * qn;
            const float rden = __builtin_amdgcn_rcpf(fmaxf(fabsf(den), __expf(-(bq + Mq))));
            PG_LAS unsigned char* vb = lds + hd * 16384;
#pragma unroll
            for (int dt = 0; dt < 2; ++dt) { const bf16* src = ST + ((size_t)cc * 8 + dt * 4 + 1) * 1024 + lane * 16; cs[1][dt][0] = *(const pg::bf16x8*)src; cs[1][dt][1] = *(const pg::bf16x8*)(src + 8); }
#pragma unroll
            for (int et = 0; et < 4; ++et) {
                f32x16 acc = {};
#pragma unroll
                for (int dt = 0; dt < 2; ++dt) {
                    acc = __builtin_amdgcn_mfma_f32_32x32x16_bf16(cs[et & 1][dt][0], D3_QF(2 * dt), acc, 0, 0, 0);
                    acc = __builtin_amdgcn_mfma_f32_32x32x16_bf16(cs[et & 1][dt][1], D3_QF(2 * dt + 1), acc, 0, 0, 0); }
                if (et < 2) {
#pragma unroll
                    for (int dt = 0; dt < 2; ++dt) { const bf16* src = ST + ((size_t)cc * 8 + dt * 4 + et + 2) * 1024 + lane * 16; cs[et & 1][dt][0] = *(const pg::bf16x8*)src; cs[et & 1][dt][1] = *(const pg::bf16x8*)(src + 8); } }
#pragma unroll
                for (int i = 0; i < 16; ++i) acc[i] *= wq;
                const int ebyte = 2 * (32 * et + 16 * tr_g + 4 * tr_p);
#pragma unroll
                for (int st = 0; st < 2; ++st)
#pragma unroll
                    for (int s2 = 0; s2 < 2; ++s2) { const int r1 = 32 * st + 16 * s2 + 4 * hh + tr_q, r2 = r1 + 8;
                        const v4s v1 = __builtin_amdgcn_ds_read_tr16_b64_v4i16((PG_LAS v4s*)(vb + r1 * 256 + (ebyte ^ ((r1 & 3) << 6))));
                        const v4s v2 = __builtin_amdgcn_ds_read_tr16_b64_v4i16((PG_LAS v4s*)(vb + r2 * 256 + (ebyte ^ ((r2 & 3) << 6))));
                        const pg::bf16x8 vf = {v1[0], v1[1], v1[2], v1[3], v2[0], v2[1], v2[2], v2[3]};
                        acc = __builtin_amdgcn_mfma_f32_32x32x16_bf16(vf, pf[st][s2], acc, 0, 0, 0); }
                hs[et] += acc * rden;
            }
        }
        const bf16* om = U + (size_t)(tk0 + tq) * UW + U_OM + hd * 128;
        v2u ov[4][4];
#pragma unroll
        for (int et = 0; et < 4; ++et)
#pragma unroll
            for (int i4 = 0; i4 < 4; ++i4) ov[et][i4] = *(const v2u*)(om + 32 * et + 8 * i4 + 4 * hh);
        float sq = 0.f;
#pragma unroll
        for (int et = 0; et < 4; ++et)
#pragma unroll
            for (int i = 0; i < 16; ++i) sq += hs[et][i] * hs[et][i];
        sq = hsum32(sq);
        const float rstd = rsqrtf(sq * (1.f / 128.f) + EPS);
        bf16* orow = MIX + (size_t)(tk0 + tq) * D + 512 + hd * 128;
#pragma unroll
        for (int et = 0; et < 4; ++et)
#pragma unroll
            for (int i4 = 0; i4 < 4; ++i4) { const int e = 32 * et + 8 * i4 + 4 * hh; const f32x4 gg = *(const PG_LAS f32x4*)(aarr + 320 + e); const v2u o2 = ov[et][i4];
                const float y0 = hs[et][4 * i4 + 0] * rstd * gg.x * sigmoid_f(bf_lo(o2.x)), y1 = hs[et][4 * i4 + 1] * rstd * gg.y * sigmoid_f(bf_hi(o2.x));
                const float y2 = hs[et][4 * i4 + 2] * rstd * gg.z * sigmoid_f(bf_lo(o2.y)), y3 = hs[et][4 * i4 + 3] * rstd * gg.w * sigmoid_f(bf_hi(o2.y));
                v2u w; w.x = cvt_pk_bf16(y0, y1); w.y = cvt_pk_bf16(y2, y3); *(v2u*)(orow + e) = w; }
        __syncthreads();
    }
}
__global__ void __launch_bounds__(NTHR, 2) k_ml_d1(P a, int l) { a.wv = __builtin_amdgcn_readfirstlane(threadIdx.x >> 6); extern __shared__ __attribute__((aligned(16))) unsigned char smem[]; ml_d1_phase(a, l, (PG_LAS unsigned char*)smem, (int)gridDim.x, (int)blockIdx.x); }
__global__ void __launch_bounds__(NTHR, 2) k_ml_d2(P a) { a.wv = __builtin_amdgcn_readfirstlane(threadIdx.x >> 6); ml_d2_phase(a, (int)blockIdx.x); }
__global__ void __launch_bounds__(NTHR, 2) k_ml_d3(P a, int l) { a.wv = __builtin_amdgcn_readfirstlane(threadIdx.x >> 6); extern __shared__ __attribute__((aligned(16))) unsigned char smem[]; ml_d3_phase(a, l, (PG_LAS unsigned char*)smem, (int)gridDim.x, (int)blockIdx.x); }

#define XB_TMO      128
#define XB_XCNT(j)  (256  + 64 * (j))
#define XB_XSUB(j)  (1280 + 64 * (j))
#define XB_XGEN(j)  (2304 + 64 * (j))
#define XB_TOP      3328
#define XB_TOPGEN   3392
#define XCD_BAR_WORDS 3456
#define XB_SPIN_CAP (1u << 20)
__device__ __forceinline__ unsigned xb_ld(unsigned* p)              { return __hip_atomic_load(p, __ATOMIC_RELAXED, __HIP_MEMORY_SCOPE_AGENT); }
__device__ __forceinline__ unsigned xb_add(unsigned* p, unsigned v) { return __hip_atomic_fetch_add(p, v, __ATOMIC_RELAXED, __HIP_MEMORY_SCOPE_AGENT); }
__device__ __forceinline__ unsigned xb_xcc_id() { return (unsigned)__builtin_amdgcn_s_getreg((3 << 11) | 20) & 0xFu; }
#define XB_SPIN(cond, bar) do { unsigned _sp = 0; while (cond) { __builtin_amdgcn_s_sleep(8); \
    if ((++_sp & 255u) == 0u) { if (xb_ld(&(bar)[XB_TMO])) break; if (_sp > XB_SPIN_CAP) { atomicAdd(&(bar)[XB_TMO], 1u); break; } } } } while (0)
struct XcdBarrier { unsigned* bar; unsigned x; volatile PG_LAS unsigned* st; };
__device__ __forceinline__ XcdBarrier xcd_barrier_post(unsigned* bar, volatile PG_LAS unsigned* st, int tid) {
    XcdBarrier b; b.bar = bar; b.x = xb_xcc_id(); b.st = st;
    if (tid == 0) (void)xb_add(&bar[XB_XCNT(b.x)], 1u);
    return b;
}
__device__ __forceinline__ void xcd_barrier_complete(unsigned* bar, unsigned x, unsigned& nloc, unsigned& nx) {
    const unsigned G = gridDim.x * gridDim.y * gridDim.z;
    unsigned sum, cnt, mine, sp = 0u;
    for (;;) {
        sum = 0u; cnt = 0u; mine = 0u;
#pragma unroll
        for (unsigned j = 0; j < 16; ++j) { const unsigned c = xb_ld(&bar[XB_XCNT(j)]); sum += c; cnt += (c > 0u) ? 1u : 0u; mine = (j == x) ? c : mine; }
        if (sum == G) break;
        __builtin_amdgcn_s_sleep(1);
        if ((++sp & 255u) == 0u) { if (xb_ld(&bar[XB_TMO])) break; if (sp > XB_SPIN_CAP) { atomicAdd(&bar[XB_TMO], 1u); break; } }
    }
    nloc = mine > 0u ? mine : 1u; nx = cnt > 0u ? cnt : 1u;
}
__device__ __forceinline__ void xcd_barrier(const XcdBarrier& b, int tid) {
    asm volatile("s_waitcnt vmcnt(0)" ::: "memory");
    __syncthreads();
    if (tid == 0) {
        unsigned* bar = b.bar; asm volatile("" : "+s"(bar)); unsigned bx = b.x; asm volatile("" : "+s"(bx));
        __builtin_amdgcn_s_waitcnt(0);
        unsigned nloc = b.st[0], nx = b.st[1];
        if (nloc == 0u) { xcd_barrier_complete(bar, bx, nloc, nx); b.st[0] = nloc; b.st[1] = nx; }
        const unsigned old = xb_add(&bar[XB_XSUB(bx)], 1u);
        const unsigned gen = old / nloc;
        if (old + 1u == (gen + 1u) * nloc) {
            __builtin_amdgcn_fence(__ATOMIC_RELEASE, "agent");
            asm volatile("s_waitcnt vmcnt(0)" ::: "memory");
            const unsigned og = xb_add(&bar[XB_TOP], 1u);
            const unsigned tg = og / nx;
            if (og + 1u == (tg + 1u) * nx) xb_add(&bar[XB_TOPGEN], 1u);
            else XB_SPIN(xb_ld(&bar[XB_TOPGEN]) == tg, bar);
            __builtin_amdgcn_fence(__ATOMIC_ACQUIRE, "agent");
            xb_add(&bar[XB_XGEN(bx)], 1u);
            asm volatile("s_waitcnt vmcnt(0)" ::: "memory");
        } else {
            XB_SPIN(xb_ld(&bar[XB_XGEN(bx)]) == gen, bar);
            __builtin_amdgcn_fence(__ATOMIC_ACQUIRE, "agent");
            asm volatile("s_waitcnt vmcnt(0)" ::: "memory");
        }
    }
    __syncthreads();
}
__device__ __forceinline__ void modvec_phase(const P& a_in, PG_LAS float* lds, int G, int c) {
    PHASE_ENTRY(a_in)
    PG_LAS float* cond = lds;
    PG_LAS float* red = lds + MODR * D;
    const int t = otid(), kg = t >> 5, cl = t & 31;
    for (int i = t; i < MODR * D; i += NTHR) { const int r = i / D, k = i % D; const float v = r < NB ? a.c[r * D + k] : a.c_ctx[k]; cond[i] = silu_f(v); }
    __syncthreads();
    float* mod = (float*)(a.ws + WS_MOD);
    for (int item = c; item < DEPTH * 192; item += G) {
        const int l = item / 192, nc = item % 192, n = nc * 32 + cl;
        float acc[MODR];
#pragma unroll
        for (int r = 0; r < MODR; ++r) acc[r] = 0.f;
        const float* w = a.w_mod + (size_t)l * D * MODW + n;
#pragma unroll 8
        for (int k = kg * 64; k < kg * 64 + 64; ++k) { const float wv = w[(size_t)k * MODW];
#pragma unroll
            for (int r = 0; r < MODR; ++r) acc[r] += cond[r * D + k] * wv; }
#pragma unroll
        for (int r = 0; r < MODR; ++r) red[(kg * MODR + r) * 32 + cl] = acc[r];
        __syncthreads();
        for (int i = t; i < MODR * 32; i += NTHR) { const int r = i / 32, j = i % 32, nn = nc * 32 + j; float sacc = a.b_mod[l * MODW + nn];
#pragma unroll
            for (int q = 0; q < 16; ++q) sacc += red[(q * MODR + r) * 32 + j];
            mod[((size_t)l * MODR + r) * MODW + nn] = sacc; }
        __syncthreads();
    }
}
__device__ __forceinline__ void conv_dense_weights(const P& a_in, PG_LAS float* scr, int gw, int ngw, int lane) {
    PHASE_ENTRY(a_in)
    conv_dense_range(a, 0, DN_ITEMS, gw, ngw, scr, lane);
}
__device__ __forceinline__ void conv_expert_weights(const P& a_in, int li, PG_LAS float* scr, int gw, int ngw, int lane) {
    PHASE_ENTRY(a_in)
    unsigned char* ws = a.ws;
#pragma unroll 1
    for (int e = 0; e < NE; ++e) {
        tr_matrix(a.exp_w1 + ((size_t)li * NE + e) * D * FFN, D, FFN, FFN, (bf16*)(ws + WS_WE13) + (size_t)e * 2 * FFN * D, 1, scr, gw, ngw, lane);
        tr_matrix(a.exp_w3 + ((size_t)li * NE + e) * D * FFN, D, FFN, FFN, (bf16*)(ws + WS_WE13) + (size_t)e * 2 * FFN * D, 2, scr, gw, ngw, lane);
        tr_matrix(a.exp_w2 + ((size_t)li * NE + e) * FFN * D, FFN, D, D, (bf16*)(ws + WS_WE2) + (size_t)e * D * FFN, 0, scr, gw, ngw, lane);
    }
}
#if MEGA
constexpr int MEGA_LDS = 147456;
__global__ void __launch_bounds__(NTHR, 2) k_mega(P a_k) {
    extern __shared__ __attribute__((aligned(16))) unsigned char smem[];
    PG_LAS unsigned char* lds = (PG_LAS unsigned char*)smem;
    P a = a_k; a.wv = __builtin_amdgcn_readfirstlane(threadIdx.x >> 6);
    const int G = (int)gridDim.x, wg = (int)blockIdx.x;
    volatile PG_LAS unsigned* bst = (volatile PG_LAS unsigned*)(lds + MEGA_LDS - 16);
    if (otid() == 0) { bst[0] = 0u; bst[1] = 0u; bst[2] = 0u; bst[3] = 0u; }
    __syncthreads();
    const XcdBarrier bar = xcd_barrier_post((unsigned*)(a.ws + WS_CTL) + 1024, bst, otid());
    { const int t_ = otid(); conv_dense_weights(a, (PG_LAS float*)smem + (t_ >> 6) * (64 * 33), wg * 8 + (t_ >> 6), G * 8, t_ & 63); }
    __syncthreads();
    modvec_phase(a, (PG_LAS float*)smem, G, wg);
      { for (int i = otid(); i < 64 * 16; i += NTHR) { const int pos = i / 16, f = i % 16; const float ang = (float)pos * powf(10000.0f, -(float)f / 16.0f);
        float* t = (float*)(a.ws + WS_ROPE); t[2 * i] = cosf(ang); t[2 * i + 1] = sinf(ang); } }
    xcd_barrier(bar, otid());
    if (PROBE == 31) { { const int t_ = otid(); conv_dense_weights(a, (PG_LAS float*)smem + (t_ >> 6) * (64 * 33), wg * 8 + (t_ >> 6), G * 8, t_ & 63); } __syncthreads(); modvec_phase(a, (PG_LAS float*)smem, G, wg); xcd_barrier(bar, otid()); }
#pragma unroll 1
    for (int l = 0; l < DEPTH; ++l) {
        if (l == 0) norm_phase<0, true, 0>(a, l, wg, (PG_LAS float*)smem);
        else if (l == 2) norm_phase<0, false, 2>(a, l, wg, (PG_LAS float*)smem, l - 1, 5);
        else norm_phase<0, false, 1>(a, l, wg, (PG_LAS float*)smem, l - 1, 5);
        xcd_barrier(bar, otid());
        gemm_run<EM_IN>(a, l, lds, G, wg);
        xcd_barrier(bar, otid());
        if (PROBE == 6) { gemm_run<EM_IN>(a, l, lds, G, wg); xcd_barrier(bar, otid()); }
        ml_d1_phase(a, l, lds, G, wg);
        attn_phase<0>(a, l, lds, G, wg, 0);
        xcd_barrier(bar, otid());
        if (PROBE == 5) { ml_d1_phase(a, l, lds, G, wg); xcd_barrier(bar, otid()); }
        ml_d2_phase(a, wg);
        { int li_, j0_, j1_; if (conv_sched(l, CP_D2, li_, j0_, j1_)) { __syncthreads(); const int t_ = otid(), wv_ = __builtin_amdgcn_readfirstlane(t_ >> 6);
            conv_expert_range(a, li_, j0_, j1_, wg * 8 + wv_, G * 8, (PG_LAS float*)smem + wv_ * (64 * 33), t_ & 63); } }
        xcd_barrier(bar, otid());
        ml_d3_phase(a, l, lds, G, wg);
        attn_phase<0>(a, l, lds, G, wg, 1);
        xcd_barrier(bar, otid());
        if (PROBE == 2) { ml_d3_phase(a, l, lds, G, wg); xcd_barrier(bar, otid()); }
        if (PROBE == 30) { attn_phase<1>(a, l, lds, G, wg, 1); xcd_barrier(bar, otid()); }
        if (PROBE == 4) { xcd_barrier(bar, otid()); xcd_barrier(bar, otid()); xcd_barrier(bar, otid()); xcd_barrier(bar, otid()); }
        gemm_run<EM_OUT>(a, l, lds, G, wg);
        xcd_barrier(bar, otid());
        if (PROBE == 10) { gemm_run<EM_OUT>(a, l, lds, G, wg); xcd_barrier(bar, otid()); }
        if ((l & 1) == 0) {
            if (l == 0) norm_phase<1, true, 1>(a, l, wg, (PG_LAS float*)smem, l, 2);
            else norm_phase<1, false, 1>(a, l, wg, (PG_LAS float*)smem, l, 2);
            xcd_barrier(bar, otid());
            gemm_run<EM_F1>(a, l, lds, G, wg);
            xcd_barrier(bar, otid());
            if (PROBE == 7) { gemm_run<EM_F1>(a, l, lds, G, wg); xcd_barrier(bar, otid()); }
            if (PROBE == 20 || PROBE == 21) { gemm_run<EM_F1>(a, l, lds, G, wg, true); xcd_barrier(bar, otid()); }
            gemm_run<EM_F2D>(a, l, lds, G, wg);
            xcd_barrier(bar, otid());
            if (PROBE == 11) { gemm_run<EM_F2D>(a, l, lds, G, wg); xcd_barrier(bar, otid()); }
        } else {
            norm_phase<2, false, 1>(a, l, wg, (PG_LAS float*)smem, l, 2);
            xcd_barrier(bar, otid());
            if (PROBE == 12) { norm_phase<2, false, 0>(a, l, wg, (PG_LAS float*)smem, l, 2); xcd_barrier(bar, otid()); }
            moe_pos_phase(a, wg, (int*)smem);
            xcd_barrier(bar, otid());
            gemm_run<EM_F1M>(a, l, lds, G, wg);
            xcd_barrier(bar, otid());
            if (PROBE == 8) { gemm_run<EM_F1M>(a, l, lds, G, wg); xcd_barrier(bar, otid()); }
            gemm_run<EM_F2M>(a, l, lds, G, wg);
            {
                const int nt_ = __builtin_amdgcn_readfirstlane(((const int*)(a.ws + WS_TILEE))[MOE_TILES]); const int nwg_ = nt_ * (D / 256), full_ = (nwg_ / G) * G, rem_ = nwg_ - full_;
                const int S_ = rem_ == 0 ? 1 : ((SPLIT_MAXS >= 3 && rem_ * 3 <= G) ? 3 : ((SPLIT_MAXS >= 2 && rem_ * 2 <= G) ? 2 : 1));
                if (S_ > 1) { xcd_barrier(bar, otid()); ys_fixup_phase(a, wg, G, (full_ / (D / 256)) * 256, (rem_ / (D / 256)) * 256, S_); }
            }
            xcd_barrier(bar, otid());
            if (PROBE == 9) { gemm_run<EM_F2M>(a, l, lds, G, wg); xcd_barrier(bar, otid()); }
        }
    }
    norm_phase<3, false, 2>(a, DEPTH, wg, (PG_LAS float*)smem, DEPTH - 1, 5);
}
#endif

#ifndef FAST_IN
#define FAST_IN 1
#endif
#ifndef FAST_OUT
#define FAST_OUT 1
#endif
#ifndef FAST_F1
#define FAST_F1 1
#endif
#ifndef FAST_F2
#define FAST_F2 1
#endif
#ifndef FAST_F1M
#define FAST_F1M 1
#endif
#ifndef FAST_F2M
#define FAST_F2M 1
#endif
constexpr int GEMM_LDS = 131072 + 1024 + 8192;
template <int WHICH> static void launch_gemm(hipStream_t s, const P& a, int l) {
    static bool once = false;
    if (!once) { (void)hipFuncSetAttribute((const void*)k_gemm<WHICH>, hipFuncAttributeMaxDynamicSharedMemorySize, GEMM_LDS); once = true; }
    hipLaunchKernelGGL((k_gemm<WHICH>), dim3(NWG), dim3(NTHR), GEMM_LDS, s, a, l);
}
static void launch_tr(hipStream_t s, const float* W, int K, int ld, int N, bf16* WT, int mode) {
    hipLaunchKernelGGL(k_transpose, dim3(512), dim3(256), 0, s, W, K, ld, N, WT, mode);
}
extern "C" void kernel_launch(void* const* d_in, const int* in_sizes, int n_in, void* d_out, int out_size, void* d_ws, size_t ws_size, hipStream_t stream) {
    if (n_in != 25 || ws_size < WS_END) { fprintf(stderr, "kernel_launch: bad args n_in %d ws %zu need %zu\n", n_in, ws_size, (size_t)WS_END); return; }
    static bool init = false;
    constexpr int NORM_LDS = 8192 * 4 + 8 * 32 * 4 + 64;
    if (!init) {
        init = true;
    }
    P a{};
    const float** f = (const float**)&a;
    for (int i = 0; i < 25; ++i) f[i] = (const float*)d_in[i];
    a.out = (float*)d_out; a.ws = (unsigned char*)d_ws;
    unsigned char* ws = a.ws;
    hipMemsetAsync(ws + WS_CTL, 0, 32768, stream);
#if MEGA
    {
        static bool once = false;
        if (!once) { (void)hipFuncSetAttribute((const void*)k_mega, hipFuncAttributeMaxDynamicSharedMemorySize, MEGA_LDS); once = true; }
        hipLaunchKernelGGL(k_mega, dim3(NWG), dim3(NTHR), MEGA_LDS, stream, a);
        return;
    }
#endif
#if !MEGA
    for (int l = 0; l < DEPTH; ++l) {
        launch_tr(stream, a.w_in + (size_t)l * D * INW, D, INW, UW, (bf16*)(ws + WS_WIN) + (size_t)l * UW * D, 0);
        launch_tr(stream, a.w_out + (size_t)l * D * D, D, D, D, (bf16*)(ws + WS_WOUT) + (size_t)l * D * D, 0);
    }
    for (int i = 0; i < 2; ++i) {
        launch_tr(stream, a.ffn_w1 + (size_t)i * D * FFN, D, FFN, FFN, (bf16*)(ws + WS_WF13) + (size_t)i * 2 * FFN * D, 1);
        launch_tr(stream, a.ffn_w3 + (size_t)i * D * FFN, D, FFN, FFN, (bf16*)(ws + WS_WF13) + (size_t)i * 2 * FFN * D, 2);
        launch_tr(stream, a.ffn_w2 + (size_t)i * FFN * D, FFN, D, D, (bf16*)(ws + WS_WF2) + (size_t)i * D * FFN, 0);
    }
    hipLaunchKernelGGL(k_modvec, dim3(DEPTH * 96), dim3(256), 0, stream, a);
    hipLaunchKernelGGL(k_rope_table, dim3(4), dim3(256), 0, stream, a);
    for (int l = 0; l < DEPTH; ++l) {
        const bool moe = l & 1;
        if (l == 0) hipLaunchKernelGGL((k_norm<0, true, false>), dim3(NWG), dim3(NTHR), NORM_LDS, stream, a, l);
        else if (l == 2) hipLaunchKernelGGL((k_norm<0, false, true>), dim3(NWG), dim3(NTHR), NORM_LDS, stream, a, l);
        else hipLaunchKernelGGL((k_norm<0, false, false>), dim3(NWG), dim3(NTHR), NORM_LDS, stream, a, l);
        if (FAST_IN) launch_gemm<EM_IN>(stream, a, l);
        else {
        hipLaunchKernelGGL((k_ngemm<EM_IN>), dim3(UW / 64, T_ALL / 64), dim3(256), 0, stream, a, l, (const bf16*)(ws + WS_HX), (const bf16*)(ws + WS_WIN) + (size_t)l * UW * D, T_ALL, UW, D);
        hipLaunchKernelGGL(k_rope_apply, dim3((T_ALL * 320 + 255) / 256), dim3(256), 0, stream, a); }
#ifndef FAST_ATT
#define FAST_ATT 1
#endif
        if (FAST_ATT) hipLaunchKernelGGL(k_attn, dim3(NWG), dim3(NTHR), ATT_LDS, stream, a, l);
        else hipLaunchKernelGGL(k_attn_naive, dim3(T_ALL), dim3(512), 0, stream, a, l);
#ifndef FAST_ML
#define FAST_ML 1
#endif
        if (FAST_ML) {
            static bool once = false;
            if (!once) { (void)hipFuncSetAttribute((const void*)k_ml_d1, hipFuncAttributeMaxDynamicSharedMemorySize, ML_LDS); (void)hipFuncSetAttribute((const void*)k_ml_d3, hipFuncAttributeMaxDynamicSharedMemorySize, ML_LDS); once = true; }
            hipLaunchKernelGGL(k_ml_d1, dim3(NWG), dim3(NTHR), ML_LDS, stream, a, l);
            hipLaunchKernelGGL(k_ml_d2, dim3(NWG), dim3(NTHR), 0, stream, a);
            hipLaunchKernelGGL(k_ml_d3, dim3(NWG), dim3(NTHR), ML_LDS, stream, a, l);
        } else {
        hipLaunchKernelGGL(k_mlstm_naive, dim3(64), dim3(256), 0, stream, a, l);
        hipLaunchKernelGGL(k_merge_naive, dim3(T_ALL), dim3(256), 0, stream, a, l); }
        if (FAST_OUT) launch_gemm<EM_OUT>(stream, a, l);
        else hipLaunchKernelGGL((k_ngemm<EM_OUT>), dim3(D / 64, T_ALL / 64), dim3(256), 0, stream, a, l, (const bf16*)(ws + WS_MIX), (const bf16*)(ws + WS_WOUT) + (size_t)l * D * D, T_ALL, D, D);
        if (!moe) {
            hipLaunchKernelGGL((k_norm<1, false, false>), dim3(NWG), dim3(NTHR), NORM_LDS, stream, a, l);
            if (FAST_F1) launch_gemm<EM_F1>(stream, a, l);
            else hipLaunchKernelGGL((k_ngemm<EM_F1>), dim3(FFN / 64, T_ALL / 64), dim3(256), 0, stream, a, l, (const bf16*)(ws + WS_HX), (const bf16*)(ws + WS_WF13) + (size_t)(l >> 1) * 2 * FFN * D, T_ALL, FFN, D);
            if (FAST_F2) launch_gemm<EM_F2D>(stream, a, l);
            else hipLaunchKernelGGL((k_ngemm<EM_F2D>), dim3(D / 64, T_ALL / 64), dim3(256), 0, stream, a, l, (const bf16*)(ws + WS_HID), (const bf16*)(ws + WS_WF2) + (size_t)(l >> 1) * D * FFN, T_ALL, D, FFN);
        } else {
            const int li = l >> 1;
            for (int e = 0; e < NE; ++e) {
                launch_tr(stream, a.exp_w1 + ((size_t)li * NE + e) * D * FFN, D, FFN, FFN, (bf16*)(ws + WS_WE13) + (size_t)e * 2 * FFN * D, 1);
                launch_tr(stream, a.exp_w3 + ((size_t)li * NE + e) * D * FFN, D, FFN, FFN, (bf16*)(ws + WS_WE13) + (size_t)e * 2 * FFN * D, 2);
                launch_tr(stream, a.exp_w2 + ((size_t)li * NE + e) * FFN * D, FFN, D, D, (bf16*)(ws + WS_WE2) + (size_t)e * D * FFN, 0);
            }
            hipLaunchKernelGGL((k_norm<2, false, false>), dim3(NWG), dim3(NTHR), NORM_LDS, stream, a, l);
            hipLaunchKernelGGL(k_moe_pos, dim3(NWG), dim3(NTHR), 16384, stream, a);
            if (FAST_F1M) launch_gemm<EM_F1M>(stream, a, l);
            else hipLaunchKernelGGL((k_ngemm<EM_F1M>), dim3(FFN / 64, MOE_ROWS / 64), dim3(256), 0, stream, a, l, (const bf16*)(ws + WS_HX), (const bf16*)(ws + WS_WE13), MOE_ROWS, FFN, D);
            if (FAST_F2M) launch_gemm<EM_F2M>(stream, a, l);
            else hipLaunchKernelGGL((k_ngemm<EM_F2M>), dim3(D / 64, MOE_ROWS / 64), dim3(256), 0, stream, a, l, (const bf16*)(ws + WS_HID), (const bf16*)(ws + WS_WE2), MOE_ROWS, D, FFN);
        }
    }
    hipLaunchKernelGGL((k_norm<3, false, true>), dim3(NWG), dim3(NTHR), NORM_LDS, stream, a, DEPTH);
#endif
}
```
